# Optimizing an MI355X kernel written in HIP

```python
import math
import jax
import jax.numpy as jnp
from jax import lax
import numpy as np

D_MODEL = 1024
BATCH = 4
SEQ = 8192
DEPTH = 4

CTX_LEN = 256
GRID_W = 64
HEAD_DIM = 64
ROPE_THETA = 10000.0
BLOCK_Q = 128
EPS = 1e-6
A_HEADS = 8
A_KV_HEADS = 2
B_HEADS = 4
B_V_DIM = 2 * HEAD_DIM
C_HEADS = 8
NA_KH = 8
NA_KW = 16
N_BRANCH = 3
IN_SIZES = (A_HEADS * HEAD_DIM, A_KV_HEADS * HEAD_DIM, A_KV_HEADS * HEAD_DIM,
            2 * B_HEADS * HEAD_DIM, 2 * B_HEADS * HEAD_DIM, B_HEADS * B_V_DIM,
            C_HEADS * HEAD_DIM, C_HEADS * HEAD_DIM, C_HEADS * HEAD_DIM,
            N_BRANCH * D_MODEL)
D_IN = sum(IN_SIZES)
D_FF = 2816
N_EXPERTS = 8
TOP_K = 2
D_FF_EXPERT = 3584

kernel_name = 'hybrid_gated_dit_block'


def rmsnorm(x, g):
    xf = x.astype(jnp.float32)
    y = xf * lax.rsqrt(jnp.mean(xf * xf, axis=-1, keepdims=True) + EPS)
    return (y * g.astype(jnp.float32)).astype(x.dtype)


def modulate(h, shift, scale):
    return h * (1.0 + scale) + shift


def heads(t, n):
    return t.reshape(t.shape[:-1] + (n, t.shape[-1] // n))


def split_in(p):
    out, start = [], 0
    for size in IN_SIZES:
        out.append(p[..., start:start + size])
        start += size
    return out


def axial_rope_tables(n_tokens):
    t = jnp.arange(n_tokens, dtype=jnp.int32)
    row = (t // GRID_W).astype(jnp.float32)
    col = (t % GRID_W).astype(jnp.float32)
    n_pairs = HEAD_DIM // 4
    inv = ROPE_THETA ** (-jnp.arange(n_pairs, dtype=jnp.float32) / n_pairs)
    ang = jnp.concatenate([row[:, None] * inv, col[:, None] * inv], axis=-1)
    return jnp.cos(ang), jnp.sin(ang)


def apply_rope(x, cos, sin):
    xf = x.astype(jnp.float32).reshape(x.shape[:-1] + (HEAD_DIM // 2, 2))
    x1, x2 = xf[..., 0], xf[..., 1]
    cs = cos[None, :, None, :]
    sn = sin[None, :, None, :]
    out = jnp.stack([x1 * cs - x2 * sn, x1 * sn + x2 * cs], axis=-1)
    return out.reshape(x.shape).astype(x.dtype)


def to_blocks(t):
    b, l = t.shape[:2]
    return jnp.moveaxis(t.reshape((b, l // BLOCK_Q, BLOCK_Q) + t.shape[2:]), 1, 0)


def from_blocks(o):
    nb, b, bq = o.shape[:3]
    return jnp.moveaxis(o, 0, 1).reshape((b, nb * bq) + o.shape[3:])


def gqa_attend(q, k, v):
    s = jnp.einsum('bqhgd,bnhd->bhgqn', q, k).astype(jnp.float32) * (q.shape[-1] ** -0.5)
    p = jax.nn.softmax(s, axis=-1).astype(v.dtype)
    return jnp.einsum('bhgqn,bnhd->bqhgd', p, v)


def diff_attend(q1, q2, k1, k2, v, lam):
    scale = q1.shape[-1] ** -0.5
    s1 = jnp.einsum('bqhd,bnhd->bhqn', q1, k1).astype(jnp.float32) * scale
    s2 = jnp.einsum('bqhd,bnhd->bhqn', q2, k2).astype(jnp.float32) * scale
    p = jax.nn.softmax(s1, axis=-1) - lam * jax.nn.softmax(s2, axis=-1)
    return jnp.einsum('bhqn,bnhd->bqhd', p.astype(v.dtype), v)


def neighbourhood_attend(q, k, v, kc, vc, rpb):
    b, l, h, d = q.shape
    rows = l // GRID_W
    kh = min(NA_KH, rows)
    kg = k.reshape(b, rows, GRID_W, h, d)
    vg = v.reshape(b, rows, GRID_W, h, d)
    qg_rows = jnp.moveaxis(q.reshape(b, rows, GRID_W, h, d), 1, 0)
    col = jnp.arange(GRID_W, dtype=jnp.int32)
    cs = jnp.clip(col - NA_KW // 2, 0, GRID_W - NA_KW)
    col_idx = cs[:, None] + jnp.arange(NA_KW, dtype=jnp.int32)[None, :]
    dc = col_idx - col[:, None] + (NA_KW - 1)
    scale = d ** -0.5
    n_nb = kh * NA_KW

    def row_block(args):
        r, q_row = args
        rs = jnp.clip(r - kh // 2, 0, rows - kh)
        k_band = lax.dynamic_slice_in_dim(kg, rs, kh, axis=1)
        v_band = lax.dynamic_slice_in_dim(vg, rs, kh, axis=1)
        k_nb = k_band[:, :, col_idx]
        v_nb = v_band[:, :, col_idx]
        dr = rs + jnp.arange(kh, dtype=jnp.int32) - r + (NA_KH - 1)
        bias = jnp.transpose(rpb[:, dr[:, None, None], dc[None, :, :]], (0, 2, 1, 3))
        s_nb = jnp.einsum('bqhd,biqjhd->bhqij', q_row, k_nb).astype(jnp.float32) * scale
        s_nb = (s_nb + bias[None].astype(jnp.float32)).reshape(b, h, GRID_W, n_nb)
        s_c = jnp.einsum('bqhd,bnhd->bhqn', q_row, kc).astype(jnp.float32) * scale
        p = jax.nn.softmax(jnp.concatenate([s_nb, s_c], axis=-1), axis=-1)
        p_nb = p[..., :n_nb].reshape(b, h, GRID_W, kh, NA_KW).astype(v.dtype)
        p_c = p[..., n_nb:].astype(v.dtype)
        return (jnp.einsum('bhqij,biqjhd->bqhd', p_nb, v_nb)
                + jnp.einsum('bhqn,bnhd->bqhd', p_c, vc))

    out = lax.map(row_block, (jnp.arange(rows, dtype=jnp.int32), qg_rows))
    return jnp.moveaxis(out, 0, 1).reshape(b, l, h, d)


def qkv_a(parts, qn, kn, cos, sin):
    q = rmsnorm(heads(parts[0], A_HEADS), qn)
    k = rmsnorm(heads(parts[1], A_KV_HEADS), kn)
    v = heads(parts[2], A_KV_HEADS)
    if cos is not None:
        q = apply_rope(q, cos, sin)
        k = apply_rope(k, cos, sin)
    q = q.reshape(q.shape[:2] + (A_KV_HEADS, A_HEADS // A_KV_HEADS, HEAD_DIM))
    return q, k, v


def qkv_b(parts, cos, sin):
    q = parts[3].reshape(parts[3].shape[:2] + (2, B_HEADS, HEAD_DIM))
    k = parts[4].reshape(parts[4].shape[:2] + (2, B_HEADS, HEAD_DIM))
    q1, q2, k1, k2 = q[:, :, 0], q[:, :, 1], k[:, :, 0], k[:, :, 1]
    if cos is not None:
        q1, q2 = apply_rope(q1, cos, sin), apply_rope(q2, cos, sin)
        k1, k2 = apply_rope(k1, cos, sin), apply_rope(k2, cos, sin)
    return q1, q2, k1, k2, heads(parts[5], B_HEADS)


def merge_branches(o_a, o_b, o_c, gate_logits, w_br_a, w_br_b, w_br_c, w_out):
    flat = lambda t: t.reshape(t.shape[:2] + (-1,))
    g = jax.nn.sigmoid(gate_logits.astype(jnp.float32)).astype(o_a.dtype)
    g_a, g_b, g_c = jnp.split(g, N_BRANCH, axis=-1)
    m = g_a * (flat(o_a) @ w_br_a) + g_b * (flat(o_b) @ w_br_b) + g_c * (flat(o_c) @ w_br_c)
    return m @ w_out


def swiglu(h, w1, w3, w2):
    return (jax.nn.silu(h @ w1) * (h @ w3)) @ w2


def moe_ffn(h, router, w1, w3, w2):
    logits = (h @ router).astype(jnp.float32)
    top_v, top_i = lax.top_k(logits, TOP_K)
    top_w = jax.nn.softmax(top_v, axis=-1)
    combine = jnp.sum(jax.nn.one_hot(top_i, N_EXPERTS, dtype=jnp.float32) * top_w[..., None], axis=-2)
    combine = combine.astype(h.dtype)
    out = jnp.zeros_like(h)
    for e in range(N_EXPERTS):
        out = out + combine[..., e:e + 1] * swiglu(h, w1[e], w3[e], w2[e])
    return out


def channel_mixer(h, layer, ffn_w1, ffn_w3, ffn_w2, router, moe_w1, moe_w3, moe_w2):
    i = layer // 2
    if layer % 2 == 0:
        return swiglu(h, ffn_w1[i], ffn_w3[i], ffn_w2[i])
    return moe_ffn(h, router[i], moe_w1[i], moe_w3[i], moe_w2[i])


def setup_inputs(seed: int = 0) -> dict:
    key = jax.random.key(seed)
    ks = iter(jax.random.split(key, 32))
    n_dense = (DEPTH + 1) // 2
    n_moe = DEPTH // 2

    def nrm(shape, scale):
        return jax.random.normal(next(ks), shape, jnp.float32) * scale

    d = D_MODEL
    return {
        'x': nrm((BATCH, SEQ, d), 1.0),
        'c': nrm((BATCH, d), 1.0),
        'ctx': nrm((BATCH, CTX_LEN, d), 1.0),
        'c_ctx': nrm((d,), 1.0),
        'w_mod': nrm((DEPTH, d, 6 * d), d ** -0.5),
        'b_mod': nrm((DEPTH, 6 * d), 0.02),
        'g_mix': 1.0 + nrm((DEPTH, d), 0.05),
        'g_ffn': 1.0 + nrm((DEPTH, d), 0.05),
        'w_in': nrm((DEPTH, d, D_IN), d ** -0.5),
        'qn_a': 1.0 + nrm((DEPTH, HEAD_DIM), 0.05),
        'kn_a': 1.0 + nrm((DEPTH, HEAD_DIM), 0.05),
        'lam_q1': nrm((DEPTH, HEAD_DIM), 0.1),
        'lam_k1': nrm((DEPTH, HEAD_DIM), 0.1),
        'lam_q2': nrm((DEPTH, HEAD_DIM), 0.1),
        'lam_k2': nrm((DEPTH, HEAD_DIM), 0.1),
        'subln_b': 1.0 + nrm((DEPTH, B_V_DIM), 0.05),
        'rpb_c': nrm((DEPTH, C_HEADS, 2 * NA_KH - 1, 2 * NA_KW - 1), 0.1),
        'w_br_a': nrm((DEPTH, A_HEADS * HEAD_DIM, d), (A_HEADS * HEAD_DIM) ** -0.5),
        'w_br_b': nrm((DEPTH, B_HEADS * B_V_DIM, d), (B_HEADS * B_V_DIM) ** -0.5),
        'w_br_c': nrm((DEPTH, C_HEADS * HEAD_DIM, d), (C_HEADS * HEAD_DIM) ** -0.5),
        'w_out': nrm((DEPTH, d, d), d ** -0.5),
        'ffn_w1': nrm((n_dense, d, D_FF), d ** -0.5),
        'ffn_w3': nrm((n_dense, d, D_FF), d ** -0.5),
        'ffn_w2': nrm((n_dense, D_FF, d), D_FF ** -0.5),
        'router': nrm((n_moe, d, N_EXPERTS), d ** -0.5),
        'moe_w1': nrm((n_moe, N_EXPERTS, d, D_FF_EXPERT), d ** -0.5),
        'moe_w3': nrm((n_moe, N_EXPERTS, d, D_FF_EXPERT), d ** -0.5),
        'moe_w2': nrm((n_moe, N_EXPERTS, D_FF_EXPERT, d), D_FF_EXPERT ** -0.5),
        'g_final': 1.0 + nrm((d,), 0.05),
    }


def reference(x, c, ctx, c_ctx, w_mod, b_mod, g_mix, g_ffn, w_in, qn_a, kn_a,
              lam_q1, lam_k1, lam_q2, lam_k2, subln_b, rpb_c, w_br_a, w_br_b, w_br_c,
              w_out, ffn_w1, ffn_w3, ffn_w2, router, moe_w1, moe_w3, moe_w2, g_final):
    n_lat = x.shape[1]
    cos, sin = axial_rope_tables(n_lat)
    silu_c = jax.nn.silu(c)
    silu_cc = jax.nn.silu(c_ctx)
    xl, xc = x, ctx
    for layer in range(DEPTH):
        update_ctx = layer < DEPTH - 1
        mod_l = jnp.split((silu_c @ w_mod[layer] + b_mod[layer])[:, None, :], 6, axis=-1)
        mod_c = jnp.split(silu_cc @ w_mod[layer] + b_mod[layer], 6, axis=-1)
        h_l = modulate(rmsnorm(xl, g_mix[layer]), mod_l[0], mod_l[1])
        h_c = modulate(rmsnorm(xc, g_mix[layer]), mod_c[0], mod_c[1])
        pl = split_in(h_l @ w_in[layer])
        pc = split_in(h_c @ w_in[layer])

        qa_l, ka_l, va_l = qkv_a(pl, qn_a[layer], kn_a[layer], cos, sin)
        qa_c, ka_c, va_c = qkv_a(pc, qn_a[layer], kn_a[layer], None, None)
        ka_all = jnp.concatenate([ka_c, ka_l], axis=1)
        va_all = jnp.concatenate([va_c, va_l], axis=1)
        o_a_l = from_blocks(lax.map(lambda qb: gqa_attend(qb, ka_all, va_all), to_blocks(qa_l)))

        lam_init = 0.8 - 0.6 * math.exp(-0.3 * layer)
        lam = (jnp.exp(jnp.sum((lam_q1[layer] * lam_k1[layer]).astype(jnp.float32)))
               - jnp.exp(jnp.sum((lam_q2[layer] * lam_k2[layer]).astype(jnp.float32))) + lam_init)
        q1_l, q2_l, k1_l, k2_l, vb_l = qkv_b(pl, cos, sin)
        q1_c, q2_c, k1_c, k2_c, vb_c = qkv_b(pc, None, None)
        k1_all = jnp.concatenate([k1_c, k1_l], axis=1)
        k2_all = jnp.concatenate([k2_c, k2_l], axis=1)
        vb_all = jnp.concatenate([vb_c, vb_l], axis=1)
        o_b_l = from_blocks(lax.map(
            lambda qs: diff_attend(qs[0], qs[1], k1_all, k2_all, vb_all, lam),
            (to_blocks(q1_l), to_blocks(q2_l))))
        o_b_l = rmsnorm(o_b_l, subln_b[layer]) * (1.0 - lam_init)

        qc_l, kc_l, vc_l = [heads(t, C_HEADS) for t in pl[6:9]]
        qc_c, kc_c, vc_c = [heads(t, C_HEADS) for t in pc[6:9]]
        o_c_l = neighbourhood_attend(qc_l, kc_l, vc_l, kc_c, vc_c, rpb_c[layer])

        xl = xl + mod_l[2] * merge_branches(o_a_l, o_b_l, o_c_l, pl[9], w_br_a[layer],
                                            w_br_b[layer], w_br_c[layer], w_out[layer])
        h2 = modulate(rmsnorm(xl, g_ffn[layer]), mod_l[3], mod_l[4])
        xl = xl + mod_l[5] * channel_mixer(h2, layer, ffn_w1, ffn_w3, ffn_w2,
                                           router, moe_w1, moe_w3, moe_w2)

        if update_ctx:
            o_a_c = gqa_attend(qa_c, ka_c, va_c)
            o_b_c = rmsnorm(diff_attend(q1_c, q2_c, k1_c, k2_c, vb_c, lam), subln_b[layer]) * (1.0 - lam_init)
            o_c_c = gqa_attend(qc_c[:, :, :, None, :], kc_c, vc_c)
            xc = xc + mod_c[2] * merge_branches(o_a_c, o_b_c, o_c_c, pc[9], w_br_a[layer],
                                                w_br_b[layer], w_br_c[layer], w_out[layer])
            h2c = modulate(rmsnorm(xc, g_ffn[layer]), mod_c[3], mod_c[4])
            xc = xc + mod_c[5] * channel_mixer(h2c, layer, ffn_w1, ffn_w3, ffn_w2,
                                               router, moe_w1, moe_w3, moe_w2)
    return rmsnorm(xl, g_final)
```

```cpp
#include <hip/hip_runtime.h>
#include <cstdio>
#include <cstdint>
namespace pg8 {
#define PG8_LAS __attribute__((address_space(3)))
typedef unsigned short bf16_t;
typedef short bf16x8 __attribute__((ext_vector_type(8)));
typedef float f32x4 __attribute__((ext_vector_type(4)));
typedef unsigned u32x4 __attribute__((ext_vector_type(4)));
constexpr int BM = 256, BK = 64, HALF = 128, HTB = HALF * BK * 2  , STAGE_BYTES = 8 * HTB, NXCD = 8, WGM = 8;

__host__ __device__ __forceinline__ int lds_byte(int r, int c) { const int st = (r >> 4) * 2 + (c >> 5), rr = r & 15, cc = c & 31, ob = rr * 64 + cc * 2; return st * 1024 + (ob ^ (((ob >> 9) & 1) << 5)); }
__host__ __device__ __forceinline__ void stage_rc(int b, int& R, int& C) { const int st = b / 1024, sb = b % 1024, swz = sb ^ (((sb >> 9) & 1) << 5); R = (st >> 1) * 16 + swz / 64; C = (st & 1) * 32 + (swz % 64) / 2; }
__host__ __device__ __forceinline__ int perm32(int rho) { const int n = rho >> 4, i = rho & 15; return 8 * (i >> 2) + 4 * n + (i & 3); }

struct Unit { int pm, pn, aux; size_t aoff, boff; };
struct Gemm { const bf16_t* A; const bf16_t* Bt; int lda, ldb, K; };

struct TileOrder {
    int nM, nN, nwg, G, c;
    __host__ __device__ void init(int nM_, int nN_, int G_, int c_) { nM = nM_; nN = nN_; nwg = nM * nN; G = G_; c = c_; }
    __host__ __device__ bool tile(int i, int& pm, int& pn) const {
        const long L = (long)i * G + c; if (L >= nwg) return false;
        int wgid = (int)L; { const int q = nwg / NXCD, r = nwg % NXCD, xcd = wgid % NXCD, off = wgid / NXCD; wgid = (xcd < r ? xcd * (q + 1) : r * (q + 1) + (xcd - r) * q) + off; }
        const int nig = WGM * nN, gid = wgid / nig, fm = gid * WGM, gsz = (nM - fm) < WGM ? (nM - fm) : WGM;
        pm = fm + ((wgid % nig) % gsz); pn = (wgid % nig) / gsz; return true;
    }
};
__device__ __forceinline__ unsigned cvt_pk_bf16(float lo, float hi) { unsigned r; asm volatile("v_cvt_pk_bf16_f32 %0, %1, %2" : "=v"(r) : "v"(lo), "v"(hi)); return r; }
typedef float f32x2 __attribute__((ext_vector_type(2)));

template <class Epi, class Sched, bool ALIGN_EPI = false>
__device__ __forceinline__ void gemm_phase(PG8_LAS unsigned char* lds, const Gemm g, const Sched& S, const Epi& E) {
    int tid_ = threadIdx.x; asm volatile("; LAUNDER" : "+v"(tid_));
    const int tid = tid_, wid = __builtin_amdgcn_readfirstlane(tid >> 6), lane = tid & 63, wr = wid >> 2, wc = wid & 3, fr = lane & 15, fq = lane >> 4;
    const int K = g.K, nt = K / BK;
    unsigned voffA[2], voffB[2];
#pragma unroll
    for (int i = 0; i < 2; ++i) { int R, C; stage_rc(tid * 16 + i * 8192, R, C); const int Rb = Epi::PERM ? ((R & ~31) + perm32(R & 31)) : R;
        voffA[i] = (unsigned)(R * g.lda + C) * 2u; voffB[i] = (unsigned)(Rb * g.ldb + C) * 2u; }
    const size_t kstep = (size_t)(BK * 2);
    const size_t hstepA = (size_t)HALF * g.lda * 2, hstepB = (size_t)HALF * g.ldb * 2;
    const unsigned ldsw = (unsigned)wid * 1024u;
    const int aoff = lds_byte(wr * 64 + fr, fq * 8), boff = lds_byte(wc * 32 + fr, fq * 8);
#define PG8_SA(b, h) (((b) * 2 + (h)) * HTB)
#define PG8_SB(b, h) ((4 + (b) * 2 + (h)) * HTB)
#define PG8_STAGE(bufoff, gbase, voff) do { _Pragma("unroll") for (int _i = 0; _i < 2; ++_i) \
        __builtin_amdgcn_global_load_lds((const unsigned*)((const char*)(gbase) + (voff)[_i]), (PG8_LAS unsigned*)(lds + (bufoff) + ldsw + _i * 8192), 16, 0, 0); } while (0)
#define PG8_LDA(dst, b, h) do { _Pragma("unroll") for (int m = 0; m < 4; ++m) _Pragma("unroll") for (int k = 0; k < 2; ++k) dst[m][k] = *(const PG8_LAS bf16x8*)(lds + PG8_SA(b, h) + aoff + m * 2048 + k * 1024); } while (0)
#define PG8_LDB(dst, b, h) do { _Pragma("unroll") for (int n = 0; n < 2; ++n) _Pragma("unroll") for (int k = 0; k < 2; ++k) dst[n][k] = *(const PG8_LAS bf16x8*)(lds + PG8_SB(b, h) + boff + n * 2048 + k * 1024); } while (0)
#define PG8_MMA(ai, bj, At, Bt) do { __builtin_amdgcn_s_setprio(1); _Pragma("unroll") for (int m = 0; m < 4; ++m) _Pragma("unroll") for (int n = 0; n < 2; ++n) _Pragma("unroll") for (int k = 0; k < 2; ++k) \
        acc[ai][bj][m][n] = __builtin_amdgcn_mfma_f32_16x16x32_bf16(Bt[n][k], At[m][k], acc[ai][bj][m][n], 0, 0, 0); __builtin_amdgcn_s_setprio(0); } while (0)
#define PG8_WAIT_V(n) asm volatile("s_waitcnt vmcnt(" #n ")" ::: "memory")
#define PG8_WAIT_L(n) asm volatile("s_waitcnt lgkmcnt(" #n ")" ::: "memory")
#define PG8_BAR __builtin_amdgcn_s_barrier()
#define PG8_SCHED __builtin_amdgcn_sched_barrier(0)
    Unit cur, nxt; int ui = 0;
    if (!S.next(0, cur)) return;
    f32x4 acc[2][2][4][2];
#pragma unroll
    for (int a = 0; a < 2; ++a)
#pragma unroll
        for (int b = 0; b < 2; ++b)
#pragma unroll
            for (int m = 0; m < 4; ++m)
#pragma unroll
                for (int n = 0; n < 2; ++n) acc[a][b][m][n] = (f32x4){0.f, 0.f, 0.f, 0.f};
    bf16x8 At[4][2], B0[2][2], B1[2][2];
    const char* cA = (const char*)g.A + cur.aoff; const char* cB = (const char*)g.Bt + cur.boff;
    S.a_ready(cur);
    PG8_STAGE(PG8_SB(0, 0), cB, voffB); PG8_STAGE(PG8_SB(0, 1), cB + hstepB, voffB); PG8_STAGE(PG8_SA(0, 0), cA, voffA); PG8_STAGE(PG8_SA(0, 1), cA + hstepA, voffA);
    if (wr == 1) PG8_BAR;
    PG8_WAIT_V(2); PG8_BAR;
    PG8_STAGE(PG8_SB(1, 0), cB + kstep, voffB); PG8_STAGE(PG8_SA(1, 0), cA + kstep, voffA); PG8_STAGE(PG8_SB(1, 1), cB + hstepB + kstep, voffB);
    PG8_WAIT_V(6); PG8_BAR;
    for (;;) {
        const bool has_next = S.next(ui + 1, nxt);
        const char* nA = has_next ? (const char*)g.A + nxt.aoff : cA; const char* nB = has_next ? (const char*)g.Bt + nxt.boff : cB;
        for (int t = 0; t < nt; t += 2) {
            const bool last = (t == nt - 2);
            const char* a1 = cA + (size_t)(t + 1) * kstep;
            const char* a2 = last ? nA : cA + (size_t)(t + 2) * kstep; const char* b2 = last ? nB : cB + (size_t)(t + 2) * kstep;
            const char* a3 = a2 + kstep; const char* b3 = b2 + kstep;
            if (last && has_next) S.a_ready(nxt);
            PG8_LDB(B0, 0, 0); PG8_LDB(B1, 0, 1); PG8_SCHED; PG8_LDA(At, 0, 0); PG8_STAGE(PG8_SA(1, 1), a1 + hstepA, voffA);
            PG8_WAIT_V(8); PG8_WAIT_L(0); PG8_BAR; PG8_MMA(0, 0, At, B0); PG8_MMA(0, 1, At, B1); PG8_BAR; PG8_SCHED;
            PG8_LDA(At, 0, 1); PG8_STAGE(PG8_SB(0, 0), b2, voffB); PG8_STAGE(PG8_SB(0, 1), b2 + hstepB, voffB); PG8_STAGE(PG8_SA(0, 0), a2, voffA);
            PG8_WAIT_V(8); PG8_WAIT_L(0); PG8_BAR; PG8_MMA(1, 0, At, B0); PG8_MMA(1, 1, At, B1); PG8_BAR; PG8_SCHED;
            PG8_LDB(B0, 1, 0); PG8_LDB(B1, 1, 1); PG8_SCHED; PG8_LDA(At, 1, 0); PG8_STAGE(PG8_SA(0, 1), a2 + hstepA, voffA);
            PG8_WAIT_V(8); PG8_WAIT_L(0); PG8_BAR; PG8_MMA(0, 0, At, B0); PG8_MMA(0, 1, At, B1); PG8_BAR; PG8_SCHED;
            PG8_LDA(At, 1, 1); PG8_STAGE(PG8_SB(1, 0), b3, voffB); PG8_STAGE(PG8_SB(1, 1), b3 + hstepB, voffB); PG8_STAGE(PG8_SA(1, 0), a3, voffA);
            PG8_WAIT_V(8); PG8_WAIT_L(0); PG8_BAR; PG8_MMA(1, 0, At, B0); PG8_MMA(1, 1, At, B1); PG8_BAR; PG8_SCHED;
        }
        if constexpr (ALIGN_EPI) { if (wr == 0) PG8_BAR; }
        if constexpr (!Epi::AFTER_DRAIN) { E(acc, cur, wr, wc, fr, fq); S.done(cur); }
        if (!has_next) break;
#pragma unroll
        for (int a = 0; a < 2; ++a)
#pragma unroll
            for (int b = 0; b < 2; ++b)
#pragma unroll
                for (int m = 0; m < 4; ++m)
#pragma unroll
                    for (int n = 0; n < 2; ++n) acc[a][b][m][n] = (f32x4){0.f, 0.f, 0.f, 0.f};
        cur = nxt; cA = nA; cB = nB; ++ui;
        if constexpr (ALIGN_EPI) { if (wr == 1) PG8_BAR; }
    }
    PG8_WAIT_V(0);
    if constexpr (!ALIGN_EPI) { if (wr == 0) PG8_BAR; }
    PG8_BAR;
    if constexpr (Epi::AFTER_DRAIN) { E.fused(acc, cur, wr, wc, fr, fq, lds, wid, lane); S.done(cur); }
#undef PG8_SA
#undef PG8_SB
#undef PG8_STAGE
#undef PG8_LDA
#undef PG8_LDB
#undef PG8_MMA
#undef PG8_WAIT_V
#undef PG8_WAIT_L
#undef PG8_BAR
#undef PG8_SCHED
}
}
#include <hip/hip_bf16.h>
#include <cmath>
#include <hip/hip_bf16.h>
#include <cmath>
namespace attn_body {
using bf16=__hip_bfloat16;
using bf16x8=__attribute__((ext_vector_type(8)))short;
using s16x4=__attribute__((ext_vector_type(4)))short;
using f32x16=__attribute__((ext_vector_type(16)))float;
using u32x4=__attribute__((ext_vector_type(4)))unsigned;
constexpr int D=64, QKP=6912, OPITCH=2048;
constexpr int NW=8,QBLK=32,QB=QBLK*NW,KVBLK=64;
constexpr int ATTN_UNIT_ROWS=QB;
__device__ __forceinline__ int crow(int r,int hi){return (r&3)+8*(r>>2)+4*hi;}
#define SBAR() __builtin_amdgcn_sched_barrier(0)
typedef __attribute__((address_space(3))) const float* lds_cfptr;
__device__ __forceinline__ void cbias(f32x16&p0,f32x16&p1,int t,int kr0,int r0,int wid,int r32,int hi,lds_cfptr bt){
  if(t<4)return;
  asm volatile("; LAUNDER":"+v"(r32),"+v"(hi));
  const float NEG=-INFINITY; const int kr=kr0+t-4, r=r0+(wid>>1); int rs=r-4; rs=rs<0?0:(rs>120?120:rs);
  if(kr<rs||kr>=rs+8){
    #pragma unroll
    for(int rr=0;rr<16;++rr){p0[rr]=NEG;p1[rr]=NEG;}
    return; }
  const int dr=kr-r+7, qc=32*(wid&1)+r32; int cs=qc-8; cs=cs<0?0:(cs>48?48:cs);
  const lds_cfptr brow=bt+dr*31;
  #pragma unroll
  for(int rr=0;rr<16;++rr){
    const int kc=(rr&3)+8*(rr>>2)+4*hi;
    { const int dc=kc-qc+15; const bool ok=(kc>=cs)&&(kc<cs+16); const int di=dc<0?0:(dc>30?30:dc); const float b=brow[di]; p0[rr]=ok?p0[rr]+b:NEG; }
    { const int k2=kc+32, dc=k2-qc+15; const bool ok=(k2>=cs)&&(k2<cs+16); const int di=dc<0?0:(dc>30?30:dc); const float b=brow[di]; p1[rr]=ok?p1[rr]+b:NEG; }
  }
}
constexpr int NSLOT=3, SLOTB=8192;
constexpr int LDS_K=0, LDS_V=NSLOT*SLOTB, LDS_WS=2*NSLOT*SLOTB, LDS_OST=LDS_WS+NW*64*4, LDS_BYTES=LDS_OST+NW*4096;
constexpr float C2=0.125f*1.4426950408889634f;
__device__ __forceinline__ void glds16(const void*gsrc,unsigned lds_dst){unsigned keep;
  asm volatile("s_mov_b32 %0, m0\n\ts_mov_b32 m0, %2\n\ts_nop 0\n\tglobal_load_lds_dwordx4 %1, off\n\ts_mov_b32 m0, %0":"=&s"(keep):"v"(gsrc),"s"(lds_dst):"memory");}
__device__ __forceinline__ float max3f(float a,float b,float c){float r;asm("v_max3_f32 %0, %1, %2, %3":"=v"(r):"v"(a),"v"(b),"v"(c));return r;}
__device__ __forceinline__ float max2f(float a,float b){float r;asm("v_max_f32_e32 %0, %1, %2":"=v"(r):"v"(a),"v"(b));return r;}
__device__ __forceinline__ float fadd_s(float a,float b){float r;asm("v_add_f32_e32 %0, %1, %2":"=v"(r):"v"(a),"v"(b));return r;}
__device__ __forceinline__ float fsub_s(float a,float b){float r;asm("v_sub_f32_e32 %0, %1, %2":"=v"(r):"v"(a),"v"(b));return r;}
typedef float f32x2_t __attribute__((ext_vector_type(2))); typedef __bf16 bf16x2_t __attribute__((ext_vector_type(2)));
__device__ __forceinline__ unsigned cvtpk_s(float lo,float hi){f32x2_t v={lo,hi};bf16x2_t b=__builtin_convertvector(v,bf16x2_t);return __builtin_bit_cast(unsigned,b);}
#define WAIT_BAR(N) asm volatile("s_waitcnt vmcnt(" #N ") lgkmcnt(0)\n\ts_barrier":::"memory")

__device__ __forceinline__ void qkt(f32x16&p0,f32x16&p1,const char*Kslot,const bf16x8*qr,const f32x16&negm,int r32,int hi){
  const char*kb=Kslot+hi*1024+r32*16;
  #pragma unroll
  for(int d0=0;d0<4;++d0){
    const bf16x8 b0=*reinterpret_cast<const bf16x8*>(kb+d0*2048);
    const bf16x8 b1=*reinterpret_cast<const bf16x8*>(kb+d0*2048+512);
    if(d0==0){p0=__builtin_amdgcn_mfma_f32_32x32x16_bf16(b0,qr[0],negm,0,0,0);p1=__builtin_amdgcn_mfma_f32_32x32x16_bf16(b1,qr[0],negm,0,0,0);}
    else{p0=__builtin_amdgcn_mfma_f32_32x32x16_bf16(b0,qr[d0],p0,0,0,0);p1=__builtin_amdgcn_mfma_f32_32x32x16_bf16(b1,qr[d0],p1,0,0,0);}}
}
typedef __attribute__((address_space(3))) const char* lds_cptr;
typedef short v4i16_t __attribute__((ext_vector_type(4)));
__device__ __forceinline__ void kload8(bf16x8*kf,lds_cptr kp){
  kf[0]=*(const __attribute__((address_space(3))) bf16x8*)(kp);      kf[1]=*(const __attribute__((address_space(3))) bf16x8*)(kp+512);
  kf[2]=*(const __attribute__((address_space(3))) bf16x8*)(kp+2048); kf[3]=*(const __attribute__((address_space(3))) bf16x8*)(kp+2560);
  kf[4]=*(const __attribute__((address_space(3))) bf16x8*)(kp+4096); kf[5]=*(const __attribute__((address_space(3))) bf16x8*)(kp+4608);
  kf[6]=*(const __attribute__((address_space(3))) bf16x8*)(kp+6144); kf[7]=*(const __attribute__((address_space(3))) bf16x8*)(kp+6656);
}
__device__ __forceinline__ void kload2(bf16x8*kf,lds_cptr kp,int j){ kf[2*j]=*(const __attribute__((address_space(3))) bf16x8*)(kp+j*2048); kf[2*j+1]=*(const __attribute__((address_space(3))) bf16x8*)(kp+j*2048+512); }
__device__ __forceinline__ s16x4 vtr(lds_cptr p){ return __builtin_bit_cast(s16x4,__builtin_amdgcn_ds_read_tr16_b64_v4i16((__attribute__((address_space(3))) v4i16_t*)p)); }
__device__ __forceinline__ float rowmax(const f32x16&p0,const f32x16&p1){
  float a=max3f(p0[0],p0[1],p1[0]),b=max3f(p0[2],p0[3],p1[1]);a=max3f(a,p1[2],p1[3]);
  #pragma unroll
  for(int r=4;r<16;r+=4){a=max3f(a,p0[r],p0[r+1]);b=max3f(b,p0[r+2],p0[r+3]);a=max3f(a,p1[r],p1[r+1]);b=max3f(b,p1[r+2],p1[r+3]);}
  const float m=max2f(a,b);
  auto rr=__builtin_amdgcn_permlane32_swap(__float_as_uint(m),__float_as_uint(m),false,false);
  return max2f(__uint_as_float(rr[0]),__uint_as_float(rr[1]));
}
__device__ __forceinline__ void pv(f32x16*o,int vb,bf16x8 pa0,bf16x8 pa1,bf16x8 pa2,bf16x8 pa3){
  #pragma unroll
  for(int d0=0;d0<2;++d0){s16x4 lo[4],hi[4];
    #pragma unroll
    for(int ks=0;ks<4;++ks){
      asm volatile("ds_read_b64_tr_b16 %0,%1 offset:%c2":"=&v"(lo[ks]):"v"(vb),"i"(d0*4096+ks*1024):"memory");
      asm volatile("ds_read_b64_tr_b16 %0,%1 offset:%c2":"=&v"(hi[ks]):"v"(vb),"i"(d0*4096+ks*1024+512):"memory");}
    asm volatile("s_waitcnt lgkmcnt(0)":::"memory");SBAR();
    #define PK(k) (bf16x8){lo[k][0],lo[k][1],lo[k][2],lo[k][3],hi[k][0],hi[k][1],hi[k][2],hi[k][3]}
    o[d0]=__builtin_amdgcn_mfma_f32_32x32x16_bf16(pa0,PK(0),o[d0],0,0,0);
    o[d0]=__builtin_amdgcn_mfma_f32_32x32x16_bf16(pa1,PK(1),o[d0],0,0,0);
    o[d0]=__builtin_amdgcn_mfma_f32_32x32x16_bf16(pa2,PK(2),o[d0],0,0,0);
    o[d0]=__builtin_amdgcn_mfma_f32_32x32x16_bf16(pa3,PK(3),o[d0],0,0,0);
    #undef PK
  }
}

#ifndef ATTN_STORE16
#define ATTN_STORE16(p,v) (*(u32x4*)(p)=(v))
#endif
template<int THRL,bool ISC> __device__ __forceinline__ void attn_unit(const bf16*Qw0,const bf16*__restrict__ Kh,const bf16*__restrict__ Vh,bf16*Ow0,int NT,int kr0,int r0,lds_cfptr bt,char*shm){
  int tid_=threadIdx.x; asm volatile("; LAUNDER":"+v"(tid_)); const int tid=tid_,lane=tid&63,r32=lane&31,hi=lane>>5; const int wid=__builtin_amdgcn_readfirstlane(tid>>6);
  const bf16*Qw=Qw0+(long)(wid*QBLK)*QKP;
  const unsigned lds0=(unsigned)(uintptr_t)shm;
  float*wsf=(float*)(shm+LDS_WS)+wid*64;
  const bf16*ksrc=Kh+(long)lane*QKP+wid*8;
  const bf16*vsrc=Vh+(long)(16*(wid&3)+(lane>>2))*QKP+(wid>>2)*32+(lane&3)*8;
  const unsigned kdst=lds0+LDS_K+wid*1024, vdst=lds0+LDS_V+wid*1024;
  #define KROW(t) (ISC ? ((t)<4 ? 64*(t) : 256+64*(kr0+(t)-4)) : 64*(t))
  #define DMA_K(t,slot) glds16(ksrc+(long)KROW(t)*QKP,(unsigned)__builtin_amdgcn_readfirstlane(kdst+(slot)))
  #define DMA_V(t,slot) glds16(vsrc+(long)KROW(t)*QKP,(unsigned)__builtin_amdgcn_readfirstlane(vdst+(slot)))
  const int vb0=(int)(lds0+LDS_V)+((lane>>4)&1)*32+(lane&3)*8+(4*hi+((lane&15)>>2))*64;
  const char*Kbase=shm+LDS_K; bf16x8 kf[8];
  const lds_cptr shm3=(lds_cptr)shm; const lds_cptr kp0=shm3+LDS_K+hi*1024+r32*16; const lds_cptr vp0=shm3+LDS_V+((lane>>4)&1)*32+(lane&3)*8+(4*hi+((lane&15)>>2))*64;
  DMA_K(0,0);DMA_V(0,0);DMA_K(1,SLOTB);
  bf16x8 qr[4];
  #pragma unroll
  for(int d0=0;d0<4;++d0)qr[d0]=*reinterpret_cast<const bf16x8*>(&Qw[(long)r32*QKP+d0*16+hi*8]);
  float mhat=0.f,l_reg=0.f;f32x16 o[2];o[0]=f32x16{};o[1]=f32x16{};f32x16 negm=f32x16{};asm volatile("":"+v"(negm));
  #define CMASK(P0,P1,t) do{ if constexpr(ISC){ cbias(P0,P1,(t),kr0,r0,wid,r32,hi,bt); } }while(0)
  bool resc=false;
  #define START(P0,P1) do{ const float rm=rowmax(P0,P1); resc=false; \
    { const float dl=rm; mhat=fadd_s(mhat,dl); \
      _Pragma("unroll") for(int r=0;r<16;++r){P0[r]=fsub_s(P0[r],dl);P1[r]=fsub_s(P1[r],dl);} \
      _Pragma("unroll") for(int r=0;r<16;++r)negm[r]=-mhat; asm volatile("":"+v"(negm)); } \
    _Pragma("unroll") for(int r=0;r<16;++r)P0[r]=__builtin_amdgcn_exp2f(P0[r]); }while(0)
  #define RESC() do{ if(resc){ asm volatile("s_waitcnt lgkmcnt(0)":::"memory"); \
      _Pragma("unroll") for(int d_=0;d_<2;++d_) _Pragma("unroll") for(int r=0;r<16;++r)o[d_][r]*=wsf[crow(r,hi)]; } }while(0)
  f32x16 pA0,pA1,pB0,pB1;
  int sl_prev=0,sl_cur=0,sl_next=SLOTB;
  #define ROT() do{sl_prev=sl_cur;sl_cur=sl_next;sl_next=(sl_next==(NSLOT-1)*SLOTB)?0:sl_next+SLOTB;}while(0)
  DMA_K(2,2*SLOTB);
  WAIT_BAR(3);
  qkt(pA0,pA1,Kbase,qr,negm,r32,hi);asm volatile("s_nop 15\n\ts_nop 7":"+v"(pA0),"+v"(pA1));CMASK(pA0,pA1,0);
  START(pA0,pA1);
  _Pragma("unroll") for(int r=0;r<16;++r)pA1[r]=__builtin_amdgcn_exp2f(pA1[r]);
  WAIT_BAR(0);
  DMA_K(3,0);DMA_V(1,SLOTB);
  ROT();
  kload8(kf,kp0+sl_cur);
  WAIT_BAR(2);
  s16x4 vlo[8],vhi[8]; u32x4 pw0,pw1,pw2,pw3;
  #define PKW(P,B) cvtpk_s(P[B],P[B+1])
  #define PAF(k) __builtin_bit_cast(bf16x8,pw##k)
  #define VFR(i) (bf16x8){vlo[i][0],vlo[i][1],vlo[i][2],vlo[i][3],vhi[i][0],vhi[i][1],vhi[i][2],vhi[i][3]}
  #define PIN(x) asm volatile("":"+v"(x))
  #define MX3(a,b,c) __builtin_fmaxf(__builtin_fmaxf((a),(b)),(c))
  #define GAPA(MF,A0,A1,A2,A3,W0,W1,PW) do{ MF; sacc+=A0; sacc+=A1; sacc+=A2; sacc+=A3; PIN(sacc); W0; W1; PIN(PW); SBAR(); }while(0)
  #define EX(v) __builtin_amdgcn_exp2f(v)
  #define GAPB(MF,X,B) do{ MF; X[B]=EX(X[B]); X[B+1]=EX(X[B+1]); X[B+2]=EX(X[B+2]); X[B+3]=EX(X[B+3]); PIN(X); SBAR(); }while(0)
  #define VRD(i) do{ vlo[i]=vtr(vp_+(((i)>>2)*4096+((i)&3)*1024)); vhi[i]=vtr(vp_+(((i)>>2)*4096+((i)&3)*1024+512)); }while(0)
  #define KRD(G,j) do{ if(G){ kload2(kf,kp0+sl_next,j); SBAR(); } }while(0)
  #define STEP(C0,C1,P0,P1,t,GK,GV,GL) do{ SBAR(); \
    const lds_cptr vp_=vp0+sl_prev; \
    VRD(0); SBAR(); float sacc=(P0[0]+P0[1]); \
    GAPA(C0=__builtin_amdgcn_mfma_f32_32x32x16_bf16(kf[0],qr[0],negm,0,0,0), P0[2],P0[3],P0[4],P0[5],     pw0[0]=PKW(P0,0), pw0[1]=PKW(P0,2), pw0); \
    VRD(4); SBAR(); GAPA(C1=__builtin_amdgcn_mfma_f32_32x32x16_bf16(kf[1],qr[0],negm,0,0,0), P0[6],P0[7],P0[8],P0[9],     pw0[2]=PKW(P0,4), pw0[3]=PKW(P0,6), pw0); \
    VRD(1); SBAR(); GAPA(C0=__builtin_amdgcn_mfma_f32_32x32x16_bf16(kf[2],qr[1],C0,0,0,0),   P0[10],P0[11],P0[12],P0[13], pw1[0]=PKW(P0,8), pw1[1]=PKW(P0,10), pw1); \
    VRD(5); SBAR(); GAPA(C1=__builtin_amdgcn_mfma_f32_32x32x16_bf16(kf[3],qr[1],C1,0,0,0),   P0[14],P0[15],P1[0],P1[1],   pw1[2]=PKW(P0,12),pw1[3]=PKW(P0,14), pw1); \
    VRD(2); SBAR(); GAPA(C0=__builtin_amdgcn_mfma_f32_32x32x16_bf16(kf[4],qr[2],C0,0,0,0),   P1[2],P1[3],P1[4],P1[5],     pw2[0]=PKW(P1,0), pw2[1]=PKW(P1,2), pw2); \
    VRD(6); SBAR(); GAPA(C1=__builtin_amdgcn_mfma_f32_32x32x16_bf16(kf[5],qr[2],C1,0,0,0),   P1[6],P1[7],P1[8],P1[9],     pw2[2]=PKW(P1,4), pw2[3]=PKW(P1,6), pw2); \
    VRD(3); SBAR(); GAPA(C0=__builtin_amdgcn_mfma_f32_32x32x16_bf16(kf[6],qr[3],C0,0,0,0),   P1[10],P1[11],P1[12],P1[13], pw3[0]=PKW(P1,8), pw3[1]=PKW(P1,10), pw3); \
    VRD(7); SBAR(); GAPA(C1=__builtin_amdgcn_mfma_f32_32x32x16_bf16(kf[7],qr[3],C1,0,0,0),   P1[14],P1[15],0.f,0.f,       pw3[2]=PKW(P1,12),pw3[3]=PKW(P1,14), pw3); \
    l_reg+=sacc; \
    if(GK){DMA_K((t)+3,sl_cur);} if(GV){DMA_V((t)+1,sl_next);} \
    CMASK(C0,C1,t); \
    { float a=MX3(C0[0],C0[1],C1[0]),b=MX3(C0[2],C0[3],C1[1]); a=MX3(a,C1[2],C1[3]); \
      _Pragma("unroll") for(int r=4;r<16;r+=4){a=MX3(a,C0[r],C0[r+1]);b=MX3(b,C0[r+2],C0[r+3]);a=MX3(a,C1[r],C1[r+1]);b=MX3(b,C1[r+2],C1[r+3]);} \
      float rm=__builtin_fmaxf(a,b); { auto rr=__builtin_amdgcn_permlane32_swap(__float_as_uint(rm),__float_as_uint(rm),false,false); rm=__builtin_fmaxf(__uint_as_float(rr[0]),__uint_as_float(rr[1])); } \
      resc=false; \
      if(__builtin_expect(__any(rm>(float)THRL),0)){ const float dl=__builtin_fmaxf(rm,0.f); mhat+=dl; \
        _Pragma("unroll") for(int r=0;r<16;++r){C0[r]-=dl;C1[r]-=dl;} \
        _Pragma("unroll") for(int r=0;r<16;++r)negm[r]=-mhat; asm volatile("":"+v"(negm)); \
        const float f=__builtin_amdgcn_exp2f(-dl); l_reg*=f; if(hi==0)wsf[r32]=f; resc=true; } } \
    SBAR(); \
    GAPB(o[0]=__builtin_amdgcn_mfma_f32_32x32x16_bf16(PAF(0),VFR(0),o[0],0,0,0), C0,0); \
    GAPB(o[1]=__builtin_amdgcn_mfma_f32_32x32x16_bf16(PAF(0),VFR(4),o[1],0,0,0), C0,4); \
    KRD(GL,0); GAPB(o[0]=__builtin_amdgcn_mfma_f32_32x32x16_bf16(PAF(1),VFR(1),o[0],0,0,0), C0,8); \
    KRD(GL,1); GAPB(o[1]=__builtin_amdgcn_mfma_f32_32x32x16_bf16(PAF(1),VFR(5),o[1],0,0,0), C0,12); \
    KRD(GL,2); GAPB(o[0]=__builtin_amdgcn_mfma_f32_32x32x16_bf16(PAF(2),VFR(2),o[0],0,0,0), C1,0); \
    KRD(GL,3); GAPB(o[1]=__builtin_amdgcn_mfma_f32_32x32x16_bf16(PAF(2),VFR(6),o[1],0,0,0), C1,4); \
    GAPB(o[0]=__builtin_amdgcn_mfma_f32_32x32x16_bf16(PAF(3),VFR(3),o[0],0,0,0), C1,8); \
    GAPB(o[1]=__builtin_amdgcn_mfma_f32_32x32x16_bf16(PAF(3),VFR(7),o[1],0,0,0), C1,12); \
    }while(0)
  int t=1;
  for(;t+5<NT;t+=2){
    STEP(pB0,pB1,pA0,pA1,t,true,true,true);     WAIT_BAR(2); RESC(); ROT();
    STEP(pA0,pA1,pB0,pB1,t+1,true,true,true);   WAIT_BAR(2); RESC(); ROT();
  }
  #define ENDW(tt) do{ if((tt)+3<NT){WAIT_BAR(2);} else if((tt)+2<NT){WAIT_BAR(1);} else {WAIT_BAR(0);} }while(0)
  for(;t+1<NT;t+=2){
    STEP(pB0,pB1,pA0,pA1,t,(t+3<NT),(t+1<NT),(t+1<NT));       ENDW(t);   RESC(); ROT();
    STEP(pA0,pA1,pB0,pB1,t+1,(t+4<NT),(t+2<NT),(t+2<NT));     ENDW(t+1); RESC(); ROT();
  }
  STEP(pB0,pB1,pA0,pA1,NT-1,false,false,false); RESC();
  { float sacc=pB0[0]+pB0[1]; _Pragma("unroll") for(int r=2;r<16;++r)sacc+=pB0[r]; _Pragma("unroll") for(int r=0;r<16;++r)sacc+=pB1[r]; l_reg+=sacc;
    pw0=(u32x4){PKW(pB0,0),PKW(pB0,2),PKW(pB0,4),PKW(pB0,6)};pw1=(u32x4){PKW(pB0,8),PKW(pB0,10),PKW(pB0,12),PKW(pB0,14)};pw2=(u32x4){PKW(pB1,0),PKW(pB1,2),PKW(pB1,4),PKW(pB1,6)};pw3=(u32x4){PKW(pB1,8),PKW(pB1,10),PKW(pB1,12),PKW(pB1,14)};
    SBAR(); pv(o,vb0+sl_cur,PAF(0),PAF(1),PAF(2),PAF(3)); }
  #undef PKW
  #undef PAF
  #undef VFR
  #undef PIN
  #undef MX3
  #undef GAPA
  #undef GAPB
  #undef EX
  #undef VRD
  #undef KRD
  #undef STEP
  #undef ENDW
  {auto rr=__builtin_amdgcn_permlane32_swap(__float_as_uint(l_reg),__float_as_uint(l_reg),false,false);l_reg=__uint_as_float(rr[0])+__uint_as_float(rr[1]);}
  if(hi==0)wsf[32+r32]=l_reg;asm volatile("s_waitcnt lgkmcnt(0)":::"memory");
  float rli[16];
  #pragma unroll
  for(int r=0;r<16;++r)rli[r]=__builtin_amdgcn_rcpf(wsf[32+crow(r,hi)]);
  bf16*Ow=Ow0+(long)(wid*QBLK)*OPITCH;
  { bf16*stg=(bf16*)(shm+LDS_OST)+wid*2048;
    #pragma unroll
    for(int r=0;r<16;++r){const int orow=crow(r,hi);
      #pragma unroll
      for(int d0=0;d0<2;++d0)stg[orow*64+d0*32+r32]=__float2bfloat16(o[d0][r]*rli[r]);}
    asm volatile("s_waitcnt lgkmcnt(0)":::"memory");
    #pragma unroll
    for(int i=0;i<4;++i){const int row=i*8+(lane>>3),ch=lane&7; const u32x4 v=*(const u32x4*)(stg+row*64+ch*8); ATTN_STORE16(Ow+(long)row*OPITCH+ch*8,v);} }
  asm volatile("s_waitcnt lgkmcnt(0)\n\ts_barrier":::"memory");
  #undef DMA_K
  #undef KROW
  #undef DMA_V
  #undef CMASK
  #undef START
  #undef RESC
  #undef ROT
}
constexpr int ATTN_LDS_BYTES=LDS_BYTES;
#undef SBAR
#undef WAIT_BAR
}
#define GAS __attribute__((address_space(1)))
#define LAS __attribute__((address_space(3)))
typedef unsigned short bf16;
typedef unsigned v4u __attribute__((ext_vector_type(4)));
typedef float f32x4 __attribute__((ext_vector_type(4)));
typedef short bf16x8 __attribute__((ext_vector_type(8)));
typedef GAS unsigned gu32;
typedef GAS unsigned long long gu64;
#define RLX_AGENT __ATOMIC_RELAXED, __HIP_MEMORY_SCOPE_AGENT
#define LDS_WAIT() asm volatile("s_waitcnt lgkmcnt(0)" ::: "memory")
#define VM_WAIT() asm volatile("s_waitcnt vmcnt(0)" ::: "memory")
__device__ __forceinline__ unsigned long long rt() { return __builtin_amdgcn_s_memrealtime(); }
__device__ __forceinline__ unsigned f2bf(float f) { unsigned u = __builtin_bit_cast(unsigned, f); return (u + 0x7fffu + ((u >> 16) & 1u)) >> 16; }
__device__ __forceinline__ unsigned pk2(float lo, float hi) { return f2bf(lo) | (f2bf(hi) << 16); }

#define XB_TMO      128
#define XB_XCNT(j)  (256  + 64 * (j))
#define XB_XSUB(j)  (1280 + 64 * (j))
#define XB_XGEN(j)  (2304 + 64 * (j))
#define XB_TOP      3328
#define XB_TOPGEN   3392
#define XCD_BAR_WORDS 3456
#define XB_SPIN_CAP (1u << 22)

__device__ __forceinline__ unsigned xb_ld(unsigned* p)              { return __hip_atomic_load(p, __ATOMIC_RELAXED, __HIP_MEMORY_SCOPE_AGENT); }
__device__ __forceinline__ unsigned xb_add(unsigned* p, unsigned v) { return __hip_atomic_fetch_add(p, v, __ATOMIC_RELAXED, __HIP_MEMORY_SCOPE_AGENT); }
__device__ __forceinline__ unsigned xb_xcc_id() { return (unsigned)__builtin_amdgcn_s_getreg((3 << 11) | 20) & 0xFu; }
#define XB_SPIN(cond, bar) do { unsigned _sp = 0; while (cond) { __builtin_amdgcn_s_sleep(1); \
    if ((++_sp & 255u) == 0u) { if (xb_ld(&(bar)[XB_TMO])) break; if (_sp > XB_SPIN_CAP) { atomicAdd(&(bar)[XB_TMO], 1u); break; } } } } while (0)

struct XcdBarrier {
    unsigned* bar; unsigned x;
    volatile LAS unsigned* st;
};

__device__ __forceinline__ XcdBarrier xcd_barrier_post(unsigned* bar, volatile LAS unsigned* st) {
    XcdBarrier b; b.bar = bar; b.x = xb_xcc_id(); b.st = st;
    if (threadIdx.x == 0) (void)xb_add(&bar[XB_XCNT(b.x)], 1u);
    return b;
}
__device__ __forceinline__ void xcd_barrier_complete(unsigned* bar, unsigned x, unsigned& nloc, unsigned& nx) {
    const unsigned G = gridDim.x * gridDim.y * gridDim.z;
    unsigned sum, cnt, mine, sp = 0u;
    for (;;) {
        sum = 0u; cnt = 0u; mine = 0u;
#pragma unroll
        for (unsigned j = 0; j < 16; ++j) { const unsigned c = xb_ld(&bar[XB_XCNT(j)]); sum += c; cnt += (c > 0u) ? 1u : 0u; mine = (j == x) ? c : mine; }
        if (sum == G) break;
        __builtin_amdgcn_s_sleep(1);
        if ((++sp & 255u) == 0u) { if (xb_ld(&bar[XB_TMO])) break; if (sp > XB_SPIN_CAP) { atomicAdd(&bar[XB_TMO], 1u); break; } }
    }
    nloc = mine > 0u ? mine : 1u; nx = cnt > 0u ? cnt : 1u;
}

__device__ __forceinline__ void xcd_barrier(const XcdBarrier& b) {
    asm volatile("s_waitcnt vmcnt(0)" ::: "memory");
    __syncthreads();
    if (threadIdx.x == 0) {
        unsigned* bar = b.bar;
        __builtin_amdgcn_s_waitcnt(0);
        unsigned nloc = b.st[0], nx = b.st[1];
        if (nloc == 0u) { xcd_barrier_complete(bar, b.x, nloc, nx); b.st[0] = nloc; b.st[1] = nx; }
        const unsigned old = xb_add(&bar[XB_XSUB(b.x)], 1u);
        const unsigned gen = old / nloc;
        if (old + 1u == (gen + 1u) * nloc) {
            __builtin_amdgcn_fence(__ATOMIC_RELEASE, "agent");
            asm volatile("s_waitcnt vmcnt(0)" ::: "memory");
            const unsigned og = xb_add(&bar[XB_TOP], 1u);
            const unsigned tg = og / nx;
            if (og + 1u == (tg + 1u) * nx) xb_add(&bar[XB_TOPGEN], 1u);
            else XB_SPIN(xb_ld(&bar[XB_TOPGEN]) == tg, bar);
            __builtin_amdgcn_fence(__ATOMIC_ACQUIRE, "agent");
            xb_add(&bar[XB_XGEN(b.x)], 1u);
            asm volatile("s_waitcnt vmcnt(0)" ::: "memory");
        } else {
            XB_SPIN(xb_ld(&bar[XB_XGEN(b.x)]) == gen, bar);
            __builtin_amdgcn_fence(__ATOMIC_ACQUIRE, "agent");
            asm volatile("s_waitcnt vmcnt(0)" ::: "memory");
        }
    }
    __syncthreads();
}

constexpr int NWAVES = 8;
constexpr int D = 1024, BATCH = 4, SEQ = 8192, DEPTH = 4, CTX = 256, NTOK = CTX + SEQ  , M = BATCH * NTOK  ;
constexpr int DIN = 6912;
constexpr int C_AQ = 0, C_AK = 512, C_AV = 640, C_BQ = 768, C_BK = 1280, C_BV = 1792, C_CQ = 2304, C_CK = 2816, C_CV = 3328, C_G = 3840;
constexpr int FF = 2816, NE = 8, FE = 3584;
constexpr int OPITCH = 2048, O_A = 0, O_B1 = 512, O_B2 = 1024, O_C = 1536;
constexpr int SMAX = 69632;
constexpr float EPS = 1e-6f;
constexpr float LOG2E = 1.4426950408889634f;
constexpr int PANELS_PER_B = NTOK / 256;
static_assert(attn_body::QKP == DIN && attn_body::OPITCH == OPITCH, "attention body pitches");
enum { I_X = 0, I_C, I_CTX, I_CCTX, I_WMOD, I_BMOD, I_GMIX, I_GFFN, I_WIN, I_QNA, I_KNA, I_LQ1, I_LK1, I_LQ2, I_LK2, I_SUBLN, I_RPB, I_WBRA, I_WBRB, I_WBRC, I_WOUT,
       I_FW1, I_FW3, I_FW2, I_ROUTER, I_MW1, I_MW3, I_MW2, I_GFINAL, N_IN };

constexpr size_t MiB = 1u << 20;
constexpr size_t WS_CTL = 0, CTL_ZERO_BYTES = 1 * MiB;
constexpr size_t WS_MOD = 1 * MiB;
constexpr size_t WS_ROPE = 1 * MiB + 512 * 1024;
constexpr size_t WS_TOK = 2 * MiB;
constexpr size_t WS_XC = 4 * MiB;
constexpr size_t WS_W = 8 * MiB;
constexpr size_t WS_WIN = WS_W, WS_WBR = WS_W + 14 * MiB, WS_WOUT = WS_W + 17 * MiB, WS_W13 = WS_W + 19 * MiB, WS_W2 = WS_W + 131 * MiB;
constexpr size_t WS_XN = 196 * MiB;
constexpr size_t WS_MB = 262 * MiB;
constexpr size_t WS_P = 398 * MiB;
constexpr size_t WS_O = 844 * MiB;
constexpr size_t WS_YS = 874 * MiB;
constexpr size_t WS_END = 1010 * MiB;
static_assert(WS_W2 + (size_t)NE * D * FE * 2 <= WS_XN && WS_XN + (size_t)M * D * 2 <= WS_MB && WS_MB + (size_t)SMAX * D * 2 <= WS_P && WS_MB + (size_t)M * D * 4 <= WS_P, "ws map 1");
static_assert(WS_P + (size_t)M * DIN * 2 <= WS_O && WS_O + (size_t)M * OPITCH * 2 <= WS_END && WS_P + (size_t)SMAX * FE * 2 <= WS_YS && WS_YS + (size_t)SMAX * D * 2 <= WS_END, "ws map 2");
static_assert(WS_W13 + (size_t)NE * 2 * FE * D * 2 <= WS_W2 && WS_WIN + (size_t)DIN * D * 2 <= WS_WBR, "ws map 3");
constexpr int CW_BAR = 4096;
constexpr int CW_CNT = 8192;
static_assert((CW_CNT + 2 * 8 * 64) * 4 <= (int)CTL_ZERO_BYTES, "CTL words inside the memset region");

constexpr int RING_OFF = 0, RING_BYTES = 131072;
constexpr int LDSCTL_OFF = RING_BYTES, MISC_OFF = LDSCTL_OFF + 320;
constexpr int LDS_BYTES = 147456;
constexpr int BIAS_OFF = 86016;
static_assert(attn_body::ATTN_LDS_BYTES <= BIAS_OFF && BIAS_OFF + 8 * 465 * 4 <= RING_BYTES, "LDS map");

typedef unsigned u32x2 __attribute__((ext_vector_type(2)));
typedef float f32x2v __attribute__((ext_vector_type(2)));
struct Args { const float* in[N_IN]; float* out; unsigned char* ws; };
typedef const __attribute__((address_space(4))) Args* CArgsP;
struct Frame {
    LAS unsigned char* lds;
    int tid, lane, wave, vcu, G;
};
#define REFRESH(F) do { int t_ = threadIdx.x; asm volatile("; LAUNDER" : "+v"(t_)); (F).tid = t_; (F).lane = t_ & 63; (F).wave = __builtin_amdgcn_readfirstlane(t_ >> 6); } while (0)
__device__ __forceinline__ CArgsP fresh_args() { CArgsP p = (CArgsP)__builtin_amdgcn_kernarg_segment_ptr(); asm volatile("; LAUNDER_S" : "+s"(p)); return p; }

__device__ __forceinline__ float wave_sum(float v) {
#pragma unroll
    for (int o = 1; o < 64; o <<= 1) v += __shfl_xor(v, o);
    return v;
}
__device__ __forceinline__ unsigned cvtpk(float lo, float hi) { return pg8::cvt_pk_bf16(lo, hi); }
__device__ __forceinline__ float bf_lo(unsigned w) { return __uint_as_float(w << 16); }
__device__ __forceinline__ float bf_hi(unsigned w) { return __uint_as_float(w & 0xffff0000u); }
__device__ __forceinline__ float sigmoidf_(float x) { return __builtin_amdgcn_rcpf(1.0f + __builtin_amdgcn_exp2f(-x * LOG2E)); }

__device__ __forceinline__ void tr_item(const float* W, int K, int N, bf16* WT, int base, int il, LAS float* scr, int item, int lane) {
    const int nblk = N / 32, kb = item / nblk, nb = item % nblk, k0 = 64 * kb, n0 = 32 * nb;
#pragma unroll 8
    for (int i = 0; i < 32; ++i) { const int kk = 2 * i + (lane >> 5); scr[kk * 33 + (lane & 31)] = W[(size_t)(k0 + kk) * N + n0 + (lane & 31)]; }
    LDS_WAIT(); asm volatile("" ::: "memory");
    const int c = lane & 7;
#pragma unroll
    for (int j = 0; j < 4; ++j) { const int n = (lane >> 3) + 8 * j; const LAS float* s = scr + (8 * c) * 33 + n;
        v4u o; o.x = cvtpk(s[0 * 33], s[1 * 33]); o.y = cvtpk(s[2 * 33], s[3 * 33]); o.z = cvtpk(s[4 * 33], s[5 * 33]); o.w = cvtpk(s[6 * 33], s[7 * 33]);
        const int ng = n0 + n, drow = base + (il ? (256 * (ng >> 7) + (ng & 127)) : ng);
        *(GAS v4u*)(WT + (size_t)drow * K + k0 + 8 * c) = o; }
    LDS_WAIT(); asm volatile("" ::: "memory");
}
__device__ __forceinline__ void convert_weights(Frame& F, CArgsP AP, int l) {
    LAS float* scr = (LAS float*)(F.lds + RING_OFF + F.wave * 16384);
    const int gw = F.vcu * NWAVES + F.wave, NGW = F.G * NWAVES;
    bf16* WIN = (bf16*)(AP->ws + WS_WIN); bf16* WBR = (bf16*)(AP->ws + WS_WBR); bf16* WOUT = (bf16*)(AP->ws + WS_WOUT); bf16* W13 = (bf16*)(AP->ws + WS_W13); bf16* W2 = (bf16*)(AP->ws + WS_W2);
    constexpr int I_IN = (D / 64) * (DIN / 32), I_BR = (512 / 64) * (D / 32), I_OUT = (D / 64) * (D / 32);
    constexpr int I_F1 = (D / 64) * (FF / 32), I_F2 = (FF / 64) * (D / 32), I_M1 = (D / 64) * (FE / 32), I_M2 = (FE / 64) * (D / 32);
    const int i2 = l >> 1;
    const int nbase = I_IN + 3 * I_BR + I_OUT;
    const int nitems = nbase + ((l & 1) ? NE * (2 * I_M1 + I_M2) : (2 * I_F1 + I_F2));
    for (int it = gw; it < nitems; it += NGW) {
        int r = it;
        if (r < I_IN) { tr_item(AP->in[I_WIN] + (size_t)l * D * DIN, D, DIN, WIN, 0, 0, scr, r, F.lane); continue; } r -= I_IN;
        if (r < 3 * I_BR) { const int x = r / I_BR; r -= x * I_BR; const float* src = (x == 0 ? AP->in[I_WBRA] : x == 1 ? AP->in[I_WBRB] : AP->in[I_WBRC]) + (size_t)l * 512 * D;
            tr_item(src, 512, D, WBR + (size_t)x * D * 512, 0, 0, scr, r, F.lane); continue; } r -= 3 * I_BR;
        if (r < I_OUT) { tr_item(AP->in[I_WOUT] + (size_t)l * D * D, D, D, WOUT, 0, 0, scr, r, F.lane); continue; } r -= I_OUT;
        if (!(l & 1)) {
            if (r < I_F1) { tr_item(AP->in[I_FW1] + (size_t)i2 * D * FF, D, FF, W13, 0, 1, scr, r, F.lane); continue; } r -= I_F1;
            if (r < I_F1) { tr_item(AP->in[I_FW3] + (size_t)i2 * D * FF, D, FF, W13, 128, 1, scr, r, F.lane); continue; } r -= I_F1;
            tr_item(AP->in[I_FW2] + (size_t)i2 * FF * D, FF, D, W2, 0, 0, scr, r, F.lane);
        } else {
            const int per = 2 * I_M1 + I_M2, e = r / per; r -= e * per; const size_t eo = (size_t)(i2 * NE + e);
            if (r < I_M1) { tr_item(AP->in[I_MW1] + eo * D * FE, D, FE, W13 + (size_t)e * 2 * FE * D, 0, 1, scr, r, F.lane); continue; } r -= I_M1;
            if (r < I_M1) { tr_item(AP->in[I_MW3] + eo * D * FE, D, FE, W13 + (size_t)e * 2 * FE * D, 128, 1, scr, r, F.lane); continue; } r -= I_M1;
            tr_item(AP->in[I_MW2] + eo * FE * D, FE, D, W2 + (size_t)e * D * FE, 0, 0, scr, r, F.lane);
        }
    }
}

__device__ __forceinline__ void prologue_mod(Frame& F, CArgsP AP) {
    LAS float* sv = (LAS float*)(F.lds + RING_OFF);
    LAS float* red = sv + 5 * 1024;
    for (int i = F.tid; i < 5 * 1024; i += NWAVES * 64) { const int j = i >> 10, k = i & 1023; const float v = j < 4 ? AP->in[I_C][j * 1024 + k] : AP->in[I_CCTX][k]; sv[i] = v * sigmoidf_(v); }
    __syncthreads();
    float* MOD = (float*)(AP->ws + WS_MOD);
    for (int it = blockIdx.x; it < DEPTH * 96; it += F.G) {
        const int l = it / 96, cb = it % 96, col = cb * 64 + F.lane;
        const float* wp = AP->in[I_WMOD] + ((size_t)l * D + F.wave * 128) * 6144 + col;
        const LAS float* s = sv + F.wave * 128;
        float a0 = 0.f, a1 = 0.f, a2 = 0.f, a3 = 0.f, a4 = 0.f;
#pragma unroll 8
        for (int k = 0; k < 128; ++k) { const float w = wp[(size_t)k * 6144]; a0 += s[k] * w; a1 += s[1024 + k] * w; a2 += s[2048 + k] * w; a3 += s[3072 + k] * w; a4 += s[4096 + k] * w; }
        LAS float* rr = red + F.wave * 320 + F.lane;
        rr[0] = a0; rr[64] = a1; rr[128] = a2; rr[192] = a3; rr[256] = a4;
        __syncthreads();
        if (F.tid < 320) { const int j = F.tid >> 6, ln = F.tid & 63; float sacc = 0.f;
#pragma unroll
            for (int w = 0; w < 8; ++w) sacc += red[w * 320 + j * 64 + ln];
            MOD[(size_t)(l * 5 + j) * 6144 + cb * 64 + ln] = sacc + AP->in[I_BMOD][l * 6144 + cb * 64 + ln]; }
        __syncthreads();
    }
    if (blockIdx.x == 0) {
        float* RT = (float*)(AP->ws + WS_ROPE);
        for (int i = F.tid; i < 128 * 16; i += NWAVES * 64) {
            const int pos = i >> 4, j = i & 15;
            double inv = 1.0; for (int q = 0; q < j; ++q) inv *= 0.56234132519034908;
            const float invf = (float)inv; const float angf = (float)pos * invf;
            double a = (double)angf; const double TWO_PI = 6.283185307179586476925;
            const double nrev = __builtin_floor(a / TWO_PI + 0.5); a -= nrev * TWO_PI;
            const double a2 = a * a; double cs = 1.0, sn = a, tc = 1.0, ts = a;
            for (int q = 1; q < 16; ++q) { tc *= -a2 / (double)((2 * q - 1) * (2 * q)); ts *= -a2 / (double)((2 * q) * (2 * q + 1)); cs += tc; sn += ts; }
            RT[2 * i] = (float)cs; RT[2 * i + 1] = (float)sn;
        }
    }
}

struct RowRef { int b, n, bsel; bool isctx; };
__device__ __forceinline__ RowRef row_ref(int row) { RowRef r; r.b = row / NTOK; r.n = row - r.b * NTOK; r.isctx = r.n < CTX; r.bsel = r.isctx ? 4 : r.b; return r; }
__device__ __forceinline__ float* row_x(Frame& F, CArgsP AP, const RowRef& r) {
    return r.isctx ? (float*)(AP->ws + WS_XC) + (size_t)(r.b * CTX + r.n) * D : AP->out + (size_t)(r.b * SEQ + (r.n - CTX)) * D;
}
__device__ __forceinline__ void load_row(const float* p, int lane, f32x4 (&v)[4]) {
#pragma unroll
    for (int j = 0; j < 4; ++j) v[j] = *(const GAS f32x4*)(p + 256 * j + 4 * lane);
}
__device__ __forceinline__ void store_row(float* p, int lane, const f32x4 (&v)[4]) {
#pragma unroll
    for (int j = 0; j < 4; ++j) *(GAS f32x4*)(p + 256 * j + 4 * lane) = v[j];
}
__device__ __forceinline__ void moe_combine(Frame& F, CArgsP AP, int row, const RowRef& r, int lp, f32x4 (&v)[4]) {
    const unsigned* info = (const unsigned*)(AP->ws + WS_TOK) + (size_t)row * 8;
    const float w0 = __uint_as_float(info[4]), w1 = __uint_as_float(info[5]); const unsigned s0 = info[6], s1 = info[7];
    const bf16* Y = (const bf16*)(AP->ws + WS_YS);
    const float* gate = (const float*)(AP->ws + WS_MOD) + (size_t)(lp * 5 + r.bsel) * 6144 + 5 * 1024;
#pragma unroll
    for (int j = 0; j < 4; ++j) {
        const u32x2 y0 = *(const GAS u32x2*)(Y + (size_t)s0 * D + 256 * j + 4 * F.lane), y1 = *(const GAS u32x2*)(Y + (size_t)s1 * D + 256 * j + 4 * F.lane);
        const f32x4 g = *(const GAS f32x4*)(gate + 256 * j + 4 * F.lane);
        v[j].x += g.x * (w0 * bf_lo(y0.x) + w1 * bf_lo(y1.x)); v[j].y += g.y * (w0 * bf_hi(y0.x) + w1 * bf_hi(y1.x));
        v[j].z += g.z * (w0 * bf_lo(y0.y) + w1 * bf_lo(y1.y)); v[j].w += g.w * (w0 * bf_hi(y0.y) + w1 * bf_hi(y1.y));
    }
}
__device__ __forceinline__ float row_rstd(const f32x4 (&v)[4]) {
    float s = 0.f;
#pragma unroll
    for (int j = 0; j < 4; ++j) s += (v[j].x * v[j].x + v[j].y * v[j].y) + (v[j].z * v[j].z + v[j].w * v[j].w);
    return 1.0f / sqrtf(wave_sum(s) * (1.0f / D) + EPS);
}
__device__ __forceinline__ void norm_mod(const f32x4 (&v)[4], float rstd, const float* g, const float* shift, const float* scale, int lane, f32x4 (&y)[4]) {
#pragma unroll
    for (int j = 0; j < 4; ++j) {
        const f32x4 gg = *(const GAS f32x4*)(g + 256 * j + 4 * lane), sh = *(const GAS f32x4*)(shift + 256 * j + 4 * lane), sc = *(const GAS f32x4*)(scale + 256 * j + 4 * lane);
        y[j] = (v[j] * rstd) * gg * (sc + 1.0f) + sh;
    }
}
__device__ __forceinline__ void store_row_bf16(bf16* p, int lane, const f32x4 (&y)[4]) {
#pragma unroll
    for (int j = 0; j < 4; ++j) { u32x2 o; o.x = cvtpk(y[j].x, y[j].y); o.y = cvtpk(y[j].z, y[j].w); *(GAS u32x2*)(p + 256 * j + 4 * lane) = o; }
}

__device__ __forceinline__ void phase_norm1(Frame& F, CArgsP AP, int l) {
    const int gw = F.vcu * NWAVES + F.wave, NGW = F.G * NWAVES;
    bf16* XN = (bf16*)(AP->ws + WS_XN);
    const float* MOD = (const float*)(AP->ws + WS_MOD);
    const float* g = AP->in[I_GMIX] + l * D;
    for (int row = gw; row < M; row += NGW) {
        const RowRef r = row_ref(row); float* xr = row_x(F, AP, r);
        const float* src = (l == 0) ? (r.isctx ? AP->in[I_CTX] + (size_t)(r.b * CTX + r.n) * D : AP->in[I_X] + (size_t)(r.b * SEQ + (r.n - CTX)) * D) : xr;
        f32x4 v[4]; load_row(src, F.lane, v);
        const bool comb = (l > 0) && ((l - 1) & 1);
        if (comb) moe_combine(F, AP, row, r, l - 1, v);
        if (l == 0 || comb) store_row(xr, F.lane, v);
        const float rstd = row_rstd(v);
        const float* mv = MOD + (size_t)(l * 5 + r.bsel) * 6144;
        f32x4 y[4]; norm_mod(v, rstd, g, mv + 0 * 1024, mv + 1 * 1024, F.lane, y);
        store_row_bf16(XN + (size_t)row * D, F.lane, y);
    }
}
__device__ __forceinline__ void phase_norm2(Frame& F, CArgsP AP, int l) {
    const int gw = F.vcu * NWAVES + F.wave, NGW = F.G * NWAVES;
    bf16* XN = (bf16*)(AP->ws + WS_XN);
    const float* MOD = (const float*)(AP->ws + WS_MOD);
    const float* g = AP->in[I_GFFN] + l * D;
    const bool moe = (l & 1);
    LAS float* Rt = (LAS float*)(F.lds + RING_OFF);
    if (moe) {
        const float* R = AP->in[I_ROUTER] + (size_t)(l >> 1) * D * NE;
        for (int i = F.tid; i < D * NE; i += NWAVES * 64) Rt[(i & 7) * 1024 + (i >> 3)] = R[i];
        __syncthreads();
    }
    unsigned* cnt = (unsigned*)(AP->ws + WS_CTL) + CW_CNT + (l >> 1) * 8 * 64;
    for (int row = gw; row < M; row += NGW) {
        const RowRef r = row_ref(row); const float* xr = row_x(F, AP, r);
        f32x4 v[4]; load_row(xr, F.lane, v);
        const float rstd = row_rstd(v);
        const float* mv = MOD + (size_t)(l * 5 + r.bsel) * 6144;
        f32x4 y[4]; norm_mod(v, rstd, g, mv + 3 * 1024, mv + 4 * 1024, F.lane, y);
        store_row_bf16(XN + (size_t)row * D, F.lane, y);
        if (moe) {
            float lg[8];
#pragma unroll
            for (int e = 0; e < 8; ++e) { float s = 0.f;
#pragma unroll
                for (int j = 0; j < 4; ++j) { const f32x4 w = *(const LAS f32x4*)(Rt + e * 1024 + 256 * j + 4 * F.lane); s += (y[j].x * w.x + y[j].y * w.y) + (y[j].z * w.z + y[j].w * w.w); }
                lg[e] = wave_sum(s); }
            int e0 = 0; float v0 = lg[0];
#pragma unroll
            for (int e = 1; e < 8; ++e) if (lg[e] > v0) { v0 = lg[e]; e0 = e; }
            int e1 = -1; float v1 = -INFINITY;
#pragma unroll
            for (int e = 0; e < 8; ++e) if (e != e0 && lg[e] > v1) { v1 = lg[e]; e1 = e; }
            const float ex = __expf(v1 - v0), w0 = 1.0f / (1.0f + ex), w1 = ex * w0;
            if (F.lane == 0) {
                const unsigned p0 = __hip_atomic_fetch_add(cnt + e0 * 64, 1u, RLX_AGENT), p1 = __hip_atomic_fetch_add(cnt + e1 * 64, 1u, RLX_AGENT);
                unsigned* info = (unsigned*)(AP->ws + WS_TOK) + (size_t)row * 8;
                info[0] = (unsigned)e0; info[1] = (unsigned)e1; info[2] = p0; info[3] = p1; info[4] = __float_as_uint(w0); info[5] = __float_as_uint(w1);
            }
        }
    }
}
struct MoeOff { int off[9]; int cnt[8]; };
__device__ __forceinline__ void moe_offsets(Frame& F, CArgsP AP, int l, MoeOff& o) {
    const unsigned* cnt = (const unsigned*)(AP->ws + WS_CTL) + CW_CNT + (l >> 1) * 8 * 64;
    int acc = 0;
#pragma unroll
    for (int e = 0; e < 8; ++e) { const int c = (int)__builtin_amdgcn_readfirstlane(__hip_atomic_load(cnt + e * 64, RLX_AGENT)); o.cnt[e] = c; o.off[e] = acc; acc += (c + 255) & ~255; }
    o.off[8] = acc;
}
__device__ __forceinline__ void phase_moe_gather(Frame& F, CArgsP AP, int l) {
    const int gw = F.vcu * NWAVES + F.wave, NGW = F.G * NWAVES;
    MoeOff mo; moe_offsets(F, AP, l, mo);
    const bf16* XN = (const bf16*)(AP->ws + WS_XN); bf16* XS = (bf16*)(AP->ws + WS_MB);
    for (int row = gw; row < M; row += NGW) {
        unsigned* info = (unsigned*)(AP->ws + WS_TOK) + (size_t)row * 8;
        const int e0 = (int)info[0], e1 = (int)info[1]; const unsigned p0 = info[2], p1 = info[3];
        int o0 = 0, o1 = 0;
#pragma unroll
        for (int e = 0; e < 8; ++e) { o0 = (e == e0) ? mo.off[e] : o0; o1 = (e == e1) ? mo.off[e] : o1; }
        const unsigned s0 = (unsigned)o0 + p0, s1 = (unsigned)o1 + p1;
        const v4u a = *(const GAS v4u*)(XN + (size_t)row * D + 8 * F.lane), b = *(const GAS v4u*)(XN + (size_t)row * D + 512 + 8 * F.lane);
        *(GAS v4u*)(XS + (size_t)s0 * D + 8 * F.lane) = a; *(GAS v4u*)(XS + (size_t)s0 * D + 512 + 8 * F.lane) = b;
        *(GAS v4u*)(XS + (size_t)s1 * D + 8 * F.lane) = a; *(GAS v4u*)(XS + (size_t)s1 * D + 512 + 8 * F.lane) = b;
        if (F.lane == 0) { info[6] = s0; info[7] = s1; }
    }
    for (int p = gw; p < 8 * 256; p += NGW) {
        const int e = p >> 8, k = p & 255; int c = 0, o = 0;
#pragma unroll
        for (int q = 0; q < 8; ++q) { c = (q == e) ? mo.cnt[q] : c; o = (q == e) ? mo.off[q] : o; }
        if (c + k < ((c + 255) & ~255)) { const v4u z = {0u, 0u, 0u, 0u}; bf16* dst = XS + (size_t)(o + c + k) * D;
            *(GAS v4u*)(dst + 8 * F.lane) = z; *(GAS v4u*)(dst + 512 + 8 * F.lane) = z; }
    }
}
__device__ __forceinline__ void phase_post(Frame& F, CArgsP AP, int l) {
    const int gw = F.vcu * NWAVES + F.wave, NGW = F.G * NWAVES;
    bf16* P = (bf16*)(AP->ws + WS_P);
    const float* RT = (const float*)(AP->ws + WS_ROPE);
    const float C2 = 0.125f * LOG2E;
    const int hl = F.lane & 31;
    const float qg0 = AP->in[I_QNA][l * 64 + 2 * hl], qg1 = AP->in[I_QNA][l * 64 + 2 * hl + 1], kg0 = AP->in[I_KNA][l * 64 + 2 * hl], kg1 = AP->in[I_KNA][l * 64 + 2 * hl + 1];
    for (int row = gw; row < M; row += NGW) {
        const RowRef r = row_ref(row);
        float cs = 1.f, sn = 0.f;
        if (!r.isctx) { const int t = r.n - CTX, pos = hl < 16 ? (t >> 6) : (t & 63); const f32x2v c = *(const GAS f32x2v*)(RT + (size_t)(pos * 16 + (hl & 15)) * 2); cs = c.x; sn = c.y; }
        bf16* pr = P + (size_t)row * DIN;
#pragma unroll
        for (int s = 0; s < 17; ++s) {
            const int col = (s < 4) ? C_AQ + 128 * s : (s == 4) ? C_AK : (s < 9) ? C_BQ + 128 * (s - 5) : (s < 13) ? C_BK + 128 * (s - 9) : C_CQ + 128 * (s - 13);
            GAS unsigned* p = (GAS unsigned*)(pr + col) + F.lane;
            const unsigned w = *p; float x1 = bf_lo(w), x2 = bf_hi(w);
            if (s <= 4) {
                float ss = x1 * x1 + x2 * x2;
#pragma unroll
                for (int o = 1; o < 32; o <<= 1) ss += __shfl_xor(ss, o);
                const float rs = 1.0f / sqrtf(ss * (1.0f / 64.0f) + EPS);
                x1 = x1 * rs * (s < 4 ? qg0 : kg0); x2 = x2 * rs * (s < 4 ? qg1 : kg1);
            }
            if (s < 13) { const float y1 = x1 * cs - x2 * sn, y2 = x1 * sn + x2 * cs; x1 = y1; x2 = y2; }
            if (s < 4 || (s >= 5 && s < 9) || s >= 13) { x1 *= C2; x2 *= C2; }
            *p = cvtpk(x1, x2);
        }
    }
}
__device__ __forceinline__ float layer_lam_init(int l) { return 0.8f - 0.6f * __expf(-0.3f * (float)l); }
__device__ __forceinline__ void phase_bcomb(Frame& F, CArgsP AP, int l) {
    const int gw = F.vcu * NWAVES + F.wave, NGW = F.G * NWAVES;
    bf16* OB = (bf16*)(AP->ws + WS_O);
    const float li = layer_lam_init(l);
    const float s1 = wave_sum(AP->in[I_LQ1][l * 64 + F.lane] * AP->in[I_LK1][l * 64 + F.lane]), s2 = wave_sum(AP->in[I_LQ2][l * 64 + F.lane] * AP->in[I_LK2][l * 64 + F.lane]);
    const float lam = __expf(s1) - __expf(s2) + li;
    const float post = 1.0f - li;
    float sg[8];
#pragma unroll
    for (int q = 0; q < 8; ++q) sg[q] = AP->in[I_SUBLN][l * 128 + ((8 * F.lane) & 127) + q] * post;
    for (int row = gw; row < M; row += NGW) {
        bf16* pr = OB + (size_t)row * OPITCH;
        const v4u a = *(const GAS v4u*)(pr + O_B1 + 8 * F.lane), b = *(const GAS v4u*)(pr + O_B2 + 8 * F.lane);
        float d[8];
        d[0] = bf_lo(a.x) - lam * bf_lo(b.x); d[1] = bf_hi(a.x) - lam * bf_hi(b.x); d[2] = bf_lo(a.y) - lam * bf_lo(b.y); d[3] = bf_hi(a.y) - lam * bf_hi(b.y);
        d[4] = bf_lo(a.z) - lam * bf_lo(b.z); d[5] = bf_hi(a.z) - lam * bf_hi(b.z); d[6] = bf_lo(a.w) - lam * bf_lo(b.w); d[7] = bf_hi(a.w) - lam * bf_hi(b.w);
        float ss = 0.f;
#pragma unroll
        for (int q = 0; q < 8; ++q) ss += d[q] * d[q];
#pragma unroll
        for (int o = 1; o < 16; o <<= 1) ss += __shfl_xor(ss, o);
        const float rs = 1.0f / sqrtf(ss * (1.0f / 128.0f) + EPS);
        v4u o; o.x = cvtpk(d[0] * rs * sg[0], d[1] * rs * sg[1]); o.y = cvtpk(d[2] * rs * sg[2], d[3] * rs * sg[3]); o.z = cvtpk(d[4] * rs * sg[4], d[5] * rs * sg[5]); o.w = cvtpk(d[6] * rs * sg[6], d[7] * rs * sg[7]);
        *(GAS v4u*)(pr + O_B1 + 8 * F.lane) = o;
    }
}
__device__ __forceinline__ void phase_final(Frame& F, CArgsP AP, bool poison) {
    const int gw = F.vcu * NWAVES + F.wave, NGW = F.G * NWAVES;
    const float* g = AP->in[I_GFINAL];
    for (int lr = gw; lr < BATCH * SEQ; lr += NGW) {
        const int b = lr / SEQ, t = lr - b * SEQ, row = b * NTOK + CTX + t;
        const RowRef r = row_ref(row); float* xr = row_x(F, AP, r);
        f32x4 v[4]; load_row(xr, F.lane, v);
        moe_combine(F, AP, row, r, DEPTH - 1, v);
        const float rstd = row_rstd(v);
#pragma unroll
        for (int j = 0; j < 4; ++j) { const f32x4 gg = *(const GAS f32x4*)(g + 256 * j + 4 * F.lane); v[j] = (v[j] * rstd) * gg;
            if (poison) { const float q = __builtin_nanf(""); v[j] = (f32x4){q, q, q, q}; } }
        store_row(xr, F.lane, v);
    }
}

struct SchedPlain {
    pg8::TileOrder T; size_t astep, bstep;
    __device__ __forceinline__ bool next(int i, pg8::Unit& u) const { if (!T.tile(i, u.pm, u.pn)) return false; u.aux = 0; u.aoff = (size_t)u.pm * astep; u.boff = (size_t)u.pn * bstep; return true; }
    __device__ __forceinline__ void a_ready(const pg8::Unit&) const {}
    __device__ __forceinline__ void done(const pg8::Unit&) const {}
};
struct SchedMerge {
    pg8::TileOrder T;
    __device__ __forceinline__ bool next(int i, pg8::Unit& u) const {
        const int ti = i / 3, br = i - ti * 3; if (!T.tile(ti, u.pm, u.pn)) return false; u.aux = br;
        const int acol = br == 0 ? O_A : br == 1 ? O_B1 : O_C;
        u.aoff = ((size_t)u.pm * 256 * OPITCH + acol) * 2; u.boff = ((size_t)br * D + u.pn * 256) * 512 * 2; return true; }
    __device__ __forceinline__ void a_ready(const pg8::Unit&) const {}
    __device__ __forceinline__ void done(const pg8::Unit&) const {}
};
struct SchedMoe {
    pg8::TileOrder T; int pp1, pp2, pp3, pp4, pp5, pp6, pp7; size_t astep, bexp, bstep;
    __device__ __forceinline__ void init(const MoeOff& o, int nN, int G, int c, size_t astep_, size_t bexp_, size_t bstep_) {
        T.init(o.off[8] >> 8, nN, G, c); pp1 = o.off[1] >> 8; pp2 = o.off[2] >> 8; pp3 = o.off[3] >> 8; pp4 = o.off[4] >> 8; pp5 = o.off[5] >> 8; pp6 = o.off[6] >> 8; pp7 = o.off[7] >> 8;
        astep = astep_; bexp = bexp_; bstep = bstep_; }
    __device__ __forceinline__ bool next(int i, pg8::Unit& u) const {
        if (!T.tile(i, u.pm, u.pn)) return false;
        const int e = (u.pm >= pp1) + (u.pm >= pp2) + (u.pm >= pp3) + (u.pm >= pp4) + (u.pm >= pp5) + (u.pm >= pp6) + (u.pm >= pp7);
        u.aux = e; u.aoff = (size_t)u.pm * astep; u.boff = (size_t)e * bexp + (size_t)u.pn * bstep; return true; }
    __device__ __forceinline__ void a_ready(const pg8::Unit&) const {}
    __device__ __forceinline__ void done(const pg8::Unit&) const {}
};
using pg8::f32x4;
struct EpiStore {
    static constexpr bool PERM = true, AFTER_DRAIN = false;
    bf16* O; int ldc;
    __device__ __forceinline__ void operator()(const pg8::f32x4 (&acc)[2][2][4][2], const pg8::Unit& u, int wr, int wc, int fr, int fq) const {
        const int row0 = u.pm * 256 + wr * 64 + fr, col0 = u.pn * 256 + wc * 32 + 8 * fq;
#pragma unroll
        for (int ai = 0; ai < 2; ++ai)
#pragma unroll
            for (int m = 0; m < 4; ++m) { bf16* rowp = O + (size_t)(row0 + ai * 128 + m * 16) * ldc + col0;
#pragma unroll
                for (int bj = 0; bj < 2; ++bj) { const pg8::f32x4 v0 = acc[ai][bj][m][0], v1 = acc[ai][bj][m][1];
                    v4u w; w.x = cvtpk(v0[0], v0[1]); w.y = cvtpk(v0[2], v0[3]); w.z = cvtpk(v1[0], v1[1]); w.w = cvtpk(v1[2], v1[3]);
                    *(GAS v4u*)(rowp + bj * 128) = w; } }
    }
};
struct EpiSwiglu {
    static constexpr bool PERM = true, AFTER_DRAIN = false;
    bf16* H; int ldh;
    __device__ __forceinline__ void operator()(const pg8::f32x4 (&acc)[2][2][4][2], const pg8::Unit& u, int wr, int wc, int fr, int fq) const {
        const int row0 = u.pm * 256 + wr * 64 + fr, hid0 = u.pn * 128 + wc * 32 + 8 * fq;
#pragma unroll
        for (int ai = 0; ai < 2; ++ai)
#pragma unroll
            for (int m = 0; m < 4; ++m) { bf16* rowp = H + (size_t)(row0 + ai * 128 + m * 16) * ldh + hid0;
                float h[8];
#pragma unroll
                for (int n = 0; n < 2; ++n)
#pragma unroll
                    for (int q = 0; q < 4; ++q) { const float g = acc[ai][0][m][n][q], up = acc[ai][1][m][n][q]; h[4 * n + q] = g * sigmoidf_(g) * up; }
                v4u w; w.x = cvtpk(h[0], h[1]); w.y = cvtpk(h[2], h[3]); w.z = cvtpk(h[4], h[5]); w.w = cvtpk(h[6], h[7]);
                *(GAS v4u*)rowp = w; }
    }
};
struct EpiMerge {
    static constexpr bool PERM = true, AFTER_DRAIN = false;
    const bf16* P; float* Mf; bf16* Mb;
    __device__ __forceinline__ void operator()(const pg8::f32x4 (&acc)[2][2][4][2], const pg8::Unit& u, int wr, int wc, int fr, int fq) const {
        const int br = u.aux, row0 = u.pm * 256 + wr * 64 + fr, col0 = u.pn * 256 + wc * 32 + 8 * fq;
#pragma unroll
        for (int ai = 0; ai < 2; ++ai)
#pragma unroll
            for (int m = 0; m < 4; ++m) { const size_t row = (size_t)(row0 + ai * 128 + m * 16);
#pragma unroll
                for (int bj = 0; bj < 2; ++bj) { const int col = col0 + bj * 128;
                    const v4u gw = *(const GAS v4u*)(P + row * DIN + C_G + br * D + col);
                    const pg8::f32x4 v0 = acc[ai][bj][m][0], v1 = acc[ai][bj][m][1];
                    pg8::f32x4 r0, r1;
                    r0[0] = sigmoidf_(bf_lo(gw.x)) * v0[0]; r0[1] = sigmoidf_(bf_hi(gw.x)) * v0[1]; r0[2] = sigmoidf_(bf_lo(gw.y)) * v0[2]; r0[3] = sigmoidf_(bf_hi(gw.y)) * v0[3];
                    r1[0] = sigmoidf_(bf_lo(gw.z)) * v1[0]; r1[1] = sigmoidf_(bf_hi(gw.z)) * v1[1]; r1[2] = sigmoidf_(bf_lo(gw.w)) * v1[2]; r1[3] = sigmoidf_(bf_hi(gw.w)) * v1[3];
                    float* mp = Mf + row * D + col;
                    if (br != 0) { r0 += *(const GAS pg8::f32x4*)mp; r1 += *(const GAS pg8::f32x4*)(mp + 4); }
                    if (br != 2) { *(GAS pg8::f32x4*)mp = r0; *(GAS pg8::f32x4*)(mp + 4) = r1; }
                    else { v4u w; w.x = cvtpk(r0[0], r0[1]); w.y = cvtpk(r0[2], r0[3]); w.z = cvtpk(r1[0], r1[1]); w.w = cvtpk(r1[2], r1[3]); *(GAS v4u*)(Mb + row * D + col) = w; } }
                if (m & 1) asm volatile("" ::: "memory"); }
    }
};
struct EpiResid {
    static constexpr bool PERM = false, AFTER_DRAIN = false;
    float* XL; float* XC; const float* gate;
    __device__ __forceinline__ void operator()(const pg8::f32x4 (&acc)[2][2][4][2], const pg8::Unit& u, int wr, int wc, int fr, int fq) const {
        const int b = u.pm / PANELS_PER_B, j = u.pm - b * PANELS_PER_B;
        float* base = (j == 0) ? XC + (size_t)(b * CTX) * D : XL + (size_t)(b * SEQ + (j - 1) * 256) * D;
        const float* gv = gate + (size_t)((j == 0) ? 4 : b) * 6144;
        const int col0 = u.pn * 256 + wc * 32 + 4 * fq;
        pg8::f32x4 g4[2][2];
#pragma unroll
        for (int bj = 0; bj < 2; ++bj)
#pragma unroll
            for (int n = 0; n < 2; ++n) g4[bj][n] = *(const GAS pg8::f32x4*)(gv + col0 + bj * 128 + n * 16);
#pragma unroll
        for (int ai = 0; ai < 2; ++ai)
#pragma unroll
            for (int m = 0; m < 4; ++m) { float* rowp = base + (size_t)(wr * 64 + fr + ai * 128 + m * 16) * D + col0;
#pragma unroll
                for (int bj = 0; bj < 2; ++bj)
#pragma unroll
                    for (int n = 0; n < 2; ++n) { GAS pg8::f32x4* p = (GAS pg8::f32x4*)(rowp + bj * 128 + n * 16); *p = *p + g4[bj][n] * acc[ai][bj][m][n]; }
                if (m & 1) asm volatile("" ::: "memory"); }
    }
};

__device__ __forceinline__ void phase_attn(Frame& F, CArgsP AP, int l, unsigned char* lds_generic) {
    using abf = attn_body::bf16;
    const abf* P = (const abf*)(AP->ws + WS_P); abf* OB = (abf*)(AP->ws + WS_O);
    char* shm = (char*)lds_generic + RING_OFF;
    LAS float* bt = (LAS float*)(F.lds + BIAS_OFF);
    for (int i = F.tid; i < 8 * 465; i += NWAVES * 64) bt[i] = AP->in[I_RPB][(size_t)l * 8 * 465 + i] * LOG2E;
    __syncthreads();
    const int nunits = 4096 + ((l < DEPTH - 1) ? 128 : 0);
    for (int f = F.vcu; f < nunits; f += F.G) {
        const int round = f >> 8, v = f & 255, x = v >> 5, c = v & 31;
        if (round >= 12 && round < 16) continue;
        int b, qcol, kcol, vcol, ocol, qrow, NT;
        if (round < 4) { b = x >> 1; const int kvh = x & 1, qh = kvh * 4 + round; qcol = C_AQ + qh * 64; kcol = C_AK + kvh * 64; vcol = C_AV + kvh * 64; ocol = O_A + qh * 64; qrow = CTX + 256 * c; NT = NTOK / 64; }
        else if (round < 12) { const int i8 = round - 4; b = x >> 1; const int head = 2 * (x & 1) + (i8 >> 2), map = (i8 >> 1) & 1, vh = i8 & 1;
            qcol = C_BQ + map * 256 + head * 64; kcol = C_BK + map * 256 + head * 64; vcol = C_BV + head * 128 + vh * 64; ocol = (map ? O_B2 : O_B1) + head * 128 + vh * 64; qrow = CTX + 256 * c; NT = NTOK / 64; }
        else { const int uu = f - 4096; NT = CTX / 64; qrow = 0;
            if (uu < 32) { b = uu >> 3; const int qh = uu & 7, kvh = qh >> 2; qcol = C_AQ + qh * 64; kcol = C_AK + kvh * 64; vcol = C_AV + kvh * 64; ocol = O_A + qh * 64; }
            else if (uu < 96) { const int w = uu - 32; b = w >> 4; const int head = (w >> 2) & 3, map = (w >> 1) & 1, vh = w & 1;
                qcol = C_BQ + map * 256 + head * 64; kcol = C_BK + map * 256 + head * 64; vcol = C_BV + head * 128 + vh * 64; ocol = (map ? O_B2 : O_B1) + head * 128 + vh * 64; }
            else { const int w = uu - 96; b = w >> 3; const int h = w & 7; qcol = C_CQ + h * 64; kcol = C_CK + h * 64; vcol = C_CV + h * 64; ocol = O_C + h * 64; } }
        const size_t r0 = (size_t)b * NTOK;
        attn_body::attn_unit<8, false>(P + (r0 + qrow) * DIN + qcol, P + r0 * DIN + kcol, P + r0 * DIN + vcol, OB + (r0 + qrow) * OPITCH + ocol, NT, 0, 0, (attn_body::lds_cfptr)bt, shm);
    }
    for (int f = F.vcu + 12 * 256; f < 4096; f += F.G) {
        const int round = f >> 8, v = f & 255, x = v >> 5, c = v & 31;
        if (round < 12) continue;
        const int b = x >> 1, h = 4 * (x & 1) + (round - 12), g0 = 4 * c; int kr0 = g0 - 4; kr0 = kr0 < 0 ? 0 : (kr0 > 116 ? 116 : kr0);
        const size_t r0 = (size_t)b * NTOK; const int qrow = CTX + 256 * c;
        attn_body::attn_unit<8, true>(P + (r0 + qrow) * DIN + C_CQ + h * 64, P + r0 * DIN + C_CK + h * 64, P + r0 * DIN + C_CV + h * 64, OB + (r0 + qrow) * OPITCH + O_C + h * 64, 16, kr0, g0,
                                      (attn_body::lds_cfptr)(bt + h * 465), shm);
    }
}

__global__ void __launch_bounds__(NWAVES * 64, 2) fwd_kernel(Args args) {
    extern __shared__ __attribute__((aligned(16))) unsigned char lds[];
    Frame F;
    F.lds = (LAS unsigned char*)lds;
    REFRESH(F);
    F.G = gridDim.x; { const int bx = blockIdx.x; F.vcu = (F.G % 8 == 0) ? (bx % 8) * (F.G / 8) + bx / 8 : bx; }
    for (int u = F.tid; u < (LDS_BYTES - LDSCTL_OFF) / 4; u += NWAVES * 64) ((LAS unsigned*)(F.lds + LDSCTL_OFF))[u] = 0u;
    __syncthreads();
    XcdBarrier bar;
    {   CArgsP AP = fresh_args(); bar = xcd_barrier_post((unsigned*)(AP->ws + WS_CTL) + CW_BAR, (volatile LAS unsigned*)(F.lds + MISC_OFF) + 8); }
#define GRID_BAR() xcd_barrier(bar)
#define PH(...) do { REFRESH(F); CArgsP AP = fresh_args(); __VA_ARGS__; } while (0)
    const int G = F.G, cblk = (int)blockIdx.x;

    PH(prologue_mod(F, AP));
    PH(convert_weights(F, AP, 0));
    GRID_BAR();

    for (int l = 0; l < DEPTH; ++l) {
        if (l > 0) { PH(convert_weights(F, AP, l)); }
        PH(phase_norm1(F, AP, l));
        GRID_BAR();
        {   CArgsP AP = fresh_args();
            pg8::Gemm g{(const bf16*)(AP->ws + WS_XN), (const bf16*)(AP->ws + WS_WIN), D, D, D};
            SchedPlain S; S.T.init(M / 256, DIN / 256, G, cblk); S.astep = (size_t)256 * D * 2; S.bstep = (size_t)256 * D * 2;
            EpiStore E{(bf16*)(AP->ws + WS_P), DIN};
            pg8::gemm_phase<EpiStore, SchedPlain, true>(F.lds + RING_OFF, g, S, E); }
        GRID_BAR();
        PH(phase_post(F, AP, l));
        GRID_BAR();
        PH(phase_attn(F, AP, l, lds));
        GRID_BAR();
        PH(phase_bcomb(F, AP, l));
        GRID_BAR();
        {   CArgsP AP = fresh_args();
            pg8::Gemm g{(const bf16*)(AP->ws + WS_O), (const bf16*)(AP->ws + WS_WBR), OPITCH, 512, 512};
            SchedMerge S; S.T.init(M / 256, D / 256, G, cblk);
            EpiMerge E{(const bf16*)(AP->ws + WS_P), (float*)(AP->ws + WS_MB), (bf16*)(AP->ws + WS_XN)};
            pg8::gemm_phase<EpiMerge, SchedMerge, true>(F.lds + RING_OFF, g, S, E); }
        GRID_BAR();
        {   CArgsP AP = fresh_args();
            pg8::Gemm g{(const bf16*)(AP->ws + WS_XN), (const bf16*)(AP->ws + WS_WOUT), D, D, D};
            SchedPlain S; S.T.init(M / 256, D / 256, G, cblk); S.astep = (size_t)256 * D * 2; S.bstep = (size_t)256 * D * 2;
            EpiResid E{AP->out, (float*)(AP->ws + WS_XC), (const float*)(AP->ws + WS_MOD) + (size_t)(l * 5) * 6144 + 2 * 1024};
            pg8::gemm_phase<EpiResid, SchedPlain, true>(F.lds + RING_OFF, g, S, E); }
        GRID_BAR();
        PH(phase_norm2(F, AP, l));
        GRID_BAR();
        if (!(l & 1)) {
            {   CArgsP AP = fresh_args();
                pg8::Gemm g{(const bf16*)(AP->ws + WS_XN), (const bf16*)(AP->ws + WS_W13), D, D, D};
                SchedPlain S; S.T.init(M / 256, 2 * FF / 256, G, cblk); S.astep = (size_t)256 * D * 2; S.bstep = (size_t)256 * D * 2;
                EpiSwiglu E{(bf16*)(AP->ws + WS_P), FF};
                pg8::gemm_phase<EpiSwiglu, SchedPlain, true>(F.lds + RING_OFF, g, S, E); }
            GRID_BAR();
            {   CArgsP AP = fresh_args();
                pg8::Gemm g{(const bf16*)(AP->ws + WS_P), (const bf16*)(AP->ws + WS_W2), FF, FF, FF};
                SchedPlain S; S.T.init(M / 256, D / 256, G, cblk); S.astep = (size_t)256 * FF * 2; S.bstep = (size_t)256 * FF * 2;
                EpiResid E{AP->out, (float*)(AP->ws + WS_XC), (const float*)(AP->ws + WS_MOD) + (size_t)(l * 5) * 6144 + 5 * 1024};
                pg8::gemm_phase<EpiResid, SchedPlain, true>(F.lds + RING_OFF, g, S, E); }
            GRID_BAR();
        } else {
            PH(phase_moe_gather(F, AP, l));
            GRID_BAR();
            {   CArgsP AP = fresh_args();
                MoeOff mo; moe_offsets(F, AP, l, mo);
                pg8::Gemm g{(const bf16*)(AP->ws + WS_MB), (const bf16*)(AP->ws + WS_W13), D, D, D};
                SchedMoe S; S.init(mo, 2 * FE / 256, G, cblk, (size_t)256 * D * 2, (size_t)2 * FE * D * 2, (size_t)256 * D * 2);
                EpiSwiglu E{(bf16*)(AP->ws + WS_P), FE};
                pg8::gemm_phase<EpiSwiglu, SchedMoe, true>(F.lds + RING_OFF, g, S, E); }
            GRID_BAR();
            {   CArgsP AP = fresh_args();
                MoeOff mo; moe_offsets(F, AP, l, mo);
                pg8::Gemm g{(const bf16*)(AP->ws + WS_P), (const bf16*)(AP->ws + WS_W2), FE, FE, FE};
                SchedMoe S; S.init(mo, D / 256, G, cblk, (size_t)256 * FE * 2, (size_t)D * FE * 2, (size_t)256 * FE * 2);
                EpiStore E{(bf16*)(AP->ws + WS_YS), D};
                pg8::gemm_phase<EpiStore, SchedMoe, true>(F.lds + RING_OFF, g, S, E); }
            GRID_BAR();
        }
    }
    {   REFRESH(F); CArgsP AP = fresh_args();
        const bool poison = __hip_atomic_load((unsigned*)(AP->ws + WS_CTL) + CW_BAR + XB_TMO, RLX_AGENT) != 0u;
        phase_final(F, AP, poison); }
}

extern "C" void kernel_launch(void* const* d_in, const int* in_sizes, int n_in, void* d_out, int out_size, void* d_ws, size_t ws_size, hipStream_t stream) {
    static int grid = 0;
    if (grid == 0) {
        if (n_in != N_IN || in_sizes[0] != BATCH * SEQ * D || out_size != BATCH * SEQ * D || ws_size < WS_END) {
            fprintf(stderr, "kernel_launch: unexpected shapes: n_in %d in0 %d out %d ws %zu (need %zu)\n", n_in, n_in > 0 ? in_sizes[0] : -1, out_size, ws_size, (size_t)WS_END); grid = -1; return; }
        int dev = 0, cus = 0;
        if (hipGetDevice(&dev) != hipSuccess || hipDeviceGetAttribute(&cus, hipDeviceAttributeMultiprocessorCount, dev) != hipSuccess) { fprintf(stderr, "kernel_launch: device query failed\n"); grid = -1; return; }
        if (hipFuncSetAttribute((const void*)fwd_kernel, hipFuncAttributeMaxDynamicSharedMemorySize, LDS_BYTES) != hipSuccess) { fprintf(stderr, "kernel_launch: hipFuncSetAttribute failed\n"); grid = -1; return; }
        int per_cu = 0;
        if (hipOccupancyMaxActiveBlocksPerMultiprocessor(&per_cu, (const void*)fwd_kernel, NWAVES * 64, LDS_BYTES) != hipSuccess || per_cu < 1)
            fprintf(stderr, "kernel_launch: note: occupancy query reports %d workgroups per CU\n", per_cu);
        (void)hipGetLastError();
        grid = cus;
    }
    if (grid < 0) return;
    if (hipMemsetAsync((char*)d_ws + WS_CTL, 0, CTL_ZERO_BYTES, stream) != hipSuccess) { fprintf(stderr, "kernel_launch: memset failed\n"); return; }
    Args a{};
    for (int i = 0; i < N_IN; ++i) a.in[i] = (const float*)d_in[i];
    a.out = (float*)d_out; a.ws = (unsigned char*)d_ws;
    hipLaunchKernelGGL(fwd_kernel, dim3(grid), dim3(NWAVES * 64), LDS_BYTES, stream, a);
    const hipError_t le = hipPeekAtLastError();
    if (le != hipSuccess) fprintf(stderr, "kernel_launch: launch failed: %s\n", hipGetErrorName(le));
}
```

```cpp
#include <hip/hip_runtime.h>
#include <cstdio>
#include <cstdint>
namespace pg8 {
#define PG8_LAS __attribute__((address_space(3)))
typedef unsigned short bf16_t;
typedef short bf16x8 __attribute__((ext_vector_type(8)));
typedef float f32x4 __attribute__((ext_vector_type(4)));
typedef unsigned u32x4 __attribute__((ext_vector_type(4)));
constexpr int BM = 256, BK = 64, HALF = 128, HTB = HALF * BK * 2  , STAGE_BYTES = 8 * HTB, NXCD = 8, WGM = 8;

__host__ __device__ __forceinline__ int lds_byte(int r, int c) { const int st = (r >> 4) * 2 + (c >> 5), rr = r & 15, cc = c & 31, ob = rr * 64 + cc * 2; return st * 1024 + (ob ^ (((ob >> 9) & 1) << 5)); }
__host__ __device__ __forceinline__ void stage_rc(int b, int& R, int& C) { const int st = b / 1024, sb = b % 1024, swz = sb ^ (((sb >> 9) & 1) << 5); R = (st >> 1) * 16 + swz / 64; C = (st & 1) * 32 + (swz % 64) / 2; }
__host__ __device__ __forceinline__ int perm32(int rho) { const int n = rho >> 4, i = rho & 15; return 8 * (i >> 2) + 4 * n + (i & 3); }

struct Unit { int pm, pn, aux, nt; size_t aoff, boff; };
struct Gemm { const bf16_t* A; const bf16_t* Bt; int lda, ldb, K; };

struct TileOrder {
    int nM, nN, nwg, G, c;
    __host__ __device__ void init(int nM_, int nN_, int G_, int c_) { nM = nM_; nN = nN_; nwg = nM * nN; G = G_; c = c_; }
    __host__ __device__ bool tile(int i, int& pm, int& pn) const { return tile_at((long)i * G + c, pm, pn); }
    __host__ __device__ bool tile_at(long L, int& pm, int& pn) const {
        if (L >= nwg) return false;
        int wgid = (int)L; { const int q = nwg / NXCD, r = nwg % NXCD, xcd = wgid % NXCD, off = wgid / NXCD; wgid = (xcd < r ? xcd * (q + 1) : r * (q + 1) + (xcd - r) * q) + off; }
        const int nig = WGM * nN, gid = wgid / nig, fm = gid * WGM, gsz = (nM - fm) < WGM ? (nM - fm) : WGM;
        pm = fm + ((wgid % nig) % gsz); pn = (wgid % nig) / gsz; return true;
    }
};
__device__ __forceinline__ unsigned cvt_pk_bf16(float lo, float hi) { unsigned r; asm volatile("v_cvt_pk_bf16_f32 %0, %1, %2" : "=v"(r) : "v"(lo), "v"(hi)); return r; }
typedef float f32x2 __attribute__((ext_vector_type(2)));

typedef int i32x4_t __attribute__((ext_vector_type(4)));
typedef int i32x8_t __attribute__((ext_vector_type(8)));
__device__ __forceinline__ i32x8_t cat8(bf16x8 a, bf16x8 b) { const i32x4_t lo = __builtin_bit_cast(i32x4_t, a), hi = __builtin_bit_cast(i32x4_t, b); return __builtin_shufflevector(lo, hi, 0, 1, 2, 3, 4, 5, 6, 7); }
__device__ __forceinline__ void mfma8(f32x4& acc, i32x8_t a, i32x8_t b) { asm volatile("v_mfma_f32_16x16x128_f8f6f4 %0, %1, %2, %0" : "+v"(acc) : "v"(a), "v"(b)); }
template <class Epi, class Sched, bool ALIGN_EPI = false, bool F8 = false>
__device__ __forceinline__ void gemm_phase(PG8_LAS unsigned char* lds, const Gemm g, const Sched& S, const Epi& E, const bool do_epi = true) {
    int tid_ = threadIdx.x; asm volatile("; LAUNDER" : "+v"(tid_));
    const int tid = tid_, wid = __builtin_amdgcn_readfirstlane(tid >> 6), lane = tid & 63, wr = wid >> 2, wc = wid & 3, fr = lane & 15, fq = lane >> 4;
    (void)g.K;
    unsigned voffA[2], voffB[2];
#pragma unroll
    for (int i = 0; i < 2; ++i) { int R, C; stage_rc(tid * 16 + i * 8192, R, C); const int Rb = Epi::PERM ? ((R & ~31) + perm32(R & 31)) : R;
        if constexpr (F8) { const int p = C >> 3, gch = (p < 4) ? 2 * p : 2 * (p - 4) + 1; voffA[i] = (unsigned)(R * g.lda + 16 * gch); voffB[i] = (unsigned)(Rb * g.ldb + 16 * gch); }
        else { voffA[i] = (unsigned)(R * g.lda + C) * 2u; voffB[i] = (unsigned)(Rb * g.ldb + C) * 2u; } }
    const size_t kstep = (size_t)(BK * 2);
    const size_t hstepA = (size_t)HALF * g.lda * (F8 ? 1 : 2), hstepB = (size_t)HALF * g.ldb * (F8 ? 1 : 2);
    const unsigned ldsw = (unsigned)wid * 1024u;
    const int aoff = lds_byte(wr * 64 + fr, fq * 8), boff = lds_byte(wc * 32 + fr, fq * 8);
#define PG8_SA(b, h) (((b) * 2 + (h)) * HTB)
#define PG8_SB(b, h) ((4 + (b) * 2 + (h)) * HTB)
#define PG8_STAGE(bufoff, gbase, voff) do { _Pragma("unroll") for (int _i = 0; _i < 2; ++_i) \
        __builtin_amdgcn_global_load_lds((const unsigned*)((const char*)(gbase) + (voff)[_i]), (PG8_LAS unsigned*)(lds + (bufoff) + ldsw + _i * 8192), 16, 0, 0); } while (0)
#define PG8_LDA(dst, b, h) do { _Pragma("unroll") for (int m = 0; m < 4; ++m) _Pragma("unroll") for (int k = 0; k < 2; ++k) dst[m][k] = *(const PG8_LAS bf16x8*)(lds + PG8_SA(b, h) + aoff + m * 2048 + k * 1024); } while (0)
#define PG8_LDB(dst, b, h) do { _Pragma("unroll") for (int n = 0; n < 2; ++n) _Pragma("unroll") for (int k = 0; k < 2; ++k) dst[n][k] = *(const PG8_LAS bf16x8*)(lds + PG8_SB(b, h) + boff + n * 2048 + k * 1024); } while (0)
#define PG8_MMA(ai, bj, At, Bt) do { __builtin_amdgcn_s_setprio(1); if constexpr (F8) { _Pragma("unroll") for (int m = 0; m < 4; ++m) _Pragma("unroll") for (int n = 0; n < 2; ++n) \
        mfma8(acc[ai][bj][m][n], cat8(Bt[n][0], Bt[n][1]), cat8(At[m][0], At[m][1])); } else { \
        _Pragma("unroll") for (int m = 0; m < 4; ++m) _Pragma("unroll") for (int n = 0; n < 2; ++n) _Pragma("unroll") for (int k = 0; k < 2; ++k) \
        acc[ai][bj][m][n] = __builtin_amdgcn_mfma_f32_16x16x32_bf16(Bt[n][k], At[m][k], acc[ai][bj][m][n], 0, 0, 0); } __builtin_amdgcn_s_setprio(0); } while (0)
#define PG8_WAIT_V(n) asm volatile("s_waitcnt vmcnt(" #n ")" ::: "memory")
#define PG8_WAIT_L(n) asm volatile("s_waitcnt lgkmcnt(" #n ")" ::: "memory")
#define PG8_BAR __builtin_amdgcn_s_barrier()
#define PG8_SCHED __builtin_amdgcn_sched_barrier(0)
    Unit cur, nxt; int ui = 0;
    if (!S.next(0, cur)) return;
    f32x4 acc[2][2][4][2];
#pragma unroll
    for (int a = 0; a < 2; ++a)
#pragma unroll
        for (int b = 0; b < 2; ++b)
#pragma unroll
            for (int m = 0; m < 4; ++m)
#pragma unroll
                for (int n = 0; n < 2; ++n) acc[a][b][m][n] = (f32x4){0.f, 0.f, 0.f, 0.f};
    bf16x8 At[4][2], B0[2][2], B1[2][2];
    const char* cA = (const char*)g.A + cur.aoff; const char* cB = (const char*)g.Bt + cur.boff;
    S.a_ready(cur);
    PG8_STAGE(PG8_SB(0, 0), cB, voffB); PG8_STAGE(PG8_SB(0, 1), cB + hstepB, voffB); PG8_STAGE(PG8_SA(0, 0), cA, voffA); PG8_STAGE(PG8_SA(0, 1), cA + hstepA, voffA);
    if (wr == 1) PG8_BAR;
    PG8_WAIT_V(2); PG8_BAR;
    PG8_STAGE(PG8_SB(1, 0), cB + kstep, voffB); PG8_STAGE(PG8_SA(1, 0), cA + kstep, voffA); PG8_STAGE(PG8_SB(1, 1), cB + hstepB + kstep, voffB);
    PG8_WAIT_V(6); PG8_BAR;
    for (;;) {
        const bool has_next = S.next(ui + 1, nxt);
        const char* nA = has_next ? (const char*)g.A + nxt.aoff : cA; const char* nB = has_next ? (const char*)g.Bt + nxt.boff : cB;
        const int nt = cur.nt;
        for (int t = 0; t < nt; t += 2) {
            const bool last = (t == nt - 2);
            const char* a1 = cA + (size_t)(t + 1) * kstep;
            const char* a2 = last ? nA : cA + (size_t)(t + 2) * kstep; const char* b2 = last ? nB : cB + (size_t)(t + 2) * kstep;
            const char* a3 = a2 + kstep; const char* b3 = b2 + kstep;
            if (last && has_next) S.a_ready(nxt);
            PG8_LDB(B0, 0, 0); PG8_LDB(B1, 0, 1); PG8_SCHED; PG8_LDA(At, 0, 0); PG8_STAGE(PG8_SA(1, 1), a1 + hstepA, voffA);
            PG8_WAIT_V(8); PG8_WAIT_L(0); PG8_BAR; PG8_MMA(0, 0, At, B0); PG8_MMA(0, 1, At, B1); PG8_BAR; PG8_SCHED;
            PG8_LDA(At, 0, 1); PG8_STAGE(PG8_SB(0, 0), b2, voffB); PG8_STAGE(PG8_SB(0, 1), b2 + hstepB, voffB); PG8_STAGE(PG8_SA(0, 0), a2, voffA);
            PG8_WAIT_V(8); PG8_WAIT_L(0); PG8_BAR; PG8_MMA(1, 0, At, B0); PG8_MMA(1, 1, At, B1); PG8_BAR; PG8_SCHED;
            PG8_LDB(B0, 1, 0); PG8_LDB(B1, 1, 1); PG8_SCHED; PG8_LDA(At, 1, 0); PG8_STAGE(PG8_SA(0, 1), a2 + hstepA, voffA);
            PG8_WAIT_V(8); PG8_WAIT_L(0); PG8_BAR; PG8_MMA(0, 0, At, B0); PG8_MMA(0, 1, At, B1); PG8_BAR; PG8_SCHED;
            PG8_LDA(At, 1, 1); PG8_STAGE(PG8_SB(1, 0), b3, voffB); PG8_STAGE(PG8_SB(1, 1), b3 + hstepB, voffB); PG8_STAGE(PG8_SA(1, 0), a3, voffA);
            PG8_WAIT_V(8); PG8_WAIT_L(0); PG8_BAR; PG8_MMA(1, 0, At, B0); PG8_MMA(1, 1, At, B1); PG8_BAR; PG8_SCHED;
        }
        if constexpr (ALIGN_EPI) { if (wr == 0) PG8_BAR; }
        if constexpr (F8) asm volatile("s_nop 15\n\ts_nop 15 ; F8NOP: asm MFMA results -> VALU readers" ::: "memory");
        if constexpr (!Epi::AFTER_DRAIN) { if (do_epi) E(acc, cur, wr, wc, fr, fq); S.done(cur); }
        if (!has_next) break;
#pragma unroll
        for (int a = 0; a < 2; ++a)
#pragma unroll
            for (int b = 0; b < 2; ++b)
#pragma unroll
                for (int m = 0; m < 4; ++m)
#pragma unroll
                    for (int n = 0; n < 2; ++n) acc[a][b][m][n] = (f32x4){0.f, 0.f, 0.f, 0.f};
        cur = nxt; cA = nA; cB = nB; ++ui;
        if constexpr (ALIGN_EPI) { if (wr == 1) PG8_BAR; }
    }
    PG8_WAIT_V(0);
    if constexpr (!ALIGN_EPI) { if (wr == 0) PG8_BAR; }
    PG8_BAR;
    if constexpr (Epi::AFTER_DRAIN) { E.fused(acc, cur, wr, wc, fr, fq, lds, wid, lane); S.done(cur); }
#undef PG8_SA
#undef PG8_SB
#undef PG8_STAGE
#undef PG8_LDA
#undef PG8_LDB
#undef PG8_MMA
#undef PG8_WAIT_V
#undef PG8_WAIT_L
#undef PG8_BAR
#undef PG8_SCHED
}
}
#include <hip/hip_bf16.h>
#include <cmath>
#include <hip/hip_bf16.h>
#include <cmath>
namespace attn_body {
using bf16=__hip_bfloat16;
using bf16x8=__attribute__((ext_vector_type(8)))short;
using s16x4=__attribute__((ext_vector_type(4)))short;
using f32x16=__attribute__((ext_vector_type(16)))float;
using u32x4=__attribute__((ext_vector_type(4)))unsigned;
constexpr int D=64, QKP=64, OPITCH=2048;
constexpr long QKV_BLK=33792L*64;
constexpr int NW=8,QBLK=32,QB=QBLK*NW,KVBLK=64;
constexpr int ATTN_UNIT_ROWS=QB;
__device__ __forceinline__ int crow(int r,int hi){return (r&3)+8*(r>>2)+4*hi;}
#define SBAR() __builtin_amdgcn_sched_barrier(0)
typedef __attribute__((address_space(3))) const float* lds_cfptr;
__device__ __forceinline__ void cbias(f32x16&p0,f32x16&p1,int t,int kr0,int r0,int wid,int r32,int hi,lds_cfptr bt){
  if(t<4)return;
  asm volatile("; LAUNDER":"+v"(r32),"+v"(hi));
  const float NEG=-INFINITY; const int kr=kr0+t-4, r=r0+(wid>>1); int rs=r-4; rs=rs<0?0:(rs>120?120:rs);
  if(kr<rs||kr>=rs+8){
    #pragma unroll
    for(int rr=0;rr<16;++rr){p0[rr]=NEG;p1[rr]=NEG;}
    return; }
  const int dr=kr-r+7, qc=32*(wid&1)+r32; int cs=qc-8; cs=cs<0?0:(cs>48?48:cs);
  const lds_cfptr brow=bt+dr*31;
  #pragma unroll
  for(int rr=0;rr<16;++rr){
    const int kc=(rr&3)+8*(rr>>2)+4*hi;
    { const int dc=kc-qc+15; const bool ok=(kc>=cs)&&(kc<cs+16); const int di=dc<0?0:(dc>30?30:dc); const float b=brow[di]; p0[rr]=ok?p0[rr]+b:NEG; }
    { const int k2=kc+32, dc=k2-qc+15; const bool ok=(k2>=cs)&&(k2<cs+16); const int di=dc<0?0:(dc>30?30:dc); const float b=brow[di]; p1[rr]=ok?p1[rr]+b:NEG; }
  }
}

template<int PAR> __device__ __forceinline__ void cbias_par(f32x16&p0,f32x16&p1,int t,int kr0,int r0,int wid,int r32,int hi,lds_cfptr bt){
  if(t<4)return;
  asm volatile("; LAUNDER":"+v"(r32),"+v"(hi));
  const float NEG=-INFINITY; const int kr=kr0+t-4, r=r0+(wid>>1); int rs=r-4; rs=rs<0?0:(rs>120?120:rs);
  if(kr<rs||kr>=rs+8){
    #pragma unroll
    for(int rr=0;rr<16;++rr){p0[rr]=NEG;p1[rr]=NEG;}
    return; }
  const int dr=kr-r+7, qc=32*PAR+r32; int cs=qc-8; cs=cs<0?0:(cs>48?48:cs);
  const lds_cfptr bl=bt+dr*31+(15-qc+4*hi);
  const int ncs=4*hi-cs;
  #pragma unroll
  for(int rr=0;rr<16;++rr){
    const int kconst=(rr&3)+8*(rr>>2);
    if constexpr(PAR==0){
      { const unsigned d=(unsigned)(kconst+ncs); const float b=bl[kconst]; p0[rr]=(d<16u)?p0[rr]+b:NEG; }
      if(kconst<8){ const unsigned d=(unsigned)(kconst+32+ncs); const float b=bl[kconst+32]; p1[rr]=(d<16u)?p1[rr]+b:NEG; } else p1[rr]=NEG;
    } else {
      if(kconst>=24){ const unsigned d=(unsigned)(kconst+ncs); const float b=bl[kconst]; p0[rr]=(d<16u)?p0[rr]+b:NEG; } else p0[rr]=NEG;
      { const unsigned d=(unsigned)(kconst+32+ncs); const float b=bl[kconst+32]; p1[rr]=(d<16u)?p1[rr]+b:NEG; }
    }
  }
}
constexpr int NSLOT=3, SLOTB=8192;
constexpr int LDS_K=0, LDS_V=NSLOT*SLOTB, LDS_WS=2*NSLOT*SLOTB, LDS_OST=LDS_WS+NW*64*4, LDS_BYTES=LDS_OST+NW*4096;
constexpr float C2=0.125f*1.4426950408889634f;
__device__ __forceinline__ void glds16(const void*gsrc,unsigned lds_dst){unsigned keep;
  asm volatile("s_mov_b32 %0, m0\n\ts_mov_b32 m0, %2\n\ts_nop 0\n\tglobal_load_lds_dwordx4 %1, off\n\ts_mov_b32 m0, %0":"=&s"(keep):"v"(gsrc),"s"(lds_dst):"memory");}
__device__ __forceinline__ void glds16s(const void*sbase,unsigned voff,unsigned lds_dst){unsigned keep;
  asm volatile("s_mov_b32 %0, m0\n\ts_mov_b32 m0, %3\n\ts_nop 0\n\tglobal_load_lds_dwordx4 %1, %2\n\ts_mov_b32 m0, %0":"=&s"(keep):"v"(voff),"s"(sbase),"s"(lds_dst):"memory");}
__device__ __forceinline__ float max3f(float a,float b,float c){float r;asm("v_max3_f32 %0, %1, %2, %3":"=v"(r):"v"(a),"v"(b),"v"(c));return r;}
__device__ __forceinline__ float max2f(float a,float b){float r;asm("v_max_f32_e32 %0, %1, %2":"=v"(r):"v"(a),"v"(b));return r;}
__device__ __forceinline__ float fadd_s(float a,float b){float r;asm("v_add_f32_e32 %0, %1, %2":"=v"(r):"v"(a),"v"(b));return r;}
__device__ __forceinline__ float fsub_s(float a,float b){float r;asm("v_sub_f32_e32 %0, %1, %2":"=v"(r):"v"(a),"v"(b));return r;}
typedef float f32x2_t __attribute__((ext_vector_type(2))); typedef __bf16 bf16x2_t __attribute__((ext_vector_type(2)));
__device__ __forceinline__ unsigned cvtpk_s(float lo,float hi){f32x2_t v={lo,hi};bf16x2_t b=__builtin_convertvector(v,bf16x2_t);return __builtin_bit_cast(unsigned,b);}
#define WAIT_BAR(N) asm volatile("s_waitcnt vmcnt(" #N ") lgkmcnt(0)\n\ts_barrier":::"memory")

__device__ __forceinline__ void qkt(f32x16&p0,f32x16&p1,const char*Kslot,const bf16x8*qr,const f32x16&negm,int r32,int hi){
  const char*kb=Kslot+hi*1024+r32*16;
  #pragma unroll
  for(int d0=0;d0<4;++d0){
    const bf16x8 b0=*reinterpret_cast<const bf16x8*>(kb+d0*2048);
    const bf16x8 b1=*reinterpret_cast<const bf16x8*>(kb+d0*2048+512);
    if(d0==0){p0=__builtin_amdgcn_mfma_f32_32x32x16_bf16(b0,qr[0],negm,0,0,0);p1=__builtin_amdgcn_mfma_f32_32x32x16_bf16(b1,qr[0],negm,0,0,0);}
    else{p0=__builtin_amdgcn_mfma_f32_32x32x16_bf16(b0,qr[d0],p0,0,0,0);p1=__builtin_amdgcn_mfma_f32_32x32x16_bf16(b1,qr[d0],p1,0,0,0);}}
}
typedef __attribute__((address_space(3))) const char* lds_cptr;
typedef short v4i16_t __attribute__((ext_vector_type(4)));
__device__ __forceinline__ void kload8(bf16x8*kf,lds_cptr kp){
  kf[0]=*(const __attribute__((address_space(3))) bf16x8*)(kp);      kf[1]=*(const __attribute__((address_space(3))) bf16x8*)(kp+512);
  kf[2]=*(const __attribute__((address_space(3))) bf16x8*)(kp+2048); kf[3]=*(const __attribute__((address_space(3))) bf16x8*)(kp+2560);
  kf[4]=*(const __attribute__((address_space(3))) bf16x8*)(kp+4096); kf[5]=*(const __attribute__((address_space(3))) bf16x8*)(kp+4608);
  kf[6]=*(const __attribute__((address_space(3))) bf16x8*)(kp+6144); kf[7]=*(const __attribute__((address_space(3))) bf16x8*)(kp+6656);
}
__device__ __forceinline__ void kload2(bf16x8*kf,lds_cptr kp,int j){ kf[2*j]=*(const __attribute__((address_space(3))) bf16x8*)(kp+j*2048); kf[2*j+1]=*(const __attribute__((address_space(3))) bf16x8*)(kp+j*2048+512); }
__device__ __forceinline__ s16x4 vtr(lds_cptr p){ return __builtin_bit_cast(s16x4,__builtin_amdgcn_ds_read_tr16_b64_v4i16((__attribute__((address_space(3))) v4i16_t*)p)); }
__device__ __forceinline__ float rowmax(const f32x16&p0,const f32x16&p1){
  float a=max3f(p0[0],p0[1],p1[0]),b=max3f(p0[2],p0[3],p1[1]);a=max3f(a,p1[2],p1[3]);
  #pragma unroll
  for(int r=4;r<16;r+=4){a=max3f(a,p0[r],p0[r+1]);b=max3f(b,p0[r+2],p0[r+3]);a=max3f(a,p1[r],p1[r+1]);b=max3f(b,p1[r+2],p1[r+3]);}
  const float m=max2f(a,b);
  auto rr=__builtin_amdgcn_permlane32_swap(__float_as_uint(m),__float_as_uint(m),false,false);
  return max2f(__uint_as_float(rr[0]),__uint_as_float(rr[1]));
}
__device__ __forceinline__ void pv(f32x16*o,int vb,bf16x8 pa0,bf16x8 pa1,bf16x8 pa2,bf16x8 pa3){
  #pragma unroll
  for(int d0=0;d0<2;++d0){s16x4 lo[4],hi[4];
    #pragma unroll
    for(int ks=0;ks<4;++ks){
      asm volatile("ds_read_b64_tr_b16 %0,%1 offset:%c2":"=&v"(lo[ks]):"v"(vb),"i"(d0*4096+ks*1024):"memory");
      asm volatile("ds_read_b64_tr_b16 %0,%1 offset:%c2":"=&v"(hi[ks]):"v"(vb),"i"(d0*4096+ks*1024+512):"memory");}
    asm volatile("s_waitcnt lgkmcnt(0)":::"memory");SBAR();
    #define PK(k) (bf16x8){lo[k][0],lo[k][1],lo[k][2],lo[k][3],hi[k][0],hi[k][1],hi[k][2],hi[k][3]}
    o[d0]=__builtin_amdgcn_mfma_f32_32x32x16_bf16(pa0,PK(0),o[d0],0,0,0);
    o[d0]=__builtin_amdgcn_mfma_f32_32x32x16_bf16(pa1,PK(1),o[d0],0,0,0);
    o[d0]=__builtin_amdgcn_mfma_f32_32x32x16_bf16(pa2,PK(2),o[d0],0,0,0);
    o[d0]=__builtin_amdgcn_mfma_f32_32x32x16_bf16(pa3,PK(3),o[d0],0,0,0);
    #undef PK
  }
}

#ifndef ATTN_STORE16
#define ATTN_STORE16(p,v) (*(u32x4*)(p)=(v))
#endif
typedef int i32x8a __attribute__((ext_vector_type(8)));
typedef int i32x4a __attribute__((ext_vector_type(4)));
__device__ __forceinline__ i32x8a cat8a(i32x4a lo,i32x4a hi){ return __builtin_shufflevector(lo,hi,0,1,2,3,4,5,6,7); }
__device__ __forceinline__ i32x8a kfrag8(lds_cptr kp){ return cat8a(*(const __attribute__((address_space(3))) i32x4a*)(kp), *(const __attribute__((address_space(3))) i32x4a*)(kp+1024)); }
#define MF8(a,b,c) __builtin_amdgcn_mfma_scale_f32_32x32x64_f8f6f4(a,b,c,0,0,0,0,0,0)
template<int THRL,bool ISC,bool K8> __device__ __forceinline__ void attn_unit(const bf16*Qw0,const bf16*__restrict__ Kh,const bf16*__restrict__ Vh,bf16*Ow0,int NT,int kr0,int r0,lds_cfptr bt,char*shm,const unsigned char*Q8w0,const unsigned char*__restrict__ K8h){
  int tid_=threadIdx.x; asm volatile("; LAUNDER":"+v"(tid_)); const int tid=tid_,lane=tid&63,r32=lane&31,hi=lane>>5; const int wid=__builtin_amdgcn_readfirstlane(tid>>6);
  const bf16*Qw=Qw0+(long)(wid*QBLK)*QKP;
  const unsigned lds0=(unsigned)(uintptr_t)shm;
  float*wsf=(float*)(shm+LDS_WS)+wid*64;
  const bf16*ksrc=Kh+(long)lane*QKP+wid*8;
  const unsigned char*ksrc8=K8h+(long)lane*64+(wid&3)*16;
  const bf16*vsrc=Vh+(long)(16*(wid&3)+(lane>>2))*QKP+(wid>>2)*32+(lane&3)*8;
  const unsigned kdst=lds0+LDS_K+(K8?(wid&3):wid)*1024, vdst=lds0+LDS_V+wid*1024;
  #define KROW(t) (ISC ? ((t)<4 ? 64*(t) : 256+64*(kr0+(t)-4)) : 64*(t))
  #define DMA_K(t,slot) do{ if constexpr(K8){ glds16(ksrc8+(long)KROW(t)*64,(unsigned)__builtin_amdgcn_readfirstlane(kdst+(slot))); } else { glds16(ksrc+(long)KROW(t)*QKP,(unsigned)__builtin_amdgcn_readfirstlane(kdst+(slot))); } }while(0)
  #define DMA_V(t,slot) glds16(vsrc+(long)KROW(t)*QKP,(unsigned)__builtin_amdgcn_readfirstlane(vdst+(slot)))
  const int vb0=(int)(lds0+LDS_V)+((lane>>4)&1)*32+(lane&3)*8+(4*hi+((lane&15)>>2))*64;
  const char*Kbase=shm+LDS_K; bf16x8 kf[8];
  const lds_cptr shm3=(lds_cptr)shm; const lds_cptr kp0=shm3+LDS_K+(K8?2*hi:hi)*1024+r32*16; const lds_cptr vp0=shm3+LDS_V+((lane>>4)&1)*32+(lane&3)*8+(4*hi+((lane&15)>>2))*64;
  DMA_K(0,0);DMA_V(0,0);DMA_K(1,SLOTB);
  bf16x8 qr[4]; i32x8a q8=i32x8a{}; i32x8a k8a=i32x8a{},k8b=i32x8a{};
  if constexpr(K8){ const unsigned char*qp=Q8w0+(long)(wid*QBLK+r32)*64+32*hi; q8=cat8a(*reinterpret_cast<const i32x4a*>(qp),*reinterpret_cast<const i32x4a*>(qp+16));
    #pragma unroll
    for(int d0=0;d0<4;++d0)qr[d0]=bf16x8{}; }
  else {
  #pragma unroll
  for(int d0=0;d0<4;++d0)qr[d0]=*reinterpret_cast<const bf16x8*>(&Qw[(long)r32*QKP+d0*16+hi*8]); }
  float mhat=0.f,l_reg=0.f;f32x16 o[2];o[0]=f32x16{};o[1]=f32x16{};f32x16 negm=f32x16{};asm volatile("":"+v"(negm));
  #define CMASK(P0,P1,t) do{ if constexpr(ISC){ cbias(P0,P1,(t),kr0,r0,wid,r32,hi,bt); } }while(0)
  bool resc=false;
  #define START(P0,P1) do{ const float rm=rowmax(P0,P1); resc=false; \
    { const float dl=rm; mhat=fadd_s(mhat,dl); \
      _Pragma("unroll") for(int r=0;r<16;++r){P0[r]=fsub_s(P0[r],dl);P1[r]=fsub_s(P1[r],dl);} \
      _Pragma("unroll") for(int r=0;r<16;++r)negm[r]=-mhat; asm volatile("":"+v"(negm)); } \
    _Pragma("unroll") for(int r=0;r<16;++r)P0[r]=__builtin_amdgcn_exp2f(P0[r]); }while(0)
  #define RESC() do{ if(resc){ asm volatile("s_waitcnt lgkmcnt(0)":::"memory"); \
      _Pragma("unroll") for(int d_=0;d_<2;++d_) _Pragma("unroll") for(int r=0;r<16;++r)o[d_][r]*=wsf[crow(r,hi)]; } }while(0)
  f32x16 pA0,pA1,pB0,pB1;
  int sl_prev=0,sl_cur=0,sl_next=SLOTB;
  #define ROT() do{sl_prev=sl_cur;sl_cur=sl_next;sl_next=(sl_next==(NSLOT-1)*SLOTB)?0:sl_next+SLOTB;}while(0)
  DMA_K(2,2*SLOTB);
  WAIT_BAR(3);
  if constexpr(K8){ pA0=MF8(kfrag8(kp0),q8,negm); pA1=MF8(kfrag8(kp0+512),q8,negm); } else qkt(pA0,pA1,Kbase,qr,negm,r32,hi);
  asm volatile("s_nop 15\n\ts_nop 7":"+v"(pA0),"+v"(pA1));CMASK(pA0,pA1,0);
  START(pA0,pA1);
  _Pragma("unroll") for(int r=0;r<16;++r)pA1[r]=__builtin_amdgcn_exp2f(pA1[r]);
  WAIT_BAR(0);
  DMA_K(3,0);DMA_V(1,SLOTB);
  ROT();
  if constexpr(K8){ k8a=kfrag8(kp0+sl_cur); k8b=kfrag8(kp0+sl_cur+512); } else kload8(kf,kp0+sl_cur);
  WAIT_BAR(2);
  s16x4 vlo[8],vhi[8]; u32x4 pw0,pw1,pw2,pw3;
  #define PKW(P,B) cvtpk_s(P[B],P[B+1])
  #define PAF(k) __builtin_bit_cast(bf16x8,pw##k)
  #define VFR(i) (bf16x8){vlo[i][0],vlo[i][1],vlo[i][2],vlo[i][3],vhi[i][0],vhi[i][1],vhi[i][2],vhi[i][3]}
  #define PIN(x) asm volatile("":"+v"(x))
  #define MX3(a,b,c) __builtin_fmaxf(__builtin_fmaxf((a),(b)),(c))
  #define GAPA(MF,A0,A1,A2,A3,W0,W1,PW) do{ MF; sacc+=A0; sacc+=A1; sacc+=A2; sacc+=A3; PIN(sacc); W0; W1; PIN(PW); SBAR(); }while(0)
  #define EX(v) __builtin_amdgcn_exp2f(v)
  #define GAPB(MF,X,B) do{ MF; X[B]=EX(X[B]); X[B+1]=EX(X[B+1]); X[B+2]=EX(X[B+2]); X[B+3]=EX(X[B+3]); PIN(X); SBAR(); }while(0)
  #define VRD(i) do{ vlo[i]=vtr(vp_+(((i)>>2)*4096+((i)&3)*1024)); vhi[i]=vtr(vp_+(((i)>>2)*4096+((i)&3)*1024+512)); }while(0)
  #define KRD(G,j) do{ if(G){ if constexpr(K8){ if constexpr((j)==0){ k8a=kfrag8(kp0+sl_next); SBAR(); } else if constexpr((j)==1){ k8b=kfrag8(kp0+sl_next+512); SBAR(); } } else { kload2(kf,kp0+sl_next,j); SBAR(); } } }while(0)
  #define QKMU(i,C0,C1) do{ if constexpr(K8){ if constexpr((i)==0){ C0=MF8(k8a,q8,negm); } else if constexpr((i)==4){ C1=MF8(k8b,q8,negm); } } else { \
      if constexpr((i)==0){ C0=__builtin_amdgcn_mfma_f32_32x32x16_bf16(kf[0],qr[0],negm,0,0,0); } else if constexpr((i)==1){ C1=__builtin_amdgcn_mfma_f32_32x32x16_bf16(kf[1],qr[0],negm,0,0,0); } \
      else if constexpr(((i)&1)==0){ C0=__builtin_amdgcn_mfma_f32_32x32x16_bf16(kf[i],qr[(i)>>1],C0,0,0,0); } else { C1=__builtin_amdgcn_mfma_f32_32x32x16_bf16(kf[i],qr[(i)>>1],C1,0,0,0); } } }while(0)
  #define STEP(C0,C1,P0,P1,t,GK,GV,GL) do{ SBAR(); \
    const lds_cptr vp_=vp0+sl_prev; \
    VRD(0); SBAR(); float sacc=(P0[0]+P0[1]); \
    GAPA(QKMU(0,C0,C1), P0[2],P0[3],P0[4],P0[5],     pw0[0]=PKW(P0,0), pw0[1]=PKW(P0,2), pw0); \
    VRD(4); SBAR(); GAPA(QKMU(1,C0,C1), P0[6],P0[7],P0[8],P0[9],     pw0[2]=PKW(P0,4), pw0[3]=PKW(P0,6), pw0); \
    VRD(1); SBAR(); GAPA(QKMU(2,C0,C1),   P0[10],P0[11],P0[12],P0[13], pw1[0]=PKW(P0,8), pw1[1]=PKW(P0,10), pw1); \
    VRD(5); SBAR(); GAPA(QKMU(3,C0,C1),   P0[14],P0[15],P1[0],P1[1],   pw1[2]=PKW(P0,12),pw1[3]=PKW(P0,14), pw1); \
    VRD(2); SBAR(); GAPA(QKMU(4,C0,C1),   P1[2],P1[3],P1[4],P1[5],     pw2[0]=PKW(P1,0), pw2[1]=PKW(P1,2), pw2); \
    VRD(6); SBAR(); GAPA(QKMU(5,C0,C1),   P1[6],P1[7],P1[8],P1[9],     pw2[2]=PKW(P1,4), pw2[3]=PKW(P1,6), pw2); \
    VRD(3); SBAR(); GAPA(QKMU(6,C0,C1),   P1[10],P1[11],P1[12],P1[13], pw3[0]=PKW(P1,8), pw3[1]=PKW(P1,10), pw3); \
    VRD(7); SBAR(); GAPA(QKMU(7,C0,C1),   P1[14],P1[15],0.f,0.f,       pw3[2]=PKW(P1,12),pw3[3]=PKW(P1,14), pw3); \
    l_reg+=sacc; \
    if(GK){DMA_K((t)+3,sl_cur);} if(GV){DMA_V((t)+1,sl_next);} \
    CMASK(C0,C1,t); \
    { float a=MX3(C0[0],C0[1],C1[0]),b=MX3(C0[2],C0[3],C1[1]); a=MX3(a,C1[2],C1[3]); \
      _Pragma("unroll") for(int r=4;r<16;r+=4){a=MX3(a,C0[r],C0[r+1]);b=MX3(b,C0[r+2],C0[r+3]);a=MX3(a,C1[r],C1[r+1]);b=MX3(b,C1[r+2],C1[r+3]);} \
      float rm=__builtin_fmaxf(a,b); { auto rr=__builtin_amdgcn_permlane32_swap(__float_as_uint(rm),__float_as_uint(rm),false,false); rm=__builtin_fmaxf(__uint_as_float(rr[0]),__uint_as_float(rr[1])); } \
      resc=false; \
      if(__builtin_expect(__any(rm>(float)THRL),0)){ const float dl=__builtin_fmaxf(rm,0.f); mhat+=dl; \
        _Pragma("unroll") for(int r=0;r<16;++r){C0[r]-=dl;C1[r]-=dl;} \
        _Pragma("unroll") for(int r=0;r<16;++r)negm[r]=-mhat; asm volatile("":"+v"(negm)); \
        const float f=__builtin_amdgcn_exp2f(-dl); l_reg*=f; if(hi==0)wsf[r32]=f; resc=true; } } \
    SBAR(); \
    GAPB(o[0]=__builtin_amdgcn_mfma_f32_32x32x16_bf16(PAF(0),VFR(0),o[0],0,0,0), C0,0); \
    GAPB(o[1]=__builtin_amdgcn_mfma_f32_32x32x16_bf16(PAF(0),VFR(4),o[1],0,0,0), C0,4); \
    KRD(GL,0); GAPB(o[0]=__builtin_amdgcn_mfma_f32_32x32x16_bf16(PAF(1),VFR(1),o[0],0,0,0), C0,8); \
    KRD(GL,1); GAPB(o[1]=__builtin_amdgcn_mfma_f32_32x32x16_bf16(PAF(1),VFR(5),o[1],0,0,0), C0,12); \
    KRD(GL,2); GAPB(o[0]=__builtin_amdgcn_mfma_f32_32x32x16_bf16(PAF(2),VFR(2),o[0],0,0,0), C1,0); \
    KRD(GL,3); GAPB(o[1]=__builtin_amdgcn_mfma_f32_32x32x16_bf16(PAF(2),VFR(6),o[1],0,0,0), C1,4); \
    GAPB(o[0]=__builtin_amdgcn_mfma_f32_32x32x16_bf16(PAF(3),VFR(3),o[0],0,0,0), C1,8); \
    GAPB(o[1]=__builtin_amdgcn_mfma_f32_32x32x16_bf16(PAF(3),VFR(7),o[1],0,0,0), C1,12); \
    }while(0)
  int t=1;
  for(;t+5<NT;t+=2){
    STEP(pB0,pB1,pA0,pA1,t,true,true,true);     WAIT_BAR(2); RESC(); ROT();
    STEP(pA0,pA1,pB0,pB1,t+1,true,true,true);   WAIT_BAR(2); RESC(); ROT();
  }
  #define ENDW(tt) do{ if((tt)+3<NT){WAIT_BAR(2);} else if((tt)+2<NT){WAIT_BAR(1);} else {WAIT_BAR(0);} }while(0)
  for(;t+1<NT;t+=2){
    STEP(pB0,pB1,pA0,pA1,t,(t+3<NT),(t+1<NT),(t+1<NT));       ENDW(t);   RESC(); ROT();
    STEP(pA0,pA1,pB0,pB1,t+1,(t+4<NT),(t+2<NT),(t+2<NT));     ENDW(t+1); RESC(); ROT();
  }
  STEP(pB0,pB1,pA0,pA1,NT-1,false,false,false); RESC();
  { float sacc=pB0[0]+pB0[1]; _Pragma("unroll") for(int r=2;r<16;++r)sacc+=pB0[r]; _Pragma("unroll") for(int r=0;r<16;++r)sacc+=pB1[r]; l_reg+=sacc;
    pw0=(u32x4){PKW(pB0,0),PKW(pB0,2),PKW(pB0,4),PKW(pB0,6)};pw1=(u32x4){PKW(pB0,8),PKW(pB0,10),PKW(pB0,12),PKW(pB0,14)};pw2=(u32x4){PKW(pB1,0),PKW(pB1,2),PKW(pB1,4),PKW(pB1,6)};pw3=(u32x4){PKW(pB1,8),PKW(pB1,10),PKW(pB1,12),PKW(pB1,14)};
    SBAR(); pv(o,vb0+sl_cur,PAF(0),PAF(1),PAF(2),PAF(3)); }
  #undef PKW
  #undef PAF
  #undef VFR
  #undef PIN
  #undef MX3
  #undef GAPA
  #undef GAPB
  #undef EX
  #undef VRD
  #undef KRD
  #undef QKMU
  #undef STEP
  #undef ENDW
  {auto rr=__builtin_amdgcn_permlane32_swap(__float_as_uint(l_reg),__float_as_uint(l_reg),false,false);l_reg=__uint_as_float(rr[0])+__uint_as_float(rr[1]);}
  if(hi==0)wsf[32+r32]=l_reg;asm volatile("s_waitcnt lgkmcnt(0)":::"memory");
  float rli[16];
  #pragma unroll
  for(int r=0;r<16;++r)rli[r]=__builtin_amdgcn_rcpf(wsf[32+crow(r,hi)]);
  bf16*Ow=Ow0+(long)(wid*QBLK)*OPITCH;
  { bf16*stg=(bf16*)(shm+LDS_OST)+wid*2048;
    #pragma unroll
    for(int r=0;r<16;++r){const int orow=crow(r,hi);
      #pragma unroll
      for(int d0=0;d0<2;++d0)stg[orow*64+d0*32+r32]=__float2bfloat16(o[d0][r]*rli[r]);}
    asm volatile("s_waitcnt lgkmcnt(0)":::"memory");
    #pragma unroll
    for(int i=0;i<4;++i){const int row=i*8+(lane>>3),ch=lane&7; const u32x4 v=*(const u32x4*)(stg+row*64+ch*8); ATTN_STORE16(Ow+(long)row*OPITCH+ch*8,v);} }
  asm volatile("s_waitcnt lgkmcnt(0)\n\ts_barrier":::"memory");
  #undef DMA_K
  #undef KROW
  #undef DMA_V
  #undef CMASK
  #undef START
  #undef RESC
  #undef ROT
}
constexpr int ATTN_LDS_BYTES=LDS_BYTES;
constexpr int FS_K=0, FS_V=3*8192, FS_WS=FS_V+3*16384, FS_OST=FS_WS+NW*64*4, FS_BYTES=FS_OST+NW*4096;
constexpr float FS_LMIN=1e-30f, FS_LMAX=1e36f;
constexpr bool FS_MFSUM=false;
#define WAIT_BAR_V(NV_,A2,A1) do{ if constexpr((NV_)==2){WAIT_BAR(A2);}else{WAIT_BAR(A1);} }while(0)
template<int VW> __device__ __forceinline__ void pv_w(f32x16*o,int vb,bf16x8 pa0,bf16x8 pa1,bf16x8 pa2,bf16x8 pa3){
  #pragma unroll
  for(int d0=0;d0<2*VW;++d0){s16x4 lo[4],hi[4];
    #pragma unroll
    for(int ks=0;ks<4;++ks){
      asm volatile("ds_read_b64_tr_b16 %0,%1 offset:%c2":"=&v"(lo[ks]):"v"(vb),"i"(d0*4096+ks*1024):"memory");
      asm volatile("ds_read_b64_tr_b16 %0,%1 offset:%c2":"=&v"(hi[ks]):"v"(vb),"i"(d0*4096+ks*1024+512):"memory");}
    asm volatile("s_waitcnt lgkmcnt(0)":::"memory");SBAR();
    #define PK(k) (bf16x8){lo[k][0],lo[k][1],lo[k][2],lo[k][3],hi[k][0],hi[k][1],hi[k][2],hi[k][3]}
    o[d0]=__builtin_amdgcn_mfma_f32_32x32x16_bf16(pa0,PK(0),o[d0],0,0,0);
    o[d0]=__builtin_amdgcn_mfma_f32_32x32x16_bf16(pa1,PK(1),o[d0],0,0,0);
    o[d0]=__builtin_amdgcn_mfma_f32_32x32x16_bf16(pa2,PK(2),o[d0],0,0,0);
    o[d0]=__builtin_amdgcn_mfma_f32_32x32x16_bf16(pa3,PK(3),o[d0],0,0,0);
    #undef PK
  }
}
template<int VW,bool ISC,bool K8> __device__ __forceinline__ bool attn_fs(const bf16*Qw0,const bf16*__restrict__ Kh,const bf16*__restrict__ Vh,bf16*Ow0,int NT,int kr0,int r0,lds_cfptr bt,char*shm,const unsigned char*Q8w0,const unsigned char*__restrict__ K8h){
  int tid_=threadIdx.x; asm volatile("; LAUNDER":"+v"(tid_)); const int tid=tid_,lane=tid&63,r32=lane&31,hi=lane>>5; const int wid=__builtin_amdgcn_readfirstlane(tid>>6);
  const bf16*Qw=Qw0+(long)(wid*QBLK)*QKP;
  const unsigned lds0=(unsigned)(uintptr_t)shm;
  float*wsf=(float*)(shm+FS_WS)+wid*64;
  const bf16*ksrc=Kh+(long)lane*QKP+wid*8;
  const unsigned char*ksrc8=K8h+(long)lane*64+(wid&3)*16;
  const bf16*vsrc=Vh+(long)(16*(wid&3)+(lane>>2))*QKP+(wid>>2)*32+(lane&3)*8;
  const unsigned kdst=lds0+FS_K+(K8?(wid&3):wid)*1024, vdst=lds0+FS_V+wid*1024;
  #define KROW(t) (ISC ? ((t)<4 ? 64*(t) : 256+64*(kr0+(t)-4)) : 64*(t))
  #define DMA_K(t,slot) do{ if constexpr(K8){ glds16(ksrc8+(long)KROW(t)*64,(unsigned)__builtin_amdgcn_readfirstlane(kdst+(slot))); } else { glds16(ksrc+(long)KROW(t)*QKP,(unsigned)__builtin_amdgcn_readfirstlane(kdst+(slot))); } }while(0)
  #define DMA_V(t,slot) do{ glds16(vsrc+(long)KROW(t)*QKP,(unsigned)__builtin_amdgcn_readfirstlane(vdst+2*(slot))); \
      if constexpr(VW==2){ glds16(vsrc+(long)KROW(t)*QKP+QKV_BLK,(unsigned)__builtin_amdgcn_readfirstlane(vdst+2*(slot)+8192)); } }while(0)
  const int vb0=(int)(lds0+FS_V)+((lane>>4)&1)*32+(lane&3)*8+(4*hi+((lane&15)>>2))*64;
  const char*Kbase=shm+FS_K; bf16x8 kf[8];
  const lds_cptr shm3=(lds_cptr)shm; const lds_cptr kp0=shm3+FS_K+(K8?2*hi:hi)*1024+r32*16; const lds_cptr vp0=shm3+FS_V+((lane>>4)&1)*32+(lane&3)*8+(4*hi+((lane&15)>>2))*64;
  DMA_K(0,0);DMA_V(0,0);DMA_K(1,SLOTB);
  bf16x8 qr[4]; i32x8a q8=i32x8a{}; i32x8a k8a=i32x8a{},k8b=i32x8a{};
  if constexpr(K8){ const unsigned char*qp=Q8w0+(long)(wid*QBLK+r32)*64+32*hi; q8=cat8a(*reinterpret_cast<const i32x4a*>(qp),*reinterpret_cast<const i32x4a*>(qp+16));
    #pragma unroll
    for(int d0=0;d0<4;++d0)qr[d0]=bf16x8{}; }
  else {
  #pragma unroll
  for(int d0=0;d0<4;++d0)qr[d0]=*reinterpret_cast<const bf16x8*>(&Qw[(long)r32*QKP+d0*16+hi*8]); }
  float l_reg=0.f;f32x16 o[2*VW];
  #pragma unroll
  for(int d0=0;d0<2*VW;++d0)o[d0]=f32x16{};
  const f32x16 zero16=f32x16{};
  f32x16 lacc=f32x16{}; const bf16x8 ones8=(bf16x8){0x3F80,0x3F80,0x3F80,0x3F80,0x3F80,0x3F80,0x3F80,0x3F80};
  #define CMASK(P0,P1,t) do{ if constexpr(ISC){ if(wid&1) cbias_par<1>(P0,P1,(t),kr0,r0,wid,r32,hi,bt); else cbias_par<0>(P0,P1,(t),kr0,r0,wid,r32,hi,bt); } }while(0)
  f32x16 pA0,pA1,pB0,pB1;
  int sl_prev=0,sl_cur=0,sl_next=SLOTB;
  #define ROT() do{sl_prev=sl_cur;sl_cur=sl_next;sl_next=(sl_next==(NSLOT-1)*SLOTB)?0:sl_next+SLOTB;}while(0)
  DMA_K(2,2*SLOTB);
  WAIT_BAR_V(VW,4,3);
  if(tid==0)*(volatile unsigned*)(shm+FS_WS)=0u;
  if constexpr(K8){ pA0=MF8(kfrag8(kp0),q8,zero16); pA1=MF8(kfrag8(kp0+512),q8,zero16); } else qkt(pA0,pA1,Kbase,qr,zero16,r32,hi);
  asm volatile("s_nop 15\n\ts_nop 7":"+v"(pA0),"+v"(pA1));CMASK(pA0,pA1,0);
  _Pragma("unroll") for(int r=0;r<16;++r){pA0[r]=__builtin_amdgcn_exp2f(pA0[r]);pA1[r]=__builtin_amdgcn_exp2f(pA1[r]);}
  WAIT_BAR(0);
  DMA_K(3,0);DMA_V(1,SLOTB);
  ROT();
  if constexpr(K8){ k8a=kfrag8(kp0+sl_cur); k8b=kfrag8(kp0+sl_cur+512); } else kload8(kf,kp0+sl_cur);
  WAIT_BAR_V(VW,3,2);
  s16x4 vlo[8],vhi[8]; u32x4 pw0,pw1,pw2,pw3;
  #define PKW(P,B) cvtpk_s(P[B],P[B+1])
  #define PAF(k) __builtin_bit_cast(bf16x8,pw##k)
  #define VFR(i) (bf16x8){vlo[i][0],vlo[i][1],vlo[i][2],vlo[i][3],vhi[i][0],vhi[i][1],vhi[i][2],vhi[i][3]}
  #define PIN(x) asm volatile("":"+v"(x))
  #define MF(a,b,c) __builtin_amdgcn_mfma_f32_32x32x16_bf16(a,b,c,0,0,0)
  #define GAPA(MFX,A0,A1,A2,A3,W0,W1,PW) do{ MFX; if constexpr(!(VW==1&&FS_MFSUM)){ sacc+=A0; sacc+=A1; sacc+=A2; sacc+=A3; PIN(sacc); } W0; W1; PIN(PW); SBAR(); }while(0)
  #define QKM(i,C0,C1) do{ if constexpr(K8){ if constexpr((i)==0){ C0=MF8(k8a,q8,zero16); } else if constexpr((i)==4){ C1=MF8(k8b,q8,zero16); } } else { \
      if constexpr((i)==0){ C0=MF(kf[0],qr[0],zero16); } else if constexpr((i)==1){ C1=MF(kf[1],qr[0],zero16); } else if constexpr(((i)&1)==0){ C0=MF(kf[i],qr[(i)>>1],C0); } else { C1=MF(kf[i],qr[(i)>>1],C1); } } }while(0)
  #define EX(v) __builtin_amdgcn_exp2f(v)
  #define GAPB4(MFX,X,B) do{ MFX; X[B]=EX(X[B]); X[B+1]=EX(X[B+1]); X[B+2]=EX(X[B+2]); X[B+3]=EX(X[B+3]); PIN(X); SBAR(); }while(0)
  #define GAPB2(MFX,X,B) do{ MFX; X[B]=EX(X[B]); X[B+1]=EX(X[B+1]); PIN(X); SBAR(); }while(0)
  #define VRDX(j,dq,ks) do{ vlo[j]=vtr(vp_+((dq)*4096+(ks)*1024)); vhi[j]=vtr(vp_+((dq)*4096+(ks)*1024+512)); }while(0)
  #define KRD(G,j) do{ if(G){ if constexpr(K8){ if constexpr((j)==0){ k8a=kfrag8(kp0+sl_next); SBAR(); } else if constexpr((j)==1){ k8b=kfrag8(kp0+sl_next+512); SBAR(); } } else { kload2(kf,kp0+sl_next,j); SBAR(); } } }while(0)
  #define STEP(C0,C1,P0,P1,t,GK,GV,GL) do{ SBAR(); \
    const lds_cptr vp_=vp0+2*sl_prev; \
    if constexpr(VW==1){ VRDX(0,0,0); } else { VRDX(0,0,0); } SBAR(); float sacc=(P0[0]+P0[1]); \
    GAPA(QKM(0,C0,C1), P0[2],P0[3],P0[4],P0[5],     pw0[0]=PKW(P0,0), pw0[1]=PKW(P0,2), pw0); \
    if constexpr(VW==1){ VRDX(4,1,0); } else { VRDX(1,1,0); } SBAR(); GAPA(QKM(1,C0,C1), P0[6],P0[7],P0[8],P0[9],     pw0[2]=PKW(P0,4), pw0[3]=PKW(P0,6), pw0); \
    if constexpr(VW==1){ VRDX(1,0,1); } else { VRDX(2,2,0); } SBAR(); GAPA(QKM(2,C0,C1),   P0[10],P0[11],P0[12],P0[13], pw1[0]=PKW(P0,8), pw1[1]=PKW(P0,10), pw1); \
    if constexpr(VW==1){ VRDX(5,1,1); } else { VRDX(3,3,0); } SBAR(); GAPA(QKM(3,C0,C1),   P0[14],P0[15],P1[0],P1[1],   pw1[2]=PKW(P0,12),pw1[3]=PKW(P0,14), pw1); \
    if constexpr(VW==1){ VRDX(2,0,2); } else { VRDX(4,0,1); } SBAR(); GAPA(QKM(4,C0,C1),   P1[2],P1[3],P1[4],P1[5],     pw2[0]=PKW(P1,0), pw2[1]=PKW(P1,2), pw2); \
    if constexpr(VW==1){ VRDX(6,1,2); } else { VRDX(5,1,1); } SBAR(); GAPA(QKM(5,C0,C1),   P1[6],P1[7],P1[8],P1[9],     pw2[2]=PKW(P1,4), pw2[3]=PKW(P1,6), pw2); \
    if constexpr(VW==1){ VRDX(3,0,3); } else { VRDX(6,2,1); } SBAR(); GAPA(QKM(6,C0,C1),   P1[10],P1[11],P1[12],P1[13], pw3[0]=PKW(P1,8), pw3[1]=PKW(P1,10), pw3); \
    if constexpr(VW==1){ VRDX(7,1,3); } else { VRDX(7,3,1); } SBAR(); GAPA(QKM(7,C0,C1),   P1[14],P1[15],0.f,0.f,       pw3[2]=PKW(P1,12),pw3[3]=PKW(P1,14), pw3); \
    l_reg+=sacc; \
    if(GK){DMA_K((t)+3,sl_cur);} if(GV){DMA_V((t)+1,sl_next);} \
    CMASK(C0,C1,t); \
    SBAR(); \
    if constexpr(VW==1){ \
      GAPB4(o[0]=MF(PAF(0),VFR(0),o[0]), C0,0); \
      GAPB4(o[1]=MF(PAF(0),VFR(4),o[1]), C0,4); \
      if constexpr(FS_MFSUM){lacc=MF(PAF(0),ones8,lacc);} KRD(GL,0); GAPB4(o[0]=MF(PAF(1),VFR(1),o[0]), C0,8); \
      KRD(GL,1); GAPB4(o[1]=MF(PAF(1),VFR(5),o[1]), C0,12); \
      if constexpr(FS_MFSUM){lacc=MF(PAF(1),ones8,lacc);} KRD(GL,2); GAPB4(o[0]=MF(PAF(2),VFR(2),o[0]), C1,0); \
      KRD(GL,3); GAPB4(o[1]=MF(PAF(2),VFR(6),o[1]), C1,4); \
      if constexpr(FS_MFSUM){lacc=MF(PAF(2),ones8,lacc);} GAPB4(o[0]=MF(PAF(3),VFR(3),o[0]), C1,8); \
      if constexpr(FS_MFSUM){lacc=MF(PAF(3),ones8,lacc);} GAPB4(o[1]=MF(PAF(3),VFR(7),o[1]), C1,12); \
    } else { \
      GAPB2(o[0]=MF(PAF(0),VFR(0),o[0]), C0,0);  VRDX(0,0,2); SBAR(); \
      GAPB2(o[1]=MF(PAF(0),VFR(1),o[1]), C0,2);  VRDX(1,1,2); SBAR(); \
      GAPB2(o[2]=MF(PAF(0),VFR(2),o[2]), C0,4);  VRDX(2,2,2); SBAR(); \
      GAPB2(o[3]=MF(PAF(0),VFR(3),o[3]), C0,6);  VRDX(3,3,2); SBAR(); \
      GAPB2(o[0]=MF(PAF(1),VFR(4),o[0]), C0,8);  VRDX(4,0,3); SBAR(); \
      GAPB2(o[1]=MF(PAF(1),VFR(5),o[1]), C0,10); VRDX(5,1,3); SBAR(); \
      GAPB2(o[2]=MF(PAF(1),VFR(6),o[2]), C0,12); VRDX(6,2,3); SBAR(); \
      GAPB2(o[3]=MF(PAF(1),VFR(7),o[3]), C0,14); VRDX(7,3,3); SBAR(); \
      KRD(GL,0); GAPB2(o[0]=MF(PAF(2),VFR(0),o[0]), C1,0); \
      KRD(GL,1); GAPB2(o[1]=MF(PAF(2),VFR(1),o[1]), C1,2); \
      KRD(GL,2); GAPB2(o[2]=MF(PAF(2),VFR(2),o[2]), C1,4); \
      KRD(GL,3); GAPB2(o[3]=MF(PAF(2),VFR(3),o[3]), C1,6); \
      GAPB2(o[0]=MF(PAF(3),VFR(4),o[0]), C1,8); \
      GAPB2(o[1]=MF(PAF(3),VFR(5),o[1]), C1,10); \
      GAPB2(o[2]=MF(PAF(3),VFR(6),o[2]), C1,12); \
      GAPB2(o[3]=MF(PAF(3),VFR(7),o[3]), C1,14); \
    } \
    }while(0)
  int t=1;
  for(;t+5<NT;t+=2){
    STEP(pB0,pB1,pA0,pA1,t,true,true,true);     WAIT_BAR_V(VW,3,2); ROT();
    STEP(pA0,pA1,pB0,pB1,t+1,true,true,true);   WAIT_BAR_V(VW,3,2); ROT();
  }
  #define ENDW(tt) do{ if((tt)+3<NT){WAIT_BAR_V(VW,3,2);} else if((tt)+2<NT){WAIT_BAR_V(VW,2,1);} else {WAIT_BAR(0);} }while(0)
  for(;t+1<NT;t+=2){
    STEP(pB0,pB1,pA0,pA1,t,(t+3<NT),(t+1<NT),(t+1<NT));       ENDW(t);   ROT();
    STEP(pA0,pA1,pB0,pB1,t+1,(t+4<NT),(t+2<NT),(t+2<NT));     ENDW(t+1); ROT();
  }
  STEP(pB0,pB1,pA0,pA1,NT-1,false,false,false);
  { if constexpr(!(VW==1&&FS_MFSUM)){ float sacc=pB0[0]+pB0[1]; _Pragma("unroll") for(int r=2;r<16;++r)sacc+=pB0[r]; _Pragma("unroll") for(int r=0;r<16;++r)sacc+=pB1[r]; l_reg+=sacc; }
    pw0=(u32x4){PKW(pB0,0),PKW(pB0,2),PKW(pB0,4),PKW(pB0,6)};pw1=(u32x4){PKW(pB0,8),PKW(pB0,10),PKW(pB0,12),PKW(pB0,14)};pw2=(u32x4){PKW(pB1,0),PKW(pB1,2),PKW(pB1,4),PKW(pB1,6)};pw3=(u32x4){PKW(pB1,8),PKW(pB1,10),PKW(pB1,12),PKW(pB1,14)};
    SBAR(); if constexpr(VW==1&&FS_MFSUM){ lacc=MF(PAF(0),ones8,lacc); lacc=MF(PAF(1),ones8,lacc); lacc=MF(PAF(2),ones8,lacc); lacc=MF(PAF(3),ones8,lacc); }
    pv_w<VW>(o,vb0+2*sl_cur,PAF(0),PAF(1),PAF(2),PAF(3)); }
  #undef PKW
  #undef PAF
  #undef VFR
  #undef PIN
  #undef MF
  #undef GAPA
  #undef QKM
  #undef GAPB4
  #undef GAPB2
  #undef EX
  #undef VRDX
  #undef KRD
  #undef STEP
  #undef ENDW
  float rli[16];
  if constexpr(VW==1&&FS_MFSUM){
    #pragma unroll
    for(int r=0;r<16;++r)rli[r]=__builtin_amdgcn_rcpf(lacc[r]);
    static_assert(!FS_MFSUM,"the row-sum range check reads l_reg");
  } else {
    {auto rr=__builtin_amdgcn_permlane32_swap(__float_as_uint(l_reg),__float_as_uint(l_reg),false,false);l_reg=__uint_as_float(rr[0])+__uint_as_float(rr[1]);}
    if(__any(!(l_reg>FS_LMIN&&l_reg<FS_LMAX))){ if(lane==0)*(volatile unsigned*)(shm+FS_WS)=1u; }
    if(hi==0)wsf[32+r32]=l_reg;asm volatile("s_waitcnt lgkmcnt(0)":::"memory");
    #pragma unroll
    for(int r=0;r<16;++r)rli[r]=__builtin_amdgcn_rcpf(wsf[32+crow(r,hi)]);
  }
  bf16*Ow=Ow0+(long)(wid*QBLK)*OPITCH;
  #pragma unroll
  for(int hv=0;hv<VW;++hv){ bf16*stg=(bf16*)(shm+FS_OST)+wid*2048;
    #pragma unroll
    for(int r=0;r<16;++r){const int orow=crow(r,hi);
      #pragma unroll
      for(int d0=0;d0<2;++d0)stg[orow*64+d0*32+r32]=__float2bfloat16(o[2*hv+d0][r]*rli[r]);}
    asm volatile("s_waitcnt lgkmcnt(0)":::"memory");
    #pragma unroll
    for(int i=0;i<4;++i){const int row=i*8+(lane>>3),ch=lane&7; const u32x4 v=*(const u32x4*)(stg+row*64+ch*8); ATTN_STORE16(Ow+(long)row*OPITCH+hv*64+ch*8,v);}
    asm volatile("s_waitcnt lgkmcnt(0)":::"memory"); }
  asm volatile("s_waitcnt lgkmcnt(0)\n\ts_barrier":::"memory");
  const bool redo=*(volatile unsigned*)(shm+FS_WS)!=0u;
  #undef DMA_K
  #undef KROW
  #undef DMA_V
  #undef CMASK
  #undef ROT
  return redo;
}
#undef WAIT_BAR_V
#undef MF8
constexpr int ATTN_FS_LDS_BYTES=FS_BYTES;
constexpr int F2_K=0, F2_V=4*4096, F2_WS=F2_V+4*16384, F2_OST=F2_WS+NW*64*4, F2_BYTES=F2_OST+NW*4096;
#define MF8(a,b,c) __builtin_amdgcn_mfma_scale_f32_32x32x64_f8f6f4(a,b,c,0,0,0,0,0,0)
#define WAIT_BAR_V(NV_,A2,A1) do{ if constexpr((NV_)==2){WAIT_BAR(A2);}else{WAIT_BAR(A1);} }while(0)
template<int VW,bool ISC> __device__ __forceinline__ bool attn_fs2(const bf16*__restrict__ Vh,bf16*Ow0,int NT,int kr0,int r0,lds_cfptr bt,char*shm,const unsigned char*Q8w0,const unsigned char*__restrict__ K8h){
  int tid_=threadIdx.x; asm volatile("; LAUNDER":"+v"(tid_)); const int tid=tid_,lane=tid&63,r32=lane&31,hi=lane>>5; const int wid=__builtin_amdgcn_readfirstlane(tid>>6);
  const bool g2=wid>=4;
  const unsigned lds0=(unsigned)(uintptr_t)shm;
  float*wsf=(float*)(shm+F2_WS)+wid*64;
  const unsigned char*ksrc8=K8h+(long)lane*64+(wid&3)*16;
  const bf16*vsrc=Vh+(long)(16*(wid&3)+(lane>>2))*QKP+(wid>>2)*32+(lane&3)*8;
  const unsigned kdst=lds0+F2_K+(wid&3)*1024, vdst=lds0+F2_V+wid*1024;
  #define KS(t) ((((t))&3)*4096)
  #define VS(t) ((((t))&3)*16384)
  #define KROW(t) (ISC ? ((t)<4 ? 64*(t) : 256+64*(kr0+(t)-4)) : 64*(t))
  #define DMA_K(t) glds16(ksrc8+(long)KROW(t)*64,(unsigned)__builtin_amdgcn_readfirstlane(kdst+KS(t)))
  #define DMA_V(t) do{ glds16(vsrc+(long)KROW(t)*QKP,(unsigned)__builtin_amdgcn_readfirstlane(vdst+VS(t))); \
      if constexpr(VW==2){ glds16(vsrc+(long)KROW(t)*QKP+QKV_BLK,(unsigned)__builtin_amdgcn_readfirstlane(vdst+VS(t)+8192)); } }while(0)
  const int vb0=(int)(lds0+F2_V)+((lane>>4)&1)*32+(lane&3)*8+(4*hi+((lane&15)>>2))*64;
  const lds_cptr shm3=(lds_cptr)shm; const lds_cptr kp0=shm3+F2_K+(2*hi)*1024+r32*16; const lds_cptr vp0=shm3+F2_V+((lane>>4)&1)*32+(lane&3)*8+(4*hi+((lane&15)>>2))*64;
  DMA_K(0);DMA_V(0);DMA_K(1);
  i32x8a q8; { const unsigned char*qp=Q8w0+(long)(wid*QBLK+r32)*64+32*hi; q8=cat8a(*reinterpret_cast<const i32x4a*>(qp),*reinterpret_cast<const i32x4a*>(qp+16)); }
  i32x8a k8a=i32x8a{},k8b=i32x8a{};
  float l_reg=0.f;f32x16 o[2*VW];
  #pragma unroll
  for(int d0=0;d0<2*VW;++d0)o[d0]=f32x16{};
  const f32x16 zero16=f32x16{};
  #define CMASK(P0,P1,t) do{ if constexpr(ISC){ if(wid&1) cbias_par<1>(P0,P1,(t),kr0,r0,wid,r32,hi,bt); else cbias_par<0>(P0,P1,(t),kr0,r0,wid,r32,hi,bt); } }while(0)
  f32x16 pA0,pA1,pB0,pB1;
  DMA_K(2);
  WAIT_BAR_V(VW,4,3);
  if(tid==0)*(volatile unsigned*)(shm+F2_WS)=0u;
  pA0=MF8(kfrag8(kp0+KS(0)),q8,zero16); pA1=MF8(kfrag8(kp0+KS(0)+512),q8,zero16);
  asm volatile("s_nop 15\n\ts_nop 7":"+v"(pA0),"+v"(pA1));CMASK(pA0,pA1,0);
  if(!g2){ _Pragma("unroll") for(int r=0;r<16;++r){pA0[r]=__builtin_amdgcn_exp2f(pA0[r]);pA1[r]=__builtin_amdgcn_exp2f(pA1[r]);} }
  WAIT_BAR(0);
  DMA_K(3);DMA_V(1);
  if(!g2){ k8a=kfrag8(kp0+KS(1)); k8b=kfrag8(kp0+KS(1)+512); }
  WAIT_BAR_V(VW,3,2);
  s16x4 vlo[8],vhi[8]; u32x4 pw0,pw1,pw2,pw3;
  #define PKW(P,B) cvtpk_s(P[B],P[B+1])
  #define PAF(k) __builtin_bit_cast(bf16x8,pw##k)
  #define VFR(i) (bf16x8){vlo[i][0],vlo[i][1],vlo[i][2],vlo[i][3],vhi[i][0],vhi[i][1],vhi[i][2],vhi[i][3]}
  #define PIN(x) asm volatile("":"+v"(x))
  #define MF(a,b,c) __builtin_amdgcn_mfma_f32_32x32x16_bf16(a,b,c,0,0,0)
  #define EX(v) __builtin_amdgcn_exp2f(v)
  #define GAPA(MFX,A0,A1,A2,A3,W0,W1,PW) do{ MFX; sacc+=A0; sacc+=A1; sacc+=A2; sacc+=A3; PIN(sacc); W0; W1; PIN(PW); SBAR(); }while(0)
  #define GAPB4(MFX,X,B) do{ MFX; X[B]=EX(X[B]); X[B+1]=EX(X[B+1]); X[B+2]=EX(X[B+2]); X[B+3]=EX(X[B+3]); PIN(X); SBAR(); }while(0)
  #define GAPB2(MFX,X,B) do{ MFX; X[B]=EX(X[B]); X[B+1]=EX(X[B+1]); PIN(X); SBAR(); }while(0)
  #define VRDX(j,dq,ks) do{ vlo[j]=vtr(vp_+((dq)*4096+(ks)*1024)); vhi[j]=vtr(vp_+((dq)*4096+(ks)*1024+512)); }while(0)
  #define XPART(C0,C1,P0,P1,t) do{ SBAR(); \
    const lds_cptr vp_=vp0+VS((t)-1); \
    VRDX(0,0,0); SBAR(); float sacc=(P0[0]+P0[1]); \
    GAPA(C0=MF8(k8a,q8,zero16), P0[2],P0[3],P0[4],P0[5],     pw0[0]=PKW(P0,0), pw0[1]=PKW(P0,2), pw0); \
    if constexpr(VW==1){ VRDX(4,1,0); } else { VRDX(1,1,0); } SBAR(); GAPA((void)0, P0[6],P0[7],P0[8],P0[9],     pw0[2]=PKW(P0,4), pw0[3]=PKW(P0,6), pw0); \
    if constexpr(VW==1){ VRDX(1,0,1); } else { VRDX(2,2,0); } SBAR(); GAPA((void)0, P0[10],P0[11],P0[12],P0[13], pw1[0]=PKW(P0,8), pw1[1]=PKW(P0,10), pw1); \
    if constexpr(VW==1){ VRDX(5,1,1); } else { VRDX(3,3,0); } SBAR(); GAPA((void)0, P0[14],P0[15],P1[0],P1[1],   pw1[2]=PKW(P0,12),pw1[3]=PKW(P0,14), pw1); \
    if constexpr(VW==1){ VRDX(2,0,2); } else { VRDX(4,0,1); } SBAR(); GAPA(C1=MF8(k8b,q8,zero16), P1[2],P1[3],P1[4],P1[5],     pw2[0]=PKW(P1,0), pw2[1]=PKW(P1,2), pw2); \
    if constexpr(VW==1){ VRDX(6,1,2); } else { VRDX(5,1,1); } SBAR(); GAPA((void)0, P1[6],P1[7],P1[8],P1[9],     pw2[2]=PKW(P1,4), pw2[3]=PKW(P1,6), pw2); \
    if constexpr(VW==1){ VRDX(3,0,3); } else { VRDX(6,2,1); } SBAR(); GAPA((void)0, P1[10],P1[11],P1[12],P1[13], pw3[0]=PKW(P1,8), pw3[1]=PKW(P1,10), pw3); \
    if constexpr(VW==1){ VRDX(7,1,3); } else { VRDX(7,3,1); } SBAR(); GAPA((void)0, P1[14],P1[15],0.f,0.f,       pw3[2]=PKW(P1,12),pw3[3]=PKW(P1,14), pw3); \
    l_reg+=sacc; }while(0)
  #define KRD8(G,tk,j) do{ if(G){ if constexpr((j)==0){ k8a=kfrag8(kp0+KS(tk)); } else { k8b=kfrag8(kp0+KS(tk)+512); } SBAR(); } }while(0)
  #define YPART(E0,E1,tv,tk,GLK) do{ SBAR(); \
    if constexpr(VW==1){ \
      GAPB4(o[0]=MF(PAF(0),VFR(0),o[0]), E0,0); \
      GAPB4(o[1]=MF(PAF(0),VFR(4),o[1]), E0,4); \
      KRD8(GLK,tk,0); GAPB4(o[0]=MF(PAF(1),VFR(1),o[0]), E0,8); \
      KRD8(GLK,tk,1); GAPB4(o[1]=MF(PAF(1),VFR(5),o[1]), E0,12); \
      GAPB4(o[0]=MF(PAF(2),VFR(2),o[0]), E1,0); \
      GAPB4(o[1]=MF(PAF(2),VFR(6),o[1]), E1,4); \
      GAPB4(o[0]=MF(PAF(3),VFR(3),o[0]), E1,8); \
      GAPB4(o[1]=MF(PAF(3),VFR(7),o[1]), E1,12); \
    } else { const lds_cptr vp_=vp0+VS(tv); \
      GAPB2(o[0]=MF(PAF(0),VFR(0),o[0]), E0,0);  VRDX(0,0,2); SBAR(); \
      GAPB2(o[1]=MF(PAF(0),VFR(1),o[1]), E0,2);  VRDX(1,1,2); SBAR(); \
      GAPB2(o[2]=MF(PAF(0),VFR(2),o[2]), E0,4);  VRDX(2,2,2); SBAR(); \
      GAPB2(o[3]=MF(PAF(0),VFR(3),o[3]), E0,6);  VRDX(3,3,2); SBAR(); \
      GAPB2(o[0]=MF(PAF(1),VFR(4),o[0]), E0,8);  VRDX(4,0,3); SBAR(); \
      GAPB2(o[1]=MF(PAF(1),VFR(5),o[1]), E0,10); VRDX(5,1,3); SBAR(); \
      GAPB2(o[2]=MF(PAF(1),VFR(6),o[2]), E0,12); VRDX(6,2,3); SBAR(); \
      GAPB2(o[3]=MF(PAF(1),VFR(7),o[3]), E0,14); VRDX(7,3,3); SBAR(); \
      KRD8(GLK,tk,0); GAPB2(o[0]=MF(PAF(2),VFR(0),o[0]), E1,0); \
      KRD8(GLK,tk,1); GAPB2(o[1]=MF(PAF(2),VFR(1),o[1]), E1,2); \
      GAPB2(o[2]=MF(PAF(2),VFR(2),o[2]), E1,4); \
      GAPB2(o[3]=MF(PAF(2),VFR(3),o[3]), E1,6); \
      GAPB2(o[0]=MF(PAF(3),VFR(4),o[0]), E1,8); \
      GAPB2(o[1]=MF(PAF(3),VFR(5),o[1]), E1,10); \
      GAPB2(o[2]=MF(PAF(3),VFR(6),o[2]), E1,12); \
      GAPB2(o[3]=MF(PAF(3),VFR(7),o[3]), E1,14); \
    } }while(0)
  #define YPART0(E0,E1,tk) do{ SBAR(); k8a=kfrag8(kp0+KS(tk)); k8b=kfrag8(kp0+KS(tk)+512); SBAR(); \
    _Pragma("unroll") for(int r=0;r<16;++r){E0[r]=EX(E0[r]);E1[r]=EX(E1[r]);} PIN(E0); PIN(E1); SBAR(); }while(0)
  #define DMAS(t,GK,GV) do{ if(GK){DMA_K((t)+3);} if(GV){DMA_V((t)+1);} }while(0)
  #define STEP1(C0,C1,P0,P1,t,GK,GV,GL) do{ XPART(C0,C1,P0,P1,t); DMAS(t,GK,GV); CMASK(C0,C1,t); YPART(C0,C1,(t)-1,(t)+1,GL); }while(0)
  #define STEP2(C0,C1,P0,P1,t,GK,GV)    do{ YPART(P0,P1,(t)-2,(t),true); DMAS(t,GK,GV); XPART(C0,C1,P0,P1,t); CMASK(C0,C1,t); }while(0)
  #define ENDW(tt) do{ if((tt)+3<NT){WAIT_BAR_V(VW,3,2);} else if((tt)+2<NT){WAIT_BAR_V(VW,2,1);} else {WAIT_BAR(0);} }while(0)
  if(!g2){
    STEP1(pB0,pB1,pA0,pA1,1,(4<NT),(2<NT),(2<NT)); ENDW(1);
    int t=2;
    for(;t+6<NT;t+=2){
      STEP1(pA0,pA1,pB0,pB1,t,true,true,true);     WAIT_BAR_V(VW,3,2);
      STEP1(pB0,pB1,pA0,pA1,t+1,true,true,true);   WAIT_BAR_V(VW,3,2);
    }
    for(;t+2<NT;t+=2){
      STEP1(pA0,pA1,pB0,pB1,t,(t+3<NT),(t+1<NT),(t+1<NT));       ENDW(t);
      STEP1(pB0,pB1,pA0,pA1,t+1,(t+4<NT),(t+2<NT),(t+2<NT));     ENDW(t+1);
    }
    STEP1(pA0,pA1,pB0,pB1,NT-2,false,true,true); ENDW(NT-2);
    STEP1(pB0,pB1,pA0,pA1,NT-1,false,false,false);
  } else {
    { YPART0(pA0,pA1,1); DMAS(1,(4<NT),(2<NT)); XPART(pB0,pB1,pA0,pA1,1); CMASK(pB0,pB1,1); } ENDW(1);
    int t=2;
    for(;t+6<NT;t+=2){
      STEP2(pA0,pA1,pB0,pB1,t,true,true);     WAIT_BAR_V(VW,3,2);
      STEP2(pB0,pB1,pA0,pA1,t+1,true,true);   WAIT_BAR_V(VW,3,2);
    }
    for(;t+2<NT;t+=2){
      STEP2(pA0,pA1,pB0,pB1,t,(t+3<NT),(t+1<NT));       ENDW(t);
      STEP2(pB0,pB1,pA0,pA1,t+1,(t+4<NT),(t+2<NT));     ENDW(t+1);
    }
    STEP2(pA0,pA1,pB0,pB1,NT-2,false,true); ENDW(NT-2);
    STEP2(pB0,pB1,pA0,pA1,NT-1,false,false);
    YPART(pB0,pB1,NT-2,0,false);
  }
  { float sacc=pB0[0]+pB0[1]; _Pragma("unroll") for(int r=2;r<16;++r)sacc+=pB0[r]; _Pragma("unroll") for(int r=0;r<16;++r)sacc+=pB1[r]; l_reg+=sacc;
    pw0=(u32x4){PKW(pB0,0),PKW(pB0,2),PKW(pB0,4),PKW(pB0,6)};pw1=(u32x4){PKW(pB0,8),PKW(pB0,10),PKW(pB0,12),PKW(pB0,14)};pw2=(u32x4){PKW(pB1,0),PKW(pB1,2),PKW(pB1,4),PKW(pB1,6)};pw3=(u32x4){PKW(pB1,8),PKW(pB1,10),PKW(pB1,12),PKW(pB1,14)};
    SBAR(); pv_w<VW>(o,vb0+VS(NT-1),PAF(0),PAF(1),PAF(2),PAF(3)); }
  #undef PKW
  #undef PAF
  #undef VFR
  #undef PIN
  #undef MF
  #undef GAPA
  #undef GAPB4
  #undef GAPB2
  #undef EX
  #undef VRDX
  #undef KRD8
  #undef XPART
  #undef YPART
  #undef YPART0
  #undef DMAS
  #undef STEP1
  #undef STEP2
  #undef ENDW
  float rli[16];
  {auto rr=__builtin_amdgcn_permlane32_swap(__float_as_uint(l_reg),__float_as_uint(l_reg),false,false);l_reg=__uint_as_float(rr[0])+__uint_as_float(rr[1]);}
  if(__any(!(l_reg>FS_LMIN&&l_reg<FS_LMAX))){ if(lane==0)*(volatile unsigned*)(shm+F2_WS)=1u; }
  if(hi==0)wsf[32+r32]=l_reg;asm volatile("s_waitcnt lgkmcnt(0)":::"memory");
  #pragma unroll
  for(int r=0;r<16;++r)rli[r]=__builtin_amdgcn_rcpf(wsf[32+crow(r,hi)]);
  bf16*Ow=Ow0+(long)(wid*QBLK)*OPITCH;
  #pragma unroll
  for(int hv=0;hv<VW;++hv){ bf16*stg=(bf16*)(shm+F2_OST)+wid*2048;
    #pragma unroll
    for(int r=0;r<16;++r){const int orow=crow(r,hi);
      #pragma unroll
      for(int d0=0;d0<2;++d0)stg[orow*64+d0*32+r32]=__float2bfloat16(o[2*hv+d0][r]*rli[r]);}
    asm volatile("s_waitcnt lgkmcnt(0)":::"memory");
    #pragma unroll
    for(int i=0;i<4;++i){const int row=i*8+(lane>>3),ch=lane&7; const u32x4 v=*(const u32x4*)(stg+row*64+ch*8); ATTN_STORE16(Ow+(long)row*OPITCH+hv*64+ch*8,v);}
    asm volatile("s_waitcnt lgkmcnt(0)":::"memory"); }
  asm volatile("s_waitcnt lgkmcnt(0)\n\ts_barrier":::"memory");
  const bool redo=*(volatile unsigned*)(shm+F2_WS)!=0u;
  #undef DMA_K
  #undef KROW
  #undef DMA_V
  #undef CMASK
  #undef KS
  #undef VS
  return redo;
}
#undef WAIT_BAR_V
#undef MF8
constexpr int ATTN_FS2_LDS_BYTES=F2_BYTES;
constexpr int F8_S=4096, F8_K=0, F8_V=3*F8_S, F8_WS=F8_V+3*2*F8_S, F8_OST=F8_WS+NW*64*4, F8_BYTES=F8_OST+NW*4096;
constexpr float V8_SCALE=8.0f, F8_TRIG=128.0f;
#ifndef F8_CHK
#define F8_CHK 7
#endif
#define F8_PMEAN (1.0f/(float)(1<<FB))
#define F8_LOGK (6.0f-(float)FB)
#define F8_LMINF (2.0f*F8_PMEAN)
constexpr long VT_BLK=33792L*64;
#define MF8(a,b,c) __builtin_amdgcn_mfma_scale_f32_32x32x64_f8f6f4(a,b,c,0,0,0,0,0,0)
template<int VW,bool ISC,int FB> __device__ __forceinline__ bool attn_fs8(const unsigned char*__restrict__ VTh,int TR,bf16*Ow0,int NT,int kr0,int r0,lds_cfptr bt,char*shm,const unsigned char*Q8w0,const unsigned char*__restrict__ K8h){
  int tid_=threadIdx.x; asm volatile("; LAUNDER":"+v"(tid_)); const int tid=tid_,lane=tid&63,r32=lane&31,hi=lane>>5; const int wid=__builtin_amdgcn_readfirstlane(tid>>6);
  const unsigned lds0=(unsigned)(uintptr_t)shm;
  float*wsf=(float*)(shm+F8_WS)+wid*64;
  const unsigned char*ksrc8=K8h+(long)lane*64+(wid&3)*16;
  const unsigned char*vsrc8=VTh+(long)lane*64+(wid&3)*16+(VW==2?(long)(wid>>2)*VT_BLK:0L);
  const unsigned kdst=lds0+F8_K+(wid&3)*1024, vdst=lds0+F8_V+(wid&3)*1024+(VW==2?(wid>>2)*4096:0);
  #define KROW(t) (ISC ? ((t)<4 ? 64*(t) : 256+64*(kr0+(t)-4)) : 64*(t))
  #define DMA_K(t,slot) glds16(ksrc8+(long)KROW(t)*64,(unsigned)__builtin_amdgcn_readfirstlane(kdst+(slot)))
  #define DMA_V(t,slot) glds16(vsrc8+(long)KROW(t)*64,(unsigned)__builtin_amdgcn_readfirstlane(vdst+2*(slot)))
  const lds_cptr shm3=(lds_cptr)shm; const lds_cptr kp0=shm3+F8_K+(2*hi)*1024+r32*16; const lds_cptr vq0=shm3+F8_V+(2*hi)*1024+r32*16;
  glds16(ksrc8+(long)KROW(TR)*64,(unsigned)__builtin_amdgcn_readfirstlane(lds0+F8_V+4*F8_S+(wid&3)*1024));
  DMA_K(0,0);DMA_V(0,0);DMA_K(1,F8_S);
  i32x8a q8; { const unsigned char*qp=Q8w0+(long)(wid*QBLK+r32)*64+32*hi; q8=cat8a(*reinterpret_cast<const i32x4a*>(qp),*reinterpret_cast<const i32x4a*>(qp+16)); }
  i32x8a k8a,k8b;
  float l_reg=0.f;f32x16 o[2*VW];
  #pragma unroll
  for(int d0=0;d0<2*VW;++d0)o[d0]=f32x16{};
  const f32x16 zero16=f32x16{};
  #define CMASK(P0,P1,t) do{ if constexpr(ISC){ if(wid&1) cbias_par<1>(P0,P1,(t),kr0,r0,wid,r32,hi,bt); else cbias_par<0>(P0,P1,(t),kr0,r0,wid,r32,hi,bt); } }while(0)
  f32x16 pA0,pA1,pB0,pB1;
  int sl_prev=0,sl_cur=0,sl_next=F8_S;
  #define ROT() do{sl_prev=sl_cur;sl_cur=sl_next;sl_next=(sl_next==2*F8_S)?0:sl_next+F8_S;}while(0)
  DMA_K(2,2*F8_S);
  WAIT_BAR(5);
  if(tid==0)*(volatile unsigned*)(shm+F8_WS)=0u;
  f32x16 negc;
  { const lds_cptr kr_=shm3+F8_V+4*F8_S+(2*hi)*1024+r32*16;
    pA0=MF8(kfrag8(kr_),q8,zero16); pA1=MF8(kfrag8(kr_+512),q8,zero16);
    asm volatile("s_nop 15\n\ts_nop 7":"+v"(pA0),"+v"(pA1));CMASK(pA0,pA1,TR);
    float ts=0.f;
    if constexpr(ISC){ _Pragma("unroll") for(int r=0;r<16;++r){ts+=__builtin_amdgcn_exp2f(pA0[r]);ts+=__builtin_amdgcn_exp2f(pA1[r]);} }
    else { _Pragma("unroll") for(int r=0;r<16;++r){ts+=pA0[r];ts+=pA1[r];} }
    {auto rr=__builtin_amdgcn_permlane32_swap(__float_as_uint(ts),__float_as_uint(ts),false,false);ts=__uint_as_float(rr[0])+__uint_as_float(rr[1]);}
    const float nc=ISC?F8_LOGK-__builtin_amdgcn_logf(ts):-(ts*(1.0f/64.0f))-(float)FB;
    _Pragma("unroll") for(int r=0;r<16;++r)negc[r]=nc; }
  pA0=MF8(kfrag8(kp0),q8,negc); pA1=MF8(kfrag8(kp0+512),q8,negc);
  asm volatile("s_nop 15\n\ts_nop 7":"+v"(pA0),"+v"(pA1));CMASK(pA0,pA1,0);
  _Pragma("unroll") for(int r=0;r<16;++r){pA0[r]=__builtin_amdgcn_exp2f(pA0[r]);pA1[r]=__builtin_amdgcn_exp2f(pA1[r]);}
  WAIT_BAR(0);
  DMA_K(3,0);DMA_V(1,F8_S);
  ROT();
  k8a=kfrag8(kp0+sl_cur); k8b=kfrag8(kp0+sl_cur+512);
  WAIT_BAR(2);
  i32x8a vfa[2]; i32x8a pq=i32x8a{};
  #define PIN(x) asm volatile("":"+v"(x))
  #define EX(v) __builtin_amdgcn_exp2f(v)
  #define CV8(P,B,W) W=__builtin_amdgcn_cvt_pk_fp8_f32(P[B],P[(B)+1],W,false); W=__builtin_amdgcn_cvt_pk_fp8_f32(P[(B)+2],P[(B)+3],W,true)
  #define VOFF(dq) (((dq)>>1)*4096+((dq)&1)*512)
  #define SUM8(P,B) do{ sacc+=P[B]; sacc+=P[(B)+1]; sacc+=P[(B)+2]; sacc+=P[(B)+3]; sacc+=P[(B)+4]; sacc+=P[(B)+5]; sacc+=P[(B)+6]; sacc+=P[(B)+7]; PIN(sacc); }while(0)
  #define PK8(P,B,I) do{ int w0_=pq[I],w1_=pq[(I)+1]; CV8(P,B,w0_); CV8(P,(B)+4,w1_); pq[I]=w0_; pq[(I)+1]=w1_; PIN(pq); }while(0)
  #define EXP8(X,B) do{ X[B]=EX(X[B]); X[(B)+1]=EX(X[(B)+1]); X[(B)+2]=EX(X[(B)+2]); X[(B)+3]=EX(X[(B)+3]); X[(B)+4]=EX(X[(B)+4]); X[(B)+5]=EX(X[(B)+5]); X[(B)+6]=EX(X[(B)+6]); X[(B)+7]=EX(X[(B)+7]); PIN(X); }while(0)
  #define RESCALE(P0,P1,HASC,C0,C1) do{ if(__builtin_expect(__any(sacc>F8_TRIG),0)){ \
      int ex_=((__float_as_int(sacc)>>23)&255)-133; ex_=ex_<0?0:ex_; \
      {auto rr=__builtin_amdgcn_permlane32_swap((unsigned)ex_,(unsigned)ex_,false,false); const int e0_=(int)rr[0],e1_=(int)rr[1]; ex_=e0_>e1_?e0_:e1_;} \
      const float f_=__builtin_amdgcn_ldexpf(1.0f,-ex_), d_=(float)ex_; \
      _Pragma("unroll") for(int r=0;r<16;++r){P0[r]*=f_;P1[r]*=f_;negc[r]-=d_;} \
      sacc*=f_; l_reg*=f_; \
      if constexpr(HASC){ _Pragma("unroll") for(int r=0;r<16;++r){C0[r]-=d_;C1[r]-=d_;} } \
      if(hi==0)wsf[32+r32]=f_; asm volatile("s_waitcnt lgkmcnt(0)":::"memory"); \
      _Pragma("unroll") for(int r=0;r<16;++r){ const float fr_=wsf[32+crow(r,hi)]; _Pragma("unroll") for(int dq=0;dq<2*VW;++dq)o[dq][r]*=fr_; } \
      asm volatile("s_waitcnt lgkmcnt(0)":::"memory"); } }while(0)
  #define STEP(C0,C1,P0,P1,t,GK,GV,GL) do{ SBAR(); \
    const lds_cptr vq_=vq0+2*sl_prev; \
    vfa[0]=kfrag8(vq_+VOFF(0)); SBAR(); \
    float sacc=0.f; \
    C0=MF8(k8a,q8,negc); SBAR(); \
    SUM8(P0,0); SBAR(); \
    vfa[1]=kfrag8(vq_+VOFF(1)); SBAR(); \
    SUM8(P0,8); SBAR(); \
    C1=MF8(k8b,q8,negc); SBAR(); \
    SUM8(P1,0); SUM8(P1,8); SBAR(); \
    RESCALE(P0,P1,true,C0,C1); \
    PK8(P0,0,0); PK8(P0,8,2); PK8(P1,0,4); PK8(P1,8,6); SBAR(); \
    l_reg+=sacc; \
    if(GK){DMA_K((t)+3,sl_cur);} if(GV){DMA_V((t)+1,sl_next);} \
    CMASK(C0,C1,t); \
    SBAR(); \
    if constexpr(VW==1){ \
      o[0]=MF8(pq,vfa[0],o[0]); SBAR(); EXP8(C0,0); SBAR(); \
      if(GL){ k8a=kfrag8(kp0+sl_next); SBAR(); } EXP8(C0,8); SBAR(); \
      o[1]=MF8(pq,vfa[1],o[1]); SBAR(); EXP8(C1,0); SBAR(); \
      if(GL){ k8b=kfrag8(kp0+sl_next+512); SBAR(); } EXP8(C1,8); SBAR(); \
    } else { \
      o[0]=MF8(pq,vfa[0],o[0]); SBAR(); vfa[0]=kfrag8(vq_+VOFF(2)); SBAR(); EXP8(C0,0); SBAR(); \
      o[1]=MF8(pq,vfa[1],o[1]); SBAR(); vfa[1]=kfrag8(vq_+VOFF(3)); SBAR(); if(GL){ k8a=kfrag8(kp0+sl_next); SBAR(); } EXP8(C0,8); SBAR(); \
      o[2]=MF8(pq,vfa[0],o[2]); SBAR(); EXP8(C1,0); SBAR(); \
      o[3]=MF8(pq,vfa[1],o[3]); SBAR(); if(GL){ k8b=kfrag8(kp0+sl_next+512); SBAR(); } EXP8(C1,8); SBAR(); \
    } \
    }while(0)
  int t=1;
  for(;t+5<NT;t+=2){
    STEP(pB0,pB1,pA0,pA1,t,true,true,true);     WAIT_BAR(2); ROT();
    STEP(pA0,pA1,pB0,pB1,t+1,true,true,true);   WAIT_BAR(2); ROT();
  }
  #define ENDW(tt) do{ if((tt)+3<NT){WAIT_BAR(2);} else if((tt)+2<NT){WAIT_BAR(1);} else {WAIT_BAR(0);} }while(0)
  for(;t+1<NT;t+=2){
    STEP(pB0,pB1,pA0,pA1,t,(t+3<NT),(t+1<NT),(t+1<NT));       ENDW(t);   ROT();
    STEP(pA0,pA1,pB0,pB1,t+1,(t+4<NT),(t+2<NT),(t+2<NT));     ENDW(t+1); ROT();
  }
  STEP(pB0,pB1,pA0,pA1,NT-1,false,false,false);
  { const lds_cptr vq_=vq0+2*sl_cur;
    float sacc=0.f; SUM8(pB0,0); SUM8(pB0,8); SUM8(pB1,0); SUM8(pB1,8); RESCALE(pB0,pB1,false,pB0,pB1); l_reg+=sacc;
    PK8(pB0,0,0); PK8(pB0,8,2); PK8(pB1,0,4); PK8(pB1,8,6); SBAR();
    #pragma unroll
    for(int dq=0;dq<2*VW;++dq)o[dq]=MF8(pq,kfrag8(vq_+VOFF(dq)),o[dq]); }
  #undef PIN
  #undef EX
  #undef CV8
  #undef VOFF
  #undef SUM8
  #undef PK8
  #undef EXP8
  #undef STEP
  #undef RESCALE
  #undef ENDW
  float rli[16];
  {auto rr=__builtin_amdgcn_permlane32_swap(__float_as_uint(l_reg),__float_as_uint(l_reg),false,false);l_reg=__uint_as_float(rr[0])+__uint_as_float(rr[1]);}
  if(__any(!((l_reg>F8_LMINF*(float)NT||!(F8_CHK&1))&&(l_reg<FS_LMAX||!(F8_CHK&4))&&!(F8_CHK&8)))){ if(lane==0)*(volatile unsigned*)(shm+F8_WS)=1u; }
  if(hi==0)wsf[32+r32]=l_reg;asm volatile("s_waitcnt lgkmcnt(0)":::"memory");
  #pragma unroll
  for(int r=0;r<16;++r)rli[r]=__builtin_amdgcn_rcpf(wsf[32+crow(r,hi)])*(1.0f/V8_SCALE);
  bf16*Ow=Ow0+(long)(wid*QBLK)*OPITCH;
  #pragma unroll
  for(int hv=0;hv<VW;++hv){ bf16*stg=(bf16*)(shm+F8_OST)+wid*2048;
    #pragma unroll
    for(int r=0;r<16;++r){const int orow=crow(r,hi);
      #pragma unroll
      for(int d0=0;d0<2;++d0)stg[orow*64+d0*32+r32]=__float2bfloat16(o[2*hv+d0][r]*rli[r]);}
    asm volatile("s_waitcnt lgkmcnt(0)":::"memory");
    #pragma unroll
    for(int i=0;i<4;++i){const int row=i*8+(lane>>3),ch=lane&7; const u32x4 v=*(const u32x4*)(stg+row*64+ch*8); ATTN_STORE16(Ow+(long)row*OPITCH+hv*64+ch*8,v);}
    asm volatile("s_waitcnt lgkmcnt(0)":::"memory"); }
  asm volatile("s_waitcnt lgkmcnt(0)\n\ts_barrier":::"memory");
  const bool redo=*(volatile unsigned*)(shm+F8_WS)!=0u;
  #undef DMA_K
  #undef KROW
  #undef DMA_V
  #undef CMASK
  #undef ROT
  return redo;
}
#undef MF8
#undef F8_PMEAN
#undef F8_LOGK
#undef F8_LMINF
constexpr int ATTN_FS8_LDS_BYTES=F8_BYTES;
#ifndef F8_MSUM
#define F8_MSUM 0
#endif
constexpr int P8_K=0, P8_V=2*8192, P8_WS=P8_V+2*16384, P8_OST=P8_WS+NW*64*4, P8_BYTES=P8_OST+NW*4096;
#define F8_PMEAN (1.0f/(float)(1<<FB))
#define F8_LOGK (6.0f-(float)FB)
#define F8_LMINF (2.0f*F8_PMEAN)
#define MF8(a,b,c) __builtin_amdgcn_mfma_scale_f32_32x32x64_f8f6f4(a,b,c,0,0,0,0,0,0)
template<int VW,bool ISC,int FB> __device__ __forceinline__ bool attn_fs8p(const unsigned char*__restrict__ VTh,int TR,bf16*Ow0,int NT,int kr0,int r0,lds_cfptr bt,char*shm,const unsigned char*Q8w0,const unsigned char*__restrict__ K8h){
  int tid_=threadIdx.x; asm volatile("; LAUNDER":"+v"(tid_)); const int tid=tid_,lane=tid&63,r32=lane&31,hi=lane>>5; const int wid=__builtin_amdgcn_readfirstlane(tid>>6);
  const unsigned lds0=(unsigned)(uintptr_t)shm;
  float*wsf=(float*)(shm+P8_WS)+wid*64;
  constexpr int VTS=4096*VW, VSL=2*VTS;
  const int wt=wid>>2, wc4=wid&3;
  const unsigned char*ksrc8=K8h+(long)lane*64+wc4*16;
  const unsigned char*vsrc8=VTh+(long)lane*64+wc4*16;
  const unsigned kdst=lds0+P8_K+wt*4096+wc4*1024, vdst=lds0+P8_V+wt*VTS+wc4*1024;
  #define KROW(t) (ISC ? ((t)<4 ? 64*(t) : 256+64*(kr0+(t)-4)) : 64*(t))
  #define DMA_KP(p) glds16(ksrc8+(long)KROW(2*(p)+wt)*64,(unsigned)__builtin_amdgcn_readfirstlane(kdst+((p)&1)*8192))
  #define DMA_VP(p) do{ glds16(vsrc8+(long)KROW(2*(p)+wt)*64,(unsigned)__builtin_amdgcn_readfirstlane(vdst+((p)&1)*VSL)); \
      if constexpr(VW==2){ glds16(vsrc8+VT_BLK+(long)KROW(2*(p)+wt)*64,(unsigned)__builtin_amdgcn_readfirstlane(vdst+((p)&1)*VSL+4096)); } }while(0)
  const lds_cptr shm3=(lds_cptr)shm; const lds_cptr kp0=shm3+P8_K+(2*hi)*1024+r32*16; const lds_cptr vq0=shm3+P8_V+(2*hi)*1024+r32*16;
  #define KADR(t) (kp0+(((t)>>1)&1)*8192+((t)&1)*4096)
  #define VADR(t) (vq0+(((t)>>1)&1)*VSL+((t)&1)*VTS)
  glds16(ksrc8+(long)KROW(TR)*64,(unsigned)__builtin_amdgcn_readfirstlane(lds0+P8_V+VSL+wc4*1024));
  DMA_KP(0);DMA_VP(0);DMA_KP(1);
  i32x8a q8; { const unsigned char*qp=Q8w0+(long)(wid*QBLK+r32)*64+32*hi; q8=cat8a(*reinterpret_cast<const i32x4a*>(qp),*reinterpret_cast<const i32x4a*>(qp+16)); }
  i32x8a k8a,k8b;
  constexpr bool MS=(VW==1)&&(F8_MSUM!=0);
  float l_reg=0.f;f32x16 o[2*VW]; f32x16 lsum=f32x16{}; const i32x8a ones8=(i32x8a){0x38383838,0x38383838,0x38383838,0x38383838,0x38383838,0x38383838,0x38383838,0x38383838};
  #pragma unroll
  for(int d0=0;d0<2*VW;++d0)o[d0]=f32x16{};
  const f32x16 zero16=f32x16{};
  #define CMASK(P0,P1,t) do{ if constexpr(ISC){ if(wid&1) cbias_par<1>(P0,P1,(t),kr0,r0,wid,r32,hi,bt); else cbias_par<0>(P0,P1,(t),kr0,r0,wid,r32,hi,bt); } }while(0)
  f32x16 pA0,pA1,pB0,pB1;
  WAIT_BAR(0);
  if(tid==0)*(volatile unsigned*)(shm+P8_WS)=0u;
  f32x16 negc;
  { const lds_cptr kr_=shm3+P8_V+VSL+(2*hi)*1024+r32*16;
    pA0=MF8(kfrag8(kr_),q8,zero16); pA1=MF8(kfrag8(kr_+512),q8,zero16);
    asm volatile("s_nop 15\n\ts_nop 7":"+v"(pA0),"+v"(pA1));CMASK(pA0,pA1,TR);
    float ts=0.f;
    if constexpr(ISC){ _Pragma("unroll") for(int r=0;r<16;++r){ts+=__builtin_amdgcn_exp2f(pA0[r]);ts+=__builtin_amdgcn_exp2f(pA1[r]);} }
    else { _Pragma("unroll") for(int r=0;r<16;++r){ts+=pA0[r];ts+=pA1[r];} }
    {auto rr=__builtin_amdgcn_permlane32_swap(__float_as_uint(ts),__float_as_uint(ts),false,false);ts=__uint_as_float(rr[0])+__uint_as_float(rr[1]);}
    const float nc=ISC?F8_LOGK-__builtin_amdgcn_logf(ts):-(ts*(1.0f/64.0f))-(float)FB;
    _Pragma("unroll") for(int r=0;r<16;++r)negc[r]=nc; }
  pA0=MF8(kfrag8(KADR(0)),q8,negc); pA1=MF8(kfrag8(KADR(0)+512),q8,negc);
  asm volatile("s_nop 15\n\ts_nop 7":"+v"(pA0),"+v"(pA1));CMASK(pA0,pA1,0);
  _Pragma("unroll") for(int r=0;r<16;++r){pA0[r]=__builtin_amdgcn_exp2f(pA0[r]);pA1[r]=__builtin_amdgcn_exp2f(pA1[r]);}
  k8a=kfrag8(KADR(1)); k8b=kfrag8(KADR(1)+512);
  WAIT_BAR(0);
  i32x8a vfa[2]; i32x8a pq=i32x8a{};
  #define PIN(x) asm volatile("":"+v"(x))
  #define EX(v) __builtin_amdgcn_exp2f(v)
  #define CV8(P,B,W) W=__builtin_amdgcn_cvt_pk_fp8_f32(P[B],P[(B)+1],W,false); W=__builtin_amdgcn_cvt_pk_fp8_f32(P[(B)+2],P[(B)+3],W,true)
  #define VOFF(dq) (((dq)>>1)*4096+((dq)&1)*512)
  #define MX3(a_,b_) asm("v_max3_f32 %0, %0, %1, %2":"+v"(sacc):"v"(a_),"v"(b_))
  #define SUM8(P,B) do{ if constexpr(MS){ MX3(P[B],P[(B)+1]); MX3(P[(B)+2],P[(B)+3]); MX3(P[(B)+4],P[(B)+5]); MX3(P[(B)+6],P[(B)+7]); PIN(sacc); } \
      else { sacc+=P[B]; sacc+=P[(B)+1]; sacc+=P[(B)+2]; sacc+=P[(B)+3]; sacc+=P[(B)+4]; sacc+=P[(B)+5]; sacc+=P[(B)+6]; sacc+=P[(B)+7]; PIN(sacc); } }while(0)
  #define PK8(P,B,I) do{ int w0_=pq[I],w1_=pq[(I)+1]; CV8(P,B,w0_); CV8(P,(B)+4,w1_); pq[I]=w0_; pq[(I)+1]=w1_; PIN(pq); }while(0)
  #define EXP8(X,B) do{ X[B]=EX(X[B]); X[(B)+1]=EX(X[(B)+1]); X[(B)+2]=EX(X[(B)+2]); X[(B)+3]=EX(X[(B)+3]); X[(B)+4]=EX(X[(B)+4]); X[(B)+5]=EX(X[(B)+5]); X[(B)+6]=EX(X[(B)+6]); X[(B)+7]=EX(X[(B)+7]); PIN(X); }while(0)
  #define RESCALE(P0,P1,HASC,C0,C1) do{ if(__builtin_expect(__any(sacc>F8_TRIG),0)){ \
      int ex_=((__float_as_int(sacc)>>23)&255)-133; ex_=ex_<0?0:ex_; \
      {auto rr=__builtin_amdgcn_permlane32_swap((unsigned)ex_,(unsigned)ex_,false,false); const int e0_=(int)rr[0],e1_=(int)rr[1]; ex_=e0_>e1_?e0_:e1_;} \
      const float f_=__builtin_amdgcn_ldexpf(1.0f,-ex_), d_=(float)ex_; \
      _Pragma("unroll") for(int r=0;r<16;++r){P0[r]*=f_;P1[r]*=f_;negc[r]-=d_;} \
      sacc*=f_; l_reg*=f_; \
      if constexpr(HASC){ _Pragma("unroll") for(int r=0;r<16;++r){C0[r]-=d_;C1[r]-=d_;} } \
      if(hi==0)wsf[32+r32]=f_; asm volatile("s_waitcnt lgkmcnt(0)":::"memory"); \
      _Pragma("unroll") for(int r=0;r<16;++r){ const float fr_=wsf[32+crow(r,hi)]; _Pragma("unroll") for(int dq=0;dq<2*VW;++dq)o[dq][r]*=fr_; if constexpr(MS){lsum[r]*=fr_;} } \
      asm volatile("s_waitcnt lgkmcnt(0)":::"memory"); } }while(0)
  #define STEP(C0,C1,P0,P1,t,VQ,KN,GL) do{ SBAR(); \
    const lds_cptr vq_=(VQ); const lds_cptr kn_=(KN); \
    vfa[0]=kfrag8(vq_+VOFF(0)); SBAR(); \
    float sacc=0.f; \
    C0=MF8(k8a,q8,negc); SBAR(); \
    SUM8(P0,0); SBAR(); \
    vfa[1]=kfrag8(vq_+VOFF(1)); SBAR(); \
    SUM8(P0,8); SBAR(); \
    C1=MF8(k8b,q8,negc); SBAR(); \
    SUM8(P1,0); SUM8(P1,8); SBAR(); \
    RESCALE(P0,P1,true,C0,C1); \
    PK8(P0,0,0); PK8(P0,8,2); PK8(P1,0,4); PK8(P1,8,6); SBAR(); \
    if constexpr(!MS){ l_reg+=sacc; } \
    CMASK(C0,C1,t); \
    SBAR(); \
    if constexpr(VW==1){ \
      o[0]=MF8(pq,vfa[0],o[0]); SBAR(); EXP8(C0,0); SBAR(); \
      if(GL){ k8a=kfrag8(kn_); SBAR(); } EXP8(C0,8); SBAR(); \
      o[1]=MF8(pq,vfa[1],o[1]); SBAR(); EXP8(C1,0); SBAR(); \
      if constexpr(MS){ lsum=MF8(pq,ones8,lsum); SBAR(); } \
      if(GL){ k8b=kfrag8(kn_+512); SBAR(); } EXP8(C1,8); SBAR(); \
    } else { \
      o[0]=MF8(pq,vfa[0],o[0]); SBAR(); vfa[0]=kfrag8(vq_+VOFF(2)); SBAR(); EXP8(C0,0); SBAR(); \
      o[1]=MF8(pq,vfa[1],o[1]); SBAR(); vfa[1]=kfrag8(vq_+VOFF(3)); SBAR(); if(GL){ k8a=kfrag8(kn_); SBAR(); } EXP8(C0,8); SBAR(); \
      o[2]=MF8(pq,vfa[0],o[2]); SBAR(); EXP8(C1,0); SBAR(); \
      o[3]=MF8(pq,vfa[1],o[3]); SBAR(); if(GL){ k8b=kfrag8(kn_+512); SBAR(); } EXP8(C1,8); SBAR(); \
    } \
    }while(0)
  const int NG=(NT>>1)-1;
  for(int g=0;g<NG;++g){
    if(g+2<(NT>>1)){DMA_KP(g+2);} DMA_VP(g+1);
    STEP(pB0,pB1,pA0,pA1,2*g+1,VADR(2*g),KADR(2*g+2),true);
    STEP(pA0,pA1,pB0,pB1,2*g+2,VADR(2*g+1),KADR(2*g+3),true);
    WAIT_BAR(0);
  }
  STEP(pB0,pB1,pA0,pA1,NT-1,VADR(NT-2),KADR(0),false);
  { const lds_cptr vq_=VADR(NT-1);
    float sacc=0.f; SUM8(pB0,0); SUM8(pB0,8); SUM8(pB1,0); SUM8(pB1,8); RESCALE(pB0,pB1,false,pB0,pB1); if constexpr(!MS){ l_reg+=sacc; }
    PK8(pB0,0,0); PK8(pB0,8,2); PK8(pB1,0,4); PK8(pB1,8,6); SBAR();
    if constexpr(MS){ lsum=MF8(pq,ones8,lsum); }
    #pragma unroll
    for(int dq=0;dq<2*VW;++dq)o[dq]=MF8(pq,kfrag8(vq_+VOFF(dq)),o[dq]); }
  #undef PIN
  #undef EX
  #undef CV8
  #undef VOFF
  #undef SUM8
  #undef MX3
  #undef PK8
  #undef EXP8
  #undef STEP
  #undef RESCALE
  float rli[16];
  if constexpr(MS){
    float mn=lsum[0],mx=lsum[0];
    #pragma unroll
    for(int r=1;r<16;++r){mn=fminf(mn,lsum[r]);mx=fmaxf(mx,lsum[r]);}
    bool bad=!((mn>F8_LMINF*(float)NT||!(F8_CHK&1))&&(mx<FS_LMAX||!(F8_CHK&4))&&!(F8_CHK&8));
    #pragma unroll
    for(int r=0;r<16;++r)bad=bad||(lsum[r]!=lsum[r]);
    if(__any(bad)){ if(lane==0)*(volatile unsigned*)(shm+P8_WS)=1u; }
    #pragma unroll
    for(int r=0;r<16;++r)rli[r]=__builtin_amdgcn_rcpf(lsum[r])*(1.0f/V8_SCALE);
  } else {
  {auto rr=__builtin_amdgcn_permlane32_swap(__float_as_uint(l_reg),__float_as_uint(l_reg),false,false);l_reg=__uint_as_float(rr[0])+__uint_as_float(rr[1]);}
  if(__any(!((l_reg>F8_LMINF*(float)NT||!(F8_CHK&1))&&(l_reg<FS_LMAX||!(F8_CHK&4))&&!(F8_CHK&8)))){ if(lane==0)*(volatile unsigned*)(shm+P8_WS)=1u; }
  if(hi==0)wsf[32+r32]=l_reg;asm volatile("s_waitcnt lgkmcnt(0)":::"memory");
  #pragma unroll
  for(int r=0;r<16;++r)rli[r]=__builtin_amdgcn_rcpf(wsf[32+crow(r,hi)])*(1.0f/V8_SCALE);
  }
  bf16*Ow=Ow0+(long)(wid*QBLK)*OPITCH;
  #pragma unroll
  for(int hv=0;hv<VW;++hv){ bf16*stg=(bf16*)(shm+P8_OST)+wid*2048;
    #pragma unroll
    for(int r=0;r<16;++r){const int orow=crow(r,hi);
      #pragma unroll
      for(int d0=0;d0<2;++d0)stg[orow*64+d0*32+r32]=__float2bfloat16(o[2*hv+d0][r]*rli[r]);}
    asm volatile("s_waitcnt lgkmcnt(0)":::"memory");
    #pragma unroll
    for(int i=0;i<4;++i){const int row=i*8+(lane>>3),ch=lane&7; const u32x4 v=*(const u32x4*)(stg+row*64+ch*8); ATTN_STORE16(Ow+(long)row*OPITCH+hv*64+ch*8,v);}
    asm volatile("s_waitcnt lgkmcnt(0)":::"memory"); }
  asm volatile("s_waitcnt lgkmcnt(0)\n\ts_barrier":::"memory");
  const bool redo=*(volatile unsigned*)(shm+P8_WS)!=0u;
  #undef DMA_KP
  #undef DMA_VP
  #undef KROW
  #undef KADR
  #undef VADR
  #undef CMASK
  return redo;
}
#undef MF8
#undef F8_PMEAN
#undef F8_LOGK
#undef F8_LMINF
constexpr int ATTN_FS8P_LDS_BYTES=P8_BYTES;
constexpr int Q8_K=0, Q8_V=2*16384, Q8_REF=Q8_V+2*32768, Q8_WS=Q8_REF+4096, Q8_OST=Q8_K, Q8_BYTES=Q8_WS+NW*64*4;
#define F8_PMEAN (1.0f/(float)(1<<FB))
#define F8_LOGK (6.0f-(float)FB)
#define F8_LMINF (2.0f*F8_PMEAN)
#define MF8(a,b,c) __builtin_amdgcn_mfma_scale_f32_32x32x64_f8f6f4(a,b,c,0,0,0,0,0,0)
template<int VW,bool ISC,int FB> __device__ __forceinline__ bool attn_fs8q(const unsigned char*__restrict__ VTh,int TR,bf16*Ow0,int NT,int kr0,int r0,lds_cfptr bt,char*shm,const unsigned char*Q8w0,const unsigned char*__restrict__ K8h){
  int tid_=threadIdx.x; asm volatile("; LAUNDER":"+v"(tid_)); const int tid=tid_,lane=tid&63,r32=lane&31,hi=lane>>5; const int wid=__builtin_amdgcn_readfirstlane(tid>>6);
  const unsigned lds0=(unsigned)(uintptr_t)shm;
  float*wsf=(float*)(shm+Q8_WS)+wid*64;
  constexpr bool MS=false;
  constexpr int VTS=4096*VW, VSL=4*VTS;
  const int wt=wid>>2, wc4=wid&3;
  const unsigned char*ksrc8=K8h+(long)lane*64+wc4*16;
  const unsigned char*vsrc8=VTh+(long)lane*64+wc4*16;
  #define KROW(t) (ISC ? ((t)<4 ? 64*(t) : 256+64*(kr0+(t)-4)) : 64*(t))
  #define DMA_KG(j) do{ _Pragma("unroll") for(int h_=0;h_<2;++h_){ const int ps_=wt+2*h_, tl_=4*(j)-3+ps_; \
      if(tl_>=0&&tl_<NT){ glds16(ksrc8+(long)KROW(tl_)*64,(unsigned)__builtin_amdgcn_readfirstlane(lds0+Q8_K+((j)&1)*16384+ps_*4096+wc4*1024)); } } }while(0)
  #define DMA_VQ(i) do{ _Pragma("unroll") for(int h_=0;h_<2;++h_){ const int ps_=wt+2*h_, tl_=4*(i)+ps_; \
      glds16(vsrc8+(long)KROW(tl_)*64,(unsigned)__builtin_amdgcn_readfirstlane(lds0+Q8_V+((i)&1)*VSL+ps_*VTS+wc4*1024)); \
      if constexpr(VW==2){ glds16(vsrc8+VT_BLK+(long)KROW(tl_)*64,(unsigned)__builtin_amdgcn_readfirstlane(lds0+Q8_V+((i)&1)*VSL+ps_*VTS+4096+wc4*1024)); } } }while(0)
  const lds_cptr shm3=(lds_cptr)shm; const lds_cptr kp0=shm3+Q8_K+(2*hi)*1024+r32*16; const lds_cptr vq0=shm3+Q8_V+(2*hi)*1024+r32*16;
  #define KADR(t) (kp0+((((t)+3)>>2)&1)*16384+(((t)+3)&3)*4096)
  #define VADR(t) (vq0+(((t)>>2)&1)*VSL+((t)&3)*VTS)
  glds16(ksrc8+(long)KROW(TR)*64,(unsigned)__builtin_amdgcn_readfirstlane(lds0+Q8_REF+wc4*1024));
  DMA_KG(0);DMA_KG(1);DMA_VQ(0);
  i32x8a q8; { const unsigned char*qp=Q8w0+(long)(wid*QBLK+r32)*64+32*hi; q8=cat8a(*reinterpret_cast<const i32x4a*>(qp),*reinterpret_cast<const i32x4a*>(qp+16)); }
  i32x8a k8a,k8b;
  float l_reg=0.f;f32x16 o[2*VW]; f32x16 lsum=f32x16{}; const i32x8a ones8=i32x8a{};
  #pragma unroll
  for(int d0=0;d0<2*VW;++d0)o[d0]=f32x16{};
  const f32x16 zero16=f32x16{};
  #define CMASK(P0,P1,t) do{ if constexpr(ISC){ if(wid&1) cbias_par<1>(P0,P1,(t),kr0,r0,wid,r32,hi,bt); else cbias_par<0>(P0,P1,(t),kr0,r0,wid,r32,hi,bt); } }while(0)
  f32x16 pA0,pA1,pB0,pB1;
  WAIT_BAR(0);
  if(tid==0)*(volatile unsigned*)(shm+Q8_WS)=0u;
  f32x16 negc;
  { const lds_cptr kr_=shm3+Q8_REF+(2*hi)*1024+r32*16;
    pA0=MF8(kfrag8(kr_),q8,zero16); pA1=MF8(kfrag8(kr_+512),q8,zero16);
    asm volatile("s_nop 15\n\ts_nop 7":"+v"(pA0),"+v"(pA1));CMASK(pA0,pA1,TR);
    float ts=0.f;
    if constexpr(ISC){ _Pragma("unroll") for(int r=0;r<16;++r){ts+=__builtin_amdgcn_exp2f(pA0[r]);ts+=__builtin_amdgcn_exp2f(pA1[r]);} }
    else { _Pragma("unroll") for(int r=0;r<16;++r){ts+=pA0[r];ts+=pA1[r];} }
    {auto rr=__builtin_amdgcn_permlane32_swap(__float_as_uint(ts),__float_as_uint(ts),false,false);ts=__uint_as_float(rr[0])+__uint_as_float(rr[1]);}
    const float nc=ISC?F8_LOGK-__builtin_amdgcn_logf(ts):-(ts*(1.0f/64.0f))-(float)FB;
    _Pragma("unroll") for(int r=0;r<16;++r)negc[r]=nc; }
  pA0=MF8(kfrag8(KADR(0)),q8,negc); pA1=MF8(kfrag8(KADR(0)+512),q8,negc);
  asm volatile("s_nop 15\n\ts_nop 7":"+v"(pA0),"+v"(pA1));CMASK(pA0,pA1,0);
  _Pragma("unroll") for(int r=0;r<16;++r){pA0[r]=__builtin_amdgcn_exp2f(pA0[r]);pA1[r]=__builtin_amdgcn_exp2f(pA1[r]);}
  WAIT_BAR(0);
  i32x8a vfa[2]; i32x8a pq=i32x8a{};
  #define PIN(x) asm volatile("":"+v"(x))
  #define EX(v) __builtin_amdgcn_exp2f(v)
  #define CV8(P,B,W) W=__builtin_amdgcn_cvt_pk_fp8_f32(P[B],P[(B)+1],W,false); W=__builtin_amdgcn_cvt_pk_fp8_f32(P[(B)+2],P[(B)+3],W,true)
  #define VOFF(dq) (((dq)>>1)*4096+((dq)&1)*512)
  #define MX3(a_,b_) asm("v_max3_f32 %0, %0, %1, %2":"+v"(sacc):"v"(a_),"v"(b_))
  #define SUM8(P,B) do{ if constexpr(MS){ MX3(P[B],P[(B)+1]); MX3(P[(B)+2],P[(B)+3]); MX3(P[(B)+4],P[(B)+5]); MX3(P[(B)+6],P[(B)+7]); PIN(sacc); } \
      else { sacc+=P[B]; sacc+=P[(B)+1]; sacc+=P[(B)+2]; sacc+=P[(B)+3]; sacc+=P[(B)+4]; sacc+=P[(B)+5]; sacc+=P[(B)+6]; sacc+=P[(B)+7]; PIN(sacc); } }while(0)
  #define PK8(P,B,I) do{ int w0_=pq[I],w1_=pq[(I)+1]; CV8(P,B,w0_); CV8(P,(B)+4,w1_); pq[I]=w0_; pq[(I)+1]=w1_; PIN(pq); }while(0)
  #define EXP8(X,B) do{ X[B]=EX(X[B]); X[(B)+1]=EX(X[(B)+1]); X[(B)+2]=EX(X[(B)+2]); X[(B)+3]=EX(X[(B)+3]); X[(B)+4]=EX(X[(B)+4]); X[(B)+5]=EX(X[(B)+5]); X[(B)+6]=EX(X[(B)+6]); X[(B)+7]=EX(X[(B)+7]); PIN(X); }while(0)
  #define RESCALE(P0,P1,HASC,C0,C1) do{ if(__builtin_expect(__any(sacc>F8_TRIG),0)){ \
      int ex_=((__float_as_int(sacc)>>23)&255)-133; ex_=ex_<0?0:ex_; \
      {auto rr=__builtin_amdgcn_permlane32_swap((unsigned)ex_,(unsigned)ex_,false,false); const int e0_=(int)rr[0],e1_=(int)rr[1]; ex_=e0_>e1_?e0_:e1_;} \
      const float f_=__builtin_amdgcn_ldexpf(1.0f,-ex_), d_=(float)ex_; \
      _Pragma("unroll") for(int r=0;r<16;++r){P0[r]*=f_;P1[r]*=f_;negc[r]-=d_;} \
      sacc*=f_; l_reg*=f_; \
      if constexpr(HASC){ _Pragma("unroll") for(int r=0;r<16;++r){C0[r]-=d_;C1[r]-=d_;} } \
      if(hi==0)wsf[32+r32]=f_; asm volatile("s_waitcnt lgkmcnt(0)":::"memory"); \
      _Pragma("unroll") for(int r=0;r<16;++r){ const float fr_=wsf[32+crow(r,hi)]; _Pragma("unroll") for(int dq=0;dq<2*VW;++dq)o[dq][r]*=fr_; if constexpr(MS){lsum[r]*=fr_;} } \
      asm volatile("s_waitcnt lgkmcnt(0)":::"memory"); } }while(0)
  #define STEP(C0,C1,P0,P1,t,KFIRST,GL) do{ SBAR(); \
    const lds_cptr vq_=VADR((t)-1); const lds_cptr kn_=KADR((t)+1); \
    if(KFIRST){ k8a=kfrag8(KADR(t)); k8b=kfrag8(KADR(t)+512); SBAR(); } \
    vfa[0]=kfrag8(vq_+VOFF(0)); SBAR(); \
    float sacc=0.f; \
    C0=MF8(k8a,q8,negc); SBAR(); \
    SUM8(P0,0); SBAR(); \
    vfa[1]=kfrag8(vq_+VOFF(1)); SBAR(); \
    SUM8(P0,8); SBAR(); \
    C1=MF8(k8b,q8,negc); SBAR(); \
    SUM8(P1,0); SUM8(P1,8); SBAR(); \
    RESCALE(P0,P1,true,C0,C1); \
    PK8(P0,0,0); PK8(P0,8,2); PK8(P1,0,4); PK8(P1,8,6); SBAR(); \
    if constexpr(!MS){ l_reg+=sacc; } \
    CMASK(C0,C1,t); \
    SBAR(); \
    if constexpr(VW==1){ \
      o[0]=MF8(pq,vfa[0],o[0]); SBAR(); EXP8(C0,0); SBAR(); \
      if(GL){ k8a=kfrag8(kn_); SBAR(); } EXP8(C0,8); SBAR(); \
      o[1]=MF8(pq,vfa[1],o[1]); SBAR(); EXP8(C1,0); SBAR(); \
      if constexpr(MS){ lsum=MF8(pq,ones8,lsum); SBAR(); } \
      if(GL){ k8b=kfrag8(kn_+512); SBAR(); } EXP8(C1,8); SBAR(); \
    } else { \
      o[0]=MF8(pq,vfa[0],o[0]); SBAR(); vfa[0]=kfrag8(vq_+VOFF(2)); SBAR(); EXP8(C0,0); SBAR(); \
      o[1]=MF8(pq,vfa[1],o[1]); SBAR(); vfa[1]=kfrag8(vq_+VOFF(3)); SBAR(); if(GL){ k8a=kfrag8(kn_); SBAR(); } EXP8(C0,8); SBAR(); \
      o[2]=MF8(pq,vfa[0],o[2]); SBAR(); EXP8(C1,0); SBAR(); \
      o[3]=MF8(pq,vfa[1],o[3]); SBAR(); if(GL){ k8b=kfrag8(kn_+512); SBAR(); } EXP8(C1,8); SBAR(); \
    } \
    }while(0)
  const int NGq=NT>>2;
  for(int g=0;g<NGq-1;++g){
    DMA_KG(g+2); DMA_VQ(g+1);
    STEP(pB0,pB1,pA0,pA1,4*g+1,true,true);
    STEP(pA0,pA1,pB0,pB1,4*g+2,false,true);
    STEP(pB0,pB1,pA0,pA1,4*g+3,false,true);
    STEP(pA0,pA1,pB0,pB1,4*g+4,false,false);
    WAIT_BAR(0);
  }
  STEP(pB0,pB1,pA0,pA1,NT-3,true,true);
  STEP(pA0,pA1,pB0,pB1,NT-2,false,true);
  STEP(pB0,pB1,pA0,pA1,NT-1,false,false);
  WAIT_BAR(0);
  { const lds_cptr vq_=VADR(NT-1);
    float sacc=0.f; SUM8(pB0,0); SUM8(pB0,8); SUM8(pB1,0); SUM8(pB1,8); RESCALE(pB0,pB1,false,pB0,pB1); l_reg+=sacc;
    PK8(pB0,0,0); PK8(pB0,8,2); PK8(pB1,0,4); PK8(pB1,8,6); SBAR();
    #pragma unroll
    for(int dq=0;dq<2*VW;++dq)o[dq]=MF8(pq,kfrag8(vq_+VOFF(dq)),o[dq]); }
  #undef PIN
  #undef EX
  #undef CV8
  #undef VOFF
  #undef SUM8
  #undef MX3
  #undef PK8
  #undef EXP8
  #undef STEP
  #undef RESCALE
  float rli[16];
  if constexpr(MS){
    float mn=lsum[0],mx=lsum[0];
    #pragma unroll
    for(int r=1;r<16;++r){mn=fminf(mn,lsum[r]);mx=fmaxf(mx,lsum[r]);}
    bool bad=!((mn>F8_LMINF*(float)NT||!(F8_CHK&1))&&(mx<FS_LMAX||!(F8_CHK&4))&&!(F8_CHK&8));
    #pragma unroll
    for(int r=0;r<16;++r)bad=bad||(lsum[r]!=lsum[r]);
    if(__any(bad)){ if(lane==0)*(volatile unsigned*)(shm+Q8_WS)=1u; }
    #pragma unroll
    for(int r=0;r<16;++r)rli[r]=__builtin_amdgcn_rcpf(lsum[r])*(1.0f/V8_SCALE);
  } else {
  {auto rr=__builtin_amdgcn_permlane32_swap(__float_as_uint(l_reg),__float_as_uint(l_reg),false,false);l_reg=__uint_as_float(rr[0])+__uint_as_float(rr[1]);}
  if(__any(!((l_reg>F8_LMINF*(float)NT||!(F8_CHK&1))&&(l_reg<FS_LMAX||!(F8_CHK&4))&&!(F8_CHK&8)))){ if(lane==0)*(volatile unsigned*)(shm+Q8_WS)=1u; }
  if(hi==0)wsf[32+r32]=l_reg;asm volatile("s_waitcnt lgkmcnt(0)":::"memory");
  #pragma unroll
  for(int r=0;r<16;++r)rli[r]=__builtin_amdgcn_rcpf(wsf[32+crow(r,hi)])*(1.0f/V8_SCALE);
  }
  bf16*Ow=Ow0+(long)(wid*QBLK)*OPITCH;
  #pragma unroll
  for(int hv=0;hv<VW;++hv){ bf16*stg=(bf16*)(shm+Q8_OST)+wid*2048;
    #pragma unroll
    for(int r=0;r<16;++r){const int orow=crow(r,hi);
      #pragma unroll
      for(int d0=0;d0<2;++d0)stg[orow*64+d0*32+r32]=__float2bfloat16(o[2*hv+d0][r]*rli[r]);}
    asm volatile("s_waitcnt lgkmcnt(0)":::"memory");
    #pragma unroll
    for(int i=0;i<4;++i){const int row=i*8+(lane>>3),ch=lane&7; const u32x4 v=*(const u32x4*)(stg+row*64+ch*8); ATTN_STORE16(Ow+(long)row*OPITCH+hv*64+ch*8,v);}
    asm volatile("s_waitcnt lgkmcnt(0)":::"memory"); }
  asm volatile("s_waitcnt lgkmcnt(0)\n\ts_barrier":::"memory");
  const bool redo=*(volatile unsigned*)(shm+Q8_WS)!=0u;
  #undef DMA_KG
  #undef DMA_VQ
  #undef KROW
  #undef KADR
  #undef VADR
  #undef CMASK
  return redo;
}
#undef MF8
#undef F8_PMEAN
#undef F8_LOGK
#undef F8_LMINF
constexpr int ATTN_FS8Q_LDS_BYTES=Q8_BYTES;
#undef SBAR
#undef WAIT_BAR
}
#define GAS __attribute__((address_space(1)))
#define LAS __attribute__((address_space(3)))
typedef unsigned short bf16;
typedef unsigned v4u __attribute__((ext_vector_type(4)));
typedef float f32x4 __attribute__((ext_vector_type(4)));
typedef short bf16x8 __attribute__((ext_vector_type(8)));
typedef GAS unsigned gu32;
typedef GAS unsigned long long gu64;
#define RLX_AGENT __ATOMIC_RELAXED, __HIP_MEMORY_SCOPE_AGENT
#define LDS_WAIT() asm volatile("s_waitcnt lgkmcnt(0)" ::: "memory")
#define VM_WAIT() asm volatile("s_waitcnt vmcnt(0)" ::: "memory")
__device__ __forceinline__ unsigned long long rt() { return __builtin_amdgcn_s_memrealtime(); }
__device__ __forceinline__ unsigned f2bf(float f) { unsigned u = __builtin_bit_cast(unsigned, f); return (u + 0x7fffu + ((u >> 16) & 1u)) >> 16; }
__device__ __forceinline__ unsigned pk2(float lo, float hi) { return f2bf(lo) | (f2bf(hi) << 16); }

#define XB_TMO      128
#define XB_XCNT(j)  (256  + 64 * (j))
#define XB_XSUB(j)  (1280 + 64 * (j))
#define XB_XGEN(j)  (2304 + 64 * (j))
#define XB_TOP      3328
#define XB_TOPGEN   3392
#define XCD_BAR_WORDS 3456
#define XB_SPIN_CAP (1u << 22)

__device__ __forceinline__ unsigned xb_ld(unsigned* p)              { return __hip_atomic_load(p, __ATOMIC_RELAXED, __HIP_MEMORY_SCOPE_AGENT); }
__device__ __forceinline__ unsigned xb_add(unsigned* p, unsigned v) { return __hip_atomic_fetch_add(p, v, __ATOMIC_RELAXED, __HIP_MEMORY_SCOPE_AGENT); }
__device__ __forceinline__ unsigned xb_xcc_id() { return (unsigned)__builtin_amdgcn_s_getreg((3 << 11) | 20) & 0xFu; }
#define XB_SPIN(cond, bar) do { unsigned _sp = 0; while (cond) { __builtin_amdgcn_s_sleep(1); \
    if ((++_sp & 255u) == 0u) { if (xb_ld(&(bar)[XB_TMO])) break; if (_sp > XB_SPIN_CAP) { atomicAdd(&(bar)[XB_TMO], 1u); break; } } } } while (0)

struct XcdBarrier {
    unsigned* bar; unsigned x;
    volatile LAS unsigned* st;
};

__device__ __forceinline__ XcdBarrier xcd_barrier_post(unsigned* bar, volatile LAS unsigned* st) {
    XcdBarrier b; b.bar = bar; b.x = xb_xcc_id(); b.st = st;
    if (threadIdx.x == 0) (void)xb_add(&bar[XB_XCNT(b.x)], 1u);
    return b;
}
__device__ __forceinline__ void xcd_barrier_complete(unsigned* bar, unsigned x, unsigned& nloc, unsigned& nx) {
    const unsigned G = gridDim.x * gridDim.y * gridDim.z;
    unsigned sum, cnt, mine, sp = 0u;
    for (;;) {
        sum = 0u; cnt = 0u; mine = 0u;
#pragma unroll
        for (unsigned j = 0; j < 16; ++j) { const unsigned c = xb_ld(&bar[XB_XCNT(j)]); sum += c; cnt += (c > 0u) ? 1u : 0u; mine = (j == x) ? c : mine; }
        if (sum == G) break;
        __builtin_amdgcn_s_sleep(1);
        if ((++sp & 255u) == 0u) { if (xb_ld(&bar[XB_TMO])) break; if (sp > XB_SPIN_CAP) { atomicAdd(&bar[XB_TMO], 1u); break; } }
    }
    nloc = mine > 0u ? mine : 1u; nx = cnt > 0u ? cnt : 1u;
}

__device__ __forceinline__ void xcd_barrier(const XcdBarrier& b) {
    asm volatile("s_waitcnt vmcnt(0)" ::: "memory");
    __syncthreads();
    if (threadIdx.x == 0) {
        unsigned* bar = b.bar;
        __builtin_amdgcn_s_waitcnt(0);
        unsigned nloc = b.st[0], nx = b.st[1];
        if (nloc == 0u) { xcd_barrier_complete(bar, b.x, nloc, nx); b.st[0] = nloc; b.st[1] = nx; }
        const unsigned old = xb_add(&bar[XB_XSUB(b.x)], 1u);
        const unsigned gen = old / nloc;
        if (old + 1u == (gen + 1u) * nloc) {
            __builtin_amdgcn_fence(__ATOMIC_RELEASE, "agent");
            asm volatile("s_waitcnt vmcnt(0)" ::: "memory");
            const unsigned og = xb_add(&bar[XB_TOP], 1u);
            const unsigned tg = og / nx;
            if (og + 1u == (tg + 1u) * nx) xb_add(&bar[XB_TOPGEN], 1u);
            else XB_SPIN(xb_ld(&bar[XB_TOPGEN]) == tg, bar);
            __builtin_amdgcn_fence(__ATOMIC_ACQUIRE, "agent");
            xb_add(&bar[XB_XGEN(b.x)], 1u);
            asm volatile("s_waitcnt vmcnt(0)" ::: "memory");
        } else {
            XB_SPIN(xb_ld(&bar[XB_XGEN(b.x)]) == gen, bar);
            __builtin_amdgcn_fence(__ATOMIC_ACQUIRE, "agent");
            asm volatile("s_waitcnt vmcnt(0)" ::: "memory");
        }
    }
    __syncthreads();
}

constexpr int NWAVES = 8;
constexpr int D = 1024, BATCH = 4, SEQ = 8192, DEPTH = 4, CTX = 256, NTOK = CTX + SEQ  , M = BATCH * NTOK  ;
constexpr int DIN = 6912;
constexpr int C_AQ = 0, C_AK = 512, C_AV = 640, C_BQ = 768, C_BK = 1280, C_BV = 1792, C_CQ = 2304, C_CK = 2816, C_CV = 3328, C_G = 3840;
constexpr int FF = 2816, NE = 8, FE = 3584;
constexpr int OPITCH = 2048, O_A = 0, O_B1 = 512, O_B2 = 1024, O_C = 1536;
constexpr int SMAX = 69632;
constexpr float EPS = 1e-6f;
constexpr float LOG2E = 1.4426950408889634f;
constexpr int PANELS_PER_B = NTOK / 256;
constexpr size_t QKV_BLK = (size_t)M * 64;
constexpr size_t WS_G_OFF = (size_t)248 << 20;
static_assert(attn_body::QKP == 64 && attn_body::OPITCH == OPITCH && attn_body::QKV_BLK == (long)QKV_BLK && 60 * QKV_BLK * 2 <= WS_G_OFF, "attention body pitches");
#ifndef CFG_ATT8
#define CFG_ATT8 1
#endif
constexpr bool ATT8 = CFG_ATT8;
__device__ __forceinline__ size_t q8_blk(int col) { const int b = col >> 6; return (size_t)(b < 10 ? b : b < 28 ? b - 2 : b - 10) * QKV_BLK; }
__device__ __forceinline__ size_t qkv_blk(int col) { return (size_t)(col >> 6) * QKV_BLK; }
enum { I_X = 0, I_C, I_CTX, I_CCTX, I_WMOD, I_BMOD, I_GMIX, I_GFFN, I_WIN, I_QNA, I_KNA, I_LQ1, I_LK1, I_LQ2, I_LK2, I_SUBLN, I_RPB, I_WBRA, I_WBRB, I_WBRC, I_WOUT,
       I_FW1, I_FW3, I_FW2, I_ROUTER, I_MW1, I_MW3, I_MW2, I_GFINAL, N_IN };

constexpr size_t MiB = 1u << 20;
constexpr size_t WS_CTL = 0, CTL_ZERO_BYTES = 1 * MiB;
constexpr size_t WS_MOD = 1 * MiB;
constexpr size_t WS_ROPE = 1 * MiB + 512 * 1024;
constexpr size_t WS_TOK = 2 * MiB;
constexpr size_t WS_WBASE = 3 * MiB + 512 * 1024;
constexpr size_t WS_XC = 4 * MiB;
constexpr size_t WS_W = 8 * MiB;
constexpr size_t WS_WIN = WS_W, WS_WBR = WS_W + 14 * MiB, WS_WOUT = WS_W + 17 * MiB, WS_W13 = WS_W + 19 * MiB, WS_W2 = WS_W + 131 * MiB;
constexpr size_t WS_XN = 196 * MiB;
constexpr size_t WS_MB = 262 * MiB;
constexpr size_t WS_P = 398 * MiB;
constexpr size_t WS_O = 844 * MiB;
constexpr size_t WS_YS = 874 * MiB;
constexpr bool TAIL_SPLIT = false;
constexpr size_t WS_PART = WS_MB + 64 * MiB;
constexpr size_t WS_XB = 1010 * MiB;
constexpr size_t WS_END = 1076 * MiB;
constexpr size_t WS_Q8 = WS_MB + 34 * MiB;
static_assert(WS_Q8 + (size_t)42 * M * 64 <= WS_P, "fp8 q/k blocks");
static_assert(WS_W2 + (size_t)NE * D * FE * 2 <= WS_XN && WS_XN + (size_t)M * D * 2 <= WS_MB && WS_MB + (size_t)SMAX * D * 2 <= WS_P && WS_MB + (size_t)M * D * 4 <= WS_P, "ws map 1");
static_assert(WS_P + WS_G_OFF + (size_t)M * 3072 * 2 <= WS_O && WS_O + (size_t)M * OPITCH * 2 <= WS_END && WS_P + (size_t)SMAX * FE * 2 <= WS_YS && WS_YS + (size_t)SMAX * D * 2 <= WS_XB && WS_XB + (size_t)M * D * 2 <= WS_END, "ws map 2");
static_assert(WS_PART + (size_t)256 * 65536 * 4 <= WS_P, "ws map 4");
static_assert(WS_W13 + (size_t)NE * 2 * FE * D * 2 <= WS_W2 && WS_WIN + (size_t)DIN * D * 2 <= WS_WBR, "ws map 3");
constexpr int CW_BAR = 4096;
constexpr int CW_CNT = 8192;
constexpr int CW_QK = 12288;
static_assert((CW_CNT + 2 * 8 * 64) * 4 <= (int)CTL_ZERO_BYTES && CW_CNT + 2 * 8 * 64 <= CW_QK && (CW_QK + DEPTH * 8 * 64) * 4 <= (int)CTL_ZERO_BYTES, "CTL words inside the memset region");

constexpr int RING_OFF = 0, RING_BYTES = 131072;
constexpr int LDSCTL_OFF = RING_BYTES, MISC_OFF = LDSCTL_OFF + 320;
constexpr int LDS_BYTES = 147456;
constexpr int BIAS_OFF = LDSCTL_OFF + 1024;
static_assert(attn_body::ATTN_LDS_BYTES <= RING_BYTES && attn_body::ATTN_FS_LDS_BYTES <= RING_BYTES && attn_body::ATTN_FS2_LDS_BYTES <= RING_BYTES && attn_body::ATTN_FS8_LDS_BYTES <= RING_BYTES && attn_body::ATTN_FS8P_LDS_BYTES <= RING_BYTES && attn_body::ATTN_FS8Q_LDS_BYTES <= RING_BYTES && BIAS_OFF + 8 * 465 * 4 <= LDS_BYTES, "LDS map");

typedef unsigned u32x2 __attribute__((ext_vector_type(2)));
typedef float f32x2v __attribute__((ext_vector_type(2)));
struct Args { const float* in[N_IN]; float* out; unsigned char* ws; };
typedef const __attribute__((address_space(4))) Args* CArgsP;
struct Frame {
    LAS unsigned char* lds;
    int tid, lane, wave, vcu, G;
};
#define REFRESH(F) do { int t_ = threadIdx.x; asm volatile("; LAUNDER" : "+v"(t_)); (F).tid = t_; (F).lane = t_ & 63; (F).wave = __builtin_amdgcn_readfirstlane(t_ >> 6); } while (0)
__device__ __forceinline__ CArgsP fresh_args() { CArgsP p = (CArgsP)__builtin_amdgcn_kernarg_segment_ptr(); asm volatile("; LAUNDER_S" : "+s"(p)); return p; }

__device__ __forceinline__ float wave_sum(float v) {
#pragma unroll
    for (int o = 1; o < 64; o <<= 1) v += __shfl_xor(v, o);
    return v;
}
__device__ __forceinline__ unsigned cvtpk(float lo, float hi) { return pg8::cvt_pk_bf16(lo, hi); }
__device__ __forceinline__ float bf_lo(unsigned w) { return __uint_as_float(w << 16); }
__device__ __forceinline__ float bf_hi(unsigned w) { return __uint_as_float(w & 0xffff0000u); }
__device__ __forceinline__ unsigned pk4_fp8(float a, float b, float c, float d) {
    a = __builtin_amdgcn_fmed3f(a, -448.f, 448.f); b = __builtin_amdgcn_fmed3f(b, -448.f, 448.f); c = __builtin_amdgcn_fmed3f(c, -448.f, 448.f); d = __builtin_amdgcn_fmed3f(d, -448.f, 448.f);
    int w = __builtin_amdgcn_cvt_pk_fp8_f32(a, b, 0, false); w = __builtin_amdgcn_cvt_pk_fp8_f32(c, d, w, true); return (unsigned)w; }
#ifndef CFG_DENSE8
#define CFG_DENSE8 0
#endif
#ifndef CFG_MOEDOWN8
#define CFG_MOEDOWN8 1
#endif
#ifndef CFG_INPROJ8
#define CFG_INPROJ8 1
#endif
constexpr bool DENSE8 = CFG_DENSE8, MOEDOWN8 = CFG_MOEDOWN8;
#ifndef CFG_GATE8
#define CFG_GATE8 0
#endif
constexpr bool GATE8 = CFG_GATE8;
constexpr int INPROJ8 = CFG_INPROJ8;
constexpr int IN8_TILES = INPROJ8 == 1 ? 27 : INPROJ8 == 2 ? 12 : INPROJ8 == 3 ? 16 : INPROJ8 == 4 ? 23 : 0;
constexpr size_t WS_WIN8 = WS_W + 83 * MiB;
__device__ __forceinline__ int in8_tile(int p) { return INPROJ8 == 1 ? p : INPROJ8 == 2 ? 15 + p : INPROJ8 == 4 ? (p < 7 ? p : p < 11 ? p + 2 : p + 4) : (p < 2 ? 7 + p : p < 4 ? 11 + p : 11 + p); }
__device__ __forceinline__ int in16_tile(int p) { return INPROJ8 == 3 ? (p < 7 ? p : p + 2) : INPROJ8 == 4 ? (p < 2 ? 7 + p : 11 + p) : p; }
typedef float f32x2p __attribute__((ext_vector_type(2)));
__device__ __forceinline__ void load_gates8(const bf16* Gp, size_t idx, float (&gl)[8]) {
    if constexpr (GATE8) { const u32x2 w = *(const GAS u32x2*)((const unsigned char*)Gp + idx);
        const f32x2p a = __builtin_amdgcn_cvt_pk_f32_fp8((int)w.x, false), b = __builtin_amdgcn_cvt_pk_f32_fp8((int)w.x, true), c = __builtin_amdgcn_cvt_pk_f32_fp8((int)w.y, false), d = __builtin_amdgcn_cvt_pk_f32_fp8((int)w.y, true);
        gl[0] = a.x; gl[1] = a.y; gl[2] = b.x; gl[3] = b.y; gl[4] = c.x; gl[5] = c.y; gl[6] = d.x; gl[7] = d.y; }
    else { const v4u w = *(const GAS v4u*)(Gp + idx);
        gl[0] = bf_lo(w.x); gl[1] = bf_hi(w.x); gl[2] = bf_lo(w.y); gl[3] = bf_hi(w.y); gl[4] = bf_lo(w.z); gl[5] = bf_hi(w.z); gl[6] = bf_lo(w.w); gl[7] = bf_hi(w.w); }
}
constexpr float WSC = 64.f, WSCI = 1.0f / 64.f;
__device__ __forceinline__ float sigmoidf_(float x) { return __builtin_amdgcn_rcpf(1.0f + __builtin_amdgcn_exp2f(-x * LOG2E)); }

#define NT_LOAD(p) __builtin_nontemporal_load(p)
__device__ __forceinline__ void tr_item(const float* W, int K, int N, bf16* WT, int base, int il, LAS float* scr, int item, int lane) {
    const int nblk = N / 32, kb = item / nblk, nb = item % nblk, k0 = 64 * kb, n0 = 32 * nb;
#pragma unroll 8
    for (int i = 0; i < 32; ++i) { const int kk = 2 * i + (lane >> 5); scr[kk * 33 + (lane & 31)] = NT_LOAD(&W[(size_t)(k0 + kk) * N + n0 + (lane & 31)]); }
    LDS_WAIT(); asm volatile("" ::: "memory");
    const int c = lane & 7;
#pragma unroll
    for (int j = 0; j < 4; ++j) { const int n = (lane >> 3) + 8 * j; const LAS float* s = scr + (8 * c) * 33 + n;
        v4u o; o.x = cvtpk(s[0 * 33], s[1 * 33]); o.y = cvtpk(s[2 * 33], s[3 * 33]); o.z = cvtpk(s[4 * 33], s[5 * 33]); o.w = cvtpk(s[6 * 33], s[7 * 33]);
        const int ng = n0 + n, drow = base + (il ? (256 * (ng >> 7) + (ng & 127)) : ng);
        *(GAS v4u*)(WT + (size_t)drow * K + k0 + 8 * c) = o; }
    LDS_WAIT(); asm volatile("" ::: "memory");
}
__device__ __forceinline__ void tr_item_f8(const float* W, int K, int N, unsigned char* WT, int base, int il, LAS float* scr, int item, int lane) {
    const int nblk = N / 32, kb = item / nblk, nb = item % nblk, k0 = 64 * kb, n0 = 32 * nb;
#pragma unroll 8
    for (int i = 0; i < 32; ++i) { const int kk = 2 * i + (lane >> 5); scr[kk * 33 + (lane & 31)] = NT_LOAD(&W[(size_t)(k0 + kk) * N + n0 + (lane & 31)]) * WSC; }
    LDS_WAIT(); asm volatile("" ::: "memory");
    const int c = lane & 3;
#pragma unroll
    for (int j = 0; j < 2; ++j) { const int n = (lane >> 2) + 16 * j; const LAS float* s = scr + (16 * c) * 33 + n;
        v4u o; o.x = pk4_fp8(s[0 * 33], s[1 * 33], s[2 * 33], s[3 * 33]); o.y = pk4_fp8(s[4 * 33], s[5 * 33], s[6 * 33], s[7 * 33]);
        o.z = pk4_fp8(s[8 * 33], s[9 * 33], s[10 * 33], s[11 * 33]); o.w = pk4_fp8(s[12 * 33], s[13 * 33], s[14 * 33], s[15 * 33]);
        const int ng = n0 + n, drow = base + (il ? (256 * (ng >> 7) + (ng & 127)) : ng);
        *(GAS v4u*)(WT + (size_t)drow * K + k0 + 16 * c) = o; }
    LDS_WAIT(); asm volatile("" ::: "memory");
}
__device__ __forceinline__ void convert_weights(Frame& F, CArgsP AP, int l) {
    LAS float* scr = (LAS float*)(F.lds + RING_OFF + F.wave * 16384);
    const int gw = F.vcu * NWAVES + F.wave, NGW = F.G * NWAVES;
    bf16* WIN = (bf16*)(AP->ws + WS_WIN); bf16* WBR = (bf16*)(AP->ws + WS_WBR); bf16* WOUT = (bf16*)(AP->ws + WS_WOUT); unsigned char* W13 = AP->ws + WS_W13; unsigned char* W2 = AP->ws + WS_W2;
    constexpr int I_IN = (D / 64) * (DIN / 32), I_BR = (512 / 64) * (D / 32), I_OUT = (D / 64) * (D / 32);
    constexpr int I_F1 = (D / 64) * (FF / 32), I_F2 = (FF / 64) * (D / 32), I_M1 = (D / 64) * (FE / 32), I_M2 = (FE / 64) * (D / 32);
    const int i2 = l >> 1;
    const int nbase = I_IN + 3 * I_BR + I_OUT;
    const int nitems = nbase + ((l & 1) ? NE * (2 * I_M1 + I_M2) : (2 * I_F1 + I_F2));
    for (int it = gw; it < nitems; it += NGW) {
        int r = it;
        if (r < I_IN) { if constexpr (INPROJ8 != 1) tr_item(AP->in[I_WIN] + (size_t)l * D * DIN, D, DIN, WIN, 0, 0, scr, r, F.lane);
            if constexpr (INPROJ8 != 0) tr_item_f8(AP->in[I_WIN] + (size_t)l * D * DIN, D, DIN, AP->ws + WS_WIN8, 0, 0, scr, r, F.lane); continue; } r -= I_IN;
        if (r < 3 * I_BR) { const int x = r / I_BR; r -= x * I_BR; const float* src = (x == 0 ? AP->in[I_WBRA] : x == 1 ? AP->in[I_WBRB] : AP->in[I_WBRC]) + (size_t)l * 512 * D;
            tr_item(src, 512, D, WBR + (size_t)x * D * 512, 0, 0, scr, r, F.lane); continue; } r -= 3 * I_BR;
        if (r < I_OUT) { tr_item(AP->in[I_WOUT] + (size_t)l * D * D, D, D, WOUT, 0, 0, scr, r, F.lane); continue; } r -= I_OUT;
        if (!(l & 1)) {
            if (r < I_F1) { if constexpr (DENSE8) tr_item_f8(AP->in[I_FW1] + (size_t)i2 * D * FF, D, FF, W13, 0, 1, scr, r, F.lane); else tr_item(AP->in[I_FW1] + (size_t)i2 * D * FF, D, FF, (bf16*)W13, 0, 1, scr, r, F.lane); continue; } r -= I_F1;
            if (r < I_F1) { if constexpr (DENSE8) tr_item_f8(AP->in[I_FW3] + (size_t)i2 * D * FF, D, FF, W13, 128, 1, scr, r, F.lane); else tr_item(AP->in[I_FW3] + (size_t)i2 * D * FF, D, FF, (bf16*)W13, 128, 1, scr, r, F.lane); continue; } r -= I_F1;
            if constexpr (DENSE8) tr_item_f8(AP->in[I_FW2] + (size_t)i2 * FF * D, FF, D, W2, 0, 0, scr, r, F.lane); else tr_item(AP->in[I_FW2] + (size_t)i2 * FF * D, FF, D, (bf16*)W2, 0, 0, scr, r, F.lane);
        } else {
            const int per = 2 * I_M1 + I_M2, e = r / per; r -= e * per; const size_t eo = (size_t)(i2 * NE + e);
            if (r < I_M1) { tr_item_f8(AP->in[I_MW1] + eo * D * FE, D, FE, W13 + (size_t)e * 2 * FE * D, 0, 1, scr, r, F.lane); continue; } r -= I_M1;
            if (r < I_M1) { tr_item_f8(AP->in[I_MW3] + eo * D * FE, D, FE, W13 + (size_t)e * 2 * FE * D, 128, 1, scr, r, F.lane); continue; } r -= I_M1;
            if constexpr (MOEDOWN8) tr_item_f8(AP->in[I_MW2] + eo * FE * D, FE, D, W2 + (size_t)e * D * FE, 0, 0, scr, r, F.lane); else tr_item(AP->in[I_MW2] + eo * FE * D, FE, D, (bf16*)W2 + (size_t)e * D * FE, 0, 0, scr, r, F.lane);
        }
    }
}

__device__ __forceinline__ void prologue_mod(Frame& F, CArgsP AP) {
    LAS float* sv = (LAS float*)(F.lds + RING_OFF);
    LAS float* red = sv + 5 * 1024;
    for (int i = F.tid; i < 5 * 1024; i += NWAVES * 64) { const int j = i >> 10, k = i & 1023; const float v = j < 4 ? AP->in[I_C][j * 1024 + k] : AP->in[I_CCTX][k]; sv[i] = v * sigmoidf_(v); }
    __syncthreads();
    float* MOD = (float*)(AP->ws + WS_MOD);
    for (int it = blockIdx.x; it < DEPTH * 96; it += F.G) {
        const int l = it / 96, cb = it % 96, col = cb * 64 + F.lane;
        const float* wp = AP->in[I_WMOD] + ((size_t)l * D + F.wave * 128) * 6144 + col;
        const LAS float* s = sv + F.wave * 128;
        float a0 = 0.f, a1 = 0.f, a2 = 0.f, a3 = 0.f, a4 = 0.f;
#pragma unroll 8
        for (int k = 0; k < 128; ++k) { const float w = NT_LOAD(&wp[(size_t)k * 6144]); a0 += s[k] * w; a1 += s[1024 + k] * w; a2 += s[2048 + k] * w; a3 += s[3072 + k] * w; a4 += s[4096 + k] * w; }
        LAS float* rr = red + F.wave * 320 + F.lane;
        rr[0] = a0; rr[64] = a1; rr[128] = a2; rr[192] = a3; rr[256] = a4;
        __syncthreads();
        if (F.tid < 320) { const int j = F.tid >> 6, ln = F.tid & 63; float sacc = 0.f;
#pragma unroll
            for (int w = 0; w < 8; ++w) sacc += red[w * 320 + j * 64 + ln];
            MOD[(size_t)(l * 5 + j) * 6144 + cb * 64 + ln] = sacc + AP->in[I_BMOD][l * 6144 + cb * 64 + ln]; }
        __syncthreads();
    }
    if (blockIdx.x == 0) {
        float* RT = (float*)(AP->ws + WS_ROPE);
        for (int i = F.tid; i < 128 * 16; i += NWAVES * 64) {
            const int pos = i >> 4, j = i & 15;
            double inv = 1.0; for (int q = 0; q < j; ++q) inv *= 0.56234132519034908;
            const float invf = (float)inv; const float angf = (float)pos * invf;
            double a = (double)angf; const double TWO_PI = 6.283185307179586476925;
            const double nrev = __builtin_floor(a / TWO_PI + 0.5); a -= nrev * TWO_PI;
            const double a2 = a * a; double cs = 1.0, sn = a, tc = 1.0, ts = a;
            for (int q = 1; q < 16; ++q) { tc *= -a2 / (double)((2 * q - 1) * (2 * q)); ts *= -a2 / (double)((2 * q) * (2 * q + 1)); cs += tc; sn += ts; }
            RT[2 * i] = (float)cs; RT[2 * i + 1] = (float)sn;
        }
    }
}

struct RowRef { int b, n, bsel; bool isctx; };
__device__ __forceinline__ RowRef row_ref(int row) { RowRef r; r.b = row / NTOK; r.n = row - r.b * NTOK; r.isctx = r.n < CTX; r.bsel = r.isctx ? 4 : r.b; return r; }
__device__ __forceinline__ bf16* row_xb(CArgsP AP, int row) { return (bf16*)(AP->ws + WS_XB) + (size_t)row * D; }
__device__ __forceinline__ void load_row_xb(const bf16* p, int lane, u32x2 (&raw)[4]) {
#pragma unroll
    for (int j = 0; j < 4; ++j) raw[j] = *(const GAS u32x2*)(p + 256 * j + 4 * lane);
}
__device__ __forceinline__ void unpack_row(const u32x2 (&raw)[4], f32x4 (&v)[4]) {
#pragma unroll
    for (int j = 0; j < 4; ++j) v[j] = (f32x4){bf_lo(raw[j].x), bf_hi(raw[j].x), bf_lo(raw[j].y), bf_hi(raw[j].y)};
}
__device__ __forceinline__ void load_row(const float* p, int lane, f32x4 (&v)[4]) {
#pragma unroll
    for (int j = 0; j < 4; ++j) v[j] = *(const GAS f32x4*)(p + 256 * j + 4 * lane);
}
__device__ __forceinline__ void store_row(float* p, int lane, const f32x4 (&v)[4]) {
#pragma unroll
    for (int j = 0; j < 4; ++j) *(GAS f32x4*)(p + 256 * j + 4 * lane) = v[j];
}
__device__ __forceinline__ void moe_combine(Frame& F, CArgsP AP, int row, const RowRef& r, int lp, f32x4 (&v)[4]) {
    const unsigned* info = (const unsigned*)(AP->ws + WS_TOK) + (size_t)row * 8;
    const float w0 = __uint_as_float(info[4]), w1 = __uint_as_float(info[5]); const unsigned s0 = info[6], s1 = info[7];
    const bf16* Y = (const bf16*)(AP->ws + WS_YS);
    const float* gate = (const float*)(AP->ws + WS_MOD) + (size_t)(lp * 5 + r.bsel) * 6144 + 5 * 1024;
#pragma unroll
    for (int j = 0; j < 4; ++j) {
        const u32x2 y0 = *(const GAS u32x2*)(Y + (size_t)s0 * D + 256 * j + 4 * F.lane), y1 = *(const GAS u32x2*)(Y + (size_t)s1 * D + 256 * j + 4 * F.lane);
        const f32x4 g = *(const GAS f32x4*)(gate + 256 * j + 4 * F.lane);
        v[j].x += g.x * (w0 * bf_lo(y0.x) + w1 * bf_lo(y1.x)); v[j].y += g.y * (w0 * bf_hi(y0.x) + w1 * bf_hi(y1.x));
        v[j].z += g.z * (w0 * bf_lo(y0.y) + w1 * bf_lo(y1.y)); v[j].w += g.w * (w0 * bf_hi(y0.y) + w1 * bf_hi(y1.y));
    }
}
__device__ __forceinline__ float row_rstd(const f32x4 (&v)[4]) {
    float s = 0.f;
#pragma unroll
    for (int j = 0; j < 4; ++j) s += (v[j].x * v[j].x + v[j].y * v[j].y) + (v[j].z * v[j].z + v[j].w * v[j].w);
    return 1.0f / sqrtf(wave_sum(s) * (1.0f / D) + EPS);
}
__device__ __forceinline__ void norm_mod(const f32x4 (&v)[4], float rstd, const float* g, const float* shift, const float* scale, int lane, f32x4 (&y)[4]) {
#pragma unroll
    for (int j = 0; j < 4; ++j) {
        const f32x4 gg = *(const GAS f32x4*)(g + 256 * j + 4 * lane), sh = *(const GAS f32x4*)(shift + 256 * j + 4 * lane), sc = *(const GAS f32x4*)(scale + 256 * j + 4 * lane);
        y[j] = (v[j] * rstd) * gg * (sc + 1.0f) + sh;
    }
}
__device__ __forceinline__ void store_row_bf16(bf16* p, int lane, const f32x4 (&y)[4]) {
#pragma unroll
    for (int j = 0; j < 4; ++j) { u32x2 o; o.x = cvtpk(y[j].x, y[j].y); o.y = cvtpk(y[j].z, y[j].w); *(GAS u32x2*)(p + 256 * j + 4 * lane) = o; }
}

struct TailTab { const float* part; int npz; LAS unsigned char* lt; };
__device__ __forceinline__ TailTab tail_setup(Frame& F, CArgsP AP, int nt_k, LAS unsigned char* lt) {
    pg8::TileOrder T; T.init(M / 256, D / 256, F.G, 0);
    const int nfull = T.nwg / T.G, R = T.nwg - nfull * T.G, P = nt_k >> 1; int npz = R ? T.G / R : 1; npz = npz < P ? npz : P;
    __syncthreads();
    for (int i = F.tid; i < (M / 256) * 4; i += NWAVES * 64) lt[i] = 0;
    __syncthreads();
    if (F.tid < R) { int pm, pn; if (T.tile_at((long)nfull * T.G + F.tid, pm, pn)) lt[pm * 4 + pn] = (unsigned char)(F.tid + 1); }
    __syncthreads();
    TailTab t; t.part = (const float*)(AP->ws + WS_PART); t.npz = npz; t.lt = lt; return t;
}
__device__ __forceinline__ bool tail_add(const TailTab& t, int row, int lane, const float* gate, float sc, f32x4 (&v)[4]) {
    const int pm = row >> 8, rit = row & 255; bool any = false;
#pragma unroll
    for (int jq = 0; jq < 4; ++jq) { const int idx = __builtin_amdgcn_readfirstlane((int)t.lt[pm * 4 + jq]);
        if (idx) { any = true; f32x4 sacc = {0.f, 0.f, 0.f, 0.f}; const float* pp = t.part + ((size_t)(idx - 1) * t.npz * 256 + rit) * 256 + 4 * lane;
            for (int p = 0; p < t.npz; ++p) sacc += *(const GAS f32x4*)(pp + (size_t)p * 65536);
            const f32x4 g4 = *(const GAS f32x4*)(gate + 256 * jq + 4 * lane); v[jq] += g4 * sc * sacc; } }
    return any;
}
__device__ __forceinline__ void phase_norm1(Frame& F, CArgsP AP, int l, bool commit) {
    const int gw = F.vcu * NWAVES + F.wave, NGW = F.G * NWAVES;
    bf16* XN = (bf16*)(AP->ws + WS_XN);
    const float* MOD = (const float*)(AP->ws + WS_MOD);
    const float* g = AP->in[I_GMIX] + l * D;
#define N1_SRC(rr_, row_) ((rr_).isctx ? AP->in[I_CTX] + (size_t)((rr_).b * CTX + (rr_).n) * D : AP->in[I_X] + (size_t)((rr_).b * SEQ + ((rr_).n - CTX)) * D)
    const bool tail = TAIL_SPLIT && (l > 0) && !((l - 1) & 1);
    TailTab tt{}; if (tail) tt = tail_setup(F, AP, DENSE8 ? FF / 128 : FF / 64, (LAS unsigned char*)(F.lds + RING_OFF + 40960));
    f32x4 vnx[4]; u32x2 rnx[4];
#pragma unroll
    for (int j = 0; j < 4; ++j) { vnx[j] = (f32x4){0.f, 0.f, 0.f, 0.f}; rnx[j] = (u32x2){0u, 0u}; }
    if (gw < M) { if (l == 0) { const RowRef r0 = row_ref(gw); load_row(N1_SRC(r0, gw), F.lane, vnx); } else load_row_xb(row_xb(AP, gw), F.lane, rnx); }
    for (int row = gw; row < M; row += NGW) {
        const RowRef r = row_ref(row); bf16* xr = row_xb(AP, row);
        f32x4 v[4];
        if (l == 0) {
#pragma unroll
            for (int j = 0; j < 4; ++j) v[j] = vnx[j];
        } else unpack_row(rnx, v);
        if (row + NGW < M) { if (l == 0) { const RowRef rn = row_ref(row + NGW); load_row(N1_SRC(rn, row + NGW), F.lane, vnx); } else load_row_xb(row_xb(AP, row + NGW), F.lane, rnx); }
        const bool comb = (l > 0) && ((l - 1) & 1);
        if (comb) moe_combine(F, AP, row, r, l - 1, v);
        bool tailed = false; if (tail) tailed = tail_add(tt, row, F.lane, MOD + (size_t)((l - 1) * 5 + r.bsel) * 6144 + 5 * 1024, DENSE8 ? WSCI : 1.0f, v);
        if ((l == 0 || comb || tailed) && commit) store_row_bf16(xr, F.lane, v);
        const float rstd = row_rstd(v);
        const float* mv = MOD + (size_t)(l * 5 + r.bsel) * 6144;
        f32x4 y[4]; norm_mod(v, rstd, g, mv + 0 * 1024, mv + 1 * 1024, F.lane, y);
        if constexpr (INPROJ8 != 0) {
#pragma unroll
            for (int j = 0; j < 4; ++j) *(GAS unsigned*)(AP->ws + WS_MB + (size_t)row * D + 256 * j + 4 * F.lane) = pk4_fp8(y[j].x, y[j].y, y[j].z, y[j].w);
        }
        if constexpr (INPROJ8 != 1) store_row_bf16(XN + (size_t)row * D, F.lane, y);
    }
}
__device__ __forceinline__ void phase_norm2(Frame& F, CArgsP AP, int l, bool commit) {
    const int gw = F.vcu * NWAVES + F.wave, NGW = F.G * NWAVES;
    unsigned char* XN8 = AP->ws + WS_XN;
    const float* MOD = (const float*)(AP->ws + WS_MOD);
    const float* g = AP->in[I_GFFN] + l * D;
    const bool moe = (l & 1) && commit;
    const bool moe_layer = (l & 1);
    LAS float* Rt = (LAS float*)(F.lds + RING_OFF);
    if (moe) {
        const float* R = AP->in[I_ROUTER] + (size_t)(l >> 1) * D * NE;
        for (int i = F.tid; i < D * NE; i += NWAVES * 64) Rt[(i & 7) * 1024 + (i >> 3)] = R[i];
        __syncthreads();
    }
    unsigned* cnt = (unsigned*)(AP->ws + WS_CTL) + CW_CNT + (l >> 1) * 8 * 64;
    int lc0 = 0, lc1 = 0, lc2 = 0, lc3 = 0, lc4 = 0, lc5 = 0, lc6 = 0, lc7 = 0;
    const bool tail = TAIL_SPLIT && (l < DEPTH - 1);
    TailTab tt{}; if (tail) tt = tail_setup(F, AP, D / 64, (LAS unsigned char*)(F.lds + RING_OFF + 40960));
    u32x2 rnx[4];
#pragma unroll
    for (int j = 0; j < 4; ++j) rnx[j] = (u32x2){0u, 0u};
    if (gw < M) load_row_xb(row_xb(AP, gw), F.lane, rnx);
    for (int row = gw; row < M; row += NGW) {
        const RowRef r = row_ref(row);
        f32x4 v[4]; unpack_row(rnx, v);
        if (row + NGW < M) load_row_xb(row_xb(AP, row + NGW), F.lane, rnx);
        if (r.isctx && l == DEPTH - 1) continue;
        const float* mv = MOD + (size_t)(l * 5 + r.bsel) * 6144;
        if (tail && tail_add(tt, row, F.lane, mv + 2 * 1024, 1.0f, v) && commit) store_row_bf16(row_xb(AP, row), F.lane, v);
        const float rstd = row_rstd(v);
        f32x4 y[4]; norm_mod(v, rstd, g, mv + 3 * 1024, mv + 4 * 1024, F.lane, y);
        if (moe_layer || DENSE8) {
#pragma unroll
            for (int j = 0; j < 4; ++j) *(GAS unsigned*)(XN8 + (size_t)row * D + 256 * j + 4 * F.lane) = pk4_fp8(y[j].x, y[j].y, y[j].z, y[j].w);
        } else store_row_bf16((bf16*)XN8 + (size_t)row * D, F.lane, y);
        if (moe) {
            float lg[8];
#pragma unroll
            for (int e = 0; e < 8; ++e) { float s = 0.f;
#pragma unroll
                for (int j = 0; j < 4; ++j) { const f32x4 w = *(const LAS f32x4*)(Rt + e * 1024 + 256 * j + 4 * F.lane); s += (y[j].x * w.x + y[j].y * w.y) + (y[j].z * w.z + y[j].w * w.w); }
                lg[e] = wave_sum(s); }
            int e0 = 0; float v0 = lg[0];
#pragma unroll
            for (int e = 1; e < 8; ++e) if (lg[e] > v0) { v0 = lg[e]; e0 = e; }
            int e1 = -1; float v1 = -INFINITY;
#pragma unroll
            for (int e = 0; e < 8; ++e) if (e != e0 && lg[e] > v1) { v1 = lg[e]; e1 = e; }
            const float ex = __expf(v1 - v0), w0 = 1.0f / (1.0f + ex), w1 = ex * w0;
            const int s0 = __builtin_amdgcn_readfirstlane(e0), s1 = __builtin_amdgcn_readfirstlane(e1);
            const int p0 = (s0 == 0 ? lc0 : 0) + (s0 == 1 ? lc1 : 0) + (s0 == 2 ? lc2 : 0) + (s0 == 3 ? lc3 : 0) + (s0 == 4 ? lc4 : 0) + (s0 == 5 ? lc5 : 0) + (s0 == 6 ? lc6 : 0) + (s0 == 7 ? lc7 : 0);
            const int p1 = (s1 == 0 ? lc0 : 0) + (s1 == 1 ? lc1 : 0) + (s1 == 2 ? lc2 : 0) + (s1 == 3 ? lc3 : 0) + (s1 == 4 ? lc4 : 0) + (s1 == 5 ? lc5 : 0) + (s1 == 6 ? lc6 : 0) + (s1 == 7 ? lc7 : 0);
            lc0 += (s0 == 0) + (s1 == 0); lc1 += (s0 == 1) + (s1 == 1); lc2 += (s0 == 2) + (s1 == 2); lc3 += (s0 == 3) + (s1 == 3);
            lc4 += (s0 == 4) + (s1 == 4); lc5 += (s0 == 5) + (s1 == 5); lc6 += (s0 == 6) + (s1 == 6); lc7 += (s0 == 7) + (s1 == 7);
            if (F.lane == 0) {
                unsigned* info = (unsigned*)(AP->ws + WS_TOK) + (size_t)row * 8;
                info[0] = (unsigned)s0; info[1] = (unsigned)s1; info[2] = (unsigned)p0; info[3] = (unsigned)p1; info[4] = __float_as_uint(w0); info[5] = __float_as_uint(w1);
            }
        }
    }
    if (moe) {
        const int mine = F.lane == 0 ? lc0 : F.lane == 1 ? lc1 : F.lane == 2 ? lc2 : F.lane == 3 ? lc3 : F.lane == 4 ? lc4 : F.lane == 5 ? lc5 : F.lane == 6 ? lc6 : lc7;
        if (F.lane < 8) { const unsigned base = __hip_atomic_fetch_add(cnt + F.lane * 64, (unsigned)mine, RLX_AGENT); ((unsigned*)(AP->ws + WS_WBASE))[(size_t)gw * 8 + F.lane] = base; }
    }
}
struct MoeOff { int off[9]; int cnt[8]; };
__device__ __forceinline__ void moe_offsets(Frame& F, CArgsP AP, int l, MoeOff& o) {
    const unsigned* cnt = (const unsigned*)(AP->ws + WS_CTL) + CW_CNT + (l >> 1) * 8 * 64;
    int acc = 0;
#pragma unroll
    for (int e = 0; e < 8; ++e) { const int c = (int)__builtin_amdgcn_readfirstlane(__hip_atomic_load(cnt + e * 64, RLX_AGENT)); o.cnt[e] = c; o.off[e] = acc; acc += (c + 255) & ~255; }
    o.off[8] = acc;
}
__device__ __forceinline__ void phase_moe_gather(Frame& F, CArgsP AP, int l) {
    const int gw = F.vcu * NWAVES + F.wave, NGW = F.G * NWAVES;
    MoeOff mo; moe_offsets(F, AP, l, mo);
    const unsigned char* XN = AP->ws + WS_XN; unsigned char* XS = AP->ws + WS_MB;
    for (int row = gw; row < M; row += NGW) {
        if (l == DEPTH - 1 && (row % NTOK) < CTX) continue;
        unsigned* info = (unsigned*)(AP->ws + WS_TOK) + (size_t)row * 8;
        const int e0 = (int)info[0], e1 = (int)info[1]; const unsigned* wb = (const unsigned*)(AP->ws + WS_WBASE) + (size_t)(row % NGW) * 8;
        const unsigned p0 = info[2] + wb[e0], p1 = info[3] + wb[e1];
        int o0 = 0, o1 = 0;
#pragma unroll
        for (int e = 0; e < 8; ++e) { o0 = (e == e0) ? mo.off[e] : o0; o1 = (e == e1) ? mo.off[e] : o1; }
        const unsigned s0 = (unsigned)o0 + p0, s1 = (unsigned)o1 + p1;
        const v4u a = *(const GAS v4u*)(XN + (size_t)row * D + 16 * F.lane);
        *(GAS v4u*)(XS + (size_t)s0 * D + 16 * F.lane) = a; *(GAS v4u*)(XS + (size_t)s1 * D + 16 * F.lane) = a;
        if (F.lane == 0) { info[6] = s0; info[7] = s1; }
    }
    for (int p = gw; p < 8 * 256; p += NGW) {
        const int e = p >> 8, k = p & 255; int c = 0, o = 0;
#pragma unroll
        for (int q = 0; q < 8; ++q) { c = (q == e) ? mo.cnt[q] : c; o = (q == e) ? mo.off[q] : o; }
        if (c + k < ((c + 255) & ~255)) { unsigned zz = 0u; asm volatile("" : "+v"(zz)); const v4u z = {zz, zz, zz, zz};     *(GAS v4u*)(XS + (size_t)(o + c + k) * D + 16 * F.lane) = z; }
    }
}
__device__ __forceinline__ void phase_post(Frame& F, CArgsP AP, int l, bool commit) {
    const int gw = F.vcu * NWAVES + F.wave, NGW = F.G * NWAVES;
    bf16* P = (bf16*)(AP->ws + WS_P);
    const float* RT = (const float*)(AP->ws + WS_ROPE);
    const float C2 = 0.125f * LOG2E;
    const int l8 = F.lane & 7;
    float qg[8], kg[8];
#pragma unroll
    for (int i = 0; i < 8; ++i) { qg[i] = AP->in[I_QNA][l * 64 + 8 * l8 + i]; kg[i] = AP->in[I_KNA][l * 64 + 8 * l8 + i]; }
    v4u wnx[2];
#pragma unroll
    for (int s = 0; s < 2; ++s) wnx[s] = (v4u){0u, 0u, 0u, 0u};
#define POST_ADDR(row_, col_) (P + qkv_blk(col_) + (size_t)(F.lane >> 3) * QKV_BLK + (size_t)(row_) * 64 + 8 * (F.lane & 7))
    if (gw < M) {
#pragma unroll
        for (int s = 0; s < 2; ++s) { const int col = (s == 0) ? C_AQ : C_AK;
            if ((s != 1) || (F.lane < 16)) wnx[s] = *(const GAS v4u*)POST_ADDR(gw, col); } }
    for (int row = gw; row < M; row += NGW) {
        const RowRef r = row_ref(row);
        float cs[4], sn[4];
#pragma unroll
        for (int j = 0; j < 4; ++j) { cs[j] = 1.f; sn[j] = 0.f; }
        if (!r.isctx) { const int t = r.n - CTX, pos = l8 < 4 ? (t >> 6) : (t & 63); const float* tp = RT + (size_t)(pos * 16 + (l8 & 3) * 4) * 2;
            const f32x4 c0 = *(const GAS f32x4*)tp, c1 = *(const GAS f32x4*)(tp + 4); cs[0] = c0.x; sn[0] = c0.y; cs[1] = c0.z; sn[1] = c0.w; cs[2] = c1.x; sn[2] = c1.y; cs[3] = c1.z; sn[3] = c1.w; }
        v4u wcur[2];
#pragma unroll
        for (int s = 0; s < 2; ++s) wcur[s] = wnx[s];
        if (row + NGW < M) {
#pragma unroll
            for (int s = 0; s < 2; ++s) { const int col = (s == 0) ? C_AQ : C_AK;
                if ((s != 1) || (F.lane < 16)) wnx[s] = *(const GAS v4u*)POST_ADDR(row + NGW, col); } }
#pragma unroll
        for (int s = 0; s < 2; ++s) {
            const int col = (s == 0) ? C_AQ : C_AK;
            const bool act = (s != 1) || (F.lane < 16);
            GAS v4u* p = (GAS v4u*)POST_ADDR(row, col);
            const v4u w = wcur[s];
            float x[8]; x[0] = bf_lo(w.x); x[1] = bf_hi(w.x); x[2] = bf_lo(w.y); x[3] = bf_hi(w.y); x[4] = bf_lo(w.z); x[5] = bf_hi(w.z); x[6] = bf_lo(w.w); x[7] = bf_hi(w.w);
            if (s <= 1) {
                float ss = 0.f;
#pragma unroll
                for (int i = 0; i < 8; ++i) ss += x[i] * x[i];
                ss += __shfl_xor(ss, 1); ss += __shfl_xor(ss, 2); ss += __shfl_xor(ss, 4);
                const float rs = 1.0f / sqrtf(ss * (1.0f / 64.0f) + EPS);
#pragma unroll
                for (int i = 0; i < 8; ++i) x[i] = x[i] * rs * (s == 0 ? qg[i] : kg[i]);
            }
            if (s < 4) {
#pragma unroll
                for (int j = 0; j < 4; ++j) { const float y1 = x[2 * j] * cs[j] - x[2 * j + 1] * sn[j], y2 = x[2 * j] * sn[j] + x[2 * j + 1] * cs[j]; x[2 * j] = y1; x[2 * j + 1] = y2; }
            }
            if (s == 0 || s == 2 || s == 4) {
#pragma unroll
                for (int i = 0; i < 8; ++i) x[i] *= C2;
            }
            { v4u wq; wq.x = cvtpk(x[0], x[1]); wq.y = cvtpk(x[2], x[3]); wq.z = cvtpk(x[4], x[5]); wq.w = cvtpk(x[6], x[7]); if (act && !ATT8) *p = commit ? wq : w; }
            if (ATT8 && act) { const float f8s = (s == 0) ? 4.0f : 0.25f; u32x2 w8; w8.x = pk4_fp8(x[0] * f8s, x[1] * f8s, x[2] * f8s, x[3] * f8s); w8.y = pk4_fp8(x[4] * f8s, x[5] * f8s, x[6] * f8s, x[7] * f8s);
                *(GAS u32x2*)(AP->ws + WS_Q8 + q8_blk(col) + (size_t)(F.lane >> 3) * QKV_BLK + (size_t)row * 64 + 8 * (F.lane & 7)) = w8; }
        }
    }
}
__device__ __forceinline__ float layer_lam_init(int l) { return 0.8f - 0.6f * __expf(-0.3f * (float)l); }
__device__ __forceinline__ void phase_bcomb(Frame& F, CArgsP AP, int l, bool commit) {
    const int gw = F.vcu * NWAVES + F.wave, NGW = F.G * NWAVES;
    bf16* OB = (bf16*)(AP->ws + WS_O);
    const float li = layer_lam_init(l);
    const float s1 = wave_sum(AP->in[I_LQ1][l * 64 + F.lane] * AP->in[I_LK1][l * 64 + F.lane]), s2 = wave_sum(AP->in[I_LQ2][l * 64 + F.lane] * AP->in[I_LK2][l * 64 + F.lane]);
    const float lam = __expf(s1) - __expf(s2) + li;
    const float post = 1.0f - li;
    float sg[8];
#pragma unroll
    for (int q = 0; q < 8; ++q) sg[q] = AP->in[I_SUBLN][l * 128 + ((8 * F.lane) & 127) + q] * post;
    for (int row = gw; row < M; row += NGW) {
        bf16* pr = OB + (size_t)row * OPITCH;
        const v4u a = *(const GAS v4u*)(pr + O_B1 + 8 * F.lane), b = *(const GAS v4u*)(pr + O_B2 + 8 * F.lane);
        float d[8];
        d[0] = bf_lo(a.x) - lam * bf_lo(b.x); d[1] = bf_hi(a.x) - lam * bf_hi(b.x); d[2] = bf_lo(a.y) - lam * bf_lo(b.y); d[3] = bf_hi(a.y) - lam * bf_hi(b.y);
        d[4] = bf_lo(a.z) - lam * bf_lo(b.z); d[5] = bf_hi(a.z) - lam * bf_hi(b.z); d[6] = bf_lo(a.w) - lam * bf_lo(b.w); d[7] = bf_hi(a.w) - lam * bf_hi(b.w);
        float ss = 0.f;
#pragma unroll
        for (int q = 0; q < 8; ++q) ss += d[q] * d[q];
#pragma unroll
        for (int o = 1; o < 16; o <<= 1) ss += __shfl_xor(ss, o);
        const float rs = 1.0f / sqrtf(ss * (1.0f / 128.0f) + EPS);
        v4u o; o.x = cvtpk(d[0] * rs * sg[0], d[1] * rs * sg[1]); o.y = cvtpk(d[2] * rs * sg[2], d[3] * rs * sg[3]); o.z = cvtpk(d[4] * rs * sg[4], d[5] * rs * sg[5]); o.w = cvtpk(d[6] * rs * sg[6], d[7] * rs * sg[7]);
        *(GAS v4u*)(pr + O_B1 + 8 * F.lane) = commit ? o : a;
    }
}
__device__ __forceinline__ void phase_final(Frame& F, CArgsP AP, bool poison) {
    const int gw = F.vcu * NWAVES + F.wave, NGW = F.G * NWAVES;
    const float* g = AP->in[I_GFINAL];
    u32x2 rnx[4];
#pragma unroll
    for (int j = 0; j < 4; ++j) rnx[j] = (u32x2){0u, 0u};
#define FIN_ROW(lr_) (((lr_) / SEQ) * NTOK + CTX + ((lr_) % SEQ))
    if (gw < BATCH * SEQ) load_row_xb(row_xb(AP, FIN_ROW(gw)), F.lane, rnx);
    for (int lr = gw; lr < BATCH * SEQ; lr += NGW) {
        const int b = lr / SEQ, t = lr - b * SEQ, row = b * NTOK + CTX + t;
        const RowRef r = row_ref(row); float* xr = AP->out + (size_t)lr * D;
        f32x4 v[4]; unpack_row(rnx, v);
        if (lr + NGW < BATCH * SEQ) load_row_xb(row_xb(AP, FIN_ROW(lr + NGW)), F.lane, rnx);
        moe_combine(F, AP, row, r, DEPTH - 1, v);
        const float rstd = row_rstd(v);
#pragma unroll
        for (int j = 0; j < 4; ++j) { const f32x4 gg = *(const GAS f32x4*)(g + 256 * j + 4 * F.lane); v[j] = (v[j] * rstd) * gg;
            if (poison) { const float q = __builtin_nanf(""); v[j] = (f32x4){q, q, q, q}; } }
        store_row(xr, F.lane, v);
    }
}

struct SchedPlain {
    pg8::TileOrder T; size_t astep, bstep; bool latent_only; int nt; bool tail_split; int colmap;
    __device__ __forceinline__ bool next(int i, pg8::Unit& u) const {
        const int nfull = T.nwg / T.G;
        if (!tail_split || i < nfull) { if (!T.tile(i, u.pm, u.pn)) return false; u.aux = 0; u.nt = nt; if (latent_only) u.pm += u.pm / 32 + 1; if (colmap == 1) u.pn = in8_tile(u.pn); else if (colmap == 2) u.pn = in16_tile(u.pn);
            u.aoff = (size_t)u.pm * astep; u.boff = (size_t)u.pn * bstep; return true; }
        if (i > nfull) return false;
        const int R = T.nwg - nfull * T.G; if (R == 0) return false;
        const int P = nt >> 1; int npz = T.G / R; npz = npz < P ? npz : P;
        if (T.c >= R * npz) return false;
        const int j = T.c / npz, p = T.c - j * npz;
        if (!T.tile_at((long)nfull * T.G + j, u.pm, u.pn)) return false;
        if (latent_only) u.pm += u.pm / 32 + 1;
        const int pair0 = p * P / npz, pair1 = (p + 1) * P / npz;
        u.aux = (T.c << 1) | 1; u.nt = 2 * (pair1 - pair0);
        const size_t koff = (size_t)pair0 * 2 * 128;
        u.aoff = (size_t)u.pm * astep + koff; u.boff = (size_t)u.pn * bstep + koff; return true; }
    __device__ __forceinline__ void a_ready(const pg8::Unit&) const {}
    __device__ __forceinline__ void done(const pg8::Unit&) const {}
};
struct SchedMerge {
    pg8::TileOrder T; bool latent_only;
    __device__ __forceinline__ bool next(int i, pg8::Unit& u) const {
        const int nfull = T.nwg / T.G;
        int br, p = 0; bool piece = false;
        if (i < 3 * nfull) { const int ti = i / 3; br = i - ti * 3; if (!T.tile(ti, u.pm, u.pn)) return false; }
        else { if (i > 3 * nfull) return false; const int R = T.nwg - nfull * T.G; if (T.c >= R * 12) return false;
            const int j = T.c / 12, q = T.c - j * 12; br = q >> 2; p = q & 3; piece = true; if (!T.tile_at((long)nfull * T.G + j, u.pm, u.pn)) return false; }
        u.aux = piece ? (4 | (T.c << 3)) : br; u.nt = piece ? 2 : 512 / 64; if (latent_only) u.pm += u.pm / 32 + 1;
        const int acol = br == 0 ? O_A : br == 1 ? O_B1 : O_C;
        u.aoff = ((size_t)u.pm * 256 * OPITCH + acol) * 2 + (size_t)p * 256; u.boff = ((size_t)br * D + u.pn * 256) * 512 * 2 + (size_t)p * 256; return true; }
    __device__ __forceinline__ void a_ready(const pg8::Unit&) const {}
    __device__ __forceinline__ void done(const pg8::Unit&) const {}
};
struct SchedMoe {
    pg8::TileOrder T; int pp1, pp2, pp3, pp4, pp5, pp6, pp7, nt; size_t astep, bexp, bstep;
    __device__ __forceinline__ void init(const MoeOff& o, int nN, int G, int c, size_t astep_, size_t bexp_, size_t bstep_, int nt_) {
        nt = nt_;
        T.init(o.off[8] >> 8, nN, G, c); pp1 = o.off[1] >> 8; pp2 = o.off[2] >> 8; pp3 = o.off[3] >> 8; pp4 = o.off[4] >> 8; pp5 = o.off[5] >> 8; pp6 = o.off[6] >> 8; pp7 = o.off[7] >> 8;
        astep = astep_; bexp = bexp_; bstep = bstep_; }
    __device__ __forceinline__ bool next(int i, pg8::Unit& u) const {
        if (!T.tile(i, u.pm, u.pn)) return false;
        const int e = (u.pm >= pp1) + (u.pm >= pp2) + (u.pm >= pp3) + (u.pm >= pp4) + (u.pm >= pp5) + (u.pm >= pp6) + (u.pm >= pp7);
        u.aux = e; u.nt = nt; u.aoff = (size_t)u.pm * astep; u.boff = (size_t)e * bexp + (size_t)u.pn * bstep; return true; }
    __device__ __forceinline__ void a_ready(const pg8::Unit&) const {}
    __device__ __forceinline__ void done(const pg8::Unit&) const {}
};
using pg8::f32x4;
struct EpiInProj {
    static constexpr bool PERM = true, AFTER_DRAIN = false;
    bf16* QKVC; bf16* G; const float* RT; unsigned char* Q8; float sc;
    __device__ __forceinline__ void operator()(const pg8::f32x4 (&acc)[2][2][4][2], const pg8::Unit& u, int wr, int wc, int fr, int fq) const {
        const int row0 = u.pm * 256 + wr * 64 + fr, c0 = u.pn * 256 + wc * 32 + 8 * fq;
        const bool qkv = u.pn < 15;
        const bool rope = (u.pn >= 3 && u.pn <= 6) && (u.pm % PANELS_PER_B != 0);
        const float qs = (u.pn == 3 || u.pn == 4 || u.pn == 9 || u.pn == 10) ? 0.125f * LOG2E : 1.0f;
        const bool f8copy = ATT8 && ((u.pn >= 3 && u.pn <= 6) || (u.pn >= 9 && u.pn <= 12));
        const float f8s = (u.pn == 3 || u.pn == 4 || u.pn == 9 || u.pn == 10) ? 4.0f : 0.25f;
        const int tbase = (u.pm % PANELS_PER_B - 1) * 256 + wr * 64 + fr;
        bf16* const base0 = qkv ? QKVC + (size_t)(c0 >> 6) * QKV_BLK + (c0 & 63) : G + (c0 - C_G);
        bf16* const base1 = qkv ? QKVC + (size_t)((c0 + 128) >> 6) * QKV_BLK + ((c0 + 128) & 63) : G + (c0 + 128 - C_G);
        const size_t pitch = qkv ? 64 : 3072;
#pragma unroll
        for (int ai = 0; ai < 2; ++ai)
#pragma unroll
            for (int m = 0; m < 4; ++m) {
                float cs[4] = {1.f, 1.f, 1.f, 1.f}, sn[4] = {0.f, 0.f, 0.f, 0.f};
                if (rope) { const int t = tbase + ai * 128 + m * 16, pos = (wc & 1) ? (t & 63) : (t >> 6);
                    const float* tp = RT + (size_t)(pos * 16 + 4 * fq) * 2; const pg8::f32x4 t0 = *(const GAS pg8::f32x4*)tp, t1 = *(const GAS pg8::f32x4*)(tp + 4);
                    cs[0] = t0[0]; sn[0] = t0[1]; cs[1] = t0[2]; sn[1] = t0[3]; cs[2] = t1[0]; sn[2] = t1[1]; cs[3] = t1[2]; sn[3] = t1[3]; }
#pragma unroll
                for (int bj = 0; bj < 2; ++bj) { pg8::f32x4 v0 = acc[ai][bj][m][0] * sc, v1 = acc[ai][bj][m][1] * sc;
                    if (rope) { const float a0 = v0[0] * cs[0] - v0[1] * sn[0], a1 = v0[0] * sn[0] + v0[1] * cs[0], a2 = v0[2] * cs[1] - v0[3] * sn[1], a3 = v0[2] * sn[1] + v0[3] * cs[1];
                        const float b0 = v1[0] * cs[2] - v1[1] * sn[2], b1 = v1[0] * sn[2] + v1[1] * cs[2], b2 = v1[2] * cs[3] - v1[3] * sn[3], b3 = v1[2] * sn[3] + v1[3] * cs[3];
                        v0 = (pg8::f32x4){a0, a1, a2, a3}; v1 = (pg8::f32x4){b0, b1, b2, b3}; }
                    v0 = v0 * qs; v1 = v1 * qs;
                    const size_t ro = (size_t)(row0 + ai * 128 + m * 16);
                    if (f8copy) { const int c = c0 + bj * 128; u32x2 w8; w8.x = pk4_fp8(v0[0] * f8s, v0[1] * f8s, v0[2] * f8s, v0[3] * f8s); w8.y = pk4_fp8(v1[0] * f8s, v1[1] * f8s, v1[2] * f8s, v1[3] * f8s);
                        *(GAS u32x2*)(Q8 + q8_blk(c) + ro * 64 + (c & 63)) = w8; continue; }
                    if (GATE8 && !qkv) { u32x2 w8; w8.x = pk4_fp8(v0[0], v0[1], v0[2], v0[3]); w8.y = pk4_fp8(v1[0], v1[1], v1[2], v1[3]);
                        *(GAS u32x2*)((unsigned char*)G + ro * 3072 + (c0 + bj * 128 - C_G)) = w8; }
                    else { v4u w; w.x = cvtpk(v0[0], v0[1]); w.y = cvtpk(v0[2], v0[3]); w.z = cvtpk(v1[0], v1[1]); w.w = cvtpk(v1[2], v1[3]);
                        *(GAS v4u*)((bj ? base1 : base0) + ro * pitch) = w; } }
                if (m & 1) asm volatile("" ::: "memory"); }
    }
};
struct EpiStore {
    static constexpr bool PERM = true, AFTER_DRAIN = false;
    bf16* O; int ldc; float sc;
    __device__ __forceinline__ void operator()(const pg8::f32x4 (&acc)[2][2][4][2], const pg8::Unit& u, int wr, int wc, int fr, int fq) const {
        const int row0 = u.pm * 256 + wr * 64 + fr, col0 = u.pn * 256 + wc * 32 + 8 * fq;
#pragma unroll
        for (int ai = 0; ai < 2; ++ai)
#pragma unroll
            for (int m = 0; m < 4; ++m) { bf16* rowp = O + (size_t)(row0 + ai * 128 + m * 16) * ldc + col0;
#pragma unroll
                for (int bj = 0; bj < 2; ++bj) { const pg8::f32x4 v0 = acc[ai][bj][m][0] * sc, v1 = acc[ai][bj][m][1] * sc;
                    v4u w; w.x = cvtpk(v0[0], v0[1]); w.y = cvtpk(v0[2], v0[3]); w.z = cvtpk(v1[0], v1[1]); w.w = cvtpk(v1[2], v1[3]);
                    *(GAS v4u*)(rowp + bj * 128) = w; } }
    }
};
template <bool OUT8> struct EpiSwiglu {
    static constexpr bool PERM = true, AFTER_DRAIN = false;
    unsigned char* H; int ldh; float sc;
    __device__ __forceinline__ void operator()(const pg8::f32x4 (&acc)[2][2][4][2], const pg8::Unit& u, int wr, int wc, int fr, int fq) const {
        const int row0 = u.pm * 256 + wr * 64 + fr, hid0 = u.pn * 128 + wc * 32 + 8 * fq;
#pragma unroll
        for (int ai = 0; ai < 2; ++ai)
#pragma unroll
            for (int m = 0; m < 4; ++m) { unsigned char* rowp = H + ((size_t)(row0 + ai * 128 + m * 16) * ldh + hid0) * (OUT8 ? 1 : 2);
                float h[8];
#pragma unroll
                for (int n = 0; n < 2; ++n)
#pragma unroll
                    for (int q = 0; q < 4; ++q) { const float g = acc[ai][0][m][n][q] * sc, up = acc[ai][1][m][n][q] * sc; h[4 * n + q] = g * sigmoidf_(g) * up; }
                if constexpr (OUT8) { u32x2 w; w.x = pk4_fp8(h[0], h[1], h[2], h[3]); w.y = pk4_fp8(h[4], h[5], h[6], h[7]); *(GAS u32x2*)rowp = w; }
                else { v4u w; w.x = cvtpk(h[0], h[1]); w.y = cvtpk(h[2], h[3]); w.z = cvtpk(h[4], h[5]); w.w = cvtpk(h[6], h[7]); *(GAS v4u*)rowp = w; } }
    }
};
struct EpiMerge {
    static constexpr bool PERM = true, AFTER_DRAIN = false;
    const bf16* P; float* Mf; bf16* Mb;
    __device__ __forceinline__ void operator()(const pg8::f32x4 (&acc)[2][2][4][2], const pg8::Unit& u, int wr, int wc, int fr, int fq) const {
        if (u.aux & 4) {
            float* pbase = Mf + ((size_t)(u.aux >> 3) * 256 + (wr * 64 + fr)) * 256 + (wc * 32 + 8 * fq);
#pragma unroll
            for (int ai = 0; ai < 2; ++ai)
#pragma unroll
                for (int m = 0; m < 4; ++m) { float* rowp = pbase + (size_t)(ai * 128 + m * 16) * 256;
#pragma unroll
                    for (int bj = 0; bj < 2; ++bj) { *(GAS pg8::f32x4*)(rowp + bj * 128) = acc[ai][bj][m][0]; *(GAS pg8::f32x4*)(rowp + bj * 128 + 4) = acc[ai][bj][m][1]; }
                    if (m & 1) asm volatile("" ::: "memory"); }
            return;
        }
        const int br = u.aux, row0 = u.pm * 256 + wr * 64 + fr, col0 = u.pn * 256 + wc * 32 + 8 * fq;
#pragma unroll
        for (int ai = 0; ai < 2; ++ai)
#pragma unroll
            for (int m = 0; m < 4; ++m) { const size_t row = (size_t)(row0 + ai * 128 + m * 16);
#pragma unroll
                for (int bj = 0; bj < 2; ++bj) { const int col = col0 + bj * 128;
                    float gl[8]; load_gates8(P, row * 3072 + br * D + col, gl);
                    const pg8::f32x4 v0 = acc[ai][bj][m][0], v1 = acc[ai][bj][m][1];
                    pg8::f32x4 r0, r1;
                    r0[0] = sigmoidf_(gl[0]) * v0[0]; r0[1] = sigmoidf_(gl[1]) * v0[1]; r0[2] = sigmoidf_(gl[2]) * v0[2]; r0[3] = sigmoidf_(gl[3]) * v0[3];
                    r1[0] = sigmoidf_(gl[4]) * v1[0]; r1[1] = sigmoidf_(gl[5]) * v1[1]; r1[2] = sigmoidf_(gl[6]) * v1[2]; r1[3] = sigmoidf_(gl[7]) * v1[3];
                    bf16* mp = Mb + row * D + col;
                    if (br != 0) { const v4u pw = *(const GAS v4u*)mp;
                        r0[0] += bf_lo(pw.x); r0[1] += bf_hi(pw.x); r0[2] += bf_lo(pw.y); r0[3] += bf_hi(pw.y); r1[0] += bf_lo(pw.z); r1[1] += bf_hi(pw.z); r1[2] += bf_lo(pw.w); r1[3] += bf_hi(pw.w); }
                    { v4u w; w.x = cvtpk(r0[0], r0[1]); w.y = cvtpk(r0[2], r0[3]); w.z = cvtpk(r1[0], r1[1]); w.w = cvtpk(r1[2], r1[3]); *(GAS v4u*)mp = w; } }
                if (m & 1) asm volatile("" ::: "memory"); }
    }
};
struct EpiResid {
    static constexpr bool PERM = true, AFTER_DRAIN = false;
    bf16* XB; const float* gate; float sc;
    __device__ __forceinline__ void operator()(const pg8::f32x4 (&acc)[2][2][4][2], const pg8::Unit& u, int wr, int wc, int fr, int fq) const {
        const int b = u.pm / PANELS_PER_B, j = u.pm - b * PANELS_PER_B;
        const float* gv = gate + (size_t)((j == 0) ? 4 : b) * 6144;
        const int col0 = u.pn * 256 + wc * 32 + 8 * fq;
        pg8::f32x4 g4[2][2];
#pragma unroll
        for (int bj = 0; bj < 2; ++bj)
#pragma unroll
            for (int n = 0; n < 2; ++n) g4[bj][n] = *(const GAS pg8::f32x4*)(gv + col0 + bj * 128 + 4 * n) * sc;
        bf16* base = XB + (size_t)(u.pm * 256 + wr * 64 + fr) * D + col0;
#pragma unroll
        for (int ai = 0; ai < 2; ++ai)
#pragma unroll
            for (int m = 0; m < 4; ++m) { bf16* rowp = base + (size_t)(ai * 128 + m * 16) * D;
#pragma unroll
                for (int bj = 0; bj < 2; ++bj) { GAS v4u* p = (GAS v4u*)(rowp + bj * 128); const v4u w = *p;
                    const pg8::f32x4 d0 = g4[bj][0] * acc[ai][bj][m][0], d1 = g4[bj][1] * acc[ai][bj][m][1];
                    v4u o; o.x = cvtpk(bf_lo(w.x) + d0[0], bf_hi(w.x) + d0[1]); o.y = cvtpk(bf_lo(w.y) + d0[2], bf_hi(w.y) + d0[3]);
                    o.z = cvtpk(bf_lo(w.z) + d1[0], bf_hi(w.z) + d1[1]); o.w = cvtpk(bf_lo(w.w) + d1[2], bf_hi(w.w) + d1[3]); *p = o; }
                if (m & 1) asm volatile("" ::: "memory"); }
    }
};

__device__ __forceinline__ void phase_merge_fix(Frame& F, CArgsP AP, int l) {
    pg8::TileOrder T; T.init(M / 256, D / 256, F.G, 0);
    const int nfull = T.nwg / T.G, R = T.nwg - nfull * T.G;
    const float* PART = (const float*)(AP->ws + WS_PART); const bf16* P = (const bf16*)(AP->ws + WS_P + WS_G_OFF); bf16* Mb = (bf16*)(AP->ws + WS_XN);
    for (int id = F.vcu * (NWAVES * 64) + F.tid; id < R * 8192; id += F.G * NWAVES * 64) {
        const int j = id >> 13, rem = id & 8191, rit = rem >> 5, ch = rem & 31;
        int pm, pn; if (!T.tile_at((long)nfull * T.G + j, pm, pn)) continue;
        const size_t row = (size_t)pm * 256 + rit; const int col = pn * 256 + ch * 8;
        float m8[8];
#pragma unroll
        for (int q = 0; q < 8; ++q) m8[q] = 0.f;
#pragma unroll
        for (int br = 0; br < 3; ++br) {
            f32x4 s0 = {0.f, 0.f, 0.f, 0.f}, s1 = {0.f, 0.f, 0.f, 0.f};
#pragma unroll
            for (int p = 0; p < 4; ++p) { const float* pp = PART + ((size_t)(j * 12 + br * 4 + p) * 256 + rit) * 256 + ch * 8; s0 += *(const GAS f32x4*)pp; s1 += *(const GAS f32x4*)(pp + 4); }
            float gl[8]; load_gates8(P, row * 3072 + br * D + col, gl);
            m8[0] += sigmoidf_(gl[0]) * s0[0]; m8[1] += sigmoidf_(gl[1]) * s0[1]; m8[2] += sigmoidf_(gl[2]) * s0[2]; m8[3] += sigmoidf_(gl[3]) * s0[3];
            m8[4] += sigmoidf_(gl[4]) * s1[0]; m8[5] += sigmoidf_(gl[5]) * s1[1]; m8[6] += sigmoidf_(gl[6]) * s1[2]; m8[7] += sigmoidf_(gl[7]) * s1[3];
        }
        v4u w; w.x = cvtpk(m8[0], m8[1]); w.y = cvtpk(m8[2], m8[3]); w.z = cvtpk(m8[4], m8[5]); w.w = cvtpk(m8[6], m8[7]);
        *(GAS v4u*)(Mb + row * D + col) = w;
    }
}
#ifndef CFG_PV8
#define CFG_PV8 3
#endif
#ifndef CFG_PAIR
#define CFG_PAIR 2
#endif
#if CFG_PAIR == 2
#define FS8FN attn_fs8q
#elif CFG_PAIR
#define FS8FN attn_fs8p
#else
#define FS8FN attn_fs8
#endif
#ifndef F8_BA
#define F8_BA 5
#endif
#ifndef F8_BB
#define F8_BB 7
#endif
#if !CFG_ATT8
#undef CFG_PV8
#define CFG_PV8 0
#endif
constexpr size_t WS_VT8 = WS_XN;
constexpr int NVB = 18;
static_assert((size_t)NVB * M * 64 <= (size_t)M * D * 2, "V^T tiles fit the XN region");
__device__ __forceinline__ const unsigned char* vt8_tiles(CArgsP AP, int vb, size_t r0) { return AP->ws + WS_VT8 + ((size_t)vb * (M / 64) + r0 / 64) * 4096; }
__device__ __forceinline__ void phase_vt8(Frame& F, CArgsP AP) {
    const int gw = F.vcu * NWAVES + F.wave, NGW = F.G * NWAVES;
    const bf16* P = (const bf16*)(AP->ws + WS_P); unsigned char* VT = AP->ws + WS_VT8;
    LAS unsigned* T = (LAS unsigned*)(F.lds + RING_OFF) + F.wave * (64 * 17);
    const LAS unsigned char* Tb = (const LAS unsigned char*)T;
    const int k = F.lane, kk = k & 31, pos = ((kk >> 2) & 1) * 32 + (kk & 3) + 4 * (kk >> 3) + 16 * (k >> 5);
    constexpr int VB0 = (CFG_PV8 & 2) ? 0 : ((CFG_PV8 & 1) ? 2 : 10), VB1 = (CFG_PV8 & 4) ? 18 : ((CFG_PV8 & 1) ? 10 : 2);
    for (int it = gw + VB0 * (M / 64); it < VB1 * (M / 64); it += NGW) {
        const int vb = it / (M / 64), tile = it - vb * (M / 64);
        const int col = vb < 2 ? C_AV + 64 * vb : (vb < 10 ? C_BV + 64 * (vb - 2) : C_CV + 64 * (vb - 10));
        const bf16* src = P + qkv_blk(col) + ((size_t)tile * 64 + k) * 64;
        v4u w[8];
#pragma unroll
        for (int j = 0; j < 8; ++j) w[j] = *(const GAS v4u*)(src + 8 * j);
#pragma unroll
        for (int j = 0; j < 8; ++j) {
            T[pos * 17 + 2 * j] = pk4_fp8(8.f * bf_lo(w[j].x), 8.f * bf_hi(w[j].x), 8.f * bf_lo(w[j].y), 8.f * bf_hi(w[j].y));
            T[pos * 17 + 2 * j + 1] = pk4_fp8(8.f * bf_lo(w[j].z), 8.f * bf_hi(w[j].z), 8.f * bf_lo(w[j].w), 8.f * bf_hi(w[j].w)); }
        asm volatile("s_waitcnt lgkmcnt(0)" ::: "memory");
        unsigned char* dst = VT + ((size_t)vb * (M / 64) + tile) * 4096 + (size_t)k * 64;
#pragma unroll
        for (int g4 = 0; g4 < 4; ++g4) { unsigned o[4];
#pragma unroll
            for (int g = 0; g < 4; ++g) { const int p0 = 16 * g4 + 4 * g;
                o[g] = (unsigned)Tb[(p0 + 0) * 68 + k] | ((unsigned)Tb[(p0 + 1) * 68 + k] << 8) | ((unsigned)Tb[(p0 + 2) * 68 + k] << 16) | ((unsigned)Tb[(p0 + 3) * 68 + k] << 24); }
            *(GAS v4u*)(dst + 16 * g4) = (v4u){o[0], o[1], o[2], o[3]}; }
        asm volatile("s_waitcnt lgkmcnt(0)" ::: "memory");
    }
}
#ifndef CFG_BFUSE
#define CFG_BFUSE 1
#endif
__device__ __forceinline__ v4u ld16_sc1(const bf16* p) { v4u r; asm volatile("global_load_dwordx4 %0, %1, off sc1" : "=v"(r) : "v"(p) : "memory"); return r; }
__device__ __forceinline__ void bcomb_unit(Frame& F, CArgsP AP, int l, size_t row0, int head) {
    bf16* OB = (bf16*)(AP->ws + WS_O);
    const int lane = F.tid & 63, wave = __builtin_amdgcn_readfirstlane(F.tid >> 6), l16 = lane & 15, rsub = lane >> 4;
    const float li = layer_lam_init(l);
    const float s1 = wave_sum(AP->in[I_LQ1][l * 64 + lane] * AP->in[I_LK1][l * 64 + lane]), s2 = wave_sum(AP->in[I_LQ2][l * 64 + lane] * AP->in[I_LK2][l * 64 + lane]);
    const float lam = __expf(s1) - __expf(s2) + li;
    const float post = 1.0f - li;
    float sg[8];
#pragma unroll
    for (int q = 0; q < 8; ++q) sg[q] = AP->in[I_SUBLN][l * 128 + 8 * l16 + q] * post;
    asm volatile("s_waitcnt vmcnt(0)" ::: "memory");
    bf16* const pr0 = OB + (row0 + (size_t)(wave * 32 + rsub)) * OPITCH + head * 128 + 8 * l16;
    v4u av[8], bv[8];
#pragma unroll
    for (int i = 0; i < 8; ++i) { av[i] = ld16_sc1(pr0 + (size_t)(4 * i) * OPITCH + O_B1); bv[i] = ld16_sc1(pr0 + (size_t)(4 * i) * OPITCH + O_B2); }
    asm volatile("s_waitcnt vmcnt(0)" ::: "memory");
#pragma unroll
    for (int i = 0; i < 8; ++i) {
        v4u a = av[i], b = bv[i];
        asm volatile("" : "+v"(a), "+v"(b));
        float d[8];
        d[0] = bf_lo(a.x) - lam * bf_lo(b.x); d[1] = bf_hi(a.x) - lam * bf_hi(b.x); d[2] = bf_lo(a.y) - lam * bf_lo(b.y); d[3] = bf_hi(a.y) - lam * bf_hi(b.y);
        d[4] = bf_lo(a.z) - lam * bf_lo(b.z); d[5] = bf_hi(a.z) - lam * bf_hi(b.z); d[6] = bf_lo(a.w) - lam * bf_lo(b.w); d[7] = bf_hi(a.w) - lam * bf_hi(b.w);
        float ss = 0.f;
#pragma unroll
        for (int q = 0; q < 8; ++q) ss += d[q] * d[q];
#pragma unroll
        for (int o = 1; o < 16; o <<= 1) ss += __shfl_xor(ss, o);
        const float rs = 1.0f / sqrtf(ss * (1.0f / 128.0f) + EPS);
        v4u o; o.x = cvtpk(d[0] * rs * sg[0], d[1] * rs * sg[1]); o.y = cvtpk(d[2] * rs * sg[2], d[3] * rs * sg[3]); o.z = cvtpk(d[4] * rs * sg[4], d[5] * rs * sg[5]); o.w = cvtpk(d[6] * rs * sg[6], d[7] * rs * sg[7]);
        *(GAS v4u*)(pr0 + (size_t)(4 * i) * OPITCH + O_B1) = o;
    }
}
#ifndef CFG_FS2
#define CFG_FS2 0
#endif
#if CFG_PV8 & 1
#define FSU2(Q_, K_, V_, VT_, TR_, ...) attn_body::FS8FN<2, false, F8_BB>(VT_, TR_, __VA_ARGS__)
#else
#define FSU2(Q_, K_, V_, VT_, TR_, ...) attn_body::attn_fs<2, false, ATT8>(Q_, K_, V_, __VA_ARGS__)
#endif
#if CFG_PV8 & 2
#define FSU1(Q_, K_, V_, VT_, TR_, ...) attn_body::FS8FN<1, false, F8_BA>(VT_, TR_, __VA_ARGS__)
#else
#define FSU1(Q_, K_, V_, VT_, TR_, ...) attn_body::attn_fs<1, false, ATT8>(Q_, K_, V_, __VA_ARGS__)
#endif
#if CFG_PV8 & 4
#define FSUC(Q_, K_, V_, VT_, TR_, ...) attn_body::FS8FN<1, true, F8_BA>(VT_, TR_, __VA_ARGS__)
#else
#define FSUC(Q_, K_, V_, VT_, TR_, ...) attn_body::attn_fs<1, true, ATT8>(Q_, K_, V_, __VA_ARGS__)
#endif
__device__ __forceinline__ void attn_fast(Frame& F, CArgsP AP, int l, char* shm, LAS float* bt, int parts) {
    using abf = attn_body::bf16;
    const abf* P = (const abf*)(AP->ws + WS_P); abf* OB = (abf*)(AP->ws + WS_O);
    const int nunits = 3072 + ((l < DEPTH - 1) ? 96 : 0);
    if (parts & 1) for (int f = F.vcu + 4 * 256; f < nunits; f += F.G) {
        const int round = f >> 8, v = f & 255, x = v >> 5, c = v & 31;
        int b, head, map0, map1, qrow, NT;
        if (round >= 4 && round < 8) { const int i4 = round - 4; b = x >> 1; head = 2 * (x & 1) + (i4 >> 1); map0 = map1 = i4 & 1; qrow = CTX + 256 * c; NT = NTOK / 64; }
        else if (f >= 3072 + 32 && f < 3072 + 48) { const int w = f - 3072 - 32; b = w >> 2; head = w & 3; map0 = 0; map1 = 1; qrow = 0; NT = CTX / 64; }
        else continue;
        const size_t r0 = (size_t)b * NTOK;
        for (int map = map0; map <= map1; ++map) {
        const abf* Qp = P + qkv_blk(C_BQ + map * 256 + head * 64) + (r0 + qrow) * 64; const abf* Kp = P + qkv_blk(C_BK + map * 256 + head * 64) + r0 * 64; const abf* Vp = P + qkv_blk(C_BV + head * 128) + r0 * 64;
        abf* Op = OB + (r0 + qrow) * OPITCH + (map ? O_B2 : O_B1) + head * 128;
        const unsigned char* Q8 = AP->ws + WS_Q8;
        if (FSU2(Qp, Kp, Vp, vt8_tiles(AP, 2 + 2 * head, r0), (NT > 4 ? 4 : 0), Op, NT, 0, 0, (attn_body::lds_cfptr)bt, shm, Q8 + q8_blk(C_BQ + map * 256 + head * 64) + (r0 + qrow) * 64, Q8 + q8_blk(C_BK + map * 256 + head * 64) + r0 * 64)) {
            attn_body::attn_unit<8, false, ATT8>(Qp, Kp, Vp, Op, NT, 0, 0, (attn_body::lds_cfptr)bt, shm, Q8 + q8_blk(C_BQ + map * 256 + head * 64) + (r0 + qrow) * 64, Q8 + q8_blk(C_BK + map * 256 + head * 64) + r0 * 64);
            attn_body::attn_unit<8, false, ATT8>(Qp, Kp, Vp + QKV_BLK, Op + 64, NT, 0, 0, (attn_body::lds_cfptr)bt, shm, Q8 + q8_blk(C_BQ + map * 256 + head * 64) + (r0 + qrow) * 64, Q8 + q8_blk(C_BK + map * 256 + head * 64) + r0 * 64); }
        }
        if (CFG_BFUSE && map1 == 1) bcomb_unit(F, AP, l, r0 + qrow, head);
    }
    if (parts & 2) for (int f = F.vcu; f < nunits; f += F.G) {
        const int round = f >> 8, v = f & 255, x = v >> 5, c = v & 31;
        int b, qcol, kcol, vcol, ocol, qrow, NT;
        if (round < 4) { b = x >> 1; const int kvh = x & 1, qh = kvh * 4 + round; qcol = C_AQ + qh * 64; kcol = C_AK + kvh * 64; vcol = C_AV + kvh * 64; ocol = O_A + qh * 64; qrow = CTX + 256 * c; NT = NTOK / 64; }
        else if (f >= 3072 && f < 3072 + 32) { const int w = f - 3072; b = w >> 3; const int qh = w & 7, kvh = qh >> 2; qcol = C_AQ + qh * 64; kcol = C_AK + kvh * 64; vcol = C_AV + kvh * 64; ocol = O_A + qh * 64; qrow = 0; NT = CTX / 64; }
        else if (f >= 3072 + 64) { const int w = f - 3072 - 64; b = w >> 3; const int h = w & 7; qcol = C_CQ + h * 64; kcol = C_CK + h * 64; vcol = C_CV + h * 64; ocol = O_C + h * 64; qrow = 0; NT = CTX / 64; }
        else continue;
        const size_t r0 = (size_t)b * NTOK;
        const unsigned char* Q8 = AP->ws + WS_Q8;
        bool redo;
        if (((CFG_PV8 & 2) != 0) && (vcol < C_CV || (CFG_PV8 & 4) != 0))
            redo = attn_body::FS8FN<1, false, F8_BA>(vt8_tiles(AP, vcol >= C_CV ? 10 + ((vcol - C_CV) >> 6) : ((vcol - C_AV) >> 6), r0), (NT > 4 ? 4 : 0), OB + (r0 + qrow) * OPITCH + ocol, NT, 0, 0, (attn_body::lds_cfptr)bt, shm,
                                           Q8 + q8_blk(qcol) + (r0 + qrow) * 64, Q8 + q8_blk(kcol) + r0 * 64);
        else
            redo = attn_body::attn_fs<1, false, ATT8>(P + qkv_blk(qcol) + (r0 + qrow) * 64, P + qkv_blk(kcol) + r0 * 64, P + qkv_blk(vcol) + r0 * 64, OB + (r0 + qrow) * OPITCH + ocol, NT, 0, 0, (attn_body::lds_cfptr)bt, shm,
                                           Q8 + q8_blk(qcol) + (r0 + qrow) * 64, Q8 + q8_blk(kcol) + r0 * 64);
        if (redo)
            attn_body::attn_unit<8, false, ATT8>(P + qkv_blk(qcol) + (r0 + qrow) * 64, P + qkv_blk(kcol) + r0 * 64, P + qkv_blk(vcol) + r0 * 64, OB + (r0 + qrow) * OPITCH + ocol, NT, 0, 0, (attn_body::lds_cfptr)bt, shm,
                                           Q8 + q8_blk(qcol) + (r0 + qrow) * 64, Q8 + q8_blk(kcol) + r0 * 64);
    }
    if (parts & 4) for (int f = F.vcu + 8 * 256; f < 3072; f += F.G) {
        const int round = f >> 8, v = f & 255, x = v >> 5, c = v & 31;
        const int b = x >> 1, h = 4 * (x & 1) + (round - 8), g0 = 4 * c; int kr0 = g0 - 4; kr0 = kr0 < 0 ? 0 : (kr0 > 116 ? 116 : kr0);
        const size_t r0 = (size_t)b * NTOK; const int qrow = CTX + 256 * c;
        const unsigned char* Q8 = AP->ws + WS_Q8;
        if (FSUC(P + qkv_blk(C_CQ + h * 64) + (r0 + qrow) * 64, P + qkv_blk(C_CK + h * 64) + r0 * 64, P + qkv_blk(C_CV + h * 64) + r0 * 64, vt8_tiles(AP, 10 + h, r0), 4 + (g0 + 2 - kr0), OB + (r0 + qrow) * OPITCH + O_C + h * 64, 16, kr0, g0,
                                    (attn_body::lds_cfptr)(bt + h * 465), shm, Q8 + q8_blk(C_CQ + h * 64) + (r0 + qrow) * 64, Q8 + q8_blk(C_CK + h * 64) + r0 * 64))
            attn_body::attn_unit<8, true, ATT8>(P + qkv_blk(C_CQ + h * 64) + (r0 + qrow) * 64, P + qkv_blk(C_CK + h * 64) + r0 * 64, P + qkv_blk(C_CV + h * 64) + r0 * 64, OB + (r0 + qrow) * OPITCH + O_C + h * 64, 16, kr0, g0,
                                    (attn_body::lds_cfptr)(bt + h * 465), shm, Q8 + q8_blk(C_CQ + h * 64) + (r0 + qrow) * 64, Q8 + q8_blk(C_CK + h * 64) + r0 * 64);
    }
}
__device__ __forceinline__ void phase_attn(Frame& F, CArgsP AP, int l, unsigned char* lds_generic, int parts) {
    char* shm = (char*)lds_generic + RING_OFF;
    LAS float* bt = (LAS float*)(F.lds + BIAS_OFF);
    for (int i = F.tid; i < 8 * 465; i += NWAVES * 64) bt[i] = AP->in[I_RPB][(size_t)l * 8 * 465 + i] * LOG2E;
    __syncthreads();
    attn_fast(F, AP, l, shm, bt, parts);
}

#ifndef DUP_PHASE
#define DUP_PHASE (-1)
#endif
#ifndef DUP_PHASE_B
#define DUP_PHASE_B (-1)
#endif
#ifndef PROBE_NOEPI
#define PROBE_NOEPI 0
#endif
#ifndef DUP_ATT
#define DUP_ATT 7
#endif
#ifndef DUP_VT
#define DUP_VT 1
#endif
#ifndef DUP_CONV
#define DUP_CONV 1
#endif
#if defined(PROBE_A)
#define TS0() do { if (blockIdx.x == 0) { t_begin = __builtin_amdgcn_s_memrealtime(); } } while (0)
#define TS1(id) do { if (blockIdx.x == 0) { const unsigned long long d_ = __builtin_amdgcn_s_memrealtime() - t_begin; if ((id) == PROBE_A) t_a += d_; if ((id) == PROBE_B) t_b += d_; } } while (0)
#else
#define TS0() do {} while (0)
#define TS1(id) do {} while (0)
#endif
__global__ void __launch_bounds__(NWAVES * 64, 2) fwd_kernel(Args args) {
    extern __shared__ __attribute__((aligned(16))) unsigned char lds[];
    Frame F;
    F.lds = (LAS unsigned char*)lds;
    REFRESH(F);
    F.G = gridDim.x; { const int bx = blockIdx.x; F.vcu = (F.G % 8 == 0) ? (bx % 8) * (F.G / 8) + bx / 8 : bx; }
    for (int u = F.tid; u < (LDS_BYTES - LDSCTL_OFF) / 4; u += NWAVES * 64) ((LAS unsigned*)(F.lds + LDSCTL_OFF))[u] = 0u;
    __syncthreads();
    {   CArgsP AP = fresh_args(); (void)xcd_barrier_post((unsigned*)(AP->ws + WS_CTL) + CW_BAR, (volatile LAS unsigned*)(F.lds + MISC_OFF) + 8); }
#ifndef DUP_BAR
#define DUP_BAR 1
#endif
#define GRID_BAR() for (int nb_ = 0; nb_ < DUP_BAR; ++nb_) do { CArgsP AP_ = fresh_args(); XcdBarrier b_; b_.bar = (unsigned*)(AP_->ws + WS_CTL) + CW_BAR; b_.x = xb_xcc_id(); b_.st = (volatile LAS unsigned*)(F.lds + MISC_OFF) + 8; xcd_barrier(b_); } while (0)
#define PH(...) do { REFRESH(F); CArgsP AP = fresh_args(); __VA_ARGS__; } while (0)
    const int G = F.G, cblk = (int)blockIdx.x;

#if defined(PROBE_A)
    unsigned long long t_begin = 0, t_a = 0, t_b = 0;
#endif
    TS0();
        for (int rep_ = 0; rep_ < ((0 == DUP_PHASE || 0 == DUP_PHASE_B || DUP_PHASE == 99) ? 2 : 1); ++rep_) {
    PH(prologue_mod(F, AP));
    PH(convert_weights(F, AP, 0));
    GRID_BAR();
        }
    TS1(0); TS0();

    for (int l = 0; l < DEPTH; ++l) {
        for (int rep_ = 0; rep_ < ((1 == DUP_PHASE || 1 == DUP_PHASE_B || DUP_PHASE == 99) ? 2 : 1); ++rep_) {
        if (l > 0) { for (int rc_ = 0; rc_ < DUP_CONV; ++rc_) { PH(convert_weights(F, AP, l)); } }
        PH(phase_norm1(F, AP, l, rep_ + 1 == ((1 == DUP_PHASE || 1 == DUP_PHASE_B || DUP_PHASE == 99) ? 2 : 1)));
        GRID_BAR();
        }
        TS1(1); TS0();
        for (int rep_ = 0; rep_ < ((2 == DUP_PHASE || 2 == DUP_PHASE_B || DUP_PHASE == 99) ? 2 : 1); ++rep_) {
        {   CArgsP AP = fresh_args();
            pg8::Gemm g{(const bf16*)(AP->ws + WS_XN), (const bf16*)(AP->ws + WS_WIN), D, D, D};
            if constexpr (IN8_TILES > 0) {
                pg8::Gemm g8{(const bf16*)(AP->ws + WS_MB), (const bf16*)(AP->ws + WS_WIN8), D, D, D};
                SchedPlain S; S.T.init(M / 256, IN8_TILES, G, cblk); S.astep = (size_t)256 * D; S.bstep = (size_t)256 * D; S.latent_only = false; S.nt = D / 128; S.tail_split = false; S.colmap = 1;
                EpiInProj E{(bf16*)(AP->ws + WS_P), (bf16*)(AP->ws + WS_P + WS_G_OFF), (const float*)(AP->ws + WS_ROPE), AP->ws + WS_Q8, WSCI};
                pg8::gemm_phase<EpiInProj, SchedPlain, true, true>(F.lds + RING_OFF, g8, S, E, !PROBE_NOEPI || rep_ + 1 == ((2 == DUP_PHASE || 2 == DUP_PHASE_B || DUP_PHASE == 99) ? 2 : 1)); }
            if constexpr (IN8_TILES < 27) {
                SchedPlain S; S.T.init(M / 256, DIN / 256 - IN8_TILES, G, cblk); S.astep = (size_t)256 * D * 2; S.bstep = (size_t)256 * D * 2; S.latent_only = false; S.nt = D / 64; S.tail_split = false; S.colmap = (IN8_TILES > 0) ? 2 : 0;
                EpiInProj E{(bf16*)(AP->ws + WS_P), (bf16*)(AP->ws + WS_P + WS_G_OFF), (const float*)(AP->ws + WS_ROPE), AP->ws + WS_Q8, 1.0f};
                pg8::gemm_phase<EpiInProj, SchedPlain, true, false>(F.lds + RING_OFF, g, S, E); } }
        GRID_BAR();
        }
        TS1(2); TS0();
        for (int rep_ = 0; rep_ < ((3 == DUP_PHASE || 3 == DUP_PHASE_B || DUP_PHASE == 99) ? 2 : 1); ++rep_) {
        PH(phase_post(F, AP, l, rep_ + 1 == ((3 == DUP_PHASE || 3 == DUP_PHASE_B || DUP_PHASE == 99) ? 2 : 1)));
        if (CFG_PV8) for (int rv_ = 0; rv_ < DUP_VT; ++rv_) PH(phase_vt8(F, AP));
        GRID_BAR();
        }
        TS1(3); TS0();
        for (int rep_ = 0; rep_ < ((4 == DUP_PHASE || 4 == DUP_PHASE_B || DUP_PHASE == 99) ? 2 : 1); ++rep_) {
        PH(phase_attn(F, AP, l, lds, rep_ ? DUP_ATT : 7));
        GRID_BAR();
        }
        TS1(4); TS0();
        for (int rep_ = 0; rep_ < ((5 == DUP_PHASE || 5 == DUP_PHASE_B || DUP_PHASE == 99) ? 2 : 1); ++rep_) {
        if (!CFG_BFUSE) { PH(phase_bcomb(F, AP, l, rep_ + 1 == ((5 == DUP_PHASE || 5 == DUP_PHASE_B || DUP_PHASE == 99) ? 2 : 1)));
        GRID_BAR(); }
        }
        TS1(5); TS0();
        for (int rep_ = 0; rep_ < ((6 == DUP_PHASE || 6 == DUP_PHASE_B || DUP_PHASE == 99) ? 2 : 1); ++rep_) {
        {   CArgsP AP = fresh_args();
            pg8::Gemm g{(const bf16*)(AP->ws + WS_O), (const bf16*)(AP->ws + WS_WBR), OPITCH, 512, 512};
            const bool lastl = (l == DEPTH - 1);
            SchedMerge S; S.T.init(lastl ? BATCH * SEQ / 256 : M / 256, D / 256, G, cblk); S.latent_only = lastl;
            EpiMerge E{(const bf16*)(AP->ws + WS_P + WS_G_OFF), (float*)(AP->ws + WS_PART), (bf16*)(AP->ws + WS_XN)};
            pg8::gemm_phase<EpiMerge, SchedMerge, true>(F.lds + RING_OFF, g, S, E); }
        GRID_BAR();
        if (l < DEPTH - 1) { PH(phase_merge_fix(F, AP, l)); GRID_BAR(); }
        }
        TS1(6); TS0();
        for (int rep_ = 0; rep_ < ((7 == DUP_PHASE || 7 == DUP_PHASE_B || DUP_PHASE == 99) ? 2 : 1); ++rep_) {
        {   CArgsP AP = fresh_args();
            pg8::Gemm g{(const bf16*)(AP->ws + WS_XN), (const bf16*)(AP->ws + WS_WOUT), D, D, D};
            const bool lastl = (l == DEPTH - 1);
            SchedPlain S; S.T.init(lastl ? BATCH * SEQ / 256 : M / 256, D / 256, G, cblk); S.astep = (size_t)256 * D * 2; S.bstep = (size_t)256 * D * 2; S.latent_only = lastl; S.nt = D / 64; S.colmap = 0; S.tail_split = TAIL_SPLIT;
            EpiResid E{(bf16*)(AP->ws + WS_XB), (const float*)(AP->ws + WS_MOD) + (size_t)(l * 5) * 6144 + 2 * 1024, (rep_ + 1 == ((7 == DUP_PHASE || 7 == DUP_PHASE_B || DUP_PHASE == 99) ? 2 : 1)) ? 1.0f : 0.0f};
            pg8::gemm_phase<EpiResid, SchedPlain, true>(F.lds + RING_OFF, g, S, E); }
        GRID_BAR();
        }
        TS1(7); TS0();
        for (int rep_ = 0; rep_ < ((8 == DUP_PHASE || 8 == DUP_PHASE_B || DUP_PHASE == 99) ? 2 : 1); ++rep_) {
        PH(phase_norm2(F, AP, l, rep_ + 1 == ((8 == DUP_PHASE || 8 == DUP_PHASE_B || DUP_PHASE == 99) ? 2 : 1)));
        GRID_BAR();
        }
        TS1(8); TS0();
        if (!(l & 1)) {
        for (int rep_ = 0; rep_ < ((9 == DUP_PHASE || 9 == DUP_PHASE_B || DUP_PHASE == 99) ? 2 : 1); ++rep_) {
            {   CArgsP AP = fresh_args();
                constexpr int EB = DENSE8 ? 1 : 2;
                pg8::Gemm g{(const bf16*)(AP->ws + WS_XN), (const bf16*)(AP->ws + WS_W13), D, D, D};
                SchedPlain S; S.T.init(M / 256, 2 * FF / 256, G, cblk); S.astep = (size_t)256 * D * EB; S.bstep = (size_t)256 * D * EB; S.latent_only = false; S.nt = DENSE8 ? D / 128 : D / 64; S.tail_split = false; S.colmap = 0;
                EpiSwiglu<DENSE8> E{AP->ws + WS_P, FF, DENSE8 ? WSCI : 1.0f};
                pg8::gemm_phase<EpiSwiglu<DENSE8>, SchedPlain, true, DENSE8>(F.lds + RING_OFF, g, S, E); }
            GRID_BAR();
        }
            TS1(9); TS0();
        for (int rep_ = 0; rep_ < ((10 == DUP_PHASE || 10 == DUP_PHASE_B || DUP_PHASE == 99) ? 2 : 1); ++rep_) {
            {   CArgsP AP = fresh_args();
                pg8::Gemm g{(const bf16*)(AP->ws + WS_P), (const bf16*)(AP->ws + WS_W2), FF, FF, FF};
                constexpr int EB = DENSE8 ? 1 : 2;
                SchedPlain S; S.T.init(M / 256, D / 256, G, cblk); S.astep = (size_t)256 * FF * EB; S.bstep = (size_t)256 * FF * EB; S.latent_only = false; S.nt = DENSE8 ? FF / 128 : FF / 64; S.tail_split = TAIL_SPLIT; S.colmap = 0;
                EpiResid E{(bf16*)(AP->ws + WS_XB), (const float*)(AP->ws + WS_MOD) + (size_t)(l * 5) * 6144 + 5 * 1024, (rep_ + 1 == ((10 == DUP_PHASE || 10 == DUP_PHASE_B || DUP_PHASE == 99) ? 2 : 1)) ? (DENSE8 ? WSCI : 1.0f) : 0.0f};
                pg8::gemm_phase<EpiResid, SchedPlain, true, DENSE8>(F.lds + RING_OFF, g, S, E); }
            GRID_BAR();
        }
            TS1(10); TS0();
        } else {
        for (int rep_ = 0; rep_ < ((11 == DUP_PHASE || 11 == DUP_PHASE_B || DUP_PHASE == 99) ? 2 : 1); ++rep_) {
            PH(phase_moe_gather(F, AP, l));
            GRID_BAR();
        }
            TS1(11); TS0();
        for (int rep_ = 0; rep_ < ((12 == DUP_PHASE || 12 == DUP_PHASE_B || DUP_PHASE == 99) ? 2 : 1); ++rep_) {
            {   CArgsP AP = fresh_args();
                MoeOff mo; moe_offsets(F, AP, l, mo);
                pg8::Gemm g{(const bf16*)(AP->ws + WS_MB), (const bf16*)(AP->ws + WS_W13), D, D, D};
                SchedMoe S; S.init(mo, 2 * FE / 256, G, cblk, (size_t)256 * D, (size_t)2 * FE * D, (size_t)256 * D, D / 128);
                EpiSwiglu<MOEDOWN8> E{AP->ws + WS_P, FE, WSCI};
                pg8::gemm_phase<EpiSwiglu<MOEDOWN8>, SchedMoe, true, true>(F.lds + RING_OFF, g, S, E, !PROBE_NOEPI || rep_ + 1 == ((12 == DUP_PHASE || 12 == DUP_PHASE_B || DUP_PHASE == 99) ? 2 : 1)); }
            GRID_BAR();
        }
            TS1(12); TS0();
        for (int rep_ = 0; rep_ < ((13 == DUP_PHASE || 13 == DUP_PHASE_B || DUP_PHASE == 99) ? 2 : 1); ++rep_) {
            {   CArgsP AP = fresh_args();
                MoeOff mo; moe_offsets(F, AP, l, mo);
                pg8::Gemm g{(const bf16*)(AP->ws + WS_P), (const bf16*)(AP->ws + WS_W2), FE, FE, FE};
                constexpr int EB = MOEDOWN8 ? 1 : 2;
                SchedMoe S; S.init(mo, D / 256, G, cblk, (size_t)256 * FE * EB, (size_t)D * FE * EB, (size_t)256 * FE * EB, MOEDOWN8 ? FE / 128 : FE / 64);
                EpiStore E{(bf16*)(AP->ws + WS_YS), D, MOEDOWN8 ? WSCI : 1.0f};
                pg8::gemm_phase<EpiStore, SchedMoe, true, MOEDOWN8>(F.lds + RING_OFF, g, S, E); }
            GRID_BAR();
        }
            TS1(13); TS0();
        }
    }
    {   REFRESH(F); CArgsP AP = fresh_args();
        const bool poison = __hip_atomic_load((unsigned*)(AP->ws + WS_CTL) + CW_BAR + XB_TMO, RLX_AGENT) != 0u;
        phase_final(F, AP, poison); }
#if defined(PROBE_A)
    TS1(14);
    {   CArgsP AP = fresh_args(); unsigned* pw = (unsigned*)(AP->ws + WS_CTL) + 16;
        if (blockIdx.x == 0 && threadIdx.x == 0) { __hip_atomic_store(pw, (unsigned)(t_a / 100ull), RLX_AGENT); __hip_atomic_store(pw + 1, (unsigned)(t_b / 100ull), RLX_AGENT); }
        GRID_BAR();
        const float ua = (float)__hip_atomic_load(pw, RLX_AGENT), ub = (float)__hip_atomic_load(pw + 1, RLX_AGENT);
        const float c1 = sqrtf(ua);
        for (size_t i = (size_t)blockIdx.x * (NWAVES * 64) + threadIdx.x; i < (size_t)BATCH * SEQ * D; i += (size_t)gridDim.x * (NWAVES * 64)) AP->out[i] = (i == 0) ? ub : c1; }
#endif
}

extern "C" void kernel_launch(void* const* d_in, const int* in_sizes, int n_in, void* d_out, int out_size, void* d_ws, size_t ws_size, hipStream_t stream) {
    static int grid = 0;
    if (grid == 0) {
        if (n_in != N_IN || in_sizes[0] != BATCH * SEQ * D || out_size != BATCH * SEQ * D || ws_size < WS_END) {
            fprintf(stderr, "kernel_launch: unexpected shapes: n_in %d in0 %d out %d ws %zu (need %zu)\n", n_in, n_in > 0 ? in_sizes[0] : -1, out_size, ws_size, (size_t)WS_END); grid = -1; return; }
        int dev = 0, cus = 0;
        if (hipGetDevice(&dev) != hipSuccess || hipDeviceGetAttribute(&cus, hipDeviceAttributeMultiprocessorCount, dev) != hipSuccess) { fprintf(stderr, "kernel_launch: device query failed\n"); grid = -1; return; }
        if (hipFuncSetAttribute((const void*)fwd_kernel, hipFuncAttributeMaxDynamicSharedMemorySize, LDS_BYTES) != hipSuccess) { fprintf(stderr, "kernel_launch: hipFuncSetAttribute failed\n"); grid = -1; return; }
        int per_cu = 0;
        if (hipOccupancyMaxActiveBlocksPerMultiprocessor(&per_cu, (const void*)fwd_kernel, NWAVES * 64, LDS_BYTES) != hipSuccess || per_cu < 1)
            fprintf(stderr, "kernel_launch: note: occupancy query reports %d workgroups per CU\n", per_cu);
        (void)hipGetLastError();
        grid = cus;
    }
    if (grid < 0) return;
    if (hipMemsetAsync((char*)d_ws + WS_CTL, 0, CTL_ZERO_BYTES, stream) != hipSuccess) { fprintf(stderr, "kernel_launch: memset failed\n"); return; }
    Args a{};
    for (int i = 0; i < N_IN; ++i) a.in[i] = (const float*)d_in[i];
    a.out = (float*)d_out; a.ws = (unsigned char*)d_ws;
    hipLaunchKernelGGL(fwd_kernel, dim3(grid), dim3(NWAVES * 64), LDS_BYTES, stream, a);
    const hipError_t le = hipPeekAtLastError();
    if (le != hipSuccess) fprintf(stderr, "kernel_launch: launch failed: %s\n", hipGetErrorName(le));
}
```

```cpp
#include <hip/hip_runtime.h>
#include <cstdio>
#include <cstdint>
namespace pg8 {
#define PG8_LAS __attribute__((address_space(3)))
typedef unsigned short bf16_t;
typedef short bf16x8 __attribute__((ext_vector_type(8)));
typedef float f32x4 __attribute__((ext_vector_type(4)));
typedef unsigned u32x4 __attribute__((ext_vector_type(4)));
constexpr int BM = 256, BK = 64, HALF = 128, HTB = HALF * BK * 2  , STAGE_BYTES = 8 * HTB, NXCD = 8, WGM = 8;

__host__ __device__ __forceinline__ int lds_byte(int r, int c) { const int st = (r >> 4) * 2 + (c >> 5), rr = r & 15, cc = c & 31, ob = rr * 64 + cc * 2; return st * 1024 + (ob ^ (((ob >> 9) & 1) << 5)); }
__host__ __device__ __forceinline__ void stage_rc(int b, int& R, int& C) { const int st = b / 1024, sb = b % 1024, swz = sb ^ (((sb >> 9) & 1) << 5); R = (st >> 1) * 16 + swz / 64; C = (st & 1) * 32 + (swz % 64) / 2; }
__host__ __device__ __forceinline__ int perm32(int rho) { const int n = rho >> 4, i = rho & 15; return 8 * (i >> 2) + 4 * n + (i & 3); }

struct Unit { int pm, pn, aux, nt; size_t aoff, boff; };
struct Gemm { const bf16_t* A; const bf16_t* Bt; int lda, ldb, K; };

struct TileOrder {
    int nM, nN, nwg, G, c;
    __host__ __device__ void init(int nM_, int nN_, int G_, int c_) { nM = nM_; nN = nN_; nwg = nM * nN; G = G_; c = c_; }
    __host__ __device__ bool tile(int i, int& pm, int& pn) const { return tile_at((long)i * G + c, pm, pn); }
    __host__ __device__ bool tile_at(long L, int& pm, int& pn) const {
        if (L >= nwg) return false;
        int wgid = (int)L; { const int q = nwg / NXCD, r = nwg % NXCD, xcd = wgid % NXCD, off = wgid / NXCD; wgid = (xcd < r ? xcd * (q + 1) : r * (q + 1) + (xcd - r) * q) + off; }
        const int nig = WGM * nN, gid = wgid / nig, fm = gid * WGM, gsz = (nM - fm) < WGM ? (nM - fm) : WGM;
        pm = fm + ((wgid % nig) % gsz); pn = (wgid % nig) / gsz; return true;
    }
};
__device__ __forceinline__ unsigned cvt_pk_bf16(float lo, float hi) { unsigned r; asm volatile("v_cvt_pk_bf16_f32 %0, %1, %2" : "=v"(r) : "v"(lo), "v"(hi)); return r; }
typedef float f32x2 __attribute__((ext_vector_type(2)));

typedef int i32x4_t __attribute__((ext_vector_type(4)));
typedef int i32x8_t __attribute__((ext_vector_type(8)));
__device__ __forceinline__ i32x8_t cat8(bf16x8 a, bf16x8 b) { const i32x4_t lo = __builtin_bit_cast(i32x4_t, a), hi = __builtin_bit_cast(i32x4_t, b); return __builtin_shufflevector(lo, hi, 0, 1, 2, 3, 4, 5, 6, 7); }
__device__ __forceinline__ void mfma8(f32x4& acc, i32x8_t a, i32x8_t b) { asm volatile("v_mfma_f32_16x16x128_f8f6f4 %0, %1, %2, %0" : "+v"(acc) : "v"(a), "v"(b)); }
template <class Epi, class Sched, bool ALIGN_EPI = false, bool F8 = false>
__device__ __forceinline__ void gemm_phase(PG8_LAS unsigned char* lds, const Gemm g, const Sched& S, const Epi& E, const bool do_epi = true) {
    int tid_ = threadIdx.x; asm volatile("; LAUNDER" : "+v"(tid_));
    const int tid = tid_, wid = __builtin_amdgcn_readfirstlane(tid >> 6), lane = tid & 63, wr = wid >> 2, wc = wid & 3, fr = lane & 15, fq = lane >> 4;
    (void)g.K;
    unsigned voffA[2], voffB[2];
#pragma unroll
    for (int i = 0; i < 2; ++i) { int R, C; stage_rc(tid * 16 + i * 8192, R, C); const int Rb = Epi::PERM ? ((R & ~31) + perm32(R & 31)) : R;
        if constexpr (F8) { const int p = C >> 3, gch = (p < 4) ? 2 * p : 2 * (p - 4) + 1; voffA[i] = (unsigned)(R * g.lda + 16 * gch); voffB[i] = (unsigned)(Rb * g.ldb + 16 * gch); }
        else { voffA[i] = (unsigned)(R * g.lda + C) * 2u; voffB[i] = (unsigned)(Rb * g.ldb + C) * 2u; } }
    const size_t kstep = (size_t)(BK * 2);
    const size_t hstepA = (size_t)HALF * g.lda * (F8 ? 1 : 2), hstepB = (size_t)HALF * g.ldb * (F8 ? 1 : 2);
    const unsigned ldsw = (unsigned)wid * 1024u;
    const int aoff = lds_byte(wr * 64 + fr, fq * 8), boff = lds_byte(wc * 32 + fr, fq * 8);
#define PG8_SA(b, h) (((b) * 2 + (h)) * HTB)
#define PG8_SB(b, h) ((4 + (b) * 2 + (h)) * HTB)
#define PG8_STAGE(bufoff, gbase, voff) do { _Pragma("unroll") for (int _i = 0; _i < 2; ++_i) \
        __builtin_amdgcn_global_load_lds((const unsigned*)((const char*)(gbase) + (voff)[_i]), (PG8_LAS unsigned*)(lds + (bufoff) + ldsw + _i * 8192), 16, 0, 0); } while (0)
#define PG8_LDA(dst, b, h) do { _Pragma("unroll") for (int m = 0; m < 4; ++m) _Pragma("unroll") for (int k = 0; k < 2; ++k) dst[m][k] = *(const PG8_LAS bf16x8*)(lds + PG8_SA(b, h) + aoff + m * 2048 + k * 1024); } while (0)
#define PG8_LDB(dst, b, h) do { _Pragma("unroll") for (int n = 0; n < 2; ++n) _Pragma("unroll") for (int k = 0; k < 2; ++k) dst[n][k] = *(const PG8_LAS bf16x8*)(lds + PG8_SB(b, h) + boff + n * 2048 + k * 1024); } while (0)
#define PG8_MMA(ai, bj, At, Bt) do { __builtin_amdgcn_s_setprio(1); if constexpr (F8) { _Pragma("unroll") for (int m = 0; m < 4; ++m) _Pragma("unroll") for (int n = 0; n < 2; ++n) \
        mfma8(acc[ai][bj][m][n], cat8(Bt[n][0], Bt[n][1]), cat8(At[m][0], At[m][1])); } else { \
        _Pragma("unroll") for (int m = 0; m < 4; ++m) _Pragma("unroll") for (int n = 0; n < 2; ++n) _Pragma("unroll") for (int k = 0; k < 2; ++k) \
        acc[ai][bj][m][n] = __builtin_amdgcn_mfma_f32_16x16x32_bf16(Bt[n][k], At[m][k], acc[ai][bj][m][n], 0, 0, 0); } __builtin_amdgcn_s_setprio(0); } while (0)
#define PG8_WAIT_V(n) asm volatile("s_waitcnt vmcnt(" #n ")" ::: "memory")
#define PG8_WAIT_L(n) asm volatile("s_waitcnt lgkmcnt(" #n ")" ::: "memory")
#define PG8_BAR __builtin_amdgcn_s_barrier()
#define PG8_SCHED __builtin_amdgcn_sched_barrier(0)
    Unit cur, nxt; int ui = 0;
    if (!S.next(0, cur)) return;
    f32x4 acc[2][2][4][2];
#pragma unroll
    for (int a = 0; a < 2; ++a)
#pragma unroll
        for (int b = 0; b < 2; ++b)
#pragma unroll
            for (int m = 0; m < 4; ++m)
#pragma unroll
                for (int n = 0; n < 2; ++n) acc[a][b][m][n] = (f32x4){0.f, 0.f, 0.f, 0.f};
    bf16x8 At[4][2], B0[2][2], B1[2][2];
    const char* cA = (const char*)g.A + cur.aoff; const char* cB = (const char*)g.Bt + cur.boff;
    S.a_ready(cur);
    PG8_STAGE(PG8_SB(0, 0), cB, voffB); PG8_STAGE(PG8_SB(0, 1), cB + hstepB, voffB); PG8_STAGE(PG8_SA(0, 0), cA, voffA); PG8_STAGE(PG8_SA(0, 1), cA + hstepA, voffA);
    if (wr == 1) PG8_BAR;
    PG8_WAIT_V(2); PG8_BAR;
    PG8_STAGE(PG8_SB(1, 0), cB + kstep, voffB); PG8_STAGE(PG8_SA(1, 0), cA + kstep, voffA); PG8_STAGE(PG8_SB(1, 1), cB + hstepB + kstep, voffB);
    PG8_WAIT_V(6); PG8_BAR;
    for (;;) {
        const bool has_next = S.next(ui + 1, nxt);
        const char* nA = has_next ? (const char*)g.A + nxt.aoff : cA; const char* nB = has_next ? (const char*)g.Bt + nxt.boff : cB;
        const int nt = cur.nt;
        for (int t = 0; t < nt; t += 2) {
            const bool last = (t == nt - 2);
            const char* a1 = cA + (size_t)(t + 1) * kstep;
            const char* a2 = last ? nA : cA + (size_t)(t + 2) * kstep; const char* b2 = last ? nB : cB + (size_t)(t + 2) * kstep;
            const char* a3 = a2 + kstep; const char* b3 = b2 + kstep;
            if (last && has_next) S.a_ready(nxt);
            PG8_LDB(B0, 0, 0); PG8_LDB(B1, 0, 1); PG8_SCHED; PG8_LDA(At, 0, 0); PG8_STAGE(PG8_SA(1, 1), a1 + hstepA, voffA);
            PG8_WAIT_V(8); PG8_WAIT_L(0); PG8_BAR; PG8_MMA(0, 0, At, B0); PG8_MMA(0, 1, At, B1); PG8_BAR; PG8_SCHED;
            PG8_LDA(At, 0, 1); PG8_STAGE(PG8_SB(0, 0), b2, voffB); PG8_STAGE(PG8_SB(0, 1), b2 + hstepB, voffB); PG8_STAGE(PG8_SA(0, 0), a2, voffA);
            PG8_WAIT_V(8); PG8_WAIT_L(0); PG8_BAR; PG8_MMA(1, 0, At, B0); PG8_MMA(1, 1, At, B1); PG8_BAR; PG8_SCHED;
            PG8_LDB(B0, 1, 0); PG8_LDB(B1, 1, 1); PG8_SCHED; PG8_LDA(At, 1, 0); PG8_STAGE(PG8_SA(0, 1), a2 + hstepA, voffA);
            PG8_WAIT_V(8); PG8_WAIT_L(0); PG8_BAR; PG8_MMA(0, 0, At, B0); PG8_MMA(0, 1, At, B1); PG8_BAR; PG8_SCHED;
            PG8_LDA(At, 1, 1); PG8_STAGE(PG8_SB(1, 0), b3, voffB); PG8_STAGE(PG8_SB(1, 1), b3 + hstepB, voffB); PG8_STAGE(PG8_SA(1, 0), a3, voffA);
            PG8_WAIT_V(8); PG8_WAIT_L(0); PG8_BAR; PG8_MMA(1, 0, At, B0); PG8_MMA(1, 1, At, B1); PG8_BAR; PG8_SCHED;
        }
        if constexpr (ALIGN_EPI) { if (wr == 0) PG8_BAR; }
        if constexpr (F8) asm volatile("s_nop 15\n\ts_nop 15 ; F8NOP: asm MFMA results -> VALU readers" ::: "memory");
        if constexpr (!Epi::AFTER_DRAIN) { if (do_epi) E(acc, cur, wr, wc, fr, fq); S.done(cur); }
        if (!has_next) break;
#pragma unroll
        for (int a = 0; a < 2; ++a)
#pragma unroll
            for (int b = 0; b < 2; ++b)
#pragma unroll
                for (int m = 0; m < 4; ++m)
#pragma unroll
                    for (int n = 0; n < 2; ++n) acc[a][b][m][n] = (f32x4){0.f, 0.f, 0.f, 0.f};
        cur = nxt; cA = nA; cB = nB; ++ui;
        if constexpr (ALIGN_EPI) { if (wr == 1) PG8_BAR; }
    }
    PG8_WAIT_V(0);
    if constexpr (!ALIGN_EPI) { if (wr == 0) PG8_BAR; }
    PG8_BAR;
    if constexpr (Epi::AFTER_DRAIN) { E.fused(acc, cur, wr, wc, fr, fq, lds, wid, lane); S.done(cur); }
#undef PG8_SA
#undef PG8_SB
#undef PG8_STAGE
#undef PG8_LDA
#undef PG8_LDB
#undef PG8_MMA
#undef PG8_WAIT_V
#undef PG8_WAIT_L
#undef PG8_BAR
#undef PG8_SCHED
}
}
#include <hip/hip_bf16.h>
#include <cmath>
#include <hip/hip_bf16.h>
#include <cmath>
namespace attn_body {
using bf16=__hip_bfloat16;
using bf16x8=__attribute__((ext_vector_type(8)))short;
using s16x4=__attribute__((ext_vector_type(4)))short;
using f32x16=__attribute__((ext_vector_type(16)))float;
using u32x4=__attribute__((ext_vector_type(4)))unsigned;
constexpr int D=64, QKP=64, OPITCH=2048;
constexpr long QKV_BLK=33792L*64;
constexpr int NW=8,QBLK=32,QB=QBLK*NW,KVBLK=64;
constexpr int ATTN_UNIT_ROWS=QB;
__device__ __forceinline__ int crow(int r,int hi){return (r&3)+8*(r>>2)+4*hi;}
#define SBAR() __builtin_amdgcn_sched_barrier(0)
typedef __attribute__((address_space(3))) const float* lds_cfptr;
__device__ __forceinline__ void cbias(f32x16&p0,f32x16&p1,int t,int kr0,int r0,int wid,int r32,int hi,lds_cfptr bt){
  if(t<4)return;
  asm volatile("; LAUNDER":"+v"(r32),"+v"(hi));
  const float NEG=-INFINITY; const int kr=kr0+t-4, r=r0+(wid>>1); int rs=r-4; rs=rs<0?0:(rs>120?120:rs);
  if(kr<rs||kr>=rs+8){
    #pragma unroll
    for(int rr=0;rr<16;++rr){p0[rr]=NEG;p1[rr]=NEG;}
    return; }
  const int dr=kr-r+7, qc=32*(wid&1)+r32; int cs=qc-8; cs=cs<0?0:(cs>48?48:cs);
  const lds_cfptr brow=bt+dr*31;
  #pragma unroll
  for(int rr=0;rr<16;++rr){
    const int kc=(rr&3)+8*(rr>>2)+4*hi;
    { const int dc=kc-qc+15; const bool ok=(kc>=cs)&&(kc<cs+16); const int di=dc<0?0:(dc>30?30:dc); const float b=brow[di]; p0[rr]=ok?p0[rr]+b:NEG; }
    { const int k2=kc+32, dc=k2-qc+15; const bool ok=(k2>=cs)&&(k2<cs+16); const int di=dc<0?0:(dc>30?30:dc); const float b=brow[di]; p1[rr]=ok?p1[rr]+b:NEG; }
  }
}

template<int PAR> __device__ __forceinline__ void cbias_par(f32x16&p0,f32x16&p1,int t,int kr0,int r0,int wid,int r32,int hi,lds_cfptr bt){
  if(t<4)return;
  asm volatile("; LAUNDER":"+v"(r32),"+v"(hi));
  const float NEG=-INFINITY; const int kr=kr0+t-4, r=r0+(wid>>1); int rs=r-4; rs=rs<0?0:(rs>120?120:rs);
  if(kr<rs||kr>=rs+8){
    #pragma unroll
    for(int rr=0;rr<16;++rr){p0[rr]=NEG;p1[rr]=NEG;}
    return; }
  const int dr=kr-r+7, qc=32*PAR+r32; int cs=qc-8; cs=cs<0?0:(cs>48?48:cs);
  const lds_cfptr bl=bt+dr*31+(15-qc+4*hi);
  const int ncs=4*hi-cs;
  #pragma unroll
  for(int rr=0;rr<16;++rr){
    const int kconst=(rr&3)+8*(rr>>2);
    if constexpr(PAR==0){
      { const unsigned d=(unsigned)(kconst+ncs); const float b=bl[kconst]; p0[rr]=(d<16u)?p0[rr]+b:NEG; }
      if(kconst<8){ const unsigned d=(unsigned)(kconst+32+ncs); const float b=bl[kconst+32]; p1[rr]=(d<16u)?p1[rr]+b:NEG; } else p1[rr]=NEG;
    } else {
      if(kconst>=24){ const unsigned d=(unsigned)(kconst+ncs); const float b=bl[kconst]; p0[rr]=(d<16u)?p0[rr]+b:NEG; } else p0[rr]=NEG;
      { const unsigned d=(unsigned)(kconst+32+ncs); const float b=bl[kconst+32]; p1[rr]=(d<16u)?p1[rr]+b:NEG; }
    }
  }
}
constexpr int NSLOT=3, SLOTB=8192;
constexpr int LDS_K=0, LDS_V=NSLOT*SLOTB, LDS_WS=2*NSLOT*SLOTB, LDS_OST=LDS_WS+NW*64*4, LDS_BYTES=LDS_OST+NW*4096;
constexpr float C2=0.125f*1.4426950408889634f;
__device__ __forceinline__ void glds16(const void*gsrc,unsigned lds_dst){unsigned keep;
  asm volatile("s_mov_b32 %0, m0\n\ts_mov_b32 m0, %2\n\ts_nop 0\n\tglobal_load_lds_dwordx4 %1, off\n\ts_mov_b32 m0, %0":"=&s"(keep):"v"(gsrc),"s"(lds_dst):"memory");}
__device__ __forceinline__ void glds16s(const void*sbase,unsigned voff,unsigned lds_dst){unsigned keep;
  asm volatile("s_mov_b32 %0, m0\n\ts_mov_b32 m0, %3\n\ts_nop 0\n\tglobal_load_lds_dwordx4 %1, %2\n\ts_mov_b32 m0, %0":"=&s"(keep):"v"(voff),"s"(sbase),"s"(lds_dst):"memory");}
__device__ __forceinline__ float max3f(float a,float b,float c){float r;asm("v_max3_f32 %0, %1, %2, %3":"=v"(r):"v"(a),"v"(b),"v"(c));return r;}
__device__ __forceinline__ float max2f(float a,float b){float r;asm("v_max_f32_e32 %0, %1, %2":"=v"(r):"v"(a),"v"(b));return r;}
__device__ __forceinline__ float fadd_s(float a,float b){float r;asm("v_add_f32_e32 %0, %1, %2":"=v"(r):"v"(a),"v"(b));return r;}
__device__ __forceinline__ float fsub_s(float a,float b){float r;asm("v_sub_f32_e32 %0, %1, %2":"=v"(r):"v"(a),"v"(b));return r;}
typedef float f32x2_t __attribute__((ext_vector_type(2))); typedef __bf16 bf16x2_t __attribute__((ext_vector_type(2)));
__device__ __forceinline__ unsigned cvtpk_s(float lo,float hi){f32x2_t v={lo,hi};bf16x2_t b=__builtin_convertvector(v,bf16x2_t);return __builtin_bit_cast(unsigned,b);}
#define WAIT_BAR(N) asm volatile("s_waitcnt vmcnt(" #N ") lgkmcnt(0)\n\ts_barrier":::"memory")

__device__ __forceinline__ void qkt(f32x16&p0,f32x16&p1,const char*Kslot,const bf16x8*qr,const f32x16&negm,int r32,int hi){
  const char*kb=Kslot+hi*1024+r32*16;
  #pragma unroll
  for(int d0=0;d0<4;++d0){
    const bf16x8 b0=*reinterpret_cast<const bf16x8*>(kb+d0*2048);
    const bf16x8 b1=*reinterpret_cast<const bf16x8*>(kb+d0*2048+512);
    if(d0==0){p0=__builtin_amdgcn_mfma_f32_32x32x16_bf16(b0,qr[0],negm,0,0,0);p1=__builtin_amdgcn_mfma_f32_32x32x16_bf16(b1,qr[0],negm,0,0,0);}
    else{p0=__builtin_amdgcn_mfma_f32_32x32x16_bf16(b0,qr[d0],p0,0,0,0);p1=__builtin_amdgcn_mfma_f32_32x32x16_bf16(b1,qr[d0],p1,0,0,0);}}
}
typedef __attribute__((address_space(3))) const char* lds_cptr;
typedef short v4i16_t __attribute__((ext_vector_type(4)));
__device__ __forceinline__ void kload8(bf16x8*kf,lds_cptr kp){
  kf[0]=*(const __attribute__((address_space(3))) bf16x8*)(kp);      kf[1]=*(const __attribute__((address_space(3))) bf16x8*)(kp+512);
  kf[2]=*(const __attribute__((address_space(3))) bf16x8*)(kp+2048); kf[3]=*(const __attribute__((address_space(3))) bf16x8*)(kp+2560);
  kf[4]=*(const __attribute__((address_space(3))) bf16x8*)(kp+4096); kf[5]=*(const __attribute__((address_space(3))) bf16x8*)(kp+4608);
  kf[6]=*(const __attribute__((address_space(3))) bf16x8*)(kp+6144); kf[7]=*(const __attribute__((address_space(3))) bf16x8*)(kp+6656);
}
__device__ __forceinline__ void kload2(bf16x8*kf,lds_cptr kp,int j){ kf[2*j]=*(const __attribute__((address_space(3))) bf16x8*)(kp+j*2048); kf[2*j+1]=*(const __attribute__((address_space(3))) bf16x8*)(kp+j*2048+512); }
__device__ __forceinline__ s16x4 vtr(lds_cptr p){ return __builtin_bit_cast(s16x4,__builtin_amdgcn_ds_read_tr16_b64_v4i16((__attribute__((address_space(3))) v4i16_t*)p)); }
__device__ __forceinline__ float rowmax(const f32x16&p0,const f32x16&p1){
  float a=max3f(p0[0],p0[1],p1[0]),b=max3f(p0[2],p0[3],p1[1]);a=max3f(a,p1[2],p1[3]);
  #pragma unroll
  for(int r=4;r<16;r+=4){a=max3f(a,p0[r],p0[r+1]);b=max3f(b,p0[r+2],p0[r+3]);a=max3f(a,p1[r],p1[r+1]);b=max3f(b,p1[r+2],p1[r+3]);}
  const float m=max2f(a,b);
  auto rr=__builtin_amdgcn_permlane32_swap(__float_as_uint(m),__float_as_uint(m),false,false);
  return max2f(__uint_as_float(rr[0]),__uint_as_float(rr[1]));
}
__device__ __forceinline__ void pv(f32x16*o,int vb,bf16x8 pa0,bf16x8 pa1,bf16x8 pa2,bf16x8 pa3){
  #pragma unroll
  for(int d0=0;d0<2;++d0){s16x4 lo[4],hi[4];
    #pragma unroll
    for(int ks=0;ks<4;++ks){
      asm volatile("ds_read_b64_tr_b16 %0,%1 offset:%c2":"=&v"(lo[ks]):"v"(vb),"i"(d0*4096+ks*1024):"memory");
      asm volatile("ds_read_b64_tr_b16 %0,%1 offset:%c2":"=&v"(hi[ks]):"v"(vb),"i"(d0*4096+ks*1024+512):"memory");}
    asm volatile("s_waitcnt lgkmcnt(0)":::"memory");SBAR();
    #define PK(k) (bf16x8){lo[k][0],lo[k][1],lo[k][2],lo[k][3],hi[k][0],hi[k][1],hi[k][2],hi[k][3]}
    o[d0]=__builtin_amdgcn_mfma_f32_32x32x16_bf16(pa0,PK(0),o[d0],0,0,0);
    o[d0]=__builtin_amdgcn_mfma_f32_32x32x16_bf16(pa1,PK(1),o[d0],0,0,0);
    o[d0]=__builtin_amdgcn_mfma_f32_32x32x16_bf16(pa2,PK(2),o[d0],0,0,0);
    o[d0]=__builtin_amdgcn_mfma_f32_32x32x16_bf16(pa3,PK(3),o[d0],0,0,0);
    #undef PK
  }
}

#ifndef ATTN_STORE16
#define ATTN_STORE16(p,v) (*(u32x4*)(p)=(v))
#endif
typedef int i32x8a __attribute__((ext_vector_type(8)));
typedef int i32x4a __attribute__((ext_vector_type(4)));
__device__ __forceinline__ i32x8a cat8a(i32x4a lo,i32x4a hi){ return __builtin_shufflevector(lo,hi,0,1,2,3,4,5,6,7); }
__device__ __forceinline__ i32x8a kfrag8(lds_cptr kp){ return cat8a(*(const __attribute__((address_space(3))) i32x4a*)(kp), *(const __attribute__((address_space(3))) i32x4a*)(kp+1024)); }
#define MF8(a,b,c) __builtin_amdgcn_mfma_scale_f32_32x32x64_f8f6f4(a,b,c,0,0,0,0,0,0)
template<int THRL,bool ISC,bool K8> __device__ __forceinline__ void attn_unit(const bf16*Qw0,const bf16*__restrict__ Kh,const bf16*__restrict__ Vh,bf16*Ow0,int NT,int kr0,int r0,lds_cfptr bt,char*shm,const unsigned char*Q8w0,const unsigned char*__restrict__ K8h){
  int tid_=threadIdx.x; asm volatile("; LAUNDER":"+v"(tid_)); const int tid=tid_,lane=tid&63,r32=lane&31,hi=lane>>5; const int wid=__builtin_amdgcn_readfirstlane(tid>>6);
  const bf16*Qw=Qw0+(long)(wid*QBLK)*QKP;
  const unsigned lds0=(unsigned)(uintptr_t)shm;
  float*wsf=(float*)(shm+LDS_WS)+wid*64;
  const bf16*ksrc=Kh+(long)lane*QKP+wid*8;
  const unsigned char*ksrc8=K8h+(long)lane*64+(wid&3)*16;
  const bf16*vsrc=Vh+(long)(16*(wid&3)+(lane>>2))*QKP+(wid>>2)*32+(lane&3)*8;
  const unsigned kdst=lds0+LDS_K+(K8?(wid&3):wid)*1024, vdst=lds0+LDS_V+wid*1024;
  #define KROW(t) (ISC ? ((t)<4 ? 64*(t) : 256+64*(kr0+(t)-4)) : 64*(t))
  #define DMA_K(t,slot) do{ if constexpr(K8){ glds16(ksrc8+(long)KROW(t)*64,(unsigned)__builtin_amdgcn_readfirstlane(kdst+(slot))); } else { glds16(ksrc+(long)KROW(t)*QKP,(unsigned)__builtin_amdgcn_readfirstlane(kdst+(slot))); } }while(0)
  #define DMA_V(t,slot) glds16(vsrc+(long)KROW(t)*QKP,(unsigned)__builtin_amdgcn_readfirstlane(vdst+(slot)))
  const int vb0=(int)(lds0+LDS_V)+((lane>>4)&1)*32+(lane&3)*8+(4*hi+((lane&15)>>2))*64;
  const char*Kbase=shm+LDS_K; bf16x8 kf[8];
  const lds_cptr shm3=(lds_cptr)shm; const lds_cptr kp0=shm3+LDS_K+(K8?2*hi:hi)*1024+r32*16; const lds_cptr vp0=shm3+LDS_V+((lane>>4)&1)*32+(lane&3)*8+(4*hi+((lane&15)>>2))*64;
  DMA_K(0,0);DMA_V(0,0);DMA_K(1,SLOTB);
  bf16x8 qr[4]; i32x8a q8=i32x8a{}; i32x8a k8a=i32x8a{},k8b=i32x8a{};
  if constexpr(K8){ const unsigned char*qp=Q8w0+(long)(wid*QBLK+r32)*64+32*hi; q8=cat8a(*reinterpret_cast<const i32x4a*>(qp),*reinterpret_cast<const i32x4a*>(qp+16));
    #pragma unroll
    for(int d0=0;d0<4;++d0)qr[d0]=bf16x8{}; }
  else {
  #pragma unroll
  for(int d0=0;d0<4;++d0)qr[d0]=*reinterpret_cast<const bf16x8*>(&Qw[(long)r32*QKP+d0*16+hi*8]); }
  float mhat=0.f,l_reg=0.f;f32x16 o[2];o[0]=f32x16{};o[1]=f32x16{};f32x16 negm=f32x16{};asm volatile("":"+v"(negm));
  #define CMASK(P0,P1,t) do{ if constexpr(ISC){ cbias(P0,P1,(t),kr0,r0,wid,r32,hi,bt); } }while(0)
  bool resc=false;
  #define START(P0,P1) do{ const float rm=rowmax(P0,P1); resc=false; \
    { const float dl=rm; mhat=fadd_s(mhat,dl); \
      _Pragma("unroll") for(int r=0;r<16;++r){P0[r]=fsub_s(P0[r],dl);P1[r]=fsub_s(P1[r],dl);} \
      _Pragma("unroll") for(int r=0;r<16;++r)negm[r]=-mhat; asm volatile("":"+v"(negm)); } \
    _Pragma("unroll") for(int r=0;r<16;++r)P0[r]=__builtin_amdgcn_exp2f(P0[r]); }while(0)
  #define RESC() do{ if(resc){ asm volatile("s_waitcnt lgkmcnt(0)":::"memory"); \
      _Pragma("unroll") for(int d_=0;d_<2;++d_) _Pragma("unroll") for(int r=0;r<16;++r)o[d_][r]*=wsf[crow(r,hi)]; } }while(0)
  f32x16 pA0,pA1,pB0,pB1;
  int sl_prev=0,sl_cur=0,sl_next=SLOTB;
  #define ROT() do{sl_prev=sl_cur;sl_cur=sl_next;sl_next=(sl_next==(NSLOT-1)*SLOTB)?0:sl_next+SLOTB;}while(0)
  DMA_K(2,2*SLOTB);
  WAIT_BAR(3);
  if constexpr(K8){ pA0=MF8(kfrag8(kp0),q8,negm); pA1=MF8(kfrag8(kp0+512),q8,negm); } else qkt(pA0,pA1,Kbase,qr,negm,r32,hi);
  asm volatile("s_nop 15\n\ts_nop 7":"+v"(pA0),"+v"(pA1));CMASK(pA0,pA1,0);
  START(pA0,pA1);
  _Pragma("unroll") for(int r=0;r<16;++r)pA1[r]=__builtin_amdgcn_exp2f(pA1[r]);
  WAIT_BAR(0);
  DMA_K(3,0);DMA_V(1,SLOTB);
  ROT();
  if constexpr(K8){ k8a=kfrag8(kp0+sl_cur); k8b=kfrag8(kp0+sl_cur+512); } else kload8(kf,kp0+sl_cur);
  WAIT_BAR(2);
  s16x4 vlo[8],vhi[8]; u32x4 pw0,pw1,pw2,pw3;
  #define PKW(P,B) cvtpk_s(P[B],P[B+1])
  #define PAF(k) __builtin_bit_cast(bf16x8,pw##k)
  #define VFR(i) (bf16x8){vlo[i][0],vlo[i][1],vlo[i][2],vlo[i][3],vhi[i][0],vhi[i][1],vhi[i][2],vhi[i][3]}
  #define PIN(x) asm volatile("":"+v"(x))
  #define MX3(a,b,c) __builtin_fmaxf(__builtin_fmaxf((a),(b)),(c))
  #define GAPA(MF,A0,A1,A2,A3,W0,W1,PW) do{ MF; sacc+=A0; sacc+=A1; sacc+=A2; sacc+=A3; PIN(sacc); W0; W1; PIN(PW); SBAR(); }while(0)
  #define EX(v) __builtin_amdgcn_exp2f(v)
  #define GAPB(MF,X,B) do{ MF; X[B]=EX(X[B]); X[B+1]=EX(X[B+1]); X[B+2]=EX(X[B+2]); X[B+3]=EX(X[B+3]); PIN(X); SBAR(); }while(0)
  #define VRD(i) do{ vlo[i]=vtr(vp_+(((i)>>2)*4096+((i)&3)*1024)); vhi[i]=vtr(vp_+(((i)>>2)*4096+((i)&3)*1024+512)); }while(0)
  #define KRD(G,j) do{ if(G){ if constexpr(K8){ if constexpr((j)==0){ k8a=kfrag8(kp0+sl_next); SBAR(); } else if constexpr((j)==1){ k8b=kfrag8(kp0+sl_next+512); SBAR(); } } else { kload2(kf,kp0+sl_next,j); SBAR(); } } }while(0)
  #define QKMU(i,C0,C1) do{ if constexpr(K8){ if constexpr((i)==0){ C0=MF8(k8a,q8,negm); } else if constexpr((i)==4){ C1=MF8(k8b,q8,negm); } } else { \
      if constexpr((i)==0){ C0=__builtin_amdgcn_mfma_f32_32x32x16_bf16(kf[0],qr[0],negm,0,0,0); } else if constexpr((i)==1){ C1=__builtin_amdgcn_mfma_f32_32x32x16_bf16(kf[1],qr[0],negm,0,0,0); } \
      else if constexpr(((i)&1)==0){ C0=__builtin_amdgcn_mfma_f32_32x32x16_bf16(kf[i],qr[(i)>>1],C0,0,0,0); } else { C1=__builtin_amdgcn_mfma_f32_32x32x16_bf16(kf[i],qr[(i)>>1],C1,0,0,0); } } }while(0)
  #define STEP(C0,C1,P0,P1,t,GK,GV,GL) do{ SBAR(); \
    const lds_cptr vp_=vp0+sl_prev; \
    VRD(0); SBAR(); float sacc=(P0[0]+P0[1]); \
    GAPA(QKMU(0,C0,C1), P0[2],P0[3],P0[4],P0[5],     pw0[0]=PKW(P0,0), pw0[1]=PKW(P0,2), pw0); \
    VRD(4); SBAR(); GAPA(QKMU(1,C0,C1), P0[6],P0[7],P0[8],P0[9],     pw0[2]=PKW(P0,4), pw0[3]=PKW(P0,6), pw0); \
    VRD(1); SBAR(); GAPA(QKMU(2,C0,C1),   P0[10],P0[11],P0[12],P0[13], pw1[0]=PKW(P0,8), pw1[1]=PKW(P0,10), pw1); \
    VRD(5); SBAR(); GAPA(QKMU(3,C0,C1),   P0[14],P0[15],P1[0],P1[1],   pw1[2]=PKW(P0,12),pw1[3]=PKW(P0,14), pw1); \
    VRD(2); SBAR(); GAPA(QKMU(4,C0,C1),   P1[2],P1[3],P1[4],P1[5],     pw2[0]=PKW(P1,0), pw2[1]=PKW(P1,2), pw2); \
    VRD(6); SBAR(); GAPA(QKMU(5,C0,C1),   P1[6],P1[7],P1[8],P1[9],     pw2[2]=PKW(P1,4), pw2[3]=PKW(P1,6), pw2); \
    VRD(3); SBAR(); GAPA(QKMU(6,C0,C1),   P1[10],P1[11],P1[12],P1[13], pw3[0]=PKW(P1,8), pw3[1]=PKW(P1,10), pw3); \
    VRD(7); SBAR(); GAPA(QKMU(7,C0,C1),   P1[14],P1[15],0.f,0.f,       pw3[2]=PKW(P1,12),pw3[3]=PKW(P1,14), pw3); \
    l_reg+=sacc; \
    if(GK){DMA_K((t)+3,sl_cur);} if(GV){DMA_V((t)+1,sl_next);} \
    CMASK(C0,C1,t); \
    { float a=MX3(C0[0],C0[1],C1[0]),b=MX3(C0[2],C0[3],C1[1]); a=MX3(a,C1[2],C1[3]); \
      _Pragma("unroll") for(int r=4;r<16;r+=4){a=MX3(a,C0[r],C0[r+1]);b=MX3(b,C0[r+2],C0[r+3]);a=MX3(a,C1[r],C1[r+1]);b=MX3(b,C1[r+2],C1[r+3]);} \
      float rm=__builtin_fmaxf(a,b); { auto rr=__builtin_amdgcn_permlane32_swap(__float_as_uint(rm),__float_as_uint(rm),false,false); rm=__builtin_fmaxf(__uint_as_float(rr[0]),__uint_as_float(rr[1])); } \
      resc=false; \
      if(__builtin_expect(__any(rm>(float)THRL),0)){ const float dl=__builtin_fmaxf(rm,0.f); mhat+=dl; \
        _Pragma("unroll") for(int r=0;r<16;++r){C0[r]-=dl;C1[r]-=dl;} \
        _Pragma("unroll") for(int r=0;r<16;++r)negm[r]=-mhat; asm volatile("":"+v"(negm)); \
        const float f=__builtin_amdgcn_exp2f(-dl); l_reg*=f; if(hi==0)wsf[r32]=f; resc=true; } } \
    SBAR(); \
    GAPB(o[0]=__builtin_amdgcn_mfma_f32_32x32x16_bf16(PAF(0),VFR(0),o[0],0,0,0), C0,0); \
    GAPB(o[1]=__builtin_amdgcn_mfma_f32_32x32x16_bf16(PAF(0),VFR(4),o[1],0,0,0), C0,4); \
    KRD(GL,0); GAPB(o[0]=__builtin_amdgcn_mfma_f32_32x32x16_bf16(PAF(1),VFR(1),o[0],0,0,0), C0,8); \
    KRD(GL,1); GAPB(o[1]=__builtin_amdgcn_mfma_f32_32x32x16_bf16(PAF(1),VFR(5),o[1],0,0,0), C0,12); \
    KRD(GL,2); GAPB(o[0]=__builtin_amdgcn_mfma_f32_32x32x16_bf16(PAF(2),VFR(2),o[0],0,0,0), C1,0); \
    KRD(GL,3); GAPB(o[1]=__builtin_amdgcn_mfma_f32_32x32x16_bf16(PAF(2),VFR(6),o[1],0,0,0), C1,4); \
    GAPB(o[0]=__builtin_amdgcn_mfma_f32_32x32x16_bf16(PAF(3),VFR(3),o[0],0,0,0), C1,8); \
    GAPB(o[1]=__builtin_amdgcn_mfma_f32_32x32x16_bf16(PAF(3),VFR(7),o[1],0,0,0), C1,12); \
    }while(0)
  int t=1;
  for(;t+5<NT;t+=2){
    STEP(pB0,pB1,pA0,pA1,t,true,true,true);     WAIT_BAR(2); RESC(); ROT();
    STEP(pA0,pA1,pB0,pB1,t+1,true,true,true);   WAIT_BAR(2); RESC(); ROT();
  }
  #define ENDW(tt) do{ if((tt)+3<NT){WAIT_BAR(2);} else if((tt)+2<NT){WAIT_BAR(1);} else {WAIT_BAR(0);} }while(0)
  for(;t+1<NT;t+=2){
    STEP(pB0,pB1,pA0,pA1,t,(t+3<NT),(t+1<NT),(t+1<NT));       ENDW(t);   RESC(); ROT();
    STEP(pA0,pA1,pB0,pB1,t+1,(t+4<NT),(t+2<NT),(t+2<NT));     ENDW(t+1); RESC(); ROT();
  }
  STEP(pB0,pB1,pA0,pA1,NT-1,false,false,false); RESC();
  { float sacc=pB0[0]+pB0[1]; _Pragma("unroll") for(int r=2;r<16;++r)sacc+=pB0[r]; _Pragma("unroll") for(int r=0;r<16;++r)sacc+=pB1[r]; l_reg+=sacc;
    pw0=(u32x4){PKW(pB0,0),PKW(pB0,2),PKW(pB0,4),PKW(pB0,6)};pw1=(u32x4){PKW(pB0,8),PKW(pB0,10),PKW(pB0,12),PKW(pB0,14)};pw2=(u32x4){PKW(pB1,0),PKW(pB1,2),PKW(pB1,4),PKW(pB1,6)};pw3=(u32x4){PKW(pB1,8),PKW(pB1,10),PKW(pB1,12),PKW(pB1,14)};
    SBAR(); pv(o,vb0+sl_cur,PAF(0),PAF(1),PAF(2),PAF(3)); }
  #undef PKW
  #undef PAF
  #undef VFR
  #undef PIN
  #undef MX3
  #undef GAPA
  #undef GAPB
  #undef EX
  #undef VRD
  #undef KRD
  #undef QKMU
  #undef STEP
  #undef ENDW
  {auto rr=__builtin_amdgcn_permlane32_swap(__float_as_uint(l_reg),__float_as_uint(l_reg),false,false);l_reg=__uint_as_float(rr[0])+__uint_as_float(rr[1]);}
  if(hi==0)wsf[32+r32]=l_reg;asm volatile("s_waitcnt lgkmcnt(0)":::"memory");
  float rli[16];
  #pragma unroll
  for(int r=0;r<16;++r)rli[r]=__builtin_amdgcn_rcpf(wsf[32+crow(r,hi)]);
  bf16*Ow=Ow0+(long)(wid*QBLK)*OPITCH;
  { bf16*stg=(bf16*)(shm+LDS_OST)+wid*2048;
    #pragma unroll
    for(int r=0;r<16;++r){const int orow=crow(r,hi);
      #pragma unroll
      for(int d0=0;d0<2;++d0)stg[orow*64+d0*32+r32]=__float2bfloat16(o[d0][r]*rli[r]);}
    asm volatile("s_waitcnt lgkmcnt(0)":::"memory");
    #pragma unroll
    for(int i=0;i<4;++i){const int row=i*8+(lane>>3),ch=lane&7; const u32x4 v=*(const u32x4*)(stg+row*64+ch*8); ATTN_STORE16(Ow+(long)row*OPITCH+ch*8,v);} }
  asm volatile("s_waitcnt lgkmcnt(0)\n\ts_barrier":::"memory");
  #undef DMA_K
  #undef KROW
  #undef DMA_V
  #undef CMASK
  #undef START
  #undef RESC
  #undef ROT
}
constexpr int ATTN_LDS_BYTES=LDS_BYTES;
constexpr int FS_K=0, FS_V=3*8192, FS_WS=FS_V+3*16384, FS_OST=FS_WS+NW*64*4, FS_BYTES=FS_OST+NW*4096;
constexpr float FS_LMIN=1e-30f, FS_LMAX=1e36f;
constexpr bool FS_MFSUM=false;
#define WAIT_BAR_V(NV_,A2,A1) do{ if constexpr((NV_)==2){WAIT_BAR(A2);}else{WAIT_BAR(A1);} }while(0)
template<int VW> __device__ __forceinline__ void pv_w(f32x16*o,int vb,bf16x8 pa0,bf16x8 pa1,bf16x8 pa2,bf16x8 pa3){
  #pragma unroll
  for(int d0=0;d0<2*VW;++d0){s16x4 lo[4],hi[4];
    #pragma unroll
    for(int ks=0;ks<4;++ks){
      asm volatile("ds_read_b64_tr_b16 %0,%1 offset:%c2":"=&v"(lo[ks]):"v"(vb),"i"(d0*4096+ks*1024):"memory");
      asm volatile("ds_read_b64_tr_b16 %0,%1 offset:%c2":"=&v"(hi[ks]):"v"(vb),"i"(d0*4096+ks*1024+512):"memory");}
    asm volatile("s_waitcnt lgkmcnt(0)":::"memory");SBAR();
    #define PK(k) (bf16x8){lo[k][0],lo[k][1],lo[k][2],lo[k][3],hi[k][0],hi[k][1],hi[k][2],hi[k][3]}
    o[d0]=__builtin_amdgcn_mfma_f32_32x32x16_bf16(pa0,PK(0),o[d0],0,0,0);
    o[d0]=__builtin_amdgcn_mfma_f32_32x32x16_bf16(pa1,PK(1),o[d0],0,0,0);
    o[d0]=__builtin_amdgcn_mfma_f32_32x32x16_bf16(pa2,PK(2),o[d0],0,0,0);
    o[d0]=__builtin_amdgcn_mfma_f32_32x32x16_bf16(pa3,PK(3),o[d0],0,0,0);
    #undef PK
  }
}
template<int VW,bool ISC,bool K8> __device__ __forceinline__ bool attn_fs(const bf16*Qw0,const bf16*__restrict__ Kh,const bf16*__restrict__ Vh,bf16*Ow0,int NT,int kr0,int r0,lds_cfptr bt,char*shm,const unsigned char*Q8w0,const unsigned char*__restrict__ K8h){
  int tid_=threadIdx.x; asm volatile("; LAUNDER":"+v"(tid_)); const int tid=tid_,lane=tid&63,r32=lane&31,hi=lane>>5; const int wid=__builtin_amdgcn_readfirstlane(tid>>6);
  const bf16*Qw=Qw0+(long)(wid*QBLK)*QKP;
  const unsigned lds0=(unsigned)(uintptr_t)shm;
  float*wsf=(float*)(shm+FS_WS)+wid*64;
  const bf16*ksrc=Kh+(long)lane*QKP+wid*8;
  const unsigned char*ksrc8=K8h+(long)lane*64+(wid&3)*16;
  const bf16*vsrc=Vh+(long)(16*(wid&3)+(lane>>2))*QKP+(wid>>2)*32+(lane&3)*8;
  const unsigned kdst=lds0+FS_K+(K8?(wid&3):wid)*1024, vdst=lds0+FS_V+wid*1024;
  #define KROW(t) (ISC ? ((t)<4 ? 64*(t) : 256+64*(kr0+(t)-4)) : 64*(t))
  #define DMA_K(t,slot) do{ if constexpr(K8){ glds16(ksrc8+(long)KROW(t)*64,(unsigned)__builtin_amdgcn_readfirstlane(kdst+(slot))); } else { glds16(ksrc+(long)KROW(t)*QKP,(unsigned)__builtin_amdgcn_readfirstlane(kdst+(slot))); } }while(0)
  #define DMA_V(t,slot) do{ glds16(vsrc+(long)KROW(t)*QKP,(unsigned)__builtin_amdgcn_readfirstlane(vdst+2*(slot))); \
      if constexpr(VW==2){ glds16(vsrc+(long)KROW(t)*QKP+QKV_BLK,(unsigned)__builtin_amdgcn_readfirstlane(vdst+2*(slot)+8192)); } }while(0)
  const int vb0=(int)(lds0+FS_V)+((lane>>4)&1)*32+(lane&3)*8+(4*hi+((lane&15)>>2))*64;
  const char*Kbase=shm+FS_K; bf16x8 kf[8];
  const lds_cptr shm3=(lds_cptr)shm; const lds_cptr kp0=shm3+FS_K+(K8?2*hi:hi)*1024+r32*16; const lds_cptr vp0=shm3+FS_V+((lane>>4)&1)*32+(lane&3)*8+(4*hi+((lane&15)>>2))*64;
  DMA_K(0,0);DMA_V(0,0);DMA_K(1,SLOTB);
  bf16x8 qr[4]; i32x8a q8=i32x8a{}; i32x8a k8a=i32x8a{},k8b=i32x8a{};
  if constexpr(K8){ const unsigned char*qp=Q8w0+(long)(wid*QBLK+r32)*64+32*hi; q8=cat8a(*reinterpret_cast<const i32x4a*>(qp),*reinterpret_cast<const i32x4a*>(qp+16));
    #pragma unroll
    for(int d0=0;d0<4;++d0)qr[d0]=bf16x8{}; }
  else {
  #pragma unroll
  for(int d0=0;d0<4;++d0)qr[d0]=*reinterpret_cast<const bf16x8*>(&Qw[(long)r32*QKP+d0*16+hi*8]); }
  float l_reg=0.f;f32x16 o[2*VW];
  #pragma unroll
  for(int d0=0;d0<2*VW;++d0)o[d0]=f32x16{};
  const f32x16 zero16=f32x16{};
  f32x16 lacc=f32x16{}; const bf16x8 ones8=(bf16x8){0x3F80,0x3F80,0x3F80,0x3F80,0x3F80,0x3F80,0x3F80,0x3F80};
  #define CMASK(P0,P1,t) do{ if constexpr(ISC){ if(wid&1) cbias_par<1>(P0,P1,(t),kr0,r0,wid,r32,hi,bt); else cbias_par<0>(P0,P1,(t),kr0,r0,wid,r32,hi,bt); } }while(0)
  f32x16 pA0,pA1,pB0,pB1;
  int sl_prev=0,sl_cur=0,sl_next=SLOTB;
  #define ROT() do{sl_prev=sl_cur;sl_cur=sl_next;sl_next=(sl_next==(NSLOT-1)*SLOTB)?0:sl_next+SLOTB;}while(0)
  DMA_K(2,2*SLOTB);
  WAIT_BAR_V(VW,4,3);
  if(tid==0)*(volatile unsigned*)(shm+FS_WS)=0u;
  if constexpr(K8){ pA0=MF8(kfrag8(kp0),q8,zero16); pA1=MF8(kfrag8(kp0+512),q8,zero16); } else qkt(pA0,pA1,Kbase,qr,zero16,r32,hi);
  asm volatile("s_nop 15\n\ts_nop 7":"+v"(pA0),"+v"(pA1));CMASK(pA0,pA1,0);
  _Pragma("unroll") for(int r=0;r<16;++r){pA0[r]=__builtin_amdgcn_exp2f(pA0[r]);pA1[r]=__builtin_amdgcn_exp2f(pA1[r]);}
  WAIT_BAR(0);
  DMA_K(3,0);DMA_V(1,SLOTB);
  ROT();
  if constexpr(K8){ k8a=kfrag8(kp0+sl_cur); k8b=kfrag8(kp0+sl_cur+512); } else kload8(kf,kp0+sl_cur);
  WAIT_BAR_V(VW,3,2);
  s16x4 vlo[8],vhi[8]; u32x4 pw0,pw1,pw2,pw3;
  #define PKW(P,B) cvtpk_s(P[B],P[B+1])
  #define PAF(k) __builtin_bit_cast(bf16x8,pw##k)
  #define VFR(i) (bf16x8){vlo[i][0],vlo[i][1],vlo[i][2],vlo[i][3],vhi[i][0],vhi[i][1],vhi[i][2],vhi[i][3]}
  #define PIN(x) asm volatile("":"+v"(x))
  #define MF(a,b,c) __builtin_amdgcn_mfma_f32_32x32x16_bf16(a,b,c,0,0,0)
  #define GAPA(MFX,A0,A1,A2,A3,W0,W1,PW) do{ MFX; if constexpr(!(VW==1&&FS_MFSUM)){ sacc+=A0; sacc+=A1; sacc+=A2; sacc+=A3; PIN(sacc); } W0; W1; PIN(PW); SBAR(); }while(0)
  #define QKM(i,C0,C1) do{ if constexpr(K8){ if constexpr((i)==0){ C0=MF8(k8a,q8,zero16); } else if constexpr((i)==4){ C1=MF8(k8b,q8,zero16); } } else { \
      if constexpr((i)==0){ C0=MF(kf[0],qr[0],zero16); } else if constexpr((i)==1){ C1=MF(kf[1],qr[0],zero16); } else if constexpr(((i)&1)==0){ C0=MF(kf[i],qr[(i)>>1],C0); } else { C1=MF(kf[i],qr[(i)>>1],C1); } } }while(0)
  #define EX(v) __builtin_amdgcn_exp2f(v)
  #define GAPB4(MFX,X,B) do{ MFX; X[B]=EX(X[B]); X[B+1]=EX(X[B+1]); X[B+2]=EX(X[B+2]); X[B+3]=EX(X[B+3]); PIN(X); SBAR(); }while(0)
  #define GAPB2(MFX,X,B) do{ MFX; X[B]=EX(X[B]); X[B+1]=EX(X[B+1]); PIN(X); SBAR(); }while(0)
  #define VRDX(j,dq,ks) do{ vlo[j]=vtr(vp_+((dq)*4096+(ks)*1024)); vhi[j]=vtr(vp_+((dq)*4096+(ks)*1024+512)); }while(0)
  #define KRD(G,j) do{ if(G){ if constexpr(K8){ if constexpr((j)==0){ k8a=kfrag8(kp0+sl_next); SBAR(); } else if constexpr((j)==1){ k8b=kfrag8(kp0+sl_next+512); SBAR(); } } else { kload2(kf,kp0+sl_next,j); SBAR(); } } }while(0)
  #define STEP(C0,C1,P0,P1,t,GK,GV,GL) do{ SBAR(); \
    const lds_cptr vp_=vp0+2*sl_prev; \
    if constexpr(VW==1){ VRDX(0,0,0); } else { VRDX(0,0,0); } SBAR(); float sacc=(P0[0]+P0[1]); \
    GAPA(QKM(0,C0,C1), P0[2],P0[3],P0[4],P0[5],     pw0[0]=PKW(P0,0), pw0[1]=PKW(P0,2), pw0); \
    if constexpr(VW==1){ VRDX(4,1,0); } else { VRDX(1,1,0); } SBAR(); GAPA(QKM(1,C0,C1), P0[6],P0[7],P0[8],P0[9],     pw0[2]=PKW(P0,4), pw0[3]=PKW(P0,6), pw0); \
    if constexpr(VW==1){ VRDX(1,0,1); } else { VRDX(2,2,0); } SBAR(); GAPA(QKM(2,C0,C1),   P0[10],P0[11],P0[12],P0[13], pw1[0]=PKW(P0,8), pw1[1]=PKW(P0,10), pw1); \
    if constexpr(VW==1){ VRDX(5,1,1); } else { VRDX(3,3,0); } SBAR(); GAPA(QKM(3,C0,C1),   P0[14],P0[15],P1[0],P1[1],   pw1[2]=PKW(P0,12),pw1[3]=PKW(P0,14), pw1); \
    if constexpr(VW==1){ VRDX(2,0,2); } else { VRDX(4,0,1); } SBAR(); GAPA(QKM(4,C0,C1),   P1[2],P1[3],P1[4],P1[5],     pw2[0]=PKW(P1,0), pw2[1]=PKW(P1,2), pw2); \
    if constexpr(VW==1){ VRDX(6,1,2); } else { VRDX(5,1,1); } SBAR(); GAPA(QKM(5,C0,C1),   P1[6],P1[7],P1[8],P1[9],     pw2[2]=PKW(P1,4), pw2[3]=PKW(P1,6), pw2); \
    if constexpr(VW==1){ VRDX(3,0,3); } else { VRDX(6,2,1); } SBAR(); GAPA(QKM(6,C0,C1),   P1[10],P1[11],P1[12],P1[13], pw3[0]=PKW(P1,8), pw3[1]=PKW(P1,10), pw3); \
    if constexpr(VW==1){ VRDX(7,1,3); } else { VRDX(7,3,1); } SBAR(); GAPA(QKM(7,C0,C1),   P1[14],P1[15],0.f,0.f,       pw3[2]=PKW(P1,12),pw3[3]=PKW(P1,14), pw3); \
    l_reg+=sacc; \
    if(GK){DMA_K((t)+3,sl_cur);} if(GV){DMA_V((t)+1,sl_next);} \
    CMASK(C0,C1,t); \
    SBAR(); \
    if constexpr(VW==1){ \
      GAPB4(o[0]=MF(PAF(0),VFR(0),o[0]), C0,0); \
      GAPB4(o[1]=MF(PAF(0),VFR(4),o[1]), C0,4); \
      if constexpr(FS_MFSUM){lacc=MF(PAF(0),ones8,lacc);} KRD(GL,0); GAPB4(o[0]=MF(PAF(1),VFR(1),o[0]), C0,8); \
      KRD(GL,1); GAPB4(o[1]=MF(PAF(1),VFR(5),o[1]), C0,12); \
      if constexpr(FS_MFSUM){lacc=MF(PAF(1),ones8,lacc);} KRD(GL,2); GAPB4(o[0]=MF(PAF(2),VFR(2),o[0]), C1,0); \
      KRD(GL,3); GAPB4(o[1]=MF(PAF(2),VFR(6),o[1]), C1,4); \
      if constexpr(FS_MFSUM){lacc=MF(PAF(2),ones8,lacc);} GAPB4(o[0]=MF(PAF(3),VFR(3),o[0]), C1,8); \
      if constexpr(FS_MFSUM){lacc=MF(PAF(3),ones8,lacc);} GAPB4(o[1]=MF(PAF(3),VFR(7),o[1]), C1,12); \
    } else { \
      GAPB2(o[0]=MF(PAF(0),VFR(0),o[0]), C0,0);  VRDX(0,0,2); SBAR(); \
      GAPB2(o[1]=MF(PAF(0),VFR(1),o[1]), C0,2);  VRDX(1,1,2); SBAR(); \
      GAPB2(o[2]=MF(PAF(0),VFR(2),o[2]), C0,4);  VRDX(2,2,2); SBAR(); \
      GAPB2(o[3]=MF(PAF(0),VFR(3),o[3]), C0,6);  VRDX(3,3,2); SBAR(); \
      GAPB2(o[0]=MF(PAF(1),VFR(4),o[0]), C0,8);  VRDX(4,0,3); SBAR(); \
      GAPB2(o[1]=MF(PAF(1),VFR(5),o[1]), C0,10); VRDX(5,1,3); SBAR(); \
      GAPB2(o[2]=MF(PAF(1),VFR(6),o[2]), C0,12); VRDX(6,2,3); SBAR(); \
      GAPB2(o[3]=MF(PAF(1),VFR(7),o[3]), C0,14); VRDX(7,3,3); SBAR(); \
      KRD(GL,0); GAPB2(o[0]=MF(PAF(2),VFR(0),o[0]), C1,0); \
      KRD(GL,1); GAPB2(o[1]=MF(PAF(2),VFR(1),o[1]), C1,2); \
      KRD(GL,2); GAPB2(o[2]=MF(PAF(2),VFR(2),o[2]), C1,4); \
      KRD(GL,3); GAPB2(o[3]=MF(PAF(2),VFR(3),o[3]), C1,6); \
      GAPB2(o[0]=MF(PAF(3),VFR(4),o[0]), C1,8); \
      GAPB2(o[1]=MF(PAF(3),VFR(5),o[1]), C1,10); \
      GAPB2(o[2]=MF(PAF(3),VFR(6),o[2]), C1,12); \
      GAPB2(o[3]=MF(PAF(3),VFR(7),o[3]), C1,14); \
    } \
    }while(0)
  int t=1;
  for(;t+5<NT;t+=2){
    STEP(pB0,pB1,pA0,pA1,t,true,true,true);     WAIT_BAR_V(VW,3,2); ROT();
    STEP(pA0,pA1,pB0,pB1,t+1,true,true,true);   WAIT_BAR_V(VW,3,2); ROT();
  }
  #define ENDW(tt) do{ if((tt)+3<NT){WAIT_BAR_V(VW,3,2);} else if((tt)+2<NT){WAIT_BAR_V(VW,2,1);} else {WAIT_BAR(0);} }while(0)
  for(;t+1<NT;t+=2){
    STEP(pB0,pB1,pA0,pA1,t,(t+3<NT),(t+1<NT),(t+1<NT));       ENDW(t);   ROT();
    STEP(pA0,pA1,pB0,pB1,t+1,(t+4<NT),(t+2<NT),(t+2<NT));     ENDW(t+1); ROT();
  }
  STEP(pB0,pB1,pA0,pA1,NT-1,false,false,false);
  { if constexpr(!(VW==1&&FS_MFSUM)){ float sacc=pB0[0]+pB0[1]; _Pragma("unroll") for(int r=2;r<16;++r)sacc+=pB0[r]; _Pragma("unroll") for(int r=0;r<16;++r)sacc+=pB1[r]; l_reg+=sacc; }
    pw0=(u32x4){PKW(pB0,0),PKW(pB0,2),PKW(pB0,4),PKW(pB0,6)};pw1=(u32x4){PKW(pB0,8),PKW(pB0,10),PKW(pB0,12),PKW(pB0,14)};pw2=(u32x4){PKW(pB1,0),PKW(pB1,2),PKW(pB1,4),PKW(pB1,6)};pw3=(u32x4){PKW(pB1,8),PKW(pB1,10),PKW(pB1,12),PKW(pB1,14)};
    SBAR(); if constexpr(VW==1&&FS_MFSUM){ lacc=MF(PAF(0),ones8,lacc); lacc=MF(PAF(1),ones8,lacc); lacc=MF(PAF(2),ones8,lacc); lacc=MF(PAF(3),ones8,lacc); }
    pv_w<VW>(o,vb0+2*sl_cur,PAF(0),PAF(1),PAF(2),PAF(3)); }
  #undef PKW
  #undef PAF
  #undef VFR
  #undef PIN
  #undef MF
  #undef GAPA
  #undef QKM
  #undef GAPB4
  #undef GAPB2
  #undef EX
  #undef VRDX
  #undef KRD
  #undef STEP
  #undef ENDW
  float rli[16];
  if constexpr(VW==1&&FS_MFSUM){
    #pragma unroll
    for(int r=0;r<16;++r)rli[r]=__builtin_amdgcn_rcpf(lacc[r]);
    static_assert(!FS_MFSUM,"the row-sum range check reads l_reg");
  } else {
    {auto rr=__builtin_amdgcn_permlane32_swap(__float_as_uint(l_reg),__float_as_uint(l_reg),false,false);l_reg=__uint_as_float(rr[0])+__uint_as_float(rr[1]);}
    if(__any(!(l_reg>FS_LMIN&&l_reg<FS_LMAX))){ if(lane==0)*(volatile unsigned*)(shm+FS_WS)=1u; }
    if(hi==0)wsf[32+r32]=l_reg;asm volatile("s_waitcnt lgkmcnt(0)":::"memory");
    #pragma unroll
    for(int r=0;r<16;++r)rli[r]=__builtin_amdgcn_rcpf(wsf[32+crow(r,hi)]);
  }
  bf16*Ow=Ow0+(long)(wid*QBLK)*OPITCH;
  #pragma unroll
  for(int hv=0;hv<VW;++hv){ bf16*stg=(bf16*)(shm+FS_OST)+wid*2048;
    #pragma unroll
    for(int r=0;r<16;++r){const int orow=crow(r,hi);
      #pragma unroll
      for(int d0=0;d0<2;++d0)stg[orow*64+d0*32+r32]=__float2bfloat16(o[2*hv+d0][r]*rli[r]);}
    asm volatile("s_waitcnt lgkmcnt(0)":::"memory");
    #pragma unroll
    for(int i=0;i<4;++i){const int row=i*8+(lane>>3),ch=lane&7; const u32x4 v=*(const u32x4*)(stg+row*64+ch*8); ATTN_STORE16(Ow+(long)row*OPITCH+hv*64+ch*8,v);}
    asm volatile("s_waitcnt lgkmcnt(0)":::"memory"); }
  asm volatile("s_waitcnt lgkmcnt(0)\n\ts_barrier":::"memory");
  const bool redo=*(volatile unsigned*)(shm+FS_WS)!=0u;
  #undef DMA_K
  #undef KROW
  #undef DMA_V
  #undef CMASK
  #undef ROT
  return redo;
}
#undef WAIT_BAR_V
#undef MF8
constexpr int ATTN_FS_LDS_BYTES=FS_BYTES;
constexpr int F2_K=0, F2_V=4*4096, F2_WS=F2_V+4*16384, F2_OST=F2_WS+NW*64*4, F2_BYTES=F2_OST+NW*4096;
#define MF8(a,b,c) __builtin_amdgcn_mfma_scale_f32_32x32x64_f8f6f4(a,b,c,0,0,0,0,0,0)
#define WAIT_BAR_V(NV_,A2,A1) do{ if constexpr((NV_)==2){WAIT_BAR(A2);}else{WAIT_BAR(A1);} }while(0)
template<int VW,bool ISC> __device__ __forceinline__ bool attn_fs2(const bf16*__restrict__ Vh,bf16*Ow0,int NT,int kr0,int r0,lds_cfptr bt,char*shm,const unsigned char*Q8w0,const unsigned char*__restrict__ K8h){
  int tid_=threadIdx.x; asm volatile("; LAUNDER":"+v"(tid_)); const int tid=tid_,lane=tid&63,r32=lane&31,hi=lane>>5; const int wid=__builtin_amdgcn_readfirstlane(tid>>6);
  const bool g2=wid>=4;
  const unsigned lds0=(unsigned)(uintptr_t)shm;
  float*wsf=(float*)(shm+F2_WS)+wid*64;
  const unsigned char*ksrc8=K8h+(long)lane*64+(wid&3)*16;
  const bf16*vsrc=Vh+(long)(16*(wid&3)+(lane>>2))*QKP+(wid>>2)*32+(lane&3)*8;
  const unsigned kdst=lds0+F2_K+(wid&3)*1024, vdst=lds0+F2_V+wid*1024;
  #define KS(t) ((((t))&3)*4096)
  #define VS(t) ((((t))&3)*16384)
  #define KROW(t) (ISC ? ((t)<4 ? 64*(t) : 256+64*(kr0+(t)-4)) : 64*(t))
  #define DMA_K(t) glds16(ksrc8+(long)KROW(t)*64,(unsigned)__builtin_amdgcn_readfirstlane(kdst+KS(t)))
  #define DMA_V(t) do{ glds16(vsrc+(long)KROW(t)*QKP,(unsigned)__builtin_amdgcn_readfirstlane(vdst+VS(t))); \
      if constexpr(VW==2){ glds16(vsrc+(long)KROW(t)*QKP+QKV_BLK,(unsigned)__builtin_amdgcn_readfirstlane(vdst+VS(t)+8192)); } }while(0)
  const int vb0=(int)(lds0+F2_V)+((lane>>4)&1)*32+(lane&3)*8+(4*hi+((lane&15)>>2))*64;
  const lds_cptr shm3=(lds_cptr)shm; const lds_cptr kp0=shm3+F2_K+(2*hi)*1024+r32*16; const lds_cptr vp0=shm3+F2_V+((lane>>4)&1)*32+(lane&3)*8+(4*hi+((lane&15)>>2))*64;
  DMA_K(0);DMA_V(0);DMA_K(1);
  i32x8a q8; { const unsigned char*qp=Q8w0+(long)(wid*QBLK+r32)*64+32*hi; q8=cat8a(*reinterpret_cast<const i32x4a*>(qp),*reinterpret_cast<const i32x4a*>(qp+16)); }
  i32x8a k8a=i32x8a{},k8b=i32x8a{};
  float l_reg=0.f;f32x16 o[2*VW];
  #pragma unroll
  for(int d0=0;d0<2*VW;++d0)o[d0]=f32x16{};
  const f32x16 zero16=f32x16{};
  #define CMASK(P0,P1,t) do{ if constexpr(ISC){ if(wid&1) cbias_par<1>(P0,P1,(t),kr0,r0,wid,r32,hi,bt); else cbias_par<0>(P0,P1,(t),kr0,r0,wid,r32,hi,bt); } }while(0)
  f32x16 pA0,pA1,pB0,pB1;
  DMA_K(2);
  WAIT_BAR_V(VW,4,3);
  if(tid==0)*(volatile unsigned*)(shm+F2_WS)=0u;
  pA0=MF8(kfrag8(kp0+KS(0)),q8,zero16); pA1=MF8(kfrag8(kp0+KS(0)+512),q8,zero16);
  asm volatile("s_nop 15\n\ts_nop 7":"+v"(pA0),"+v"(pA1));CMASK(pA0,pA1,0);
  if(!g2){ _Pragma("unroll") for(int r=0;r<16;++r){pA0[r]=__builtin_amdgcn_exp2f(pA0[r]);pA1[r]=__builtin_amdgcn_exp2f(pA1[r]);} }
  WAIT_BAR(0);
  DMA_K(3);DMA_V(1);
  if(!g2){ k8a=kfrag8(kp0+KS(1)); k8b=kfrag8(kp0+KS(1)+512); }
  WAIT_BAR_V(VW,3,2);
  s16x4 vlo[8],vhi[8]; u32x4 pw0,pw1,pw2,pw3;
  #define PKW(P,B) cvtpk_s(P[B],P[B+1])
  #define PAF(k) __builtin_bit_cast(bf16x8,pw##k)
  #define VFR(i) (bf16x8){vlo[i][0],vlo[i][1],vlo[i][2],vlo[i][3],vhi[i][0],vhi[i][1],vhi[i][2],vhi[i][3]}
  #define PIN(x) asm volatile("":"+v"(x))
  #define MF(a,b,c) __builtin_amdgcn_mfma_f32_32x32x16_bf16(a,b,c,0,0,0)
  #define EX(v) __builtin_amdgcn_exp2f(v)
  #define GAPA(MFX,A0,A1,A2,A3,W0,W1,PW) do{ MFX; sacc+=A0; sacc+=A1; sacc+=A2; sacc+=A3; PIN(sacc); W0; W1; PIN(PW); SBAR(); }while(0)
  #define GAPB4(MFX,X,B) do{ MFX; X[B]=EX(X[B]); X[B+1]=EX(X[B+1]); X[B+2]=EX(X[B+2]); X[B+3]=EX(X[B+3]); PIN(X); SBAR(); }while(0)
  #define GAPB2(MFX,X,B) do{ MFX; X[B]=EX(X[B]); X[B+1]=EX(X[B+1]); PIN(X); SBAR(); }while(0)
  #define VRDX(j,dq,ks) do{ vlo[j]=vtr(vp_+((dq)*4096+(ks)*1024)); vhi[j]=vtr(vp_+((dq)*4096+(ks)*1024+512)); }while(0)
  #define XPART(C0,C1,P0,P1,t) do{ SBAR(); \
    const lds_cptr vp_=vp0+VS((t)-1); \
    VRDX(0,0,0); SBAR(); float sacc=(P0[0]+P0[1]); \
    GAPA(C0=MF8(k8a,q8,zero16), P0[2],P0[3],P0[4],P0[5],     pw0[0]=PKW(P0,0), pw0[1]=PKW(P0,2), pw0); \
    if constexpr(VW==1){ VRDX(4,1,0); } else { VRDX(1,1,0); } SBAR(); GAPA((void)0, P0[6],P0[7],P0[8],P0[9],     pw0[2]=PKW(P0,4), pw0[3]=PKW(P0,6), pw0); \
    if constexpr(VW==1){ VRDX(1,0,1); } else { VRDX(2,2,0); } SBAR(); GAPA((void)0, P0[10],P0[11],P0[12],P0[13], pw1[0]=PKW(P0,8), pw1[1]=PKW(P0,10), pw1); \
    if constexpr(VW==1){ VRDX(5,1,1); } else { VRDX(3,3,0); } SBAR(); GAPA((void)0, P0[14],P0[15],P1[0],P1[1],   pw1[2]=PKW(P0,12),pw1[3]=PKW(P0,14), pw1); \
    if constexpr(VW==1){ VRDX(2,0,2); } else { VRDX(4,0,1); } SBAR(); GAPA(C1=MF8(k8b,q8,zero16), P1[2],P1[3],P1[4],P1[5],     pw2[0]=PKW(P1,0), pw2[1]=PKW(P1,2), pw2); \
    if constexpr(VW==1){ VRDX(6,1,2); } else { VRDX(5,1,1); } SBAR(); GAPA((void)0, P1[6],P1[7],P1[8],P1[9],     pw2[2]=PKW(P1,4), pw2[3]=PKW(P1,6), pw2); \
    if constexpr(VW==1){ VRDX(3,0,3); } else { VRDX(6,2,1); } SBAR(); GAPA((void)0, P1[10],P1[11],P1[12],P1[13], pw3[0]=PKW(P1,8), pw3[1]=PKW(P1,10), pw3); \
    if constexpr(VW==1){ VRDX(7,1,3); } else { VRDX(7,3,1); } SBAR(); GAPA((void)0, P1[14],P1[15],0.f,0.f,       pw3[2]=PKW(P1,12),pw3[3]=PKW(P1,14), pw3); \
    l_reg+=sacc; }while(0)
  #define KRD8(G,tk,j) do{ if(G){ if constexpr((j)==0){ k8a=kfrag8(kp0+KS(tk)); } else { k8b=kfrag8(kp0+KS(tk)+512); } SBAR(); } }while(0)
  #define YPART(E0,E1,tv,tk,GLK) do{ SBAR(); \
    if constexpr(VW==1){ \
      GAPB4(o[0]=MF(PAF(0),VFR(0),o[0]), E0,0); \
      GAPB4(o[1]=MF(PAF(0),VFR(4),o[1]), E0,4); \
      KRD8(GLK,tk,0); GAPB4(o[0]=MF(PAF(1),VFR(1),o[0]), E0,8); \
      KRD8(GLK,tk,1); GAPB4(o[1]=MF(PAF(1),VFR(5),o[1]), E0,12); \
      GAPB4(o[0]=MF(PAF(2),VFR(2),o[0]), E1,0); \
      GAPB4(o[1]=MF(PAF(2),VFR(6),o[1]), E1,4); \
      GAPB4(o[0]=MF(PAF(3),VFR(3),o[0]), E1,8); \
      GAPB4(o[1]=MF(PAF(3),VFR(7),o[1]), E1,12); \
    } else { const lds_cptr vp_=vp0+VS(tv); \
      GAPB2(o[0]=MF(PAF(0),VFR(0),o[0]), E0,0);  VRDX(0,0,2); SBAR(); \
      GAPB2(o[1]=MF(PAF(0),VFR(1),o[1]), E0,2);  VRDX(1,1,2); SBAR(); \
      GAPB2(o[2]=MF(PAF(0),VFR(2),o[2]), E0,4);  VRDX(2,2,2); SBAR(); \
      GAPB2(o[3]=MF(PAF(0),VFR(3),o[3]), E0,6);  VRDX(3,3,2); SBAR(); \
      GAPB2(o[0]=MF(PAF(1),VFR(4),o[0]), E0,8);  VRDX(4,0,3); SBAR(); \
      GAPB2(o[1]=MF(PAF(1),VFR(5),o[1]), E0,10); VRDX(5,1,3); SBAR(); \
      GAPB2(o[2]=MF(PAF(1),VFR(6),o[2]), E0,12); VRDX(6,2,3); SBAR(); \
      GAPB2(o[3]=MF(PAF(1),VFR(7),o[3]), E0,14); VRDX(7,3,3); SBAR(); \
      KRD8(GLK,tk,0); GAPB2(o[0]=MF(PAF(2),VFR(0),o[0]), E1,0); \
      KRD8(GLK,tk,1); GAPB2(o[1]=MF(PAF(2),VFR(1),o[1]), E1,2); \
      GAPB2(o[2]=MF(PAF(2),VFR(2),o[2]), E1,4); \
      GAPB2(o[3]=MF(PAF(2),VFR(3),o[3]), E1,6); \
      GAPB2(o[0]=MF(PAF(3),VFR(4),o[0]), E1,8); \
      GAPB2(o[1]=MF(PAF(3),VFR(5),o[1]), E1,10); \
      GAPB2(o[2]=MF(PAF(3),VFR(6),o[2]), E1,12); \
      GAPB2(o[3]=MF(PAF(3),VFR(7),o[3]), E1,14); \
    } }while(0)
  #define YPART0(E0,E1,tk) do{ SBAR(); k8a=kfrag8(kp0+KS(tk)); k8b=kfrag8(kp0+KS(tk)+512); SBAR(); \
    _Pragma("unroll") for(int r=0;r<16;++r){E0[r]=EX(E0[r]);E1[r]=EX(E1[r]);} PIN(E0); PIN(E1); SBAR(); }while(0)
  #define DMAS(t,GK,GV) do{ if(GK){DMA_K((t)+3);} if(GV){DMA_V((t)+1);} }while(0)
  #define STEP1(C0,C1,P0,P1,t,GK,GV,GL) do{ XPART(C0,C1,P0,P1,t); DMAS(t,GK,GV); CMASK(C0,C1,t); YPART(C0,C1,(t)-1,(t)+1,GL); }while(0)
  #define STEP2(C0,C1,P0,P1,t,GK,GV)    do{ YPART(P0,P1,(t)-2,(t),true); DMAS(t,GK,GV); XPART(C0,C1,P0,P1,t); CMASK(C0,C1,t); }while(0)
  #define ENDW(tt) do{ if((tt)+3<NT){WAIT_BAR_V(VW,3,2);} else if((tt)+2<NT){WAIT_BAR_V(VW,2,1);} else {WAIT_BAR(0);} }while(0)
  if(!g2){
    STEP1(pB0,pB1,pA0,pA1,1,(4<NT),(2<NT),(2<NT)); ENDW(1);
    int t=2;
    for(;t+6<NT;t+=2){
      STEP1(pA0,pA1,pB0,pB1,t,true,true,true);     WAIT_BAR_V(VW,3,2);
      STEP1(pB0,pB1,pA0,pA1,t+1,true,true,true);   WAIT_BAR_V(VW,3,2);
    }
    for(;t+2<NT;t+=2){
      STEP1(pA0,pA1,pB0,pB1,t,(t+3<NT),(t+1<NT),(t+1<NT));       ENDW(t);
      STEP1(pB0,pB1,pA0,pA1,t+1,(t+4<NT),(t+2<NT),(t+2<NT));     ENDW(t+1);
    }
    STEP1(pA0,pA1,pB0,pB1,NT-2,false,true,true); ENDW(NT-2);
    STEP1(pB0,pB1,pA0,pA1,NT-1,false,false,false);
  } else {
    { YPART0(pA0,pA1,1); DMAS(1,(4<NT),(2<NT)); XPART(pB0,pB1,pA0,pA1,1); CMASK(pB0,pB1,1); } ENDW(1);
    int t=2;
    for(;t+6<NT;t+=2){
      STEP2(pA0,pA1,pB0,pB1,t,true,true);     WAIT_BAR_V(VW,3,2);
      STEP2(pB0,pB1,pA0,pA1,t+1,true,true);   WAIT_BAR_V(VW,3,2);
    }
    for(;t+2<NT;t+=2){
      STEP2(pA0,pA1,pB0,pB1,t,(t+3<NT),(t+1<NT));       ENDW(t);
      STEP2(pB0,pB1,pA0,pA1,t+1,(t+4<NT),(t+2<NT));     ENDW(t+1);
    }
    STEP2(pA0,pA1,pB0,pB1,NT-2,false,true); ENDW(NT-2);
    STEP2(pB0,pB1,pA0,pA1,NT-1,false,false);
    YPART(pB0,pB1,NT-2,0,false);
  }
  { float sacc=pB0[0]+pB0[1]; _Pragma("unroll") for(int r=2;r<16;++r)sacc+=pB0[r]; _Pragma("unroll") for(int r=0;r<16;++r)sacc+=pB1[r]; l_reg+=sacc;
    pw0=(u32x4){PKW(pB0,0),PKW(pB0,2),PKW(pB0,4),PKW(pB0,6)};pw1=(u32x4){PKW(pB0,8),PKW(pB0,10),PKW(pB0,12),PKW(pB0,14)};pw2=(u32x4){PKW(pB1,0),PKW(pB1,2),PKW(pB1,4),PKW(pB1,6)};pw3=(u32x4){PKW(pB1,8),PKW(pB1,10),PKW(pB1,12),PKW(pB1,14)};
    SBAR(); pv_w<VW>(o,vb0+VS(NT-1),PAF(0),PAF(1),PAF(2),PAF(3)); }
  #undef PKW
  #undef PAF
  #undef VFR
  #undef PIN
  #undef MF
  #undef GAPA
  #undef GAPB4
  #undef GAPB2
  #undef EX
  #undef VRDX
  #undef KRD8
  #undef XPART
  #undef YPART
  #undef YPART0
  #undef DMAS
  #undef STEP1
  #undef STEP2
  #undef ENDW
  float rli[16];
  {auto rr=__builtin_amdgcn_permlane32_swap(__float_as_uint(l_reg),__float_as_uint(l_reg),false,false);l_reg=__uint_as_float(rr[0])+__uint_as_float(rr[1]);}
  if(__any(!(l_reg>FS_LMIN&&l_reg<FS_LMAX))){ if(lane==0)*(volatile unsigned*)(shm+F2_WS)=1u; }
  if(hi==0)wsf[32+r32]=l_reg;asm volatile("s_waitcnt lgkmcnt(0)":::"memory");
  #pragma unroll
  for(int r=0;r<16;++r)rli[r]=__builtin_amdgcn_rcpf(wsf[32+crow(r,hi)]);
  bf16*Ow=Ow0+(long)(wid*QBLK)*OPITCH;
  #pragma unroll
  for(int hv=0;hv<VW;++hv){ bf16*stg=(bf16*)(shm+F2_OST)+wid*2048;
    #pragma unroll
    for(int r=0;r<16;++r){const int orow=crow(r,hi);
      #pragma unroll
      for(int d0=0;d0<2;++d0)stg[orow*64+d0*32+r32]=__float2bfloat16(o[2*hv+d0][r]*rli[r]);}
    asm volatile("s_waitcnt lgkmcnt(0)":::"memory");
    #pragma unroll
    for(int i=0;i<4;++i){const int row=i*8+(lane>>3),ch=lane&7; const u32x4 v=*(const u32x4*)(stg+row*64+ch*8); ATTN_STORE16(Ow+(long)row*OPITCH+hv*64+ch*8,v);}
    asm volatile("s_waitcnt lgkmcnt(0)":::"memory"); }
  asm volatile("s_waitcnt lgkmcnt(0)\n\ts_barrier":::"memory");
  const bool redo=*(volatile unsigned*)(shm+F2_WS)!=0u;
  #undef DMA_K
  #undef KROW
  #undef DMA_V
  #undef CMASK
  #undef KS
  #undef VS
  return redo;
}
#undef WAIT_BAR_V
#undef MF8
constexpr int ATTN_FS2_LDS_BYTES=F2_BYTES;
constexpr int F8_S=4096, F8_K=0, F8_V=3*F8_S, F8_WS=F8_V+3*2*F8_S, F8_OST=F8_WS+NW*64*4, F8_BYTES=F8_OST+NW*4096;
constexpr float V8_SCALE=8.0f, F8_TRIG=128.0f;
#ifndef F8_CHK
#define F8_CHK 7
#endif
#define F8_PMEAN (1.0f/(float)(1<<FB))
#define F8_LOGK (6.0f-(float)FB)
#define F8_LMINF (2.0f*F8_PMEAN)
constexpr long VT_BLK=33792L*64;
#define MF8(a,b,c) __builtin_amdgcn_mfma_scale_f32_32x32x64_f8f6f4(a,b,c,0,0,0,0,0,0)
template<int VW,bool ISC,int FB> __device__ __forceinline__ bool attn_fs8(const unsigned char*__restrict__ VTh,int TR,bf16*Ow0,int NT,int kr0,int r0,lds_cfptr bt,char*shm,const unsigned char*Q8w0,const unsigned char*__restrict__ K8h){
  int tid_=threadIdx.x; asm volatile("; LAUNDER":"+v"(tid_)); const int tid=tid_,lane=tid&63,r32=lane&31,hi=lane>>5; const int wid=__builtin_amdgcn_readfirstlane(tid>>6);
  const unsigned lds0=(unsigned)(uintptr_t)shm;
  float*wsf=(float*)(shm+F8_WS)+wid*64;
  const unsigned char*ksrc8=K8h+(long)lane*64+(wid&3)*16;
  const unsigned char*vsrc8=VTh+(long)lane*64+(wid&3)*16+(VW==2?(long)(wid>>2)*VT_BLK:0L);
  const unsigned kdst=lds0+F8_K+(wid&3)*1024, vdst=lds0+F8_V+(wid&3)*1024+(VW==2?(wid>>2)*4096:0);
  #define KROW(t) (ISC ? ((t)<4 ? 64*(t) : 256+64*(kr0+(t)-4)) : 64*(t))
  #define DMA_K(t,slot) glds16(ksrc8+(long)KROW(t)*64,(unsigned)__builtin_amdgcn_readfirstlane(kdst+(slot)))
  #define DMA_V(t,slot) glds16(vsrc8+(long)KROW(t)*64,(unsigned)__builtin_amdgcn_readfirstlane(vdst+2*(slot)))
  const lds_cptr shm3=(lds_cptr)shm; const lds_cptr kp0=shm3+F8_K+(2*hi)*1024+r32*16; const lds_cptr vq0=shm3+F8_V+(2*hi)*1024+r32*16;
  glds16(ksrc8+(long)KROW(TR)*64,(unsigned)__builtin_amdgcn_readfirstlane(lds0+F8_V+4*F8_S+(wid&3)*1024));
  DMA_K(0,0);DMA_V(0,0);DMA_K(1,F8_S);
  i32x8a q8; { const unsigned char*qp=Q8w0+(long)(wid*QBLK+r32)*64+32*hi; q8=cat8a(*reinterpret_cast<const i32x4a*>(qp),*reinterpret_cast<const i32x4a*>(qp+16)); }
  i32x8a k8a,k8b;
  float l_reg=0.f;f32x16 o[2*VW];
  #pragma unroll
  for(int d0=0;d0<2*VW;++d0)o[d0]=f32x16{};
  const f32x16 zero16=f32x16{};
  #define CMASK(P0,P1,t) do{ if constexpr(ISC){ if(wid&1) cbias_par<1>(P0,P1,(t),kr0,r0,wid,r32,hi,bt); else cbias_par<0>(P0,P1,(t),kr0,r0,wid,r32,hi,bt); } }while(0)
  f32x16 pA0,pA1,pB0,pB1;
  int sl_prev=0,sl_cur=0,sl_next=F8_S;
  #define ROT() do{sl_prev=sl_cur;sl_cur=sl_next;sl_next=(sl_next==2*F8_S)?0:sl_next+F8_S;}while(0)
  DMA_K(2,2*F8_S);
  WAIT_BAR(5);
  if(tid==0)*(volatile unsigned*)(shm+F8_WS)=0u;
  f32x16 negc;
  { const lds_cptr kr_=shm3+F8_V+4*F8_S+(2*hi)*1024+r32*16;
    pA0=MF8(kfrag8(kr_),q8,zero16); pA1=MF8(kfrag8(kr_+512),q8,zero16);
    asm volatile("s_nop 15\n\ts_nop 7":"+v"(pA0),"+v"(pA1));CMASK(pA0,pA1,TR);
    float ts=0.f;
    if constexpr(ISC){ _Pragma("unroll") for(int r=0;r<16;++r){ts+=__builtin_amdgcn_exp2f(pA0[r]);ts+=__builtin_amdgcn_exp2f(pA1[r]);} }
    else { _Pragma("unroll") for(int r=0;r<16;++r){ts+=pA0[r];ts+=pA1[r];} }
    {auto rr=__builtin_amdgcn_permlane32_swap(__float_as_uint(ts),__float_as_uint(ts),false,false);ts=__uint_as_float(rr[0])+__uint_as_float(rr[1]);}
    const float nc=ISC?F8_LOGK-__builtin_amdgcn_logf(ts):-(ts*(1.0f/64.0f))-(float)FB;
    _Pragma("unroll") for(int r=0;r<16;++r)negc[r]=nc; }
  pA0=MF8(kfrag8(kp0),q8,negc); pA1=MF8(kfrag8(kp0+512),q8,negc);
  asm volatile("s_nop 15\n\ts_nop 7":"+v"(pA0),"+v"(pA1));CMASK(pA0,pA1,0);
  _Pragma("unroll") for(int r=0;r<16;++r){pA0[r]=__builtin_amdgcn_exp2f(pA0[r]);pA1[r]=__builtin_amdgcn_exp2f(pA1[r]);}
  WAIT_BAR(0);
  DMA_K(3,0);DMA_V(1,F8_S);
  ROT();
  k8a=kfrag8(kp0+sl_cur); k8b=kfrag8(kp0+sl_cur+512);
  WAIT_BAR(2);
  i32x8a vfa[2]; i32x8a pq=i32x8a{};
  #define PIN(x) asm volatile("":"+v"(x))
  #define EX(v) __builtin_amdgcn_exp2f(v)
  #define CV8(P,B,W) W=__builtin_amdgcn_cvt_pk_fp8_f32(P[B],P[(B)+1],W,false); W=__builtin_amdgcn_cvt_pk_fp8_f32(P[(B)+2],P[(B)+3],W,true)
  #define VOFF(dq) (((dq)>>1)*4096+((dq)&1)*512)
  #define SUM8(P,B) do{ sacc+=P[B]; sacc+=P[(B)+1]; sacc+=P[(B)+2]; sacc+=P[(B)+3]; sacc+=P[(B)+4]; sacc+=P[(B)+5]; sacc+=P[(B)+6]; sacc+=P[(B)+7]; PIN(sacc); }while(0)
  #define PK8(P,B,I) do{ int w0_=pq[I],w1_=pq[(I)+1]; CV8(P,B,w0_); CV8(P,(B)+4,w1_); pq[I]=w0_; pq[(I)+1]=w1_; PIN(pq); }while(0)
  #define EXP8(X,B) do{ X[B]=EX(X[B]); X[(B)+1]=EX(X[(B)+1]); X[(B)+2]=EX(X[(B)+2]); X[(B)+3]=EX(X[(B)+3]); X[(B)+4]=EX(X[(B)+4]); X[(B)+5]=EX(X[(B)+5]); X[(B)+6]=EX(X[(B)+6]); X[(B)+7]=EX(X[(B)+7]); PIN(X); }while(0)
  #define RESCALE(P0,P1,HASC,C0,C1) do{ if(__builtin_expect(__any(sacc>F8_TRIG),0)){ \
      int ex_=((__float_as_int(sacc)>>23)&255)-133; ex_=ex_<0?0:ex_; \
      {auto rr=__builtin_amdgcn_permlane32_swap((unsigned)ex_,(unsigned)ex_,false,false); const int e0_=(int)rr[0],e1_=(int)rr[1]; ex_=e0_>e1_?e0_:e1_;} \
      const float f_=__builtin_amdgcn_ldexpf(1.0f,-ex_), d_=(float)ex_; \
      _Pragma("unroll") for(int r=0;r<16;++r){P0[r]*=f_;P1[r]*=f_;negc[r]-=d_;} \
      sacc*=f_; l_reg*=f_; \
      if constexpr(HASC){ _Pragma("unroll") for(int r=0;r<16;++r){C0[r]-=d_;C1[r]-=d_;} } \
      if(hi==0)wsf[32+r32]=f_; asm volatile("s_waitcnt lgkmcnt(0)":::"memory"); \
      _Pragma("unroll") for(int r=0;r<16;++r){ const float fr_=wsf[32+crow(r,hi)]; _Pragma("unroll") for(int dq=0;dq<2*VW;++dq)o[dq][r]*=fr_; } \
      asm volatile("s_waitcnt lgkmcnt(0)":::"memory"); } }while(0)
  #define STEP(C0,C1,P0,P1,t,GK,GV,GL) do{ SBAR(); \
    const lds_cptr vq_=vq0+2*sl_prev; \
    vfa[0]=kfrag8(vq_+VOFF(0)); SBAR(); \
    float sacc=0.f; \
    C0=MF8(k8a,q8,negc); SBAR(); \
    SUM8(P0,0); SBAR(); \
    vfa[1]=kfrag8(vq_+VOFF(1)); SBAR(); \
    SUM8(P0,8); SBAR(); \
    C1=MF8(k8b,q8,negc); SBAR(); \
    SUM8(P1,0); SUM8(P1,8); SBAR(); \
    RESCALE(P0,P1,true,C0,C1); \
    PK8(P0,0,0); PK8(P0,8,2); PK8(P1,0,4); PK8(P1,8,6); SBAR(); \
    l_reg+=sacc; \
    if(GK){DMA_K((t)+3,sl_cur);} if(GV){DMA_V((t)+1,sl_next);} \
    CMASK(C0,C1,t); \
    SBAR(); \
    if constexpr(VW==1){ \
      o[0]=MF8(pq,vfa[0],o[0]); SBAR(); EXP8(C0,0); SBAR(); \
      if(GL){ k8a=kfrag8(kp0+sl_next); SBAR(); } EXP8(C0,8); SBAR(); \
      o[1]=MF8(pq,vfa[1],o[1]); SBAR(); EXP8(C1,0); SBAR(); \
      if(GL){ k8b=kfrag8(kp0+sl_next+512); SBAR(); } EXP8(C1,8); SBAR(); \
    } else { \
      o[0]=MF8(pq,vfa[0],o[0]); SBAR(); vfa[0]=kfrag8(vq_+VOFF(2)); SBAR(); EXP8(C0,0); SBAR(); \
      o[1]=MF8(pq,vfa[1],o[1]); SBAR(); vfa[1]=kfrag8(vq_+VOFF(3)); SBAR(); if(GL){ k8a=kfrag8(kp0+sl_next); SBAR(); } EXP8(C0,8); SBAR(); \
      o[2]=MF8(pq,vfa[0],o[2]); SBAR(); EXP8(C1,0); SBAR(); \
      o[3]=MF8(pq,vfa[1],o[3]); SBAR(); if(GL){ k8b=kfrag8(kp0+sl_next+512); SBAR(); } EXP8(C1,8); SBAR(); \
    } \
    }while(0)
  int t=1;
  for(;t+5<NT;t+=2){
    STEP(pB0,pB1,pA0,pA1,t,true,true,true);     WAIT_BAR(2); ROT();
    STEP(pA0,pA1,pB0,pB1,t+1,true,true,true);   WAIT_BAR(2); ROT();
  }
  #define ENDW(tt) do{ if((tt)+3<NT){WAIT_BAR(2);} else if((tt)+2<NT){WAIT_BAR(1);} else {WAIT_BAR(0);} }while(0)
  for(;t+1<NT;t+=2){
    STEP(pB0,pB1,pA0,pA1,t,(t+3<NT),(t+1<NT),(t+1<NT));       ENDW(t);   ROT();
    STEP(pA0,pA1,pB0,pB1,t+1,(t+4<NT),(t+2<NT),(t+2<NT));     ENDW(t+1); ROT();
  }
  STEP(pB0,pB1,pA0,pA1,NT-1,false,false,false);
  { const lds_cptr vq_=vq0+2*sl_cur;
    float sacc=0.f; SUM8(pB0,0); SUM8(pB0,8); SUM8(pB1,0); SUM8(pB1,8); RESCALE(pB0,pB1,false,pB0,pB1); l_reg+=sacc;
    PK8(pB0,0,0); PK8(pB0,8,2); PK8(pB1,0,4); PK8(pB1,8,6); SBAR();
    #pragma unroll
    for(int dq=0;dq<2*VW;++dq)o[dq]=MF8(pq,kfrag8(vq_+VOFF(dq)),o[dq]); }
  #undef PIN
  #undef EX
  #undef CV8
  #undef VOFF
  #undef SUM8
  #undef PK8
  #undef EXP8
  #undef STEP
  #undef RESCALE
  #undef ENDW
  float rli[16];
  {auto rr=__builtin_amdgcn_permlane32_swap(__float_as_uint(l_reg),__float_as_uint(l_reg),false,false);l_reg=__uint_as_float(rr[0])+__uint_as_float(rr[1]);}
  if(__any(!((l_reg>F8_LMINF*(float)NT||!(F8_CHK&1))&&(l_reg<FS_LMAX||!(F8_CHK&4))&&!(F8_CHK&8)))){ if(lane==0)*(volatile unsigned*)(shm+F8_WS)=1u; }
  if(hi==0)wsf[32+r32]=l_reg;asm volatile("s_waitcnt lgkmcnt(0)":::"memory");
  #pragma unroll
  for(int r=0;r<16;++r)rli[r]=__builtin_amdgcn_rcpf(wsf[32+crow(r,hi)])*(1.0f/V8_SCALE);
  bf16*Ow=Ow0+(long)(wid*QBLK)*OPITCH;
  #pragma unroll
  for(int hv=0;hv<VW;++hv){ bf16*stg=(bf16*)(shm+F8_OST)+wid*2048;
    #pragma unroll
    for(int r=0;r<16;++r){const int orow=crow(r,hi);
      #pragma unroll
      for(int d0=0;d0<2;++d0)stg[orow*64+d0*32+r32]=__float2bfloat16(o[2*hv+d0][r]*rli[r]);}
    asm volatile("s_waitcnt lgkmcnt(0)":::"memory");
    #pragma unroll
    for(int i=0;i<4;++i){const int row=i*8+(lane>>3),ch=lane&7; const u32x4 v=*(const u32x4*)(stg+row*64+ch*8); ATTN_STORE16(Ow+(long)row*OPITCH+hv*64+ch*8,v);}
    asm volatile("s_waitcnt lgkmcnt(0)":::"memory"); }
  asm volatile("s_waitcnt lgkmcnt(0)\n\ts_barrier":::"memory");
  const bool redo=*(volatile unsigned*)(shm+F8_WS)!=0u;
  #undef DMA_K
  #undef KROW
  #undef DMA_V
  #undef CMASK
  #undef ROT
  return redo;
}
#undef MF8
#undef F8_PMEAN
#undef F8_LOGK
#undef F8_LMINF
constexpr int ATTN_FS8_LDS_BYTES=F8_BYTES;
#ifndef F8_MSUM
#define F8_MSUM 0
#endif
constexpr int P8_K=0, P8_V=2*8192, P8_WS=P8_V+2*16384, P8_OST=P8_WS+NW*64*4, P8_BYTES=P8_OST+NW*4096;
#define F8_PMEAN (1.0f/(float)(1<<FB))
#define F8_LOGK (6.0f-(float)FB)
#define F8_LMINF (2.0f*F8_PMEAN)
#define MF8(a,b,c) __builtin_amdgcn_mfma_scale_f32_32x32x64_f8f6f4(a,b,c,0,0,0,0,0,0)
template<int VW,bool ISC,int FB> __device__ __forceinline__ bool attn_fs8p(const unsigned char*__restrict__ VTh,int TR,bf16*Ow0,int NT,int kr0,int r0,lds_cfptr bt,char*shm,const unsigned char*Q8w0,const unsigned char*__restrict__ K8h){
  int tid_=threadIdx.x; asm volatile("; LAUNDER":"+v"(tid_)); const int tid=tid_,lane=tid&63,r32=lane&31,hi=lane>>5; const int wid=__builtin_amdgcn_readfirstlane(tid>>6);
  const unsigned lds0=(unsigned)(uintptr_t)shm;
  float*wsf=(float*)(shm+P8_WS)+wid*64;
  constexpr int VTS=4096*VW, VSL=2*VTS;
  const int wt=wid>>2, wc4=wid&3;
  const unsigned char*ksrc8=K8h+(long)lane*64+wc4*16;
  const unsigned char*vsrc8=VTh+(long)lane*64+wc4*16;
  const unsigned kdst=lds0+P8_K+wt*4096+wc4*1024, vdst=lds0+P8_V+wt*VTS+wc4*1024;
  #define KROW(t) (ISC ? ((t)<4 ? 64*(t) : 256+64*(kr0+(t)-4)) : 64*(t))
  #define DMA_KP(p) glds16(ksrc8+(long)KROW(2*(p)+wt)*64,(unsigned)__builtin_amdgcn_readfirstlane(kdst+((p)&1)*8192))
  #define DMA_VP(p) do{ glds16(vsrc8+(long)KROW(2*(p)+wt)*64,(unsigned)__builtin_amdgcn_readfirstlane(vdst+((p)&1)*VSL)); \
      if constexpr(VW==2){ glds16(vsrc8+VT_BLK+(long)KROW(2*(p)+wt)*64,(unsigned)__builtin_amdgcn_readfirstlane(vdst+((p)&1)*VSL+4096)); } }while(0)
  const lds_cptr shm3=(lds_cptr)shm; const lds_cptr kp0=shm3+P8_K+(2*hi)*1024+r32*16; const lds_cptr vq0=shm3+P8_V+(2*hi)*1024+r32*16;
  #define KADR(t) (kp0+(((t)>>1)&1)*8192+((t)&1)*4096)
  #define VADR(t) (vq0+(((t)>>1)&1)*VSL+((t)&1)*VTS)
  glds16(ksrc8+(long)KROW(TR)*64,(unsigned)__builtin_amdgcn_readfirstlane(lds0+P8_V+VSL+wc4*1024));
  DMA_KP(0);DMA_VP(0);DMA_KP(1);
  i32x8a q8; { const unsigned char*qp=Q8w0+(long)(wid*QBLK+r32)*64+32*hi; q8=cat8a(*reinterpret_cast<const i32x4a*>(qp),*reinterpret_cast<const i32x4a*>(qp+16)); }
  i32x8a k8a,k8b;
  constexpr bool MS=(VW==1)&&(F8_MSUM!=0);
  float l_reg=0.f;f32x16 o[2*VW]; f32x16 lsum=f32x16{}; const i32x8a ones8=(i32x8a){0x38383838,0x38383838,0x38383838,0x38383838,0x38383838,0x38383838,0x38383838,0x38383838};
  #pragma unroll
  for(int d0=0;d0<2*VW;++d0)o[d0]=f32x16{};
  const f32x16 zero16=f32x16{};
  #define CMASK(P0,P1,t) do{ if constexpr(ISC){ if(wid&1) cbias_par<1>(P0,P1,(t),kr0,r0,wid,r32,hi,bt); else cbias_par<0>(P0,P1,(t),kr0,r0,wid,r32,hi,bt); } }while(0)
  f32x16 pA0,pA1,pB0,pB1;
  WAIT_BAR(0);
  if(tid==0)*(volatile unsigned*)(shm+P8_WS)=0u;
  f32x16 negc;
  { const lds_cptr kr_=shm3+P8_V+VSL+(2*hi)*1024+r32*16;
    pA0=MF8(kfrag8(kr_),q8,zero16); pA1=MF8(kfrag8(kr_+512),q8,zero16);
    asm volatile("s_nop 15\n\ts_nop 7":"+v"(pA0),"+v"(pA1));CMASK(pA0,pA1,TR);
    float ts=0.f;
    if constexpr(ISC){ _Pragma("unroll") for(int r=0;r<16;++r){ts+=__builtin_amdgcn_exp2f(pA0[r]);ts+=__builtin_amdgcn_exp2f(pA1[r]);} }
    else { _Pragma("unroll") for(int r=0;r<16;++r){ts+=pA0[r];ts+=pA1[r];} }
    {auto rr=__builtin_amdgcn_permlane32_swap(__float_as_uint(ts),__float_as_uint(ts),false,false);ts=__uint_as_float(rr[0])+__uint_as_float(rr[1]);}
    const float nc=ISC?F8_LOGK-__builtin_amdgcn_logf(ts):-(ts*(1.0f/64.0f))-(float)FB;
    _Pragma("unroll") for(int r=0;r<16;++r)negc[r]=nc; }
  pA0=MF8(kfrag8(KADR(0)),q8,negc); pA1=MF8(kfrag8(KADR(0)+512),q8,negc);
  asm volatile("s_nop 15\n\ts_nop 7":"+v"(pA0),"+v"(pA1));CMASK(pA0,pA1,0);
  _Pragma("unroll") for(int r=0;r<16;++r){pA0[r]=__builtin_amdgcn_exp2f(pA0[r]);pA1[r]=__builtin_amdgcn_exp2f(pA1[r]);}
  k8a=kfrag8(KADR(1)); k8b=kfrag8(KADR(1)+512);
  WAIT_BAR(0);
  i32x8a vfa[2]; i32x8a pq=i32x8a{};
  #define PIN(x) asm volatile("":"+v"(x))
  #define EX(v) __builtin_amdgcn_exp2f(v)
  #define CV8(P,B,W) W=__builtin_amdgcn_cvt_pk_fp8_f32(P[B],P[(B)+1],W,false); W=__builtin_amdgcn_cvt_pk_fp8_f32(P[(B)+2],P[(B)+3],W,true)
  #define VOFF(dq) (((dq)>>1)*4096+((dq)&1)*512)
  #define MX3(a_,b_) asm("v_max3_f32 %0, %0, %1, %2":"+v"(sacc):"v"(a_),"v"(b_))
  #define SUM8(P,B) do{ if constexpr(MS){ MX3(P[B],P[(B)+1]); MX3(P[(B)+2],P[(B)+3]); MX3(P[(B)+4],P[(B)+5]); MX3(P[(B)+6],P[(B)+7]); PIN(sacc); } \
      else { sacc+=P[B]; sacc+=P[(B)+1]; sacc+=P[(B)+2]; sacc+=P[(B)+3]; sacc+=P[(B)+4]; sacc+=P[(B)+5]; sacc+=P[(B)+6]; sacc+=P[(B)+7]; PIN(sacc); } }while(0)
  #define PK8(P,B,I) do{ int w0_=pq[I],w1_=pq[(I)+1]; CV8(P,B,w0_); CV8(P,(B)+4,w1_); pq[I]=w0_; pq[(I)+1]=w1_; PIN(pq); }while(0)
  #define EXP8(X,B) do{ X[B]=EX(X[B]); X[(B)+1]=EX(X[(B)+1]); X[(B)+2]=EX(X[(B)+2]); X[(B)+3]=EX(X[(B)+3]); X[(B)+4]=EX(X[(B)+4]); X[(B)+5]=EX(X[(B)+5]); X[(B)+6]=EX(X[(B)+6]); X[(B)+7]=EX(X[(B)+7]); PIN(X); }while(0)
  #define RESCALE(P0,P1,HASC,C0,C1) do{ if(__builtin_expect(__any(sacc>F8_TRIG),0)){ \
      int ex_=((__float_as_int(sacc)>>23)&255)-133; ex_=ex_<0?0:ex_; \
      {auto rr=__builtin_amdgcn_permlane32_swap((unsigned)ex_,(unsigned)ex_,false,false); const int e0_=(int)rr[0],e1_=(int)rr[1]; ex_=e0_>e1_?e0_:e1_;} \
      const float f_=__builtin_amdgcn_ldexpf(1.0f,-ex_), d_=(float)ex_; \
      _Pragma("unroll") for(int r=0;r<16;++r){P0[r]*=f_;P1[r]*=f_;negc[r]-=d_;} \
      sacc*=f_; l_reg*=f_; \
      if constexpr(HASC){ _Pragma("unroll") for(int r=0;r<16;++r){C0[r]-=d_;C1[r]-=d_;} } \
      if(hi==0)wsf[32+r32]=f_; asm volatile("s_waitcnt lgkmcnt(0)":::"memory"); \
      _Pragma("unroll") for(int r=0;r<16;++r){ const float fr_=wsf[32+crow(r,hi)]; _Pragma("unroll") for(int dq=0;dq<2*VW;++dq)o[dq][r]*=fr_; if constexpr(MS){lsum[r]*=fr_;} } \
      asm volatile("s_waitcnt lgkmcnt(0)":::"memory"); } }while(0)
  #define STEP(C0,C1,P0,P1,t,VQ,KN,GL) do{ SBAR(); \
    const lds_cptr vq_=(VQ); const lds_cptr kn_=(KN); \
    vfa[0]=kfrag8(vq_+VOFF(0)); SBAR(); \
    float sacc=0.f; \
    C0=MF8(k8a,q8,negc); SBAR(); \
    SUM8(P0,0); SBAR(); \
    vfa[1]=kfrag8(vq_+VOFF(1)); SBAR(); \
    SUM8(P0,8); SBAR(); \
    C1=MF8(k8b,q8,negc); SBAR(); \
    SUM8(P1,0); SUM8(P1,8); SBAR(); \
    RESCALE(P0,P1,true,C0,C1); \
    PK8(P0,0,0); PK8(P0,8,2); PK8(P1,0,4); PK8(P1,8,6); SBAR(); \
    if constexpr(!MS){ l_reg+=sacc; } \
    CMASK(C0,C1,t); \
    SBAR(); \
    if constexpr(VW==1){ \
      o[0]=MF8(pq,vfa[0],o[0]); SBAR(); EXP8(C0,0); SBAR(); \
      if(GL){ k8a=kfrag8(kn_); SBAR(); } EXP8(C0,8); SBAR(); \
      o[1]=MF8(pq,vfa[1],o[1]); SBAR(); EXP8(C1,0); SBAR(); \
      if constexpr(MS){ lsum=MF8(pq,ones8,lsum); SBAR(); } \
      if(GL){ k8b=kfrag8(kn_+512); SBAR(); } EXP8(C1,8); SBAR(); \
    } else { \
      o[0]=MF8(pq,vfa[0],o[0]); SBAR(); vfa[0]=kfrag8(vq_+VOFF(2)); SBAR(); EXP8(C0,0); SBAR(); \
      o[1]=MF8(pq,vfa[1],o[1]); SBAR(); vfa[1]=kfrag8(vq_+VOFF(3)); SBAR(); if(GL){ k8a=kfrag8(kn_); SBAR(); } EXP8(C0,8); SBAR(); \
      o[2]=MF8(pq,vfa[0],o[2]); SBAR(); EXP8(C1,0); SBAR(); \
      o[3]=MF8(pq,vfa[1],o[3]); SBAR(); if(GL){ k8b=kfrag8(kn_+512); SBAR(); } EXP8(C1,8); SBAR(); \
    } \
    }while(0)
  const int NG=(NT>>1)-1;
  for(int g=0;g<NG;++g){
    if(g+2<(NT>>1)){DMA_KP(g+2);} DMA_VP(g+1);
    STEP(pB0,pB1,pA0,pA1,2*g+1,VADR(2*g),KADR(2*g+2),true);
    STEP(pA0,pA1,pB0,pB1,2*g+2,VADR(2*g+1),KADR(2*g+3),true);
    WAIT_BAR(0);
  }
  STEP(pB0,pB1,pA0,pA1,NT-1,VADR(NT-2),KADR(0),false);
  { const lds_cptr vq_=VADR(NT-1);
    float sacc=0.f; SUM8(pB0,0); SUM8(pB0,8); SUM8(pB1,0); SUM8(pB1,8); RESCALE(pB0,pB1,false,pB0,pB1); if constexpr(!MS){ l_reg+=sacc; }
    PK8(pB0,0,0); PK8(pB0,8,2); PK8(pB1,0,4); PK8(pB1,8,6); SBAR();
    if constexpr(MS){ lsum=MF8(pq,ones8,lsum); }
    #pragma unroll
    for(int dq=0;dq<2*VW;++dq)o[dq]=MF8(pq,kfrag8(vq_+VOFF(dq)),o[dq]); }
  #undef PIN
  #undef EX
  #undef CV8
  #undef VOFF
  #undef SUM8
  #undef MX3
  #undef PK8
  #undef EXP8
  #undef STEP
  #undef RESCALE
  float rli[16];
  if constexpr(MS){
    float mn=lsum[0],mx=lsum[0];
    #pragma unroll
    for(int r=1;r<16;++r){mn=fminf(mn,lsum[r]);mx=fmaxf(mx,lsum[r]);}
    bool bad=!((mn>F8_LMINF*(float)NT||!(F8_CHK&1))&&(mx<FS_LMAX||!(F8_CHK&4))&&!(F8_CHK&8));
    #pragma unroll
    for(int r=0;r<16;++r)bad=bad||(lsum[r]!=lsum[r]);
    if(__any(bad)){ if(lane==0)*(volatile unsigned*)(shm+P8_WS)=1u; }
    #pragma unroll
    for(int r=0;r<16;++r)rli[r]=__builtin_amdgcn_rcpf(lsum[r])*(1.0f/V8_SCALE);
  } else {
  {auto rr=__builtin_amdgcn_permlane32_swap(__float_as_uint(l_reg),__float_as_uint(l_reg),false,false);l_reg=__uint_as_float(rr[0])+__uint_as_float(rr[1]);}
  if(__any(!((l_reg>F8_LMINF*(float)NT||!(F8_CHK&1))&&(l_reg<FS_LMAX||!(F8_CHK&4))&&!(F8_CHK&8)))){ if(lane==0)*(volatile unsigned*)(shm+P8_WS)=1u; }
  if(hi==0)wsf[32+r32]=l_reg;asm volatile("s_waitcnt lgkmcnt(0)":::"memory");
  #pragma unroll
  for(int r=0;r<16;++r)rli[r]=__builtin_amdgcn_rcpf(wsf[32+crow(r,hi)])*(1.0f/V8_SCALE);
  }
  bf16*Ow=Ow0+(long)(wid*QBLK)*OPITCH;
  #pragma unroll
  for(int hv=0;hv<VW;++hv){ bf16*stg=(bf16*)(shm+P8_OST)+wid*2048;
    #pragma unroll
    for(int r=0;r<16;++r){const int orow=crow(r,hi);
      #pragma unroll
      for(int d0=0;d0<2;++d0)stg[orow*64+d0*32+r32]=__float2bfloat16(o[2*hv+d0][r]*rli[r]);}
    asm volatile("s_waitcnt lgkmcnt(0)":::"memory");
    #pragma unroll
    for(int i=0;i<4;++i){const int row=i*8+(lane>>3),ch=lane&7; const u32x4 v=*(const u32x4*)(stg+row*64+ch*8); ATTN_STORE16(Ow+(long)row*OPITCH+hv*64+ch*8,v);}
    asm volatile("s_waitcnt lgkmcnt(0)":::"memory"); }
  asm volatile("s_waitcnt lgkmcnt(0)\n\ts_barrier":::"memory");
  const bool redo=*(volatile unsigned*)(shm+P8_WS)!=0u;
  #undef DMA_KP
  #undef DMA_VP
  #undef KROW
  #undef KADR
  #undef VADR
  #undef CMASK
  return redo;
}
#undef MF8
#undef F8_PMEAN
#undef F8_LOGK
#undef F8_LMINF
constexpr int ATTN_FS8P_LDS_BYTES=P8_BYTES;
constexpr int Q8_K=0, Q8_V=2*16384, Q8_REF=Q8_V+2*32768, Q8_WS=Q8_REF+4096, Q8_OST=Q8_K, Q8_BYTES=Q8_WS+NW*64*4;
#define F8_PMEAN (1.0f/(float)(1<<FB))
#define F8_LOGK (6.0f-(float)FB)
#define F8_LMINF (2.0f*F8_PMEAN)
#define MF8(a,b,c) __builtin_amdgcn_mfma_scale_f32_32x32x64_f8f6f4(a,b,c,0,0,0,0,0,0)
template<int VW,bool ISC,int FB> __device__ __forceinline__ bool attn_fs8q(const unsigned char*__restrict__ VTh,int TR,bf16*Ow0,int NT,int kr0,int r0,lds_cfptr bt,char*shm,const unsigned char*Q8w0,const unsigned char*__restrict__ K8h){
  int tid_=threadIdx.x; asm volatile("; LAUNDER":"+v"(tid_)); const int tid=tid_,lane=tid&63,r32=lane&31,hi=lane>>5; const int wid=__builtin_amdgcn_readfirstlane(tid>>6);
  const unsigned lds0=(unsigned)(uintptr_t)shm;
  float*wsf=(float*)(shm+Q8_WS)+wid*64;
  constexpr bool MS=false;
  constexpr int VTS=4096*VW, VSL=4*VTS;
  const int wt=wid>>2, wc4=wid&3;
  const unsigned char*ksrc8=K8h+(long)lane*64+wc4*16;
  const unsigned char*vsrc8=VTh+(long)lane*64+wc4*16;
  #define KROW(t) (ISC ? ((t)<4 ? 64*(t) : 256+64*(kr0+(t)-4)) : 64*(t))
  #define DMA_KG(j) do{ _Pragma("unroll") for(int h_=0;h_<2;++h_){ const int ps_=wt+2*h_, tl_=4*(j)-3+ps_; \
      if(tl_>=0&&tl_<NT){ glds16(ksrc8+(long)KROW(tl_)*64,(unsigned)__builtin_amdgcn_readfirstlane(lds0+Q8_K+((j)&1)*16384+ps_*4096+wc4*1024)); } } }while(0)
  #define DMA_VQ(i) do{ _Pragma("unroll") for(int h_=0;h_<2;++h_){ const int ps_=wt+2*h_, tl_=4*(i)+ps_; \
      glds16(vsrc8+(long)KROW(tl_)*64,(unsigned)__builtin_amdgcn_readfirstlane(lds0+Q8_V+((i)&1)*VSL+ps_*VTS+wc4*1024)); \
      if constexpr(VW==2){ glds16(vsrc8+VT_BLK+(long)KROW(tl_)*64,(unsigned)__builtin_amdgcn_readfirstlane(lds0+Q8_V+((i)&1)*VSL+ps_*VTS+4096+wc4*1024)); } } }while(0)
  const lds_cptr shm3=(lds_cptr)shm; const lds_cptr kp0=shm3+Q8_K+(2*hi)*1024+r32*16; const lds_cptr vq0=shm3+Q8_V+(2*hi)*1024+r32*16;
  #define KADR(t) (kp0+((((t)+3)>>2)&1)*16384+(((t)+3)&3)*4096)
  #define VADR(t) (vq0+(((t)>>2)&1)*VSL+((t)&3)*VTS)
  glds16(ksrc8+(long)KROW(TR)*64,(unsigned)__builtin_amdgcn_readfirstlane(lds0+Q8_REF+wc4*1024));
  DMA_KG(0);DMA_KG(1);DMA_VQ(0);
  i32x8a q8; { const unsigned char*qp=Q8w0+(long)(wid*QBLK+r32)*64+32*hi; q8=cat8a(*reinterpret_cast<const i32x4a*>(qp),*reinterpret_cast<const i32x4a*>(qp+16)); }
  i32x8a k8a,k8b;
  float l_reg=0.f;f32x16 o[2*VW]; f32x16 lsum=f32x16{}; const i32x8a ones8=i32x8a{};
  #pragma unroll
  for(int d0=0;d0<2*VW;++d0)o[d0]=f32x16{};
  const f32x16 zero16=f32x16{};
  #define CMASK(P0,P1,t) do{ if constexpr(ISC){ if(wid&1) cbias_par<1>(P0,P1,(t),kr0,r0,wid,r32,hi,bt); else cbias_par<0>(P0,P1,(t),kr0,r0,wid,r32,hi,bt); } }while(0)
  f32x16 pA0,pA1,pB0,pB1;
  WAIT_BAR(0);
  if(tid==0)*(volatile unsigned*)(shm+Q8_WS)=0u;
  f32x16 negc;
  { const lds_cptr kr_=shm3+Q8_REF+(2*hi)*1024+r32*16;
    pA0=MF8(kfrag8(kr_),q8,zero16); pA1=MF8(kfrag8(kr_+512),q8,zero16);
    asm volatile("s_nop 15\n\ts_nop 7":"+v"(pA0),"+v"(pA1));CMASK(pA0,pA1,TR);
    float ts=0.f;
    if constexpr(ISC){ _Pragma("unroll") for(int r=0;r<16;++r){ts+=__builtin_amdgcn_exp2f(pA0[r]);ts+=__builtin_amdgcn_exp2f(pA1[r]);} }
    else { _Pragma("unroll") for(int r=0;r<16;++r){ts+=pA0[r];ts+=pA1[r];} }
    {auto rr=__builtin_amdgcn_permlane32_swap(__float_as_uint(ts),__float_as_uint(ts),false,false);ts=__uint_as_float(rr[0])+__uint_as_float(rr[1]);}
    const float nc=ISC?F8_LOGK-__builtin_amdgcn_logf(ts):-(ts*(1.0f/64.0f))-(float)FB;
    _Pragma("unroll") for(int r=0;r<16;++r)negc[r]=nc; }
  pA0=MF8(kfrag8(KADR(0)),q8,negc); pA1=MF8(kfrag8(KADR(0)+512),q8,negc);
  asm volatile("s_nop 15\n\ts_nop 7":"+v"(pA0),"+v"(pA1));CMASK(pA0,pA1,0);
  _Pragma("unroll") for(int r=0;r<16;++r){pA0[r]=__builtin_amdgcn_exp2f(pA0[r]);pA1[r]=__builtin_amdgcn_exp2f(pA1[r]);}
  WAIT_BAR(0);
  i32x8a vfa[2]; i32x8a pq=i32x8a{};
  #define PIN(x) asm volatile("":"+v"(x))
  #define EX(v) __builtin_amdgcn_exp2f(v)
  #define CV8(P,B,W) W=__builtin_amdgcn_cvt_pk_fp8_f32(P[B],P[(B)+1],W,false); W=__builtin_amdgcn_cvt_pk_fp8_f32(P[(B)+2],P[(B)+3],W,true)
  #define VOFF(dq) (((dq)>>1)*4096+((dq)&1)*512)
  #define MX3(a_,b_) asm("v_max3_f32 %0, %0, %1, %2":"+v"(sacc):"v"(a_),"v"(b_))
  #define SUM8(P,B) do{ if constexpr(MS){ MX3(P[B],P[(B)+1]); MX3(P[(B)+2],P[(B)+3]); MX3(P[(B)+4],P[(B)+5]); MX3(P[(B)+6],P[(B)+7]); PIN(sacc); } \
      else { sacc+=P[B]; sacc+=P[(B)+1]; sacc+=P[(B)+2]; sacc+=P[(B)+3]; sacc+=P[(B)+4]; sacc+=P[(B)+5]; sacc+=P[(B)+6]; sacc+=P[(B)+7]; PIN(sacc); } }while(0)
  #define PK8(P,B,I) do{ int w0_=pq[I],w1_=pq[(I)+1]; CV8(P,B,w0_); CV8(P,(B)+4,w1_); pq[I]=w0_; pq[(I)+1]=w1_; PIN(pq); }while(0)
  #define EXP8(X,B) do{ X[B]=EX(X[B]); X[(B)+1]=EX(X[(B)+1]); X[(B)+2]=EX(X[(B)+2]); X[(B)+3]=EX(X[(B)+3]); X[(B)+4]=EX(X[(B)+4]); X[(B)+5]=EX(X[(B)+5]); X[(B)+6]=EX(X[(B)+6]); X[(B)+7]=EX(X[(B)+7]); PIN(X); }while(0)
  #define RESCALE(P0,P1,HASC,C0,C1) do{ if(__builtin_expect(__any(sacc>F8_TRIG),0)){ \
      int ex_=((__float_as_int(sacc)>>23)&255)-133; ex_=ex_<0?0:ex_; \
      {auto rr=__builtin_amdgcn_permlane32_swap((unsigned)ex_,(unsigned)ex_,false,false); const int e0_=(int)rr[0],e1_=(int)rr[1]; ex_=e0_>e1_?e0_:e1_;} \
      const float f_=__builtin_amdgcn_ldexpf(1.0f,-ex_), d_=(float)ex_; \
      _Pragma("unroll") for(int r=0;r<16;++r){P0[r]*=f_;P1[r]*=f_;negc[r]-=d_;} \
      sacc*=f_; l_reg*=f_; \
      if constexpr(HASC){ _Pragma("unroll") for(int r=0;r<16;++r){C0[r]-=d_;C1[r]-=d_;} } \
      if(hi==0)wsf[32+r32]=f_; asm volatile("s_waitcnt lgkmcnt(0)":::"memory"); \
      _Pragma("unroll") for(int r=0;r<16;++r){ const float fr_=wsf[32+crow(r,hi)]; _Pragma("unroll") for(int dq=0;dq<2*VW;++dq)o[dq][r]*=fr_; if constexpr(MS){lsum[r]*=fr_;} } \
      asm volatile("s_waitcnt lgkmcnt(0)":::"memory"); } }while(0)
  #define STEP(C0,C1,P0,P1,t,KFIRST,GL) do{ SBAR(); \
    const lds_cptr vq_=VADR((t)-1); const lds_cptr kn_=KADR((t)+1); \
    if(KFIRST){ k8a=kfrag8(KADR(t)); k8b=kfrag8(KADR(t)+512); SBAR(); } \
    vfa[0]=kfrag8(vq_+VOFF(0)); SBAR(); \
    float sacc=0.f; \
    C0=MF8(k8a,q8,negc); SBAR(); \
    SUM8(P0,0); SBAR(); \
    vfa[1]=kfrag8(vq_+VOFF(1)); SBAR(); \
    SUM8(P0,8); SBAR(); \
    C1=MF8(k8b,q8,negc); SBAR(); \
    SUM8(P1,0); SUM8(P1,8); SBAR(); \
    RESCALE(P0,P1,true,C0,C1); \
    PK8(P0,0,0); PK8(P0,8,2); PK8(P1,0,4); PK8(P1,8,6); SBAR(); \
    if constexpr(!MS){ l_reg+=sacc; } \
    CMASK(C0,C1,t); \
    SBAR(); \
    if constexpr(VW==1){ \
      o[0]=MF8(pq,vfa[0],o[0]); SBAR(); EXP8(C0,0); SBAR(); \
      if(GL){ k8a=kfrag8(kn_); SBAR(); } EXP8(C0,8); SBAR(); \
      o[1]=MF8(pq,vfa[1],o[1]); SBAR(); EXP8(C1,0); SBAR(); \
      if constexpr(MS){ lsum=MF8(pq,ones8,lsum); SBAR(); } \
      if(GL){ k8b=kfrag8(kn_+512); SBAR(); } EXP8(C1,8); SBAR(); \
    } else { \
      o[0]=MF8(pq,vfa[0],o[0]); SBAR(); vfa[0]=kfrag8(vq_+VOFF(2)); SBAR(); EXP8(C0,0); SBAR(); \
      o[1]=MF8(pq,vfa[1],o[1]); SBAR(); vfa[1]=kfrag8(vq_+VOFF(3)); SBAR(); if(GL){ k8a=kfrag8(kn_); SBAR(); } EXP8(C0,8); SBAR(); \
      o[2]=MF8(pq,vfa[0],o[2]); SBAR(); EXP8(C1,0); SBAR(); \
      o[3]=MF8(pq,vfa[1],o[3]); SBAR(); if(GL){ k8b=kfrag8(kn_+512); SBAR(); } EXP8(C1,8); SBAR(); \
    } \
    }while(0)
  const int NGq=NT>>2;
  for(int g=0;g<NGq-1;++g){
    DMA_KG(g+2); DMA_VQ(g+1);
    STEP(pB0,pB1,pA0,pA1,4*g+1,true,true);
    STEP(pA0,pA1,pB0,pB1,4*g+2,false,true);
    STEP(pB0,pB1,pA0,pA1,4*g+3,false,true);
    STEP(pA0,pA1,pB0,pB1,4*g+4,false,false);
    WAIT_BAR(0);
  }
  STEP(pB0,pB1,pA0,pA1,NT-3,true,true);
  STEP(pA0,pA1,pB0,pB1,NT-2,false,true);
  STEP(pB0,pB1,pA0,pA1,NT-1,false,false);
  WAIT_BAR(0);
  { const lds_cptr vq_=VADR(NT-1);
    float sacc=0.f; SUM8(pB0,0); SUM8(pB0,8); SUM8(pB1,0); SUM8(pB1,8); RESCALE(pB0,pB1,false,pB0,pB1); l_reg+=sacc;
    PK8(pB0,0,0); PK8(pB0,8,2); PK8(pB1,0,4); PK8(pB1,8,6); SBAR();
    #pragma unroll
    for(int dq=0;dq<2*VW;++dq)o[dq]=MF8(pq,kfrag8(vq_+VOFF(dq)),o[dq]); }
  #undef PIN
  #undef EX
  #undef CV8
  #undef VOFF
  #undef SUM8
  #undef MX3
  #undef PK8
  #undef EXP8
  #undef STEP
  #undef RESCALE
  float rli[16];
  if constexpr(MS){
    float mn=lsum[0],mx=lsum[0];
    #pragma unroll
    for(int r=1;r<16;++r){mn=fminf(mn,lsum[r]);mx=fmaxf(mx,lsum[r]);}
    bool bad=!((mn>F8_LMINF*(float)NT||!(F8_CHK&1))&&(mx<FS_LMAX||!(F8_CHK&4))&&!(F8_CHK&8));
    #pragma unroll
    for(int r=0;r<16;++r)bad=bad||(lsum[r]!=lsum[r]);
    if(__any(bad)){ if(lane==0)*(volatile unsigned*)(shm+Q8_WS)=1u; }
    #pragma unroll
    for(int r=0;r<16;++r)rli[r]=__builtin_amdgcn_rcpf(lsum[r])*(1.0f/V8_SCALE);
  } else {
  {auto rr=__builtin_amdgcn_permlane32_swap(__float_as_uint(l_reg),__float_as_uint(l_reg),false,false);l_reg=__uint_as_float(rr[0])+__uint_as_float(rr[1]);}
  if(__any(!((l_reg>F8_LMINF*(float)NT||!(F8_CHK&1))&&(l_reg<FS_LMAX||!(F8_CHK&4))&&!(F8_CHK&8)))){ if(lane==0)*(volatile unsigned*)(shm+Q8_WS)=1u; }
  if(hi==0)wsf[32+r32]=l_reg;asm volatile("s_waitcnt lgkmcnt(0)":::"memory");
  #pragma unroll
  for(int r=0;r<16;++r)rli[r]=__builtin_amdgcn_rcpf(wsf[32+crow(r,hi)])*(1.0f/V8_SCALE);
  }
  bf16*Ow=Ow0+(long)(wid*QBLK)*OPITCH;
  #pragma unroll
  for(int hv=0;hv<VW;++hv){ bf16*stg=(bf16*)(shm+Q8_OST)+wid*2048;
    #pragma unroll
    for(int r=0;r<16;++r){const int orow=crow(r,hi);
      #pragma unroll
      for(int d0=0;d0<2;++d0)stg[orow*64+d0*32+r32]=__float2bfloat16(o[2*hv+d0][r]*rli[r]);}
    asm volatile("s_waitcnt lgkmcnt(0)":::"memory");
    #pragma unroll
    for(int i=0;i<4;++i){const int row=i*8+(lane>>3),ch=lane&7; const u32x4 v=*(const u32x4*)(stg+row*64+ch*8); ATTN_STORE16(Ow+(long)row*OPITCH+hv*64+ch*8,v);}
    asm volatile("s_waitcnt lgkmcnt(0)":::"memory"); }
  asm volatile("s_waitcnt lgkmcnt(0)\n\ts_barrier":::"memory");
  const bool redo=*(volatile unsigned*)(shm+Q8_WS)!=0u;
  #undef DMA_KG
  #undef DMA_VQ
  #undef KROW
  #undef KADR
  #undef VADR
  #undef CMASK
  return redo;
}
#undef MF8
#undef F8_PMEAN
#undef F8_LOGK
#undef F8_LMINF
constexpr int ATTN_FS8Q_LDS_BYTES=Q8_BYTES;
#undef SBAR
#undef WAIT_BAR
}
#define GAS __attribute__((address_space(1)))
#define LAS __attribute__((address_space(3)))
typedef unsigned short bf16;
typedef unsigned v4u __attribute__((ext_vector_type(4)));
typedef float f32x4 __attribute__((ext_vector_type(4)));
typedef short bf16x8 __attribute__((ext_vector_type(8)));
typedef GAS unsigned gu32;
typedef GAS unsigned long long gu64;
#define RLX_AGENT __ATOMIC_RELAXED, __HIP_MEMORY_SCOPE_AGENT
#define LDS_WAIT() asm volatile("s_waitcnt lgkmcnt(0)" ::: "memory")
#define VM_WAIT() asm volatile("s_waitcnt vmcnt(0)" ::: "memory")
__device__ __forceinline__ unsigned long long rt() { return __builtin_amdgcn_s_memrealtime(); }
__device__ __forceinline__ unsigned f2bf(float f) { unsigned u = __builtin_bit_cast(unsigned, f); return (u + 0x7fffu + ((u >> 16) & 1u)) >> 16; }
__device__ __forceinline__ unsigned pk2(float lo, float hi) { return f2bf(lo) | (f2bf(hi) << 16); }

#define XB_TMO      128
#define XB_XCNT(j)  (256  + 64 * (j))
#define XB_XSUB(j)  (1280 + 64 * (j))
#define XB_XGEN(j)  (2304 + 64 * (j))
#define XB_TOP      3328
#define XB_TOPGEN   3392
#define XCD_BAR_WORDS 3456
#define XB_SPIN_CAP (1u << 22)

__device__ __forceinline__ unsigned xb_ld(unsigned* p)              { return __hip_atomic_load(p, __ATOMIC_RELAXED, __HIP_MEMORY_SCOPE_AGENT); }
__device__ __forceinline__ unsigned xb_add(unsigned* p, unsigned v) { return __hip_atomic_fetch_add(p, v, __ATOMIC_RELAXED, __HIP_MEMORY_SCOPE_AGENT); }
__device__ __forceinline__ unsigned xb_xcc_id() { return (unsigned)__builtin_amdgcn_s_getreg((3 << 11) | 20) & 0xFu; }
#define XB_SPIN(cond, bar) do { unsigned _sp = 0; while (cond) { __builtin_amdgcn_s_sleep(1); \
    if ((++_sp & 255u) == 0u) { if (xb_ld(&(bar)[XB_TMO])) break; if (_sp > XB_SPIN_CAP) { atomicAdd(&(bar)[XB_TMO], 1u); break; } } } } while (0)

struct XcdBarrier {
    unsigned* bar; unsigned x;
    volatile LAS unsigned* st;
};

__device__ __forceinline__ XcdBarrier xcd_barrier_post(unsigned* bar, volatile LAS unsigned* st) {
    XcdBarrier b; b.bar = bar; b.x = xb_xcc_id(); b.st = st;
    if (threadIdx.x == 0) (void)xb_add(&bar[XB_XCNT(b.x)], 1u);
    return b;
}
__device__ __forceinline__ void xcd_barrier_complete(unsigned* bar, unsigned x, unsigned& nloc, unsigned& nx) {
    const unsigned G = gridDim.x * gridDim.y * gridDim.z;
    unsigned sum, cnt, mine, sp = 0u;
    for (;;) {
        sum = 0u; cnt = 0u; mine = 0u;
#pragma unroll
        for (unsigned j = 0; j < 16; ++j) { const unsigned c = xb_ld(&bar[XB_XCNT(j)]); sum += c; cnt += (c > 0u) ? 1u : 0u; mine = (j == x) ? c : mine; }
        if (sum == G) break;
        __builtin_amdgcn_s_sleep(1);
        if ((++sp & 255u) == 0u) { if (xb_ld(&bar[XB_TMO])) break; if (sp > XB_SPIN_CAP) { atomicAdd(&bar[XB_TMO], 1u); break; } }
    }
    nloc = mine > 0u ? mine : 1u; nx = cnt > 0u ? cnt : 1u;
}

__device__ __forceinline__ void xcd_barrier(const XcdBarrier& b) {
    asm volatile("s_waitcnt vmcnt(0)" ::: "memory");
    __syncthreads();
    if (threadIdx.x == 0) {
        unsigned* bar = b.bar;
        __builtin_amdgcn_s_waitcnt(0);
        unsigned nloc = b.st[0], nx = b.st[1];
        if (nloc == 0u) { xcd_barrier_complete(bar, b.x, nloc, nx); b.st[0] = nloc; b.st[1] = nx; }
        const unsigned old = xb_add(&bar[XB_XSUB(b.x)], 1u);
        const unsigned gen = old / nloc;
        if (old + 1u == (gen + 1u) * nloc) {
            __builtin_amdgcn_fence(__ATOMIC_RELEASE, "agent");
            asm volatile("s_waitcnt vmcnt(0)" ::: "memory");
            const unsigned og = xb_add(&bar[XB_TOP], 1u);
            const unsigned tg = og / nx;
            if (og + 1u == (tg + 1u) * nx) xb_add(&bar[XB_TOPGEN], 1u);
            else XB_SPIN(xb_ld(&bar[XB_TOPGEN]) == tg, bar);
            __builtin_amdgcn_fence(__ATOMIC_ACQUIRE, "agent");
            xb_add(&bar[XB_XGEN(b.x)], 1u);
            asm volatile("s_waitcnt vmcnt(0)" ::: "memory");
        } else {
            XB_SPIN(xb_ld(&bar[XB_XGEN(b.x)]) == gen, bar);
            __builtin_amdgcn_fence(__ATOMIC_ACQUIRE, "agent");
            asm volatile("s_waitcnt vmcnt(0)" ::: "memory");
        }
    }
    __syncthreads();
}

constexpr int NWAVES = 8;
constexpr int D = 1024, BATCH = 4, SEQ = 8192, DEPTH = 4, CTX = 256, NTOK = CTX + SEQ  , M = BATCH * NTOK  ;
constexpr int DIN = 6912;
constexpr int C_AQ = 0, C_AK = 512, C_AV = 640, C_BQ = 768, C_BK = 1280, C_BV = 1792, C_CQ = 2304, C_CK = 2816, C_CV = 3328, C_G = 3840;
constexpr int FF = 2816, NE = 8, FE = 3584;
constexpr int OPITCH = 2048, O_A = 0, O_B1 = 512, O_B2 = 1024, O_C = 1536;
constexpr int SMAX = 69632;
constexpr float EPS = 1e-6f;
constexpr float LOG2E = 1.4426950408889634f;
constexpr int PANELS_PER_B = NTOK / 256;
constexpr size_t QKV_BLK = (size_t)M * 64;
constexpr size_t WS_G_OFF = (size_t)248 << 20;
static_assert(attn_body::QKP == 64 && attn_body::OPITCH == OPITCH && attn_body::QKV_BLK == (long)QKV_BLK && 60 * QKV_BLK * 2 <= WS_G_OFF, "attention body pitches");
#ifndef CFG_ATT8
#define CFG_ATT8 1
#endif
constexpr bool ATT8 = CFG_ATT8;
__device__ __forceinline__ size_t q8_blk(int col) { const int b = col >> 6; return (size_t)(b < 10 ? b : b < 28 ? b - 2 : b - 10) * QKV_BLK; }
__device__ __forceinline__ size_t qkv_blk(int col) { return (size_t)(col >> 6) * QKV_BLK; }
enum { I_X = 0, I_C, I_CTX, I_CCTX, I_WMOD, I_BMOD, I_GMIX, I_GFFN, I_WIN, I_QNA, I_KNA, I_LQ1, I_LK1, I_LQ2, I_LK2, I_SUBLN, I_RPB, I_WBRA, I_WBRB, I_WBRC, I_WOUT,
       I_FW1, I_FW3, I_FW2, I_ROUTER, I_MW1, I_MW3, I_MW2, I_GFINAL, N_IN };

constexpr size_t MiB = 1u << 20;
constexpr size_t WS_CTL = 0, CTL_ZERO_BYTES = 1 * MiB;
constexpr size_t WS_MOD = 1 * MiB;
constexpr size_t WS_ROPE = 1 * MiB + 512 * 1024;
constexpr size_t WS_TOK = 2 * MiB;
constexpr size_t WS_WBASE = 3 * MiB + 512 * 1024;
constexpr size_t WS_XC = 4 * MiB;
constexpr size_t WS_W = 8 * MiB;
constexpr size_t WS_WIN = WS_W, WS_WBR = WS_W + 14 * MiB, WS_WOUT = WS_W + 17 * MiB, WS_W13 = WS_W + 19 * MiB, WS_W2 = WS_W + 131 * MiB;
constexpr size_t WS_XN = 196 * MiB;
constexpr size_t WS_MB = 262 * MiB;
constexpr size_t WS_P = 398 * MiB;
constexpr size_t WS_O = 844 * MiB;
constexpr size_t WS_YS = 874 * MiB;
constexpr bool TAIL_SPLIT = false;
constexpr size_t WS_PART = WS_MB + 64 * MiB;
constexpr size_t WS_XB = 1010 * MiB;
constexpr size_t WS_END = 1076 * MiB;
constexpr size_t WS_Q8 = WS_MB + 34 * MiB;
static_assert(WS_Q8 + (size_t)42 * M * 64 <= WS_P, "fp8 q/k blocks");
static_assert(WS_W2 + (size_t)NE * D * FE * 2 <= WS_XN && WS_XN + (size_t)M * D * 2 <= WS_MB && WS_MB + (size_t)SMAX * D * 2 <= WS_P && WS_MB + (size_t)M * D * 4 <= WS_P, "ws map 1");
static_assert(WS_P + WS_G_OFF + (size_t)M * 3072 * 2 <= WS_O && WS_O + (size_t)M * OPITCH * 2 <= WS_END && WS_P + (size_t)SMAX * FE * 2 <= WS_YS && WS_YS + (size_t)SMAX * D * 2 <= WS_XB && WS_XB + (size_t)M * D * 2 <= WS_END, "ws map 2");
static_assert(WS_PART + (size_t)256 * 65536 * 4 <= WS_P, "ws map 4");
static_assert(WS_W13 + (size_t)NE * 2 * FE * D * 2 <= WS_W2 && WS_WIN + (size_t)DIN * D * 2 <= WS_WBR, "ws map 3");
constexpr int CW_BAR = 4096;
constexpr int CW_CNT = 8192;
constexpr int CW_QK = 12288;
static_assert((CW_CNT + 2 * 8 * 64) * 4 <= (int)CTL_ZERO_BYTES && CW_CNT + 2 * 8 * 64 <= CW_QK && (CW_QK + DEPTH * 8 * 64) * 4 <= (int)CTL_ZERO_BYTES, "CTL words inside the memset region");

constexpr int RING_OFF = 0, RING_BYTES = 131072;
constexpr int LDSCTL_OFF = RING_BYTES, MISC_OFF = LDSCTL_OFF + 320;
constexpr int LDS_BYTES = 147456;
constexpr int BIAS_OFF = LDSCTL_OFF + 1024;
static_assert(attn_body::ATTN_LDS_BYTES <= RING_BYTES && attn_body::ATTN_FS_LDS_BYTES <= RING_BYTES && attn_body::ATTN_FS2_LDS_BYTES <= RING_BYTES && attn_body::ATTN_FS8_LDS_BYTES <= RING_BYTES && attn_body::ATTN_FS8P_LDS_BYTES <= RING_BYTES && attn_body::ATTN_FS8Q_LDS_BYTES <= RING_BYTES && BIAS_OFF + 8 * 465 * 4 <= LDS_BYTES, "LDS map");

typedef unsigned u32x2 __attribute__((ext_vector_type(2)));
typedef float f32x2v __attribute__((ext_vector_type(2)));
struct Args { const float* in[N_IN]; float* out; unsigned char* ws; };
typedef const __attribute__((address_space(4))) Args* CArgsP;
struct Frame {
    LAS unsigned char* lds;
    int tid, lane, wave, vcu, G;
};
#define REFRESH(F) do { int t_ = threadIdx.x; asm volatile("; LAUNDER" : "+v"(t_)); (F).tid = t_; (F).lane = t_ & 63; (F).wave = __builtin_amdgcn_readfirstlane(t_ >> 6); } while (0)
__device__ __forceinline__ CArgsP fresh_args() { CArgsP p = (CArgsP)__builtin_amdgcn_kernarg_segment_ptr(); asm volatile("; LAUNDER_S" : "+s"(p)); return p; }

__device__ __forceinline__ float wave_sum(float v) {
#pragma unroll
    for (int o = 1; o < 64; o <<= 1) v += __shfl_xor(v, o);
    return v;
}
__device__ __forceinline__ unsigned cvtpk(float lo, float hi) { return pg8::cvt_pk_bf16(lo, hi); }
__device__ __forceinline__ float bf_lo(unsigned w) { return __uint_as_float(w << 16); }
__device__ __forceinline__ float bf_hi(unsigned w) { return __uint_as_float(w & 0xffff0000u); }
__device__ __forceinline__ unsigned pk4_fp8(float a, float b, float c, float d) {
    a = __builtin_amdgcn_fmed3f(a, -448.f, 448.f); b = __builtin_amdgcn_fmed3f(b, -448.f, 448.f); c = __builtin_amdgcn_fmed3f(c, -448.f, 448.f); d = __builtin_amdgcn_fmed3f(d, -448.f, 448.f);
    int w = __builtin_amdgcn_cvt_pk_fp8_f32(a, b, 0, false); w = __builtin_amdgcn_cvt_pk_fp8_f32(c, d, w, true); return (unsigned)w; }
#ifndef CFG_DENSE8
#define CFG_DENSE8 0
#endif
#ifndef CFG_MOEDOWN8
#define CFG_MOEDOWN8 1
#endif
#ifndef CFG_INPROJ8
#define CFG_INPROJ8 1
#endif
constexpr bool DENSE8 = CFG_DENSE8, MOEDOWN8 = CFG_MOEDOWN8;
#ifndef CFG_GATE8
#define CFG_GATE8 0
#endif
constexpr bool GATE8 = CFG_GATE8;
constexpr int INPROJ8 = CFG_INPROJ8;
constexpr int IN8_TILES = INPROJ8 == 1 ? 27 : INPROJ8 == 2 ? 12 : INPROJ8 == 3 ? 16 : INPROJ8 == 4 ? 23 : 0;
constexpr size_t WS_WIN8 = WS_W + 83 * MiB;
__device__ __forceinline__ int in8_tile(int p) { return INPROJ8 == 1 ? p : INPROJ8 == 2 ? 15 + p : INPROJ8 == 4 ? (p < 7 ? p : p < 11 ? p + 2 : p + 4) : (p < 2 ? 7 + p : p < 4 ? 11 + p : 11 + p); }
__device__ __forceinline__ int in16_tile(int p) { return INPROJ8 == 3 ? (p < 7 ? p : p + 2) : INPROJ8 == 4 ? (p < 2 ? 7 + p : 11 + p) : p; }
typedef float f32x2p __attribute__((ext_vector_type(2)));
__device__ __forceinline__ void load_gates8(const bf16* Gp, size_t idx, float (&gl)[8]) {
    if constexpr (GATE8) { const u32x2 w = *(const GAS u32x2*)((const unsigned char*)Gp + idx);
        const f32x2p a = __builtin_amdgcn_cvt_pk_f32_fp8((int)w.x, false), b = __builtin_amdgcn_cvt_pk_f32_fp8((int)w.x, true), c = __builtin_amdgcn_cvt_pk_f32_fp8((int)w.y, false), d = __builtin_amdgcn_cvt_pk_f32_fp8((int)w.y, true);
        gl[0] = a.x; gl[1] = a.y; gl[2] = b.x; gl[3] = b.y; gl[4] = c.x; gl[5] = c.y; gl[6] = d.x; gl[7] = d.y; }
    else { const v4u w = *(const GAS v4u*)(Gp + idx);
        gl[0] = bf_lo(w.x); gl[1] = bf_hi(w.x); gl[2] = bf_lo(w.y); gl[3] = bf_hi(w.y); gl[4] = bf_lo(w.z); gl[5] = bf_hi(w.z); gl[6] = bf_lo(w.w); gl[7] = bf_hi(w.w); }
}
constexpr float WSC = 64.f, WSCI = 1.0f / 64.f;
__device__ __forceinline__ float sigmoidf_(float x) { return __builtin_amdgcn_rcpf(1.0f + __builtin_amdgcn_exp2f(-x * LOG2E)); }

#define NT_LOAD(p) __builtin_nontemporal_load(p)
__device__ __forceinline__ void tr_item(const float* W, int K, int N, bf16* WT, int base, int il, LAS float* scr, int item, int lane) {
    const int nblk = N / 32, kb = item / nblk, nb = item % nblk, k0 = 64 * kb, n0 = 32 * nb;
#pragma unroll 8
    for (int i = 0; i < 32; ++i) { const int kk = 2 * i + (lane >> 5); scr[kk * 33 + (lane & 31)] = NT_LOAD(&W[(size_t)(k0 + kk) * N + n0 + (lane & 31)]); }
    LDS_WAIT(); asm volatile("" ::: "memory");
    const int c = lane & 7;
#pragma unroll
    for (int j = 0; j < 4; ++j) { const int n = (lane >> 3) + 8 * j; const LAS float* s = scr + (8 * c) * 33 + n;
        v4u o; o.x = cvtpk(s[0 * 33], s[1 * 33]); o.y = cvtpk(s[2 * 33], s[3 * 33]); o.z = cvtpk(s[4 * 33], s[5 * 33]); o.w = cvtpk(s[6 * 33], s[7 * 33]);
        const int ng = n0 + n, drow = base + (il ? (256 * (ng >> 7) + (ng & 127)) : ng);
        *(GAS v4u*)(WT + (size_t)drow * K + k0 + 8 * c) = o; }
    LDS_WAIT(); asm volatile("" ::: "memory");
}
__device__ __forceinline__ void tr_item_f8(const float* W, int K, int N, unsigned char* WT, int base, int il, LAS float* scr, int item, int lane) {
    const int nblk = N / 32, kb = item / nblk, nb = item % nblk, k0 = 64 * kb, n0 = 32 * nb;
#pragma unroll 8
    for (int i = 0; i < 32; ++i) { const int kk = 2 * i + (lane >> 5); scr[kk * 33 + (lane & 31)] = NT_LOAD(&W[(size_t)(k0 + kk) * N + n0 + (lane & 31)]) * WSC; }
    LDS_WAIT(); asm volatile("" ::: "memory");
    const int c = lane & 3;
#pragma unroll
    for (int j = 0; j < 2; ++j) { const int n = (lane >> 2) + 16 * j; const LAS float* s = scr + (16 * c) * 33 + n;
        v4u o; o.x = pk4_fp8(s[0 * 33], s[1 * 33], s[2 * 33], s[3 * 33]); o.y = pk4_fp8(s[4 * 33], s[5 * 33], s[6 * 33], s[7 * 33]);
        o.z = pk4_fp8(s[8 * 33], s[9 * 33], s[10 * 33], s[11 * 33]); o.w = pk4_fp8(s[12 * 33], s[13 * 33], s[14 * 33], s[15 * 33]);
        const int ng = n0 + n, drow = base + (il ? (256 * (ng >> 7) + (ng & 127)) : ng);
        *(GAS v4u*)(WT + (size_t)drow * K + k0 + 16 * c) = o; }
    LDS_WAIT(); asm volatile("" ::: "memory");
}
__device__ __forceinline__ void convert_weights(Frame& F, CArgsP AP, int l) {
    LAS float* scr = (LAS float*)(F.lds + RING_OFF + F.wave * 16384);
    const int gw = F.vcu * NWAVES + F.wave, NGW = F.G * NWAVES;
    bf16* WIN = (bf16*)(AP->ws + WS_WIN); bf16* WBR = (bf16*)(AP->ws + WS_WBR); bf16* WOUT = (bf16*)(AP->ws + WS_WOUT); unsigned char* W13 = AP->ws + WS_W13; unsigned char* W2 = AP->ws + WS_W2;
    constexpr int I_IN = (D / 64) * (DIN / 32), I_BR = (512 / 64) * (D / 32), I_OUT = (D / 64) * (D / 32);
    constexpr int I_F1 = (D / 64) * (FF / 32), I_F2 = (FF / 64) * (D / 32), I_M1 = (D / 64) * (FE / 32), I_M2 = (FE / 64) * (D / 32);
    const int i2 = l >> 1;
    const int nbase = I_IN + 3 * I_BR + I_OUT;
    const int nitems = nbase + ((l & 1) ? NE * (2 * I_M1 + I_M2) : (2 * I_F1 + I_F2));
    for (int it = gw; it < nitems; it += NGW) {
        int r = it;
        if (r < I_IN) { if constexpr (INPROJ8 != 1) tr_item(AP->in[I_WIN] + (size_t)l * D * DIN, D, DIN, WIN, 0, 0, scr, r, F.lane);
            if constexpr (INPROJ8 != 0) tr_item_f8(AP->in[I_WIN] + (size_t)l * D * DIN, D, DIN, AP->ws + WS_WIN8, 0, 0, scr, r, F.lane); continue; } r -= I_IN;
        if (r < 3 * I_BR) { const int x = r / I_BR; r -= x * I_BR; const float* src = (x == 0 ? AP->in[I_WBRA] : x == 1 ? AP->in[I_WBRB] : AP->in[I_WBRC]) + (size_t)l * 512 * D;
            tr_item(src, 512, D, WBR + (size_t)x * D * 512, 0, 0, scr, r, F.lane); continue; } r -= 3 * I_BR;
        if (r < I_OUT) { tr_item(AP->in[I_WOUT] + (size_t)l * D * D, D, D, WOUT, 0, 0, scr, r, F.lane); continue; } r -= I_OUT;
        if (!(l & 1)) {
            if (r < I_F1) { if constexpr (DENSE8) tr_item_f8(AP->in[I_FW1] + (size_t)i2 * D * FF, D, FF, W13, 0, 1, scr, r, F.lane); else tr_item(AP->in[I_FW1] + (size_t)i2 * D * FF, D, FF, (bf16*)W13, 0, 1, scr, r, F.lane); continue; } r -= I_F1;
            if (r < I_F1) { if constexpr (DENSE8) tr_item_f8(AP->in[I_FW3] + (size_t)i2 * D * FF, D, FF, W13, 128, 1, scr, r, F.lane); else tr_item(AP->in[I_FW3] + (size_t)i2 * D * FF, D, FF, (bf16*)W13, 128, 1, scr, r, F.lane); continue; } r -= I_F1;
            if constexpr (DENSE8) tr_item_f8(AP->in[I_FW2] + (size_t)i2 * FF * D, FF, D, W2, 0, 0, scr, r, F.lane); else tr_item(AP->in[I_FW2] + (size_t)i2 * FF * D, FF, D, (bf16*)W2, 0, 0, scr, r, F.lane);
        } else {
            const int per = 2 * I_M1 + I_M2, e = r / per; r -= e * per; const size_t eo = (size_t)(i2 * NE + e);
            if (r < I_M1) { tr_item_f8(AP->in[I_MW1] + eo * D * FE, D, FE, W13 + (size_t)e * 2 * FE * D, 0, 1, scr, r, F.lane); continue; } r -= I_M1;
            if (r < I_M1) { tr_item_f8(AP->in[I_MW3] + eo * D * FE, D, FE, W13 + (size_t)e * 2 * FE * D, 128, 1, scr, r, F.lane); continue; } r -= I_M1;
            if constexpr (MOEDOWN8) tr_item_f8(AP->in[I_MW2] + eo * FE * D, FE, D, W2 + (size_t)e * D * FE, 0, 0, scr, r, F.lane); else tr_item(AP->in[I_MW2] + eo * FE * D, FE, D, (bf16*)W2 + (size_t)e * D * FE, 0, 0, scr, r, F.lane);
        }
    }
}

__device__ __forceinline__ void prologue_mod(Frame& F, CArgsP AP) {
    LAS float* sv = (LAS float*)(F.lds + RING_OFF);
    LAS float* red = sv + 5 * 1024;
    for (int i = F.tid; i < 5 * 1024; i += NWAVES * 64) { const int j = i >> 10, k = i & 1023; const float v = j < 4 ? AP->in[I_C][j * 1024 + k] : AP->in[I_CCTX][k]; sv[i] = v * sigmoidf_(v); }
    __syncthreads();
    float* MOD = (float*)(AP->ws + WS_MOD);
    for (int it = blockIdx.x; it < DEPTH * 96; it += F.G) {
        const int l = it / 96, cb = it % 96, col = cb * 64 + F.lane;
        const float* wp = AP->in[I_WMOD] + ((size_t)l * D + F.wave * 128) * 6144 + col;
        const LAS float* s = sv + F.wave * 128;
        float a0 = 0.f, a1 = 0.f, a2 = 0.f, a3 = 0.f, a4 = 0.f;
#pragma unroll 8
        for (int k = 0; k < 128; ++k) { const float w = NT_LOAD(&wp[(size_t)k * 6144]); a0 += s[k] * w; a1 += s[1024 + k] * w; a2 += s[2048 + k] * w; a3 += s[3072 + k] * w; a4 += s[4096 + k] * w; }
        LAS float* rr = red + F.wave * 320 + F.lane;
        rr[0] = a0; rr[64] = a1; rr[128] = a2; rr[192] = a3; rr[256] = a4;
        __syncthreads();
        if (F.tid < 320) { const int j = F.tid >> 6, ln = F.tid & 63; float sacc = 0.f;
#pragma unroll
            for (int w = 0; w < 8; ++w) sacc += red[w * 320 + j * 64 + ln];
            MOD[(size_t)(l * 5 + j) * 6144 + cb * 64 + ln] = sacc + AP->in[I_BMOD][l * 6144 + cb * 64 + ln]; }
        __syncthreads();
    }
    if (blockIdx.x == 0) {
        float* RT = (float*)(AP->ws + WS_ROPE);
        for (int i = F.tid; i < 128 * 16; i += NWAVES * 64) {
            const int pos = i >> 4, j = i & 15;
            double inv = 1.0; for (int q = 0; q < j; ++q) inv *= 0.56234132519034908;
            const float invf = (float)inv; const float angf = (float)pos * invf;
            double a = (double)angf; const double TWO_PI = 6.283185307179586476925;
            const double nrev = __builtin_floor(a / TWO_PI + 0.5); a -= nrev * TWO_PI;
            const double a2 = a * a; double cs = 1.0, sn = a, tc = 1.0, ts = a;
            for (int q = 1; q < 16; ++q) { tc *= -a2 / (double)((2 * q - 1) * (2 * q)); ts *= -a2 / (double)((2 * q) * (2 * q + 1)); cs += tc; sn += ts; }
            RT[2 * i] = (float)cs; RT[2 * i + 1] = (float)sn;
        }
    }
}

struct RowRef { int b, n, bsel; bool isctx; };
__device__ __forceinline__ RowRef row_ref(int row) { RowRef r; r.b = row / NTOK; r.n = row - r.b * NTOK; r.isctx = r.n < CTX; r.bsel = r.isctx ? 4 : r.b; return r; }
__device__ __forceinline__ bf16* row_xb(CArgsP AP, int row) { return (bf16*)(AP->ws + WS_XB) + (size_t)row * D; }
__device__ __forceinline__ void load_row_xb(const bf16* p, int lane, u32x2 (&raw)[4]) {
#pragma unroll
    for (int j = 0; j < 4; ++j) raw[j] = *(const GAS u32x2*)(p + 256 * j + 4 * lane);
}
__device__ __forceinline__ void unpack_row(const u32x2 (&raw)[4], f32x4 (&v)[4]) {
#pragma unroll
    for (int j = 0; j < 4; ++j) v[j] = (f32x4){bf_lo(raw[j].x), bf_hi(raw[j].x), bf_lo(raw[j].y), bf_hi(raw[j].y)};
}
__device__ __forceinline__ void load_row(const float* p, int lane, f32x4 (&v)[4]) {
#pragma unroll
    for (int j = 0; j < 4; ++j) v[j] = *(const GAS f32x4*)(p + 256 * j + 4 * lane);
}
__device__ __forceinline__ void store_row(float* p, int lane, const f32x4 (&v)[4]) {
#pragma unroll
    for (int j = 0; j < 4; ++j) *(GAS f32x4*)(p + 256 * j + 4 * lane) = v[j];
}
__device__ __forceinline__ void moe_combine(Frame& F, CArgsP AP, int row, const RowRef& r, int lp, f32x4 (&v)[4]) {
    const unsigned* info = (const unsigned*)(AP->ws + WS_TOK) + (size_t)row * 8;
    const float w0 = __uint_as_float(info[4]), w1 = __uint_as_float(info[5]); const unsigned s0 = info[6], s1 = info[7];
    const bf16* Y = (const bf16*)(AP->ws + WS_YS);
    const float* gate = (const float*)(AP->ws + WS_MOD) + (size_t)(lp * 5 + r.bsel) * 6144 + 5 * 1024;
#pragma unroll
    for (int j = 0; j < 4; ++j) {
        const u32x2 y0 = *(const GAS u32x2*)(Y + (size_t)s0 * D + 256 * j + 4 * F.lane), y1 = *(const GAS u32x2*)(Y + (size_t)s1 * D + 256 * j + 4 * F.lane);
        const f32x4 g = *(const GAS f32x4*)(gate + 256 * j + 4 * F.lane);
        v[j].x += g.x * (w0 * bf_lo(y0.x) + w1 * bf_lo(y1.x)); v[j].y += g.y * (w0 * bf_hi(y0.x) + w1 * bf_hi(y1.x));
        v[j].z += g.z * (w0 * bf_lo(y0.y) + w1 * bf_lo(y1.y)); v[j].w += g.w * (w0 * bf_hi(y0.y) + w1 * bf_hi(y1.y));
    }
}
__device__ __forceinline__ float row_rstd(const f32x4 (&v)[4]) {
    float s = 0.f;
#pragma unroll
    for (int j = 0; j < 4; ++j) s += (v[j].x * v[j].x + v[j].y * v[j].y) + (v[j].z * v[j].z + v[j].w * v[j].w);
    return 1.0f / sqrtf(wave_sum(s) * (1.0f / D) + EPS);
}
__device__ __forceinline__ void norm_mod(const f32x4 (&v)[4], float rstd, const float* g, const float* shift, const float* scale, int lane, f32x4 (&y)[4]) {
#pragma unroll
    for (int j = 0; j < 4; ++j) {
        const f32x4 gg = *(const GAS f32x4*)(g + 256 * j + 4 * lane), sh = *(const GAS f32x4*)(shift + 256 * j + 4 * lane), sc = *(const GAS f32x4*)(scale + 256 * j + 4 * lane);
        y[j] = (v[j] * rstd) * gg * (sc + 1.0f) + sh;
    }
}
__device__ __forceinline__ void store_row_bf16(bf16* p, int lane, const f32x4 (&y)[4]) {
#pragma unroll
    for (int j = 0; j < 4; ++j) { u32x2 o; o.x = cvtpk(y[j].x, y[j].y); o.y = cvtpk(y[j].z, y[j].w); *(GAS u32x2*)(p + 256 * j + 4 * lane) = o; }
}

struct TailTab { const float* part; int npz; LAS unsigned char* lt; };
__device__ __forceinline__ TailTab tail_setup(Frame& F, CArgsP AP, int nt_k, LAS unsigned char* lt) {
    pg8::TileOrder T; T.init(M / 256, D / 256, F.G, 0);
    const int nfull = T.nwg / T.G, R = T.nwg - nfull * T.G, P = nt_k >> 1; int npz = R ? T.G / R : 1; npz = npz < P ? npz : P;
    __syncthreads();
    for (int i = F.tid; i < (M / 256) * 4; i += NWAVES * 64) lt[i] = 0;
    __syncthreads();
    if (F.tid < R) { int pm, pn; if (T.tile_at((long)nfull * T.G + F.tid, pm, pn)) lt[pm * 4 + pn] = (unsigned char)(F.tid + 1); }
    __syncthreads();
    TailTab t; t.part = (const float*)(AP->ws + WS_PART); t.npz = npz; t.lt = lt; return t;
}
__device__ __forceinline__ bool tail_add(const TailTab& t, int row, int lane, const float* gate, float sc, f32x4 (&v)[4]) {
    const int pm = row >> 8, rit = row & 255; bool any = false;
#pragma unroll
    for (int jq = 0; jq < 4; ++jq) { const int idx = __builtin_amdgcn_readfirstlane((int)t.lt[pm * 4 + jq]);
        if (idx) { any = true; f32x4 sacc = {0.f, 0.f, 0.f, 0.f}; const float* pp = t.part + ((size_t)(idx - 1) * t.npz * 256 + rit) * 256 + 4 * lane;
            for (int p = 0; p < t.npz; ++p) sacc += *(const GAS f32x4*)(pp + (size_t)p * 65536);
            const f32x4 g4 = *(const GAS f32x4*)(gate + 256 * jq + 4 * lane); v[jq] += g4 * sc * sacc; } }
    return any;
}
__device__ __forceinline__ void phase_norm1(Frame& F, CArgsP AP, int l, bool commit) {
    const int gw = F.vcu * NWAVES + F.wave, NGW = F.G * NWAVES;
    bf16* XN = (bf16*)(AP->ws + WS_XN);
    const float* MOD = (const float*)(AP->ws + WS_MOD);
    const float* g = AP->in[I_GMIX] + l * D;
#define N1_SRC(rr_, row_) ((rr_).isctx ? AP->in[I_CTX] + (size_t)((rr_).b * CTX + (rr_).n) * D : AP->in[I_X] + (size_t)((rr_).b * SEQ + ((rr_).n - CTX)) * D)
    const bool tail = TAIL_SPLIT && (l > 0) && !((l - 1) & 1);
    TailTab tt{}; if (tail) tt = tail_setup(F, AP, DENSE8 ? FF / 128 : FF / 64, (LAS unsigned char*)(F.lds + RING_OFF + 40960));
    f32x4 vnx[4]; u32x2 rnx[4];
#pragma unroll
    for (int j = 0; j < 4; ++j) { vnx[j] = (f32x4){0.f, 0.f, 0.f, 0.f}; rnx[j] = (u32x2){0u, 0u}; }
    if (gw < M) { if (l == 0) { const RowRef r0 = row_ref(gw); load_row(N1_SRC(r0, gw), F.lane, vnx); } else load_row_xb(row_xb(AP, gw), F.lane, rnx); }
    for (int row = gw; row < M; row += NGW) {
        const RowRef r = row_ref(row); bf16* xr = row_xb(AP, row);
        f32x4 v[4];
        if (l == 0) {
#pragma unroll
            for (int j = 0; j < 4; ++j) v[j] = vnx[j];
        } else unpack_row(rnx, v);
        if (row + NGW < M) { if (l == 0) { const RowRef rn = row_ref(row + NGW); load_row(N1_SRC(rn, row + NGW), F.lane, vnx); } else load_row_xb(row_xb(AP, row + NGW), F.lane, rnx); }
        const bool comb = (l > 0) && ((l - 1) & 1);
        if (comb) moe_combine(F, AP, row, r, l - 1, v);
        bool tailed = false; if (tail) tailed = tail_add(tt, row, F.lane, MOD + (size_t)((l - 1) * 5 + r.bsel) * 6144 + 5 * 1024, DENSE8 ? WSCI : 1.0f, v);
        if ((l == 0 || comb || tailed) && commit) store_row_bf16(xr, F.lane, v);
        const float rstd = row_rstd(v);
        const float* mv = MOD + (size_t)(l * 5 + r.bsel) * 6144;
        f32x4 y[4]; norm_mod(v, rstd, g, mv + 0 * 1024, mv + 1 * 1024, F.lane, y);
        if constexpr (INPROJ8 != 0) {
#pragma unroll
            for (int j = 0; j < 4; ++j) *(GAS unsigned*)(AP->ws + WS_MB + (size_t)row * D + 256 * j + 4 * F.lane) = pk4_fp8(y[j].x, y[j].y, y[j].z, y[j].w);
        }
        if constexpr (INPROJ8 != 1) store_row_bf16(XN + (size_t)row * D, F.lane, y);
    }
}
__device__ __forceinline__ void phase_norm2(Frame& F, CArgsP AP, int l, bool commit) {
    const int gw = F.vcu * NWAVES + F.wave, NGW = F.G * NWAVES;
    unsigned char* XN8 = AP->ws + WS_XN;
    const float* MOD = (const float*)(AP->ws + WS_MOD);
    const float* g = AP->in[I_GFFN] + l * D;
    const bool moe = (l & 1) && commit;
    const bool moe_layer = (l & 1);
    LAS float* Rt = (LAS float*)(F.lds + RING_OFF);
    if (moe) {
        const float* R = AP->in[I_ROUTER] + (size_t)(l >> 1) * D * NE;
        for (int i = F.tid; i < D * NE; i += NWAVES * 64) Rt[(i & 7) * 1024 + (i >> 3)] = R[i];
        __syncthreads();
    }
    unsigned* cnt = (unsigned*)(AP->ws + WS_CTL) + CW_CNT + (l >> 1) * 8 * 64;
    int lc0 = 0, lc1 = 0, lc2 = 0, lc3 = 0, lc4 = 0, lc5 = 0, lc6 = 0, lc7 = 0;
    const bool tail = TAIL_SPLIT && (l < DEPTH - 1);
    TailTab tt{}; if (tail) tt = tail_setup(F, AP, D / 64, (LAS unsigned char*)(F.lds + RING_OFF + 40960));
    u32x2 rnx[4];
#pragma unroll
    for (int j = 0; j < 4; ++j) rnx[j] = (u32x2){0u, 0u};
    if (gw < M) load_row_xb(row_xb(AP, gw), F.lane, rnx);
    for (int row = gw; row < M; row += NGW) {
        const RowRef r = row_ref(row);
        f32x4 v[4]; unpack_row(rnx, v);
        if (row + NGW < M) load_row_xb(row_xb(AP, row + NGW), F.lane, rnx);
        if (r.isctx && l == DEPTH - 1) continue;
        const float* mv = MOD + (size_t)(l * 5 + r.bsel) * 6144;
        if (tail && tail_add(tt, row, F.lane, mv + 2 * 1024, 1.0f, v) && commit) store_row_bf16(row_xb(AP, row), F.lane, v);
        const float rstd = row_rstd(v);
        f32x4 y[4]; norm_mod(v, rstd, g, mv + 3 * 1024, mv + 4 * 1024, F.lane, y);
        if (moe_layer || DENSE8) {
#pragma unroll
            for (int j = 0; j < 4; ++j) *(GAS unsigned*)(XN8 + (size_t)row * D + 256 * j + 4 * F.lane) = pk4_fp8(y[j].x, y[j].y, y[j].z, y[j].w);
        } else store_row_bf16((bf16*)XN8 + (size_t)row * D, F.lane, y);
        if (moe) {
            float lg[8];
#pragma unroll
            for (int e = 0; e < 8; ++e) { float s = 0.f;
#pragma unroll
                for (int j = 0; j < 4; ++j) { const f32x4 w = *(const LAS f32x4*)(Rt + e * 1024 + 256 * j + 4 * F.lane); s += (y[j].x * w.x + y[j].y * w.y) + (y[j].z * w.z + y[j].w * w.w); }
                lg[e] = wave_sum(s); }
            int e0 = 0; float v0 = lg[0];
#pragma unroll
            for (int e = 1; e < 8; ++e) if (lg[e] > v0) { v0 = lg[e]; e0 = e; }
            int e1 = -1; float v1 = -INFINITY;
#pragma unroll
            for (int e = 0; e < 8; ++e) if (e != e0 && lg[e] > v1) { v1 = lg[e]; e1 = e; }
            const float ex = __expf(v1 - v0), w0 = 1.0f / (1.0f + ex), w1 = ex * w0;
            const int s0 = __builtin_amdgcn_readfirstlane(e0), s1 = __builtin_amdgcn_readfirstlane(e1);
            const int p0 = (s0 == 0 ? lc0 : 0) + (s0 == 1 ? lc1 : 0) + (s0 == 2 ? lc2 : 0) + (s0 == 3 ? lc3 : 0) + (s0 == 4 ? lc4 : 0) + (s0 == 5 ? lc5 : 0) + (s0 == 6 ? lc6 : 0) + (s0 == 7 ? lc7 : 0);
            const int p1 = (s1 == 0 ? lc0 : 0) + (s1 == 1 ? lc1 : 0) + (s1 == 2 ? lc2 : 0) + (s1 == 3 ? lc3 : 0) + (s1 == 4 ? lc4 : 0) + (s1 == 5 ? lc5 : 0) + (s1 == 6 ? lc6 : 0) + (s1 == 7 ? lc7 : 0);
            lc0 += (s0 == 0) + (s1 == 0); lc1 += (s0 == 1) + (s1 == 1); lc2 += (s0 == 2) + (s1 == 2); lc3 += (s0 == 3) + (s1 == 3);
            lc4 += (s0 == 4) + (s1 == 4); lc5 += (s0 == 5) + (s1 == 5); lc6 += (s0 == 6) + (s1 == 6); lc7 += (s0 == 7) + (s1 == 7);
            if (F.lane == 0) {
                unsigned* info = (unsigned*)(AP->ws + WS_TOK) + (size_t)row * 8;
                info[0] = (unsigned)s0; info[1] = (unsigned)s1; info[2] = (unsigned)p0; info[3] = (unsigned)p1; info[4] = __float_as_uint(w0); info[5] = __float_as_uint(w1);
            }
        }
    }
    if (moe) {
        const int mine = F.lane == 0 ? lc0 : F.lane == 1 ? lc1 : F.lane == 2 ? lc2 : F.lane == 3 ? lc3 : F.lane == 4 ? lc4 : F.lane == 5 ? lc5 : F.lane == 6 ? lc6 : lc7;
        if (F.lane < 8) { const unsigned base = __hip_atomic_fetch_add(cnt + F.lane * 64, (unsigned)mine, RLX_AGENT); ((unsigned*)(AP->ws + WS_WBASE))[(size_t)gw * 8 + F.lane] = base; }
    }
}
struct MoeOff { int off[9]; int cnt[8]; };
__device__ __forceinline__ void moe_offsets(Frame& F, CArgsP AP, int l, MoeOff& o) {
    const unsigned* cnt = (const unsigned*)(AP->ws + WS_CTL) + CW_CNT + (l >> 1) * 8 * 64;
    int acc = 0;
#pragma unroll
    for (int e = 0; e < 8; ++e) { const int c = (int)__builtin_amdgcn_readfirstlane(__hip_atomic_load(cnt + e * 64, RLX_AGENT)); o.cnt[e] = c; o.off[e] = acc; acc += (c + 255) & ~255; }
    o.off[8] = acc;
}
__device__ __forceinline__ void phase_moe_gather(Frame& F, CArgsP AP, int l) {
    const int gw = F.vcu * NWAVES + F.wave, NGW = F.G * NWAVES;
    MoeOff mo; moe_offsets(F, AP, l, mo);
    const unsigned char* XN = AP->ws + WS_XN; unsigned char* XS = AP->ws + WS_MB;
    for (int row = gw; row < M; row += NGW) {
        if (l == DEPTH - 1 && (row % NTOK) < CTX) continue;
        unsigned* info = (unsigned*)(AP->ws + WS_TOK) + (size_t)row * 8;
        const int e0 = (int)info[0], e1 = (int)info[1]; const unsigned* wb = (const unsigned*)(AP->ws + WS_WBASE) + (size_t)(row % NGW) * 8;
        const unsigned p0 = info[2] + wb[e0], p1 = info[3] + wb[e1];
        int o0 = 0, o1 = 0;
#pragma unroll
        for (int e = 0; e < 8; ++e) { o0 = (e == e0) ? mo.off[e] : o0; o1 = (e == e1) ? mo.off[e] : o1; }
        const unsigned s0 = (unsigned)o0 + p0, s1 = (unsigned)o1 + p1;
        const v4u a = *(const GAS v4u*)(XN + (size_t)row * D + 16 * F.lane);
        *(GAS v4u*)(XS + (size_t)s0 * D + 16 * F.lane) = a; *(GAS v4u*)(XS + (size_t)s1 * D + 16 * F.lane) = a;
        if (F.lane == 0) { info[6] = s0; info[7] = s1; }
    }
    for (int p = gw; p < 8 * 256; p += NGW) {
        const int e = p >> 8, k = p & 255; int c = 0, o = 0;
#pragma unroll
        for (int q = 0; q < 8; ++q) { c = (q == e) ? mo.cnt[q] : c; o = (q == e) ? mo.off[q] : o; }
        if (c + k < ((c + 255) & ~255)) { unsigned zz = 0u; asm volatile("" : "+v"(zz)); const v4u z = {zz, zz, zz, zz};     *(GAS v4u*)(XS + (size_t)(o + c + k) * D + 16 * F.lane) = z; }
    }
}
__device__ __forceinline__ void phase_post(Frame& F, CArgsP AP, int l, bool commit) {
    const int gw = F.vcu * NWAVES + F.wave, NGW = F.G * NWAVES;
    bf16* P = (bf16*)(AP->ws + WS_P);
    const float* RT = (const float*)(AP->ws + WS_ROPE);
    const float C2 = 0.125f * LOG2E;
    const int l8 = F.lane & 7;
    float qg[8], kg[8];
#pragma unroll
    for (int i = 0; i < 8; ++i) { qg[i] = AP->in[I_QNA][l * 64 + 8 * l8 + i]; kg[i] = AP->in[I_KNA][l * 64 + 8 * l8 + i]; }
    v4u wnx[2];
#pragma unroll
    for (int s = 0; s < 2; ++s) wnx[s] = (v4u){0u, 0u, 0u, 0u};
#define POST_ADDR(row_, col_) (P + qkv_blk(col_) + (size_t)(F.lane >> 3) * QKV_BLK + (size_t)(row_) * 64 + 8 * (F.lane & 7))
    if (gw < M) {
#pragma unroll
        for (int s = 0; s < 2; ++s) { const int col = (s == 0) ? C_AQ : C_AK;
            if ((s != 1) || (F.lane < 16)) wnx[s] = *(const GAS v4u*)POST_ADDR(gw, col); } }
    for (int row = gw; row < M; row += NGW) {
        const RowRef r = row_ref(row);
        float cs[4], sn[4];
#pragma unroll
        for (int j = 0; j < 4; ++j) { cs[j] = 1.f; sn[j] = 0.f; }
        if (!r.isctx) { const int t = r.n - CTX, pos = l8 < 4 ? (t >> 6) : (t & 63); const float* tp = RT + (size_t)(pos * 16 + (l8 & 3) * 4) * 2;
            const f32x4 c0 = *(const GAS f32x4*)tp, c1 = *(const GAS f32x4*)(tp + 4); cs[0] = c0.x; sn[0] = c0.y; cs[1] = c0.z; sn[1] = c0.w; cs[2] = c1.x; sn[2] = c1.y; cs[3] = c1.z; sn[3] = c1.w; }
        v4u wcur[2];
#pragma unroll
        for (int s = 0; s < 2; ++s) wcur[s] = wnx[s];
        if (row + NGW < M) {
#pragma unroll
            for (int s = 0; s < 2; ++s) { const int col = (s == 0) ? C_AQ : C_AK;
                if ((s != 1) || (F.lane < 16)) wnx[s] = *(const GAS v4u*)POST_ADDR(row + NGW, col); } }
#pragma unroll
        for (int s = 0; s < 2; ++s) {
            const int col = (s == 0) ? C_AQ : C_AK;
            const bool act = (s != 1) || (F.lane < 16);
            GAS v4u* p = (GAS v4u*)POST_ADDR(row, col);
            const v4u w = wcur[s];
            float x[8]; x[0] = bf_lo(w.x); x[1] = bf_hi(w.x); x[2] = bf_lo(w.y); x[3] = bf_hi(w.y); x[4] = bf_lo(w.z); x[5] = bf_hi(w.z); x[6] = bf_lo(w.w); x[7] = bf_hi(w.w);
            if (s <= 1) {
                float ss = 0.f;
#pragma unroll
                for (int i = 0; i < 8; ++i) ss += x[i] * x[i];
                ss += __shfl_xor(ss, 1); ss += __shfl_xor(ss, 2); ss += __shfl_xor(ss, 4);
                const float rs = 1.0f / sqrtf(ss * (1.0f / 64.0f) + EPS);
#pragma unroll
                for (int i = 0; i < 8; ++i) x[i] = x[i] * rs * (s == 0 ? qg[i] : kg[i]);
            }
            if (s < 4) {
#pragma unroll
                for (int j = 0; j < 4; ++j) { const float y1 = x[2 * j] * cs[j] - x[2 * j + 1] * sn[j], y2 = x[2 * j] * sn[j] + x[2 * j + 1] * cs[j]; x[2 * j] = y1; x[2 * j + 1] = y2; }
            }
            if (s == 0 || s == 2 || s == 4) {
#pragma unroll
                for (int i = 0; i < 8; ++i) x[i] *= C2;
            }
            { v4u wq; wq.x = cvtpk(x[0], x[1]); wq.y = cvtpk(x[2], x[3]); wq.z = cvtpk(x[4], x[5]); wq.w = cvtpk(x[6], x[7]); if (act && !ATT8) *p = commit ? wq : w; }
            if (ATT8 && act) { const float f8s = (s == 0) ? 4.0f : 0.25f; u32x2 w8; w8.x = pk4_fp8(x[0] * f8s, x[1] * f8s, x[2] * f8s, x[3] * f8s); w8.y = pk4_fp8(x[4] * f8s, x[5] * f8s, x[6] * f8s, x[7] * f8s);
                *(GAS u32x2*)(AP->ws + WS_Q8 + q8_blk(col) + (size_t)(F.lane >> 3) * QKV_BLK + (size_t)row * 64 + 8 * (F.lane & 7)) = w8; }
        }
    }
}
__device__ __forceinline__ float layer_lam_init(int l) { return 0.8f - 0.6f * __expf(-0.3f * (float)l); }
__device__ __forceinline__ void phase_bcomb(Frame& F, CArgsP AP, int l, bool commit) {
    const int gw = F.vcu * NWAVES + F.wave, NGW = F.G * NWAVES;
    bf16* OB = (bf16*)(AP->ws + WS_O);
    const float li = layer_lam_init(l);
    const float s1 = wave_sum(AP->in[I_LQ1][l * 64 + F.lane] * AP->in[I_LK1][l * 64 + F.lane]), s2 = wave_sum(AP->in[I_LQ2][l * 64 + F.lane] * AP->in[I_LK2][l * 64 + F.lane]);
    const float lam = __expf(s1) - __expf(s2) + li;
    const float post = 1.0f - li;
    float sg[8];
#pragma unroll
    for (int q = 0; q < 8; ++q) sg[q] = AP->in[I_SUBLN][l * 128 + ((8 * F.lane) & 127) + q] * post;
    for (int row = gw; row < M; row += NGW) {
        bf16* pr = OB + (size_t)row * OPITCH;
        const v4u a = *(const GAS v4u*)(pr + O_B1 + 8 * F.lane), b = *(const GAS v4u*)(pr + O_B2 + 8 * F.lane);
        float d[8];
        d[0] = bf_lo(a.x) - lam * bf_lo(b.x); d[1] = bf_hi(a.x) - lam * bf_hi(b.x); d[2] = bf_lo(a.y) - lam * bf_lo(b.y); d[3] = bf_hi(a.y) - lam * bf_hi(b.y);
        d[4] = bf_lo(a.z) - lam * bf_lo(b.z); d[5] = bf_hi(a.z) - lam * bf_hi(b.z); d[6] = bf_lo(a.w) - lam * bf_lo(b.w); d[7] = bf_hi(a.w) - lam * bf_hi(b.w);
        float ss = 0.f;
#pragma unroll
        for (int q = 0; q < 8; ++q) ss += d[q] * d[q];
#pragma unroll
        for (int o = 1; o < 16; o <<= 1) ss += __shfl_xor(ss, o);
        const float rs = 1.0f / sqrtf(ss * (1.0f / 128.0f) + EPS);
        v4u o; o.x = cvtpk(d[0] * rs * sg[0], d[1] * rs * sg[1]); o.y = cvtpk(d[2] * rs * sg[2], d[3] * rs * sg[3]); o.z = cvtpk(d[4] * rs * sg[4], d[5] * rs * sg[5]); o.w = cvtpk(d[6] * rs * sg[6], d[7] * rs * sg[7]);
        *(GAS v4u*)(pr + O_B1 + 8 * F.lane) = commit ? o : a;
    }
}
__device__ __forceinline__ void phase_final(Frame& F, CArgsP AP, bool poison) {
    const int gw = F.vcu * NWAVES + F.wave, NGW = F.G * NWAVES;
    const float* g = AP->in[I_GFINAL];
    u32x2 rnx[4];
#pragma unroll
    for (int j = 0; j < 4; ++j) rnx[j] = (u32x2){0u, 0u};
#define FIN_ROW(lr_) (((lr_) / SEQ) * NTOK + CTX + ((lr_) % SEQ))
    if (gw < BATCH * SEQ) load_row_xb(row_xb(AP, FIN_ROW(gw)), F.lane, rnx);
    for (int lr = gw; lr < BATCH * SEQ; lr += NGW) {
        const int b = lr / SEQ, t = lr - b * SEQ, row = b * NTOK + CTX + t;
        const RowRef r = row_ref(row); float* xr = AP->out + (size_t)lr * D;
        f32x4 v[4]; unpack_row(rnx, v);
        if (lr + NGW < BATCH * SEQ) load_row_xb(row_xb(AP, FIN_ROW(lr + NGW)), F.lane, rnx);
        moe_combine(F, AP, row, r, DEPTH - 1, v);
        const float rstd = row_rstd(v);
#pragma unroll
        for (int j = 0; j < 4; ++j) { const f32x4 gg = *(const GAS f32x4*)(g + 256 * j + 4 * F.lane); v[j] = (v[j] * rstd) * gg;
            if (poison) { const float q = __builtin_nanf(""); v[j] = (f32x4){q, q, q, q}; } }
        store_row(xr, F.lane, v);
    }
}

struct SchedPlain {
    pg8::TileOrder T; size_t astep, bstep; bool latent_only; int nt; bool tail_split; int colmap;
    __device__ __forceinline__ bool next(int i, pg8::Unit& u) const {
        const int nfull = T.nwg / T.G;
        if (!tail_split || i < nfull) { if (!T.tile(i, u.pm, u.pn)) return false; u.aux = 0; u.nt = nt; if (latent_only) u.pm += u.pm / 32 + 1; if (colmap == 1) u.pn = in8_tile(u.pn); else if (colmap == 2) u.pn = in16_tile(u.pn);
            u.aoff = (size_t)u.pm * astep; u.boff = (size_t)u.pn * bstep; return true; }
        if (i > nfull) return false;
        const int R = T.nwg - nfull * T.G; if (R == 0) return false;
        const int P = nt >> 1; int npz = T.G / R; npz = npz < P ? npz : P;
        if (T.c >= R * npz) return false;
        const int j = T.c / npz, p = T.c - j * npz;
        if (!T.tile_at((long)nfull * T.G + j, u.pm, u.pn)) return false;
        if (latent_only) u.pm += u.pm / 32 + 1;
        const int pair0 = p * P / npz, pair1 = (p + 1) * P / npz;
        u.aux = (T.c << 1) | 1; u.nt = 2 * (pair1 - pair0);
        const size_t koff = (size_t)pair0 * 2 * 128;
        u.aoff = (size_t)u.pm * astep + koff; u.boff = (size_t)u.pn * bstep + koff; return true; }
    __device__ __forceinline__ void a_ready(const pg8::Unit&) const {}
    __device__ __forceinline__ void done(const pg8::Unit&) const {}
};
struct SchedMerge {
    pg8::TileOrder T; bool latent_only;
    __device__ __forceinline__ bool next(int i, pg8::Unit& u) const {
        const int nfull = T.nwg / T.G;
        int br, p = 0; bool piece = false;
        if (i < 3 * nfull) { const int ti = i / 3; br = i - ti * 3; if (!T.tile(ti, u.pm, u.pn)) return false; }
        else { if (i > 3 * nfull) return false; const int R = T.nwg - nfull * T.G; if (T.c >= R * 12) return false;
            const int j = T.c / 12, q = T.c - j * 12; br = q >> 2; p = q & 3; piece = true; if (!T.tile_at((long)nfull * T.G + j, u.pm, u.pn)) return false; }
        u.aux = piece ? (4 | (T.c << 3)) : br; u.nt = piece ? 2 : 512 / 64; if (latent_only) u.pm += u.pm / 32 + 1;
        const int acol = br == 0 ? O_A : br == 1 ? O_B1 : O_C;
        u.aoff = ((size_t)u.pm * 256 * OPITCH + acol) * 2 + (size_t)p * 256; u.boff = ((size_t)br * D + u.pn * 256) * 512 * 2 + (size_t)p * 256; return true; }
    __device__ __forceinline__ void a_ready(const pg8::Unit&) const {}
    __device__ __forceinline__ void done(const pg8::Unit&) const {}
};
struct SchedMoe {
    pg8::TileOrder T; int pp1, pp2, pp3, pp4, pp5, pp6, pp7, nt; size_t astep, bexp, bstep;
    __device__ __forceinline__ void init(const MoeOff& o, int nN, int G, int c, size_t astep_, size_t bexp_, size_t bstep_, int nt_) {
        nt = nt_;
        T.init(o.off[8] >> 8, nN, G, c); pp1 = o.off[1] >> 8; pp2 = o.off[2] >> 8; pp3 = o.off[3] >> 8; pp4 = o.off[4] >> 8; pp5 = o.off[5] >> 8; pp6 = o.off[6] >> 8; pp7 = o.off[7] >> 8;
        astep = astep_; bexp = bexp_; bstep = bstep_; }
    __device__ __forceinline__ bool next(int i, pg8::Unit& u) const {
        if (!T.tile(i, u.pm, u.pn)) return false;
        const int e = (u.pm >= pp1) + (u.pm >= pp2) + (u.pm >= pp3) + (u.pm >= pp4) + (u.pm >= pp5) + (u.pm >= pp6) + (u.pm >= pp7);
        u.aux = e; u.nt = nt; u.aoff = (size_t)u.pm * astep; u.boff = (size_t)e * bexp + (size_t)u.pn * bstep; return true; }
    __device__ __forceinline__ void a_ready(const pg8::Unit&) const {}
    __device__ __forceinline__ void done(const pg8::Unit&) const {}
};
using pg8::f32x4;
struct EpiInProj {
    static constexpr bool PERM = true, AFTER_DRAIN = false;
    bf16* QKVC; bf16* G; const float* RT; unsigned char* Q8; float sc;
    __device__ __forceinline__ void operator()(const pg8::f32x4 (&acc)[2][2][4][2], const pg8::Unit& u, int wr, int wc, int fr, int fq) const {
        const int row0 = u.pm * 256 + wr * 64 + fr, c0 = u.pn * 256 + wc * 32 + 8 * fq;
        const bool qkv = u.pn < 15;
        const bool rope = (u.pn >= 3 && u.pn <= 6) && (u.pm % PANELS_PER_B != 0);
        const float qs = (u.pn == 3 || u.pn == 4 || u.pn == 9 || u.pn == 10) ? 0.125f * LOG2E : 1.0f;
        const bool f8copy = ATT8 && ((u.pn >= 3 && u.pn <= 6) || (u.pn >= 9 && u.pn <= 12));
        const float f8s = (u.pn == 3 || u.pn == 4 || u.pn == 9 || u.pn == 10) ? 4.0f : 0.25f;
        const int tbase = (u.pm % PANELS_PER_B - 1) * 256 + wr * 64 + fr;
        bf16* const base0 = qkv ? QKVC + (size_t)(c0 >> 6) * QKV_BLK + (c0 & 63) : G + (c0 - C_G);
        bf16* const base1 = qkv ? QKVC + (size_t)((c0 + 128) >> 6) * QKV_BLK + ((c0 + 128) & 63) : G + (c0 + 128 - C_G);
        const size_t pitch = qkv ? 64 : 3072;
#pragma unroll
        for (int ai = 0; ai < 2; ++ai)
#pragma unroll
            for (int m = 0; m < 4; ++m) {
                float cs[4] = {1.f, 1.f, 1.f, 1.f}, sn[4] = {0.f, 0.f, 0.f, 0.f};
                if (rope) { const int t = tbase + ai * 128 + m * 16, pos = (wc & 1) ? (t & 63) : (t >> 6);
                    const float* tp = RT + (size_t)(pos * 16 + 4 * fq) * 2; const pg8::f32x4 t0 = *(const GAS pg8::f32x4*)tp, t1 = *(const GAS pg8::f32x4*)(tp + 4);
                    cs[0] = t0[0]; sn[0] = t0[1]; cs[1] = t0[2]; sn[1] = t0[3]; cs[2] = t1[0]; sn[2] = t1[1]; cs[3] = t1[2]; sn[3] = t1[3]; }
#pragma unroll
                for (int bj = 0; bj < 2; ++bj) { pg8::f32x4 v0 = acc[ai][bj][m][0] * sc, v1 = acc[ai][bj][m][1] * sc;
                    if (rope) { const float a0 = v0[0] * cs[0] - v0[1] * sn[0], a1 = v0[0] * sn[0] + v0[1] * cs[0], a2 = v0[2] * cs[1] - v0[3] * sn[1], a3 = v0[2] * sn[1] + v0[3] * cs[1];
                        const float b0 = v1[0] * cs[2] - v1[1] * sn[2], b1 = v1[0] * sn[2] + v1[1] * cs[2], b2 = v1[2] * cs[3] - v1[3] * sn[3], b3 = v1[2] * sn[3] + v1[3] * cs[3];
                        v0 = (pg8::f32x4){a0, a1, a2, a3}; v1 = (pg8::f32x4){b0, b1, b2, b3}; }
                    v0 = v0 * qs; v1 = v1 * qs;
                    const size_t ro = (size_t)(row0 + ai * 128 + m * 16);
                    if (f8copy) { const int c = c0 + bj * 128; u32x2 w8; w8.x = pk4_fp8(v0[0] * f8s, v0[1] * f8s, v0[2] * f8s, v0[3] * f8s); w8.y = pk4_fp8(v1[0] * f8s, v1[1] * f8s, v1[2] * f8s, v1[3] * f8s);
                        *(GAS u32x2*)(Q8 + q8_blk(c) + ro * 64 + (c & 63)) = w8; continue; }
                    if (GATE8 && !qkv) { u32x2 w8; w8.x = pk4_fp8(v0[0], v0[1], v0[2], v0[3]); w8.y = pk4_fp8(v1[0], v1[1], v1[2], v1[3]);
                        *(GAS u32x2*)((unsigned char*)G + ro * 3072 + (c0 + bj * 128 - C_G)) = w8; }
                    else { v4u w; w.x = cvtpk(v0[0], v0[1]); w.y = cvtpk(v0[2], v0[3]); w.z = cvtpk(v1[0], v1[1]); w.w = cvtpk(v1[2], v1[3]);
                        *(GAS v4u*)((bj ? base1 : base0) + ro * pitch) = w; } }
                if (m & 1) asm volatile("" ::: "memory"); }
    }
};
struct EpiStore {
    static constexpr bool PERM = true, AFTER_DRAIN = false;
    bf16* O; int ldc; float sc;
    __device__ __forceinline__ void operator()(const pg8::f32x4 (&acc)[2][2][4][2], const pg8::Unit& u, int wr, int wc, int fr, int fq) const {
        const int row0 = u.pm * 256 + wr * 64 + fr, col0 = u.pn * 256 + wc * 32 + 8 * fq;
#pragma unroll
        for (int ai = 0; ai < 2; ++ai)
#pragma unroll
            for (int m = 0; m < 4; ++m) { bf16* rowp = O + (size_t)(row0 + ai * 128 + m * 16) * ldc + col0;
#pragma unroll
                for (int bj = 0; bj < 2; ++bj) { const pg8::f32x4 v0 = acc[ai][bj][m][0] * sc, v1 = acc[ai][bj][m][1] * sc;
                    v4u w; w.x = cvtpk(v0[0], v0[1]); w.y = cvtpk(v0[2], v0[3]); w.z = cvtpk(v1[0], v1[1]); w.w = cvtpk(v1[2], v1[3]);
                    *(GAS v4u*)(rowp + bj * 128) = w; } }
    }
};
template <bool OUT8> struct EpiSwiglu {
    static constexpr bool PERM = true, AFTER_DRAIN = false;
    unsigned char* H; int ldh; float sc;
    __device__ __forceinline__ void operator()(const pg8::f32x4 (&acc)[2][2][4][2], const pg8::Unit& u, int wr, int wc, int fr, int fq) const {
        const int row0 = u.pm * 256 + wr * 64 + fr, hid0 = u.pn * 128 + wc * 32 + 8 * fq;
#pragma unroll
        for (int ai = 0; ai < 2; ++ai)
#pragma unroll
            for (int m = 0; m < 4; ++m) { unsigned char* rowp = H + ((size_t)(row0 + ai * 128 + m * 16) * ldh + hid0) * (OUT8 ? 1 : 2);
                float h[8];
#pragma unroll
                for (int n = 0; n < 2; ++n)
#pragma unroll
                    for (int q = 0; q < 4; ++q) { const float g = acc[ai][0][m][n][q] * sc, up = acc[ai][1][m][n][q] * sc; h[4 * n + q] = g * sigmoidf_(g) * up; }
                if constexpr (OUT8) { u32x2 w; w.x = pk4_fp8(h[0], h[1], h[2], h[3]); w.y = pk4_fp8(h[4], h[5], h[6], h[7]); *(GAS u32x2*)rowp = w; }
                else { v4u w; w.x = cvtpk(h[0], h[1]); w.y = cvtpk(h[2], h[3]); w.z = cvtpk(h[4], h[5]); w.w = cvtpk(h[6], h[7]); *(GAS v4u*)rowp = w; } }
    }
};
static_assert(!GATE8, "the pipelined merge epilogue reads bf16 gate logits");
struct EpiMerge {
    static constexpr bool PERM = true, AFTER_DRAIN = false;
    const bf16* P; float* Mf; bf16* Mb;
    __device__ __forceinline__ void operator()(const pg8::f32x4 (&acc)[2][2][4][2], const pg8::Unit& u, int wr, int wc, int fr, int fq) const {
        if (u.aux & 4) {
            float* pbase = Mf + ((size_t)(u.aux >> 3) * 256 + (wr * 64 + fr)) * 256 + (wc * 32 + 8 * fq);
#pragma unroll
            for (int ai = 0; ai < 2; ++ai)
#pragma unroll
                for (int m = 0; m < 4; ++m) { float* rowp = pbase + (size_t)(ai * 128 + m * 16) * 256;
#pragma unroll
                    for (int bj = 0; bj < 2; ++bj) { *(GAS pg8::f32x4*)(rowp + bj * 128) = acc[ai][bj][m][0]; *(GAS pg8::f32x4*)(rowp + bj * 128 + 4) = acc[ai][bj][m][1]; }
                    if (m & 1) asm volatile("" ::: "memory"); }
            return;
        }
        const int br = u.aux, row0 = u.pm * 256 + wr * 64 + fr, col0 = u.pn * 256 + wc * 32 + 8 * fq;
        const bf16* gp = P + (size_t)row0 * 3072 + br * D + col0; bf16* mp0 = Mb + (size_t)row0 * D + col0;
        v4u gq[2][4], mq[2][4];
#define MRG_LOAD(g_, b_) do { _Pragma("unroll") for (int mm_ = 0; mm_ < 2; ++mm_) _Pragma("unroll") for (int bj_ = 0; bj_ < 2; ++bj_) { \
            const size_t r_ = (size_t)(((g_) >> 1) * 128 + (2 * ((g_) & 1) + mm_) * 16); \
            gq[b_][mm_ * 2 + bj_] = *(const GAS v4u*)(gp + r_ * 3072 + bj_ * 128); \
            if (br != 0) mq[b_][mm_ * 2 + bj_] = *(const GAS v4u*)(mp0 + r_ * D + bj_ * 128); } } while (0)
#pragma unroll
        for (int b_ = 0; b_ < 2; ++b_)
#pragma unroll
            for (int i_ = 0; i_ < 4; ++i_) mq[b_][i_] = (v4u){0u, 0u, 0u, 0u};
        MRG_LOAD(0, 0);
        asm volatile("" ::: "memory");
#pragma unroll
        for (int g = 0; g < 4; ++g) {
            if (g < 3) MRG_LOAD(g + 1, (g + 1) & 1);
            asm volatile("" ::: "memory");
#pragma unroll
            for (int mm = 0; mm < 2; ++mm)
#pragma unroll
                for (int bj = 0; bj < 2; ++bj) { const int ai = g >> 1, m = 2 * (g & 1) + mm;
                    const v4u gw = gq[g & 1][mm * 2 + bj], pw = mq[g & 1][mm * 2 + bj];
                    const pg8::f32x4 v0 = acc[ai][bj][m][0], v1 = acc[ai][bj][m][1];
                    pg8::f32x4 r0, r1;
                    r0[0] = sigmoidf_(bf_lo(gw.x)) * v0[0]; r0[1] = sigmoidf_(bf_hi(gw.x)) * v0[1]; r0[2] = sigmoidf_(bf_lo(gw.y)) * v0[2]; r0[3] = sigmoidf_(bf_hi(gw.y)) * v0[3];
                    r1[0] = sigmoidf_(bf_lo(gw.z)) * v1[0]; r1[1] = sigmoidf_(bf_hi(gw.z)) * v1[1]; r1[2] = sigmoidf_(bf_lo(gw.w)) * v1[2]; r1[3] = sigmoidf_(bf_hi(gw.w)) * v1[3];
                    if (br != 0) { r0[0] += bf_lo(pw.x); r0[1] += bf_hi(pw.x); r0[2] += bf_lo(pw.y); r0[3] += bf_hi(pw.y); r1[0] += bf_lo(pw.z); r1[1] += bf_hi(pw.z); r1[2] += bf_lo(pw.w); r1[3] += bf_hi(pw.w); }
                    v4u w; w.x = cvtpk(r0[0], r0[1]); w.y = cvtpk(r0[2], r0[3]); w.z = cvtpk(r1[0], r1[1]); w.w = cvtpk(r1[2], r1[3]);
                    *(GAS v4u*)(mp0 + (size_t)(ai * 128 + m * 16) * D + bj * 128) = w; }
            asm volatile("" ::: "memory");
        }
#undef MRG_LOAD
    }
};
struct EpiResid {
    static constexpr bool PERM = true, AFTER_DRAIN = false;
    bf16* XB; const float* gate; float sc;
    __device__ __forceinline__ void operator()(const pg8::f32x4 (&acc)[2][2][4][2], const pg8::Unit& u, int wr, int wc, int fr, int fq) const {
        const int b = u.pm / PANELS_PER_B, j = u.pm - b * PANELS_PER_B;
        const float* gv = gate + (size_t)((j == 0) ? 4 : b) * 6144;
        const int col0 = u.pn * 256 + wc * 32 + 8 * fq;
        pg8::f32x4 g4[2][2];
#pragma unroll
        for (int bj = 0; bj < 2; ++bj)
#pragma unroll
            for (int n = 0; n < 2; ++n) g4[bj][n] = *(const GAS pg8::f32x4*)(gv + col0 + bj * 128 + 4 * n) * sc;
        bf16* base = XB + (size_t)(u.pm * 256 + wr * 64 + fr) * D + col0;
        v4u wq[2][4];
#define RES_LOAD(g_, b_) do { _Pragma("unroll") for (int mm_ = 0; mm_ < 2; ++mm_) _Pragma("unroll") for (int bj_ = 0; bj_ < 2; ++bj_) \
            wq[b_][mm_ * 2 + bj_] = *(const GAS v4u*)(base + (size_t)(((g_) >> 1) * 128 + (2 * ((g_) & 1) + mm_) * 16) * D + bj_ * 128); } while (0)
        RES_LOAD(0, 0);
        asm volatile("" ::: "memory");
#pragma unroll
        for (int g = 0; g < 4; ++g) {
            if (g < 3) RES_LOAD(g + 1, (g + 1) & 1);
            asm volatile("" ::: "memory");
#pragma unroll
            for (int mm = 0; mm < 2; ++mm)
#pragma unroll
                for (int bj = 0; bj < 2; ++bj) { const int ai = g >> 1, m = 2 * (g & 1) + mm; const v4u w = wq[g & 1][mm * 2 + bj];
                    const pg8::f32x4 d0 = g4[bj][0] * acc[ai][bj][m][0], d1 = g4[bj][1] * acc[ai][bj][m][1];
                    v4u o; o.x = cvtpk(bf_lo(w.x) + d0[0], bf_hi(w.x) + d0[1]); o.y = cvtpk(bf_lo(w.y) + d0[2], bf_hi(w.y) + d0[3]);
                    o.z = cvtpk(bf_lo(w.z) + d1[0], bf_hi(w.z) + d1[1]); o.w = cvtpk(bf_lo(w.w) + d1[2], bf_hi(w.w) + d1[3]);
                    *(GAS v4u*)(base + (size_t)(ai * 128 + m * 16) * D + bj * 128) = o; }
            asm volatile("" ::: "memory");
        }
#undef RES_LOAD
    }
};

__device__ __forceinline__ void phase_merge_fix(Frame& F, CArgsP AP, int l) {
    pg8::TileOrder T; T.init(M / 256, D / 256, F.G, 0);
    const int nfull = T.nwg / T.G, R = T.nwg - nfull * T.G;
    const float* PART = (const float*)(AP->ws + WS_PART); const bf16* P = (const bf16*)(AP->ws + WS_P + WS_G_OFF); bf16* Mb = (bf16*)(AP->ws + WS_XN);
    for (int id = F.vcu * (NWAVES * 64) + F.tid; id < R * 8192; id += F.G * NWAVES * 64) {
        const int j = id >> 13, rem = id & 8191, rit = rem >> 5, ch = rem & 31;
        int pm, pn; if (!T.tile_at((long)nfull * T.G + j, pm, pn)) continue;
        const size_t row = (size_t)pm * 256 + rit; const int col = pn * 256 + ch * 8;
        float m8[8];
#pragma unroll
        for (int q = 0; q < 8; ++q) m8[q] = 0.f;
#pragma unroll
        for (int br = 0; br < 3; ++br) {
            f32x4 s0 = {0.f, 0.f, 0.f, 0.f}, s1 = {0.f, 0.f, 0.f, 0.f};
#pragma unroll
            for (int p = 0; p < 4; ++p) { const float* pp = PART + ((size_t)(j * 12 + br * 4 + p) * 256 + rit) * 256 + ch * 8; s0 += *(const GAS f32x4*)pp; s1 += *(const GAS f32x4*)(pp + 4); }
            float gl[8]; load_gates8(P, row * 3072 + br * D + col, gl);
            m8[0] += sigmoidf_(gl[0]) * s0[0]; m8[1] += sigmoidf_(gl[1]) * s0[1]; m8[2] += sigmoidf_(gl[2]) * s0[2]; m8[3] += sigmoidf_(gl[3]) * s0[3];
            m8[4] += sigmoidf_(gl[4]) * s1[0]; m8[5] += sigmoidf_(gl[5]) * s1[1]; m8[6] += sigmoidf_(gl[6]) * s1[2]; m8[7] += sigmoidf_(gl[7]) * s1[3];
        }
        v4u w; w.x = cvtpk(m8[0], m8[1]); w.y = cvtpk(m8[2], m8[3]); w.z = cvtpk(m8[4], m8[5]); w.w = cvtpk(m8[6], m8[7]);
        *(GAS v4u*)(Mb + row * D + col) = w;
    }
}
#ifndef CFG_PV8
#define CFG_PV8 3
#endif
#ifndef CFG_PAIR
#define CFG_PAIR 1
#endif
#if CFG_PAIR == 2
#define FS8FN attn_fs8q
#elif CFG_PAIR
#define FS8FN attn_fs8p
#else
#define FS8FN attn_fs8
#endif
#ifndef F8_BA
#define F8_BA 5
#endif
#ifndef F8_BB
#define F8_BB 7
#endif
#if !CFG_ATT8
#undef CFG_PV8
#define CFG_PV8 0
#endif
constexpr size_t WS_VT8 = WS_XN;
constexpr int NVB = 18;
static_assert((size_t)NVB * M * 64 <= (size_t)M * D * 2, "V^T tiles fit the XN region");
__device__ __forceinline__ const unsigned char* vt8_tiles(CArgsP AP, int vb, size_t r0) { return AP->ws + WS_VT8 + ((size_t)vb * (M / 64) + r0 / 64) * 4096; }
__device__ __forceinline__ void phase_vt8(Frame& F, CArgsP AP) {
    const int gw = F.vcu * NWAVES + F.wave, NGW = F.G * NWAVES;
    const bf16* P = (const bf16*)(AP->ws + WS_P); unsigned char* VT = AP->ws + WS_VT8;
    LAS unsigned* T = (LAS unsigned*)(F.lds + RING_OFF) + F.wave * (64 * 17);
    const LAS unsigned char* Tb = (const LAS unsigned char*)T;
    const int k = F.lane, kk = k & 31, pos = ((kk >> 2) & 1) * 32 + (kk & 3) + 4 * (kk >> 3) + 16 * (k >> 5);
    constexpr int VB0 = (CFG_PV8 & 2) ? 0 : ((CFG_PV8 & 1) ? 2 : 10), VB1 = (CFG_PV8 & 4) ? 18 : ((CFG_PV8 & 1) ? 10 : 2);
    for (int it = gw + VB0 * (M / 64); it < VB1 * (M / 64); it += NGW) {
        const int vb = it / (M / 64), tile = it - vb * (M / 64);
        const int col = vb < 2 ? C_AV + 64 * vb : (vb < 10 ? C_BV + 64 * (vb - 2) : C_CV + 64 * (vb - 10));
        const bf16* src = P + qkv_blk(col) + ((size_t)tile * 64 + k) * 64;
        v4u w[8];
#pragma unroll
        for (int j = 0; j < 8; ++j) w[j] = *(const GAS v4u*)(src + 8 * j);
#pragma unroll
        for (int j = 0; j < 8; ++j) {
            T[pos * 17 + 2 * j] = pk4_fp8(8.f * bf_lo(w[j].x), 8.f * bf_hi(w[j].x), 8.f * bf_lo(w[j].y), 8.f * bf_hi(w[j].y));
            T[pos * 17 + 2 * j + 1] = pk4_fp8(8.f * bf_lo(w[j].z), 8.f * bf_hi(w[j].z), 8.f * bf_lo(w[j].w), 8.f * bf_hi(w[j].w)); }
        asm volatile("s_waitcnt lgkmcnt(0)" ::: "memory");
        unsigned char* dst = VT + ((size_t)vb * (M / 64) + tile) * 4096 + (size_t)k * 64;
#pragma unroll
        for (int g4 = 0; g4 < 4; ++g4) { unsigned o[4];
#pragma unroll
            for (int g = 0; g < 4; ++g) { const int p0 = 16 * g4 + 4 * g;
                o[g] = (unsigned)Tb[(p0 + 0) * 68 + k] | ((unsigned)Tb[(p0 + 1) * 68 + k] << 8) | ((unsigned)Tb[(p0 + 2) * 68 + k] << 16) | ((unsigned)Tb[(p0 + 3) * 68 + k] << 24); }
            *(GAS v4u*)(dst + 16 * g4) = (v4u){o[0], o[1], o[2], o[3]}; }
        asm volatile("s_waitcnt lgkmcnt(0)" ::: "memory");
    }
}
#ifndef CFG_BFUSE
#define CFG_BFUSE 1
#endif
__device__ __forceinline__ v4u ld16_sc1(const bf16* p) { v4u r; asm volatile("global_load_dwordx4 %0, %1, off sc1" : "=v"(r) : "v"(p) : "memory"); return r; }
__device__ __forceinline__ void bcomb_unit(Frame& F, CArgsP AP, int l, size_t row0, int head) {
    bf16* OB = (bf16*)(AP->ws + WS_O);
    const int lane = F.tid & 63, wave = __builtin_amdgcn_readfirstlane(F.tid >> 6), l16 = lane & 15, rsub = lane >> 4;
    const float li = layer_lam_init(l);
    const float s1 = wave_sum(AP->in[I_LQ1][l * 64 + lane] * AP->in[I_LK1][l * 64 + lane]), s2 = wave_sum(AP->in[I_LQ2][l * 64 + lane] * AP->in[I_LK2][l * 64 + lane]);
    const float lam = __expf(s1) - __expf(s2) + li;
    const float post = 1.0f - li;
    float sg[8];
#pragma unroll
    for (int q = 0; q < 8; ++q) sg[q] = AP->in[I_SUBLN][l * 128 + 8 * l16 + q] * post;
    asm volatile("s_waitcnt vmcnt(0)" ::: "memory");
    bf16* const pr0 = OB + (row0 + (size_t)(wave * 32 + rsub)) * OPITCH + head * 128 + 8 * l16;
    v4u av[8], bv[8];
#pragma unroll
    for (int i = 0; i < 8; ++i) { av[i] = ld16_sc1(pr0 + (size_t)(4 * i) * OPITCH + O_B1); bv[i] = ld16_sc1(pr0 + (size_t)(4 * i) * OPITCH + O_B2); }
    asm volatile("s_waitcnt vmcnt(0)" ::: "memory");
#pragma unroll
    for (int i = 0; i < 8; ++i) {
        v4u a = av[i], b = bv[i];
        asm volatile("" : "+v"(a), "+v"(b));
        float d[8];
        d[0] = bf_lo(a.x) - lam * bf_lo(b.x); d[1] = bf_hi(a.x) - lam * bf_hi(b.x); d[2] = bf_lo(a.y) - lam * bf_lo(b.y); d[3] = bf_hi(a.y) - lam * bf_hi(b.y);
        d[4] = bf_lo(a.z) - lam * bf_lo(b.z); d[5] = bf_hi(a.z) - lam * bf_hi(b.z); d[6] = bf_lo(a.w) - lam * bf_lo(b.w); d[7] = bf_hi(a.w) - lam * bf_hi(b.w);
        float ss = 0.f;
#pragma unroll
        for (int q = 0; q < 8; ++q) ss += d[q] * d[q];
#pragma unroll
        for (int o = 1; o < 16; o <<= 1) ss += __shfl_xor(ss, o);
        const float rs = 1.0f / sqrtf(ss * (1.0f / 128.0f) + EPS);
        v4u o; o.x = cvtpk(d[0] * rs * sg[0], d[1] * rs * sg[1]); o.y = cvtpk(d[2] * rs * sg[2], d[3] * rs * sg[3]); o.z = cvtpk(d[4] * rs * sg[4], d[5] * rs * sg[5]); o.w = cvtpk(d[6] * rs * sg[6], d[7] * rs * sg[7]);
        *(GAS v4u*)(pr0 + (size_t)(4 * i) * OPITCH + O_B1) = o;
    }
}
#ifndef CFG_FS2
#define CFG_FS2 0
#endif
#if CFG_PV8 & 1
#define FSU2(Q_, K_, V_, VT_, TR_, ...) attn_body::FS8FN<2, false, F8_BB>(VT_, TR_, __VA_ARGS__)
#else
#define FSU2(Q_, K_, V_, VT_, TR_, ...) attn_body::attn_fs<2, false, ATT8>(Q_, K_, V_, __VA_ARGS__)
#endif
#if CFG_PV8 & 2
#define FSU1(Q_, K_, V_, VT_, TR_, ...) attn_body::FS8FN<1, false, F8_BA>(VT_, TR_, __VA_ARGS__)
#else
#define FSU1(Q_, K_, V_, VT_, TR_, ...) attn_body::attn_fs<1, false, ATT8>(Q_, K_, V_, __VA_ARGS__)
#endif
#if CFG_PV8 & 4
#define FSUC(Q_, K_, V_, VT_, TR_, ...) attn_body::FS8FN<1, true, F8_BA>(VT_, TR_, __VA_ARGS__)
#else
#define FSUC(Q_, K_, V_, VT_, TR_, ...) attn_body::attn_fs<1, true, ATT8>(Q_, K_, V_, __VA_ARGS__)
#endif
__device__ __forceinline__ void attn_fast(Frame& F, CArgsP AP, int l, char* shm, LAS float* bt, int parts) {
    using abf = attn_body::bf16;
    const abf* P = (const abf*)(AP->ws + WS_P); abf* OB = (abf*)(AP->ws + WS_O);
    const int nunits = 3072 + ((l < DEPTH - 1) ? 96 : 0);
    if (parts & 1) for (int f = F.vcu + 4 * 256; f < nunits; f += F.G) {
        const int round = f >> 8, v = f & 255, x = v >> 5, c = v & 31;
        int b, head, map0, map1, qrow, NT;
        if (round >= 4 && round < 8) { const int i4 = round - 4; b = x >> 1; head = 2 * (x & 1) + (i4 >> 1); map0 = map1 = i4 & 1; qrow = CTX + 256 * c; NT = NTOK / 64; }
        else if (f >= 3072 + 32 && f < 3072 + 48) { const int w = f - 3072 - 32; b = w >> 2; head = w & 3; map0 = 0; map1 = 1; qrow = 0; NT = CTX / 64; }
        else continue;
        const size_t r0 = (size_t)b * NTOK;
        for (int map = map0; map <= map1; ++map) {
        const abf* Qp = P + qkv_blk(C_BQ + map * 256 + head * 64) + (r0 + qrow) * 64; const abf* Kp = P + qkv_blk(C_BK + map * 256 + head * 64) + r0 * 64; const abf* Vp = P + qkv_blk(C_BV + head * 128) + r0 * 64;
        abf* Op = OB + (r0 + qrow) * OPITCH + (map ? O_B2 : O_B1) + head * 128;
        const unsigned char* Q8 = AP->ws + WS_Q8;
        if (FSU2(Qp, Kp, Vp, vt8_tiles(AP, 2 + 2 * head, r0), (NT > 4 ? 4 : 0), Op, NT, 0, 0, (attn_body::lds_cfptr)bt, shm, Q8 + q8_blk(C_BQ + map * 256 + head * 64) + (r0 + qrow) * 64, Q8 + q8_blk(C_BK + map * 256 + head * 64) + r0 * 64)) {
            attn_body::attn_unit<8, false, ATT8>(Qp, Kp, Vp, Op, NT, 0, 0, (attn_body::lds_cfptr)bt, shm, Q8 + q8_blk(C_BQ + map * 256 + head * 64) + (r0 + qrow) * 64, Q8 + q8_blk(C_BK + map * 256 + head * 64) + r0 * 64);
            attn_body::attn_unit<8, false, ATT8>(Qp, Kp, Vp + QKV_BLK, Op + 64, NT, 0, 0, (attn_body::lds_cfptr)bt, shm, Q8 + q8_blk(C_BQ + map * 256 + head * 64) + (r0 + qrow) * 64, Q8 + q8_blk(C_BK + map * 256 + head * 64) + r0 * 64); }
        }
        if (CFG_BFUSE && map1 == 1) bcomb_unit(F, AP, l, r0 + qrow, head);
    }
    if (parts & 2) for (int f = F.vcu; f < nunits; f += F.G) {
        const int round = f >> 8, v = f & 255, x = v >> 5, c = v & 31;
        int b, qcol, kcol, vcol, ocol, qrow, NT;
        if (round < 4) { b = x >> 1; const int kvh = x & 1, qh = kvh * 4 + round; qcol = C_AQ + qh * 64; kcol = C_AK + kvh * 64; vcol = C_AV + kvh * 64; ocol = O_A + qh * 64; qrow = CTX + 256 * c; NT = NTOK / 64; }
        else if (f >= 3072 && f < 3072 + 32) { const int w = f - 3072; b = w >> 3; const int qh = w & 7, kvh = qh >> 2; qcol = C_AQ + qh * 64; kcol = C_AK + kvh * 64; vcol = C_AV + kvh * 64; ocol = O_A + qh * 64; qrow = 0; NT = CTX / 64; }
        else if (f >= 3072 + 64) { const int w = f - 3072 - 64; b = w >> 3; const int h = w & 7; qcol = C_CQ + h * 64; kcol = C_CK + h * 64; vcol = C_CV + h * 64; ocol = O_C + h * 64; qrow = 0; NT = CTX / 64; }
        else continue;
        const size_t r0 = (size_t)b * NTOK;
        const unsigned char* Q8 = AP->ws + WS_Q8;
        bool redo;
        if (((CFG_PV8 & 2) != 0) && (vcol < C_CV || (CFG_PV8 & 4) != 0))
            redo = attn_body::FS8FN<1, false, F8_BA>(vt8_tiles(AP, vcol >= C_CV ? 10 + ((vcol - C_CV) >> 6) : ((vcol - C_AV) >> 6), r0), (NT > 4 ? 4 : 0), OB + (r0 + qrow) * OPITCH + ocol, NT, 0, 0, (attn_body::lds_cfptr)bt, shm,
                                           Q8 + q8_blk(qcol) + (r0 + qrow) * 64, Q8 + q8_blk(kcol) + r0 * 64);
        else
            redo = attn_body::attn_fs<1, false, ATT8>(P + qkv_blk(qcol) + (r0 + qrow) * 64, P + qkv_blk(kcol) + r0 * 64, P + qkv_blk(vcol) + r0 * 64, OB + (r0 + qrow) * OPITCH + ocol, NT, 0, 0, (attn_body::lds_cfptr)bt, shm,
                                           Q8 + q8_blk(qcol) + (r0 + qrow) * 64, Q8 + q8_blk(kcol) + r0 * 64);
        if (redo)
            attn_body::attn_unit<8, false, ATT8>(P + qkv_blk(qcol) + (r0 + qrow) * 64, P + qkv_blk(kcol) + r0 * 64, P + qkv_blk(vcol) + r0 * 64, OB + (r0 + qrow) * OPITCH + ocol, NT, 0, 0, (attn_body::lds_cfptr)bt, shm,
                                           Q8 + q8_blk(qcol) + (r0 + qrow) * 64, Q8 + q8_blk(kcol) + r0 * 64);
    }
    if (parts & 4) for (int f = F.vcu + 8 * 256; f < 3072; f += F.G) {
        const int round = f >> 8, v = f & 255, x = v >> 5, c = v & 31;
        const int b = x >> 1, h = 4 * (x & 1) + (round - 8), g0 = 4 * c; int kr0 = g0 - 4; kr0 = kr0 < 0 ? 0 : (kr0 > 116 ? 116 : kr0);
        const size_t r0 = (size_t)b * NTOK; const int qrow = CTX + 256 * c;
        const unsigned char* Q8 = AP->ws + WS_Q8;
        if (FSUC(P + qkv_blk(C_CQ + h * 64) + (r0 + qrow) * 64, P + qkv_blk(C_CK + h * 64) + r0 * 64, P + qkv_blk(C_CV + h * 64) + r0 * 64, vt8_tiles(AP, 10 + h, r0), 4 + (g0 + 2 - kr0), OB + (r0 + qrow) * OPITCH + O_C + h * 64, 16, kr0, g0,
                                    (attn_body::lds_cfptr)(bt + h * 465), shm, Q8 + q8_blk(C_CQ + h * 64) + (r0 + qrow) * 64, Q8 + q8_blk(C_CK + h * 64) + r0 * 64))
            attn_body::attn_unit<8, true, ATT8>(P + qkv_blk(C_CQ + h * 64) + (r0 + qrow) * 64, P + qkv_blk(C_CK + h * 64) + r0 * 64, P + qkv_blk(C_CV + h * 64) + r0 * 64, OB + (r0 + qrow) * OPITCH + O_C + h * 64, 16, kr0, g0,
                                    (attn_body::lds_cfptr)(bt + h * 465), shm, Q8 + q8_blk(C_CQ + h * 64) + (r0 + qrow) * 64, Q8 + q8_blk(C_CK + h * 64) + r0 * 64);
    }
}
__device__ __forceinline__ void phase_attn(Frame& F, CArgsP AP, int l, unsigned char* lds_generic, int parts) {
    char* shm = (char*)lds_generic + RING_OFF;
    LAS float* bt = (LAS float*)(F.lds + BIAS_OFF);
    for (int i = F.tid; i < 8 * 465; i += NWAVES * 64) bt[i] = AP->in[I_RPB][(size_t)l * 8 * 465 + i] * LOG2E;
    __syncthreads();
    attn_fast(F, AP, l, shm, bt, parts);
}

#ifndef DUP_PHASE
#define DUP_PHASE (-1)
#endif
#ifndef DUP_PHASE_B
#define DUP_PHASE_B (-1)
#endif
#ifndef PROBE_NOEPI
#define PROBE_NOEPI 0
#endif
#ifndef DUP_ATT
#define DUP_ATT 7
#endif
#ifndef DUP_VT
#define DUP_VT 1
#endif
#ifndef DUP_CONV
#define DUP_CONV 1
#endif
#if defined(PROBE_A)
#define TS0() do { if (blockIdx.x == 0) { t_begin = __builtin_amdgcn_s_memrealtime(); } } while (0)
#define TS1(id) do { if (blockIdx.x == 0) { const unsigned long long d_ = __builtin_amdgcn_s_memrealtime() - t_begin; if ((id) == PROBE_A) t_a += d_; if ((id) == PROBE_B) t_b += d_; } } while (0)
#else
#define TS0() do {} while (0)
#define TS1(id) do {} while (0)
#endif
__global__ void __launch_bounds__(NWAVES * 64, 2) fwd_kernel(Args args) {
    extern __shared__ __attribute__((aligned(16))) unsigned char lds[];
    Frame F;
    F.lds = (LAS unsigned char*)lds;
    REFRESH(F);
    F.G = gridDim.x; { const int bx = blockIdx.x; F.vcu = (F.G % 8 == 0) ? (bx % 8) * (F.G / 8) + bx / 8 : bx; }
    for (int u = F.tid; u < (LDS_BYTES - LDSCTL_OFF) / 4; u += NWAVES * 64) ((LAS unsigned*)(F.lds + LDSCTL_OFF))[u] = 0u;
    __syncthreads();
    {   CArgsP AP = fresh_args(); (void)xcd_barrier_post((unsigned*)(AP->ws + WS_CTL) + CW_BAR, (volatile LAS unsigned*)(F.lds + MISC_OFF) + 8); }
#ifndef DUP_BAR
#define DUP_BAR 1
#endif
#define GRID_BAR() for (int nb_ = 0; nb_ < DUP_BAR; ++nb_) do { CArgsP AP_ = fresh_args(); XcdBarrier b_; b_.bar = (unsigned*)(AP_->ws + WS_CTL) + CW_BAR; b_.x = xb_xcc_id(); b_.st = (volatile LAS unsigned*)(F.lds + MISC_OFF) + 8; xcd_barrier(b_); } while (0)
#define PH(...) do { REFRESH(F); CArgsP AP = fresh_args(); __VA_ARGS__; } while (0)
    const int G = F.G, cblk = (int)blockIdx.x;

#if defined(PROBE_A)
    unsigned long long t_begin = 0, t_a = 0, t_b = 0;
#endif
    TS0();
        for (int rep_ = 0; rep_ < ((0 == DUP_PHASE || 0 == DUP_PHASE_B || DUP_PHASE == 99) ? 2 : 1); ++rep_) {
    PH(prologue_mod(F, AP));
    PH(convert_weights(F, AP, 0));
    GRID_BAR();
        }
    TS1(0); TS0();

    for (int l = 0; l < DEPTH; ++l) {
        for (int rep_ = 0; rep_ < ((1 == DUP_PHASE || 1 == DUP_PHASE_B || DUP_PHASE == 99) ? 2 : 1); ++rep_) {
        if (l > 0) { for (int rc_ = 0; rc_ < DUP_CONV; ++rc_) { PH(convert_weights(F, AP, l)); } }
        PH(phase_norm1(F, AP, l, rep_ + 1 == ((1 == DUP_PHASE || 1 == DUP_PHASE_B || DUP_PHASE == 99) ? 2 : 1)));
        GRID_BAR();
        }
        TS1(1); TS0();
        for (int rep_ = 0; rep_ < ((2 == DUP_PHASE || 2 == DUP_PHASE_B || DUP_PHASE == 99) ? 2 : 1); ++rep_) {
        {   CArgsP AP = fresh_args();
            pg8::Gemm g{(const bf16*)(AP->ws + WS_XN), (const bf16*)(AP->ws + WS_WIN), D, D, D};
            if constexpr (IN8_TILES > 0) {
                pg8::Gemm g8{(const bf16*)(AP->ws + WS_MB), (const bf16*)(AP->ws + WS_WIN8), D, D, D};
                SchedPlain S; S.T.init(M / 256, IN8_TILES, G, cblk); S.astep = (size_t)256 * D; S.bstep = (size_t)256 * D; S.latent_only = false; S.nt = D / 128; S.tail_split = false; S.colmap = 1;
                EpiInProj E{(bf16*)(AP->ws + WS_P), (bf16*)(AP->ws + WS_P + WS_G_OFF), (const float*)(AP->ws + WS_ROPE), AP->ws + WS_Q8, WSCI};
                pg8::gemm_phase<EpiInProj, SchedPlain, true, true>(F.lds + RING_OFF, g8, S, E, !PROBE_NOEPI || rep_ + 1 == ((2 == DUP_PHASE || 2 == DUP_PHASE_B || DUP_PHASE == 99) ? 2 : 1)); }
            if constexpr (IN8_TILES < 27) {
                SchedPlain S; S.T.init(M / 256, DIN / 256 - IN8_TILES, G, cblk); S.astep = (size_t)256 * D * 2; S.bstep = (size_t)256 * D * 2; S.latent_only = false; S.nt = D / 64; S.tail_split = false; S.colmap = (IN8_TILES > 0) ? 2 : 0;
                EpiInProj E{(bf16*)(AP->ws + WS_P), (bf16*)(AP->ws + WS_P + WS_G_OFF), (const float*)(AP->ws + WS_ROPE), AP->ws + WS_Q8, 1.0f};
                pg8::gemm_phase<EpiInProj, SchedPlain, true, false>(F.lds + RING_OFF, g, S, E); } }
        GRID_BAR();
        }
        TS1(2); TS0();
        for (int rep_ = 0; rep_ < ((3 == DUP_PHASE || 3 == DUP_PHASE_B || DUP_PHASE == 99) ? 2 : 1); ++rep_) {
        PH(phase_post(F, AP, l, rep_ + 1 == ((3 == DUP_PHASE || 3 == DUP_PHASE_B || DUP_PHASE == 99) ? 2 : 1)));
        if (CFG_PV8) for (int rv_ = 0; rv_ < DUP_VT; ++rv_) PH(phase_vt8(F, AP));
        GRID_BAR();
        }
        TS1(3); TS0();
        for (int rep_ = 0; rep_ < ((4 == DUP_PHASE || 4 == DUP_PHASE_B || DUP_PHASE == 99) ? 2 : 1); ++rep_) {
        PH(phase_attn(F, AP, l, lds, rep_ ? DUP_ATT : 7));
        GRID_BAR();
        }
        TS1(4); TS0();
        for (int rep_ = 0; rep_ < ((5 == DUP_PHASE || 5 == DUP_PHASE_B || DUP_PHASE == 99) ? 2 : 1); ++rep_) {
        if (!CFG_BFUSE) { PH(phase_bcomb(F, AP, l, rep_ + 1 == ((5 == DUP_PHASE || 5 == DUP_PHASE_B || DUP_PHASE == 99) ? 2 : 1)));
        GRID_BAR(); }
        }
        TS1(5); TS0();
        for (int rep_ = 0; rep_ < ((6 == DUP_PHASE || 6 == DUP_PHASE_B || DUP_PHASE == 99) ? 2 : 1); ++rep_) {
        {   CArgsP AP = fresh_args();
            pg8::Gemm g{(const bf16*)(AP->ws + WS_O), (const bf16*)(AP->ws + WS_WBR), OPITCH, 512, 512};
            const bool lastl = (l == DEPTH - 1);
            SchedMerge S; S.T.init(lastl ? BATCH * SEQ / 256 : M / 256, D / 256, G, cblk); S.latent_only = lastl;
            EpiMerge E{(const bf16*)(AP->ws + WS_P + WS_G_OFF), (float*)(AP->ws + WS_PART), (bf16*)(AP->ws + WS_XN)};
            pg8::gemm_phase<EpiMerge, SchedMerge, true>(F.lds + RING_OFF, g, S, E, !PROBE_NOEPI || rep_ + 1 == ((6 == DUP_PHASE || 6 == DUP_PHASE_B || DUP_PHASE == 99) ? 2 : 1)); }
        GRID_BAR();
        if (l < DEPTH - 1) { PH(phase_merge_fix(F, AP, l)); GRID_BAR(); }
        }
        TS1(6); TS0();
        for (int rep_ = 0; rep_ < ((7 == DUP_PHASE || 7 == DUP_PHASE_B || DUP_PHASE == 99) ? 2 : 1); ++rep_) {
        {   CArgsP AP = fresh_args();
            pg8::Gemm g{(const bf16*)(AP->ws + WS_XN), (const bf16*)(AP->ws + WS_WOUT), D, D, D};
            const bool lastl = (l == DEPTH - 1);
            SchedPlain S; S.T.init(lastl ? BATCH * SEQ / 256 : M / 256, D / 256, G, cblk); S.astep = (size_t)256 * D * 2; S.bstep = (size_t)256 * D * 2; S.latent_only = lastl; S.nt = D / 64; S.colmap = 0; S.tail_split = TAIL_SPLIT;
            EpiResid E{(bf16*)(AP->ws + WS_XB), (const float*)(AP->ws + WS_MOD) + (size_t)(l * 5) * 6144 + 2 * 1024, (rep_ + 1 == ((7 == DUP_PHASE || 7 == DUP_PHASE_B || DUP_PHASE == 99) ? 2 : 1)) ? 1.0f : 0.0f};
            pg8::gemm_phase<EpiResid, SchedPlain, true>(F.lds + RING_OFF, g, S, E); }
        GRID_BAR();
        }
        TS1(7); TS0();
        for (int rep_ = 0; rep_ < ((8 == DUP_PHASE || 8 == DUP_PHASE_B || DUP_PHASE == 99) ? 2 : 1); ++rep_) {
        PH(phase_norm2(F, AP, l, rep_ + 1 == ((8 == DUP_PHASE || 8 == DUP_PHASE_B || DUP_PHASE == 99) ? 2 : 1)));
        GRID_BAR();
        }
        TS1(8); TS0();
        if (!(l & 1)) {
        for (int rep_ = 0; rep_ < ((9 == DUP_PHASE || 9 == DUP_PHASE_B || DUP_PHASE == 99) ? 2 : 1); ++rep_) {
            {   CArgsP AP = fresh_args();
                constexpr int EB = DENSE8 ? 1 : 2;
                pg8::Gemm g{(const bf16*)(AP->ws + WS_XN), (const bf16*)(AP->ws + WS_W13), D, D, D};
                SchedPlain S; S.T.init(M / 256, 2 * FF / 256, G, cblk); S.astep = (size_t)256 * D * EB; S.bstep = (size_t)256 * D * EB; S.latent_only = false; S.nt = DENSE8 ? D / 128 : D / 64; S.tail_split = false; S.colmap = 0;
                EpiSwiglu<DENSE8> E{AP->ws + WS_P, FF, DENSE8 ? WSCI : 1.0f};
                pg8::gemm_phase<EpiSwiglu<DENSE8>, SchedPlain, true, DENSE8>(F.lds + RING_OFF, g, S, E); }
            GRID_BAR();
        }
            TS1(9); TS0();
        for (int rep_ = 0; rep_ < ((10 == DUP_PHASE || 10 == DUP_PHASE_B || DUP_PHASE == 99) ? 2 : 1); ++rep_) {
            {   CArgsP AP = fresh_args();
                pg8::Gemm g{(const bf16*)(AP->ws + WS_P), (const bf16*)(AP->ws + WS_W2), FF, FF, FF};
                constexpr int EB = DENSE8 ? 1 : 2;
                SchedPlain S; S.T.init(M / 256, D / 256, G, cblk); S.astep = (size_t)256 * FF * EB; S.bstep = (size_t)256 * FF * EB; S.latent_only = false; S.nt = DENSE8 ? FF / 128 : FF / 64; S.tail_split = TAIL_SPLIT; S.colmap = 0;
                EpiResid E{(bf16*)(AP->ws + WS_XB), (const float*)(AP->ws + WS_MOD) + (size_t)(l * 5) * 6144 + 5 * 1024, (rep_ + 1 == ((10 == DUP_PHASE || 10 == DUP_PHASE_B || DUP_PHASE == 99) ? 2 : 1)) ? (DENSE8 ? WSCI : 1.0f) : 0.0f};
                pg8::gemm_phase<EpiResid, SchedPlain, true, DENSE8>(F.lds + RING_OFF, g, S, E); }
            GRID_BAR();
        }
            TS1(10); TS0();
        } else {
        for (int rep_ = 0; rep_ < ((11 == DUP_PHASE || 11 == DUP_PHASE_B || DUP_PHASE == 99) ? 2 : 1); ++rep_) {
            PH(phase_moe_gather(F, AP, l));
            GRID_BAR();
        }
            TS1(11); TS0();
        for (int rep_ = 0; rep_ < ((12 == DUP_PHASE || 12 == DUP_PHASE_B || DUP_PHASE == 99) ? 2 : 1); ++rep_) {
            {   CArgsP AP = fresh_args();
                MoeOff mo; moe_offsets(F, AP, l, mo);
                pg8::Gemm g{(const bf16*)(AP->ws + WS_MB), (const bf16*)(AP->ws + WS_W13), D, D, D};
                SchedMoe S; S.init(mo, 2 * FE / 256, G, cblk, (size_t)256 * D, (size_t)2 * FE * D, (size_t)256 * D, D / 128);
                EpiSwiglu<MOEDOWN8> E{AP->ws + WS_P, FE, WSCI};
                pg8::gemm_phase<EpiSwiglu<MOEDOWN8>, SchedMoe, true, true>(F.lds + RING_OFF, g, S, E, !PROBE_NOEPI || rep_ + 1 == ((12 == DUP_PHASE || 12 == DUP_PHASE_B || DUP_PHASE == 99) ? 2 : 1)); }
            GRID_BAR();
        }
            TS1(12); TS0();
        for (int rep_ = 0; rep_ < ((13 == DUP_PHASE || 13 == DUP_PHASE_B || DUP_PHASE == 99) ? 2 : 1); ++rep_) {
            {   CArgsP AP = fresh_args();
                MoeOff mo; moe_offsets(F, AP, l, mo);
                pg8::Gemm g{(const bf16*)(AP->ws + WS_P), (const bf16*)(AP->ws + WS_W2), FE, FE, FE};
                constexpr int EB = MOEDOWN8 ? 1 : 2;
                SchedMoe S; S.init(mo, D / 256, G, cblk, (size_t)256 * FE * EB, (size_t)D * FE * EB, (size_t)256 * FE * EB, MOEDOWN8 ? FE / 128 : FE / 64);
                EpiStore E{(bf16*)(AP->ws + WS_YS), D, MOEDOWN8 ? WSCI : 1.0f};
                pg8::gemm_phase<EpiStore, SchedMoe, true, MOEDOWN8>(F.lds + RING_OFF, g, S, E); }
            GRID_BAR();
        }
            TS1(13); TS0();
        }
    }
    {   REFRESH(F); CArgsP AP = fresh_args();
        const bool poison = __hip_atomic_load((unsigned*)(AP->ws + WS_CTL) + CW_BAR + XB_TMO, RLX_AGENT) != 0u;
        phase_final(F, AP, poison); }
#if defined(PROBE_A)
    TS1(14);
    {   CArgsP AP = fresh_args(); unsigned* pw = (unsigned*)(AP->ws + WS_CTL) + 16;
        if (blockIdx.x == 0 && threadIdx.x == 0) { __hip_atomic_store(pw, (unsigned)(t_a / 100ull), RLX_AGENT); __hip_atomic_store(pw + 1, (unsigned)(t_b / 100ull), RLX_AGENT); }
        GRID_BAR();
        const float ua = (float)__hip_atomic_load(pw, RLX_AGENT), ub = (float)__hip_atomic_load(pw + 1, RLX_AGENT);
        const float c1 = sqrtf(ua);
        for (size_t i = (size_t)blockIdx.x * (NWAVES * 64) + threadIdx.x; i < (size_t)BATCH * SEQ * D; i += (size_t)gridDim.x * (NWAVES * 64)) AP->out[i] = (i == 0) ? ub : c1; }
#endif
}

extern "C" void kernel_launch(void* const* d_in, const int* in_sizes, int n_in, void* d_out, int out_size, void* d_ws, size_t ws_size, hipStream_t stream) {
    static int grid = 0;
    if (grid == 0) {
        if (n_in != N_IN || in_sizes[0] != BATCH * SEQ * D || out_size != BATCH * SEQ * D || ws_size < WS_END) {
            fprintf(stderr, "kernel_launch: unexpected shapes: n_in %d in0 %d out %d ws %zu (need %zu)\n", n_in, n_in > 0 ? in_sizes[0] : -1, out_size, ws_size, (size_t)WS_END); grid = -1; return; }
        int dev = 0, cus = 0;
        if (hipGetDevice(&dev) != hipSuccess || hipDeviceGetAttribute(&cus, hipDeviceAttributeMultiprocessorCount, dev) != hipSuccess) { fprintf(stderr, "kernel_launch: device query failed\n"); grid = -1; return; }
        if (hipFuncSetAttribute((const void*)fwd_kernel, hipFuncAttributeMaxDynamicSharedMemorySize, LDS_BYTES) != hipSuccess) { fprintf(stderr, "kernel_launch: hipFuncSetAttribute failed\n"); grid = -1; return; }
        int per_cu = 0;
        if (hipOccupancyMaxActiveBlocksPerMultiprocessor(&per_cu, (const void*)fwd_kernel, NWAVES * 64, LDS_BYTES) != hipSuccess || per_cu < 1)
            fprintf(stderr, "kernel_launch: note: occupancy query reports %d workgroups per CU\n", per_cu);
        (void)hipGetLastError();
        grid = cus;
    }
    if (grid < 0) return;
    if (hipMemsetAsync((char*)d_ws + WS_CTL, 0, CTL_ZERO_BYTES, stream) != hipSuccess) { fprintf(stderr, "kernel_launch: memset failed\n"); return; }
    Args a{};
    for (int i = 0; i < N_IN; ++i) a.in[i] = (const float*)d_in[i];
    a.out = (float*)d_out; a.ws = (unsigned char*)d_ws;
    hipLaunchKernelGGL(fwd_kernel, dim3(grid), dim3(NWAVES * 64), LDS_BYTES, stream, a);
    const hipError_t le = hipPeekAtLastError();
    if (le != hipSuccess) fprintf(stderr, "kernel_launch: launch failed: %s\n", hipGetErrorName(le));
}
```

```cpp
#include <hip/hip_runtime.h>
#include <cstdio>
#include <cstdint>
namespace pg8 {
#define PG8_LAS __attribute__((address_space(3)))
typedef unsigned short bf16_t;
typedef short bf16x8 __attribute__((ext_vector_type(8)));
typedef float f32x4 __attribute__((ext_vector_type(4)));
typedef unsigned u32x4 __attribute__((ext_vector_type(4)));
constexpr int BM = 256, BK = 64, HALF = 128, HTB = HALF * BK * 2  , STAGE_BYTES = 8 * HTB, NXCD = 8, WGM = 8;

__host__ __device__ __forceinline__ int lds_byte(int r, int c) { const int st = (r >> 4) * 2 + (c >> 5), rr = r & 15, cc = c & 31, ob = rr * 64 + cc * 2; return st * 1024 + (ob ^ (((ob >> 9) & 1) << 5)); }
__host__ __device__ __forceinline__ void stage_rc(int b, int& R, int& C) { const int st = b / 1024, sb = b % 1024, swz = sb ^ (((sb >> 9) & 1) << 5); R = (st >> 1) * 16 + swz / 64; C = (st & 1) * 32 + (swz % 64) / 2; }
__host__ __device__ __forceinline__ int perm32(int rho) { const int n = rho >> 4, i = rho & 15; return 8 * (i >> 2) + 4 * n + (i & 3); }

struct Unit { int pm, pn, aux, nt; size_t aoff, boff; };
struct Gemm { const bf16_t* A; const bf16_t* Bt; int lda, ldb, K; };

struct TileOrder {
    int nM, nN, nwg, G, c;
    __host__ __device__ void init(int nM_, int nN_, int G_, int c_) { nM = nM_; nN = nN_; nwg = nM * nN; G = G_; c = c_; }
    __host__ __device__ bool tile(int i, int& pm, int& pn) const { return tile_at((long)i * G + c, pm, pn); }
    __host__ __device__ bool tile_at(long L, int& pm, int& pn) const {
        if (L >= nwg) return false;
        int wgid = (int)L; { const int q = nwg / NXCD, r = nwg % NXCD, xcd = wgid % NXCD, off = wgid / NXCD; wgid = (xcd < r ? xcd * (q + 1) : r * (q + 1) + (xcd - r) * q) + off; }
        const int nig = WGM * nN, gid = wgid / nig, fm = gid * WGM, gsz = (nM - fm) < WGM ? (nM - fm) : WGM;
        pm = fm + ((wgid % nig) % gsz); pn = (wgid % nig) / gsz; return true;
    }
};
__device__ __forceinline__ unsigned cvt_pk_bf16(float lo, float hi) { unsigned r; asm volatile("v_cvt_pk_bf16_f32 %0, %1, %2" : "=v"(r) : "v"(lo), "v"(hi)); return r; }
typedef float f32x2 __attribute__((ext_vector_type(2)));

typedef int i32x4_t __attribute__((ext_vector_type(4)));
typedef int i32x8_t __attribute__((ext_vector_type(8)));
__device__ __forceinline__ i32x8_t cat8(bf16x8 a, bf16x8 b) { const i32x4_t lo = __builtin_bit_cast(i32x4_t, a), hi = __builtin_bit_cast(i32x4_t, b); return __builtin_shufflevector(lo, hi, 0, 1, 2, 3, 4, 5, 6, 7); }
__device__ __forceinline__ void mfma8(f32x4& acc, i32x8_t a, i32x8_t b) { asm volatile("v_mfma_f32_16x16x128_f8f6f4 %0, %1, %2, %0" : "+v"(acc) : "v"(a), "v"(b)); }
template <class Epi, class Sched, bool ALIGN_EPI = false, bool F8 = false>
__device__ __forceinline__ void gemm_phase(PG8_LAS unsigned char* lds, const Gemm g, const Sched& S, const Epi& E, const bool do_epi = true) {
    int tid_ = threadIdx.x; asm volatile("; LAUNDER" : "+v"(tid_));
    const int tid = tid_, wid = __builtin_amdgcn_readfirstlane(tid >> 6), lane = tid & 63, wr = wid >> 2, wc = wid & 3, fr = lane & 15, fq = lane >> 4;
    (void)g.K;
    unsigned voffA[2], voffB[2];
#pragma unroll
    for (int i = 0; i < 2; ++i) { int R, C; stage_rc(tid * 16 + i * 8192, R, C); const int Rb = Epi::PERM ? ((R & ~31) + perm32(R & 31)) : R;
        if constexpr (F8) { const int p = C >> 3, gch = (p < 4) ? 2 * p : 2 * (p - 4) + 1; voffA[i] = (unsigned)(R * g.lda + 16 * gch); voffB[i] = (unsigned)(Rb * g.ldb + 16 * gch); }
        else { voffA[i] = (unsigned)(R * g.lda + C) * 2u; voffB[i] = (unsigned)(Rb * g.ldb + C) * 2u; } }
    const size_t kstep = (size_t)(BK * 2);
    const size_t hstepA = (size_t)HALF * g.lda * (F8 ? 1 : 2), hstepB = (size_t)HALF * g.ldb * (F8 ? 1 : 2);
    const unsigned ldsw = (unsigned)wid * 1024u;
    const int aoff = lds_byte(wr * 64 + fr, fq * 8), boff = lds_byte(wc * 32 + fr, fq * 8);
#define PG8_SA(b, h) (((b) * 2 + (h)) * HTB)
#define PG8_SB(b, h) ((4 + (b) * 2 + (h)) * HTB)
#define PG8_STAGE(bufoff, gbase, voff) do { _Pragma("unroll") for (int _i = 0; _i < 2; ++_i) \
        __builtin_amdgcn_global_load_lds((const unsigned*)((const char*)(gbase) + (voff)[_i]), (PG8_LAS unsigned*)(lds + (bufoff) + ldsw + _i * 8192), 16, 0, 0); } while (0)
#define PG8_LDA(dst, b, h) do { _Pragma("unroll") for (int m = 0; m < 4; ++m) _Pragma("unroll") for (int k = 0; k < 2; ++k) dst[m][k] = *(const PG8_LAS bf16x8*)(lds + PG8_SA(b, h) + aoff + m * 2048 + k * 1024); } while (0)
#define PG8_LDB(dst, b, h) do { _Pragma("unroll") for (int n = 0; n < 2; ++n) _Pragma("unroll") for (int k = 0; k < 2; ++k) dst[n][k] = *(const PG8_LAS bf16x8*)(lds + PG8_SB(b, h) + boff + n * 2048 + k * 1024); } while (0)
#define PG8_MMA(ai, bj, At, Bt) do { __builtin_amdgcn_s_setprio(1); if constexpr (F8) { _Pragma("unroll") for (int m = 0; m < 4; ++m) _Pragma("unroll") for (int n = 0; n < 2; ++n) \
        mfma8(acc[ai][bj][m][n], cat8(Bt[n][0], Bt[n][1]), cat8(At[m][0], At[m][1])); } else { \
        _Pragma("unroll") for (int m = 0; m < 4; ++m) _Pragma("unroll") for (int n = 0; n < 2; ++n) _Pragma("unroll") for (int k = 0; k < 2; ++k) \
        acc[ai][bj][m][n] = __builtin_amdgcn_mfma_f32_16x16x32_bf16(Bt[n][k], At[m][k], acc[ai][bj][m][n], 0, 0, 0); } __builtin_amdgcn_s_setprio(0); } while (0)
#define PG8_WAIT_V(n) asm volatile("s_waitcnt vmcnt(" #n ")" ::: "memory")
#define PG8_WAIT_L(n) asm volatile("s_waitcnt lgkmcnt(" #n ")" ::: "memory")
#define PG8_BAR __builtin_amdgcn_s_barrier()
#define PG8_SCHED __builtin_amdgcn_sched_barrier(0)
    Unit cur, nxt; int ui = 0;
    if (!S.next(0, cur)) return;
    f32x4 acc[2][2][4][2];
#pragma unroll
    for (int a = 0; a < 2; ++a)
#pragma unroll
        for (int b = 0; b < 2; ++b)
#pragma unroll
            for (int m = 0; m < 4; ++m)
#pragma unroll
                for (int n = 0; n < 2; ++n) acc[a][b][m][n] = (f32x4){0.f, 0.f, 0.f, 0.f};
    bf16x8 At[4][2], B0[2][2], B1[2][2];
    const char* cA = (const char*)g.A + cur.aoff; const char* cB = (const char*)g.Bt + cur.boff;
    S.a_ready(cur);
    PG8_STAGE(PG8_SB(0, 0), cB, voffB); PG8_STAGE(PG8_SB(0, 1), cB + hstepB, voffB); PG8_STAGE(PG8_SA(0, 0), cA, voffA); PG8_STAGE(PG8_SA(0, 1), cA + hstepA, voffA);
    if (wr == 1) PG8_BAR;
    PG8_WAIT_V(2); PG8_BAR;
    PG8_STAGE(PG8_SB(1, 0), cB + kstep, voffB); PG8_STAGE(PG8_SA(1, 0), cA + kstep, voffA); PG8_STAGE(PG8_SB(1, 1), cB + hstepB + kstep, voffB);
    PG8_WAIT_V(6); PG8_BAR;
    for (;;) {
        const bool has_next = S.next(ui + 1, nxt);
        const char* nA = has_next ? (const char*)g.A + nxt.aoff : cA; const char* nB = has_next ? (const char*)g.Bt + nxt.boff : cB;
        const int nt = cur.nt;
        for (int t = 0; t < nt; t += 2) {
            const bool last = (t == nt - 2);
            const char* a1 = cA + (size_t)(t + 1) * kstep;
            const char* a2 = last ? nA : cA + (size_t)(t + 2) * kstep; const char* b2 = last ? nB : cB + (size_t)(t + 2) * kstep;
            const char* a3 = a2 + kstep; const char* b3 = b2 + kstep;
            if (last && has_next) S.a_ready(nxt);
            PG8_LDB(B0, 0, 0); PG8_LDB(B1, 0, 1); PG8_SCHED; PG8_LDA(At, 0, 0); PG8_STAGE(PG8_SA(1, 1), a1 + hstepA, voffA);
            PG8_WAIT_V(8); PG8_WAIT_L(0); PG8_BAR; PG8_MMA(0, 0, At, B0); PG8_MMA(0, 1, At, B1); PG8_BAR; PG8_SCHED;
            PG8_LDA(At, 0, 1); PG8_STAGE(PG8_SB(0, 0), b2, voffB); PG8_STAGE(PG8_SB(0, 1), b2 + hstepB, voffB); PG8_STAGE(PG8_SA(0, 0), a2, voffA);
            PG8_WAIT_V(8); PG8_WAIT_L(0); PG8_BAR; PG8_MMA(1, 0, At, B0); PG8_MMA(1, 1, At, B1); PG8_BAR; PG8_SCHED;
            PG8_LDB(B0, 1, 0); PG8_LDB(B1, 1, 1); PG8_SCHED; PG8_LDA(At, 1, 0); PG8_STAGE(PG8_SA(0, 1), a2 + hstepA, voffA);
            PG8_WAIT_V(8); PG8_WAIT_L(0); PG8_BAR; PG8_MMA(0, 0, At, B0); PG8_MMA(0, 1, At, B1); PG8_BAR; PG8_SCHED;
            PG8_LDA(At, 1, 1); PG8_STAGE(PG8_SB(1, 0), b3, voffB); PG8_STAGE(PG8_SB(1, 1), b3 + hstepB, voffB); PG8_STAGE(PG8_SA(1, 0), a3, voffA);
            PG8_WAIT_V(8); PG8_WAIT_L(0); PG8_BAR; PG8_MMA(1, 0, At, B0); PG8_MMA(1, 1, At, B1); PG8_BAR; PG8_SCHED;
        }
        if constexpr (ALIGN_EPI) { if (wr == 0) PG8_BAR; }
        if constexpr (F8) asm volatile("s_nop 15\n\ts_nop 15 ; F8NOP: asm MFMA results -> VALU readers" ::: "memory");
        bool keep_acc = false;
        if constexpr (Epi::CHAIN) { keep_acc = E.chain(acc, cur, wr, wc, fr, fq); S.done(cur); }
        else if constexpr (!Epi::AFTER_DRAIN) { if (do_epi) E(acc, cur, wr, wc, fr, fq); S.done(cur); }
        if (!has_next) break;
        if (!keep_acc) {
#pragma unroll
        for (int a = 0; a < 2; ++a)
#pragma unroll
            for (int b = 0; b < 2; ++b)
#pragma unroll
                for (int m = 0; m < 4; ++m)
#pragma unroll
                    for (int n = 0; n < 2; ++n) acc[a][b][m][n] = (f32x4){0.f, 0.f, 0.f, 0.f};
        }
        cur = nxt; cA = nA; cB = nB; ++ui;
        if constexpr (ALIGN_EPI) { if (wr == 1) PG8_BAR; }
    }
    PG8_WAIT_V(0);
    if constexpr (!ALIGN_EPI) { if (wr == 0) PG8_BAR; }
    PG8_BAR;
    if constexpr (Epi::AFTER_DRAIN) { E.fused(acc, cur, wr, wc, fr, fq, lds, wid, lane); S.done(cur); }
#undef PG8_SA
#undef PG8_SB
#undef PG8_STAGE
#undef PG8_LDA
#undef PG8_LDB
#undef PG8_MMA
#undef PG8_WAIT_V
#undef PG8_WAIT_L
#undef PG8_BAR
#undef PG8_SCHED
}
}
#include <hip/hip_bf16.h>
#include <cmath>
#include <hip/hip_bf16.h>
#include <cmath>
namespace attn_body {
using bf16=__hip_bfloat16;
using bf16x8=__attribute__((ext_vector_type(8)))short;
using s16x4=__attribute__((ext_vector_type(4)))short;
using f32x16=__attribute__((ext_vector_type(16)))float;
using u32x4=__attribute__((ext_vector_type(4)))unsigned;
constexpr int D=64, QKP=64, OPITCH=2048;
constexpr long QKV_BLK=33792L*64;
constexpr int NW=8,QBLK=32,QB=QBLK*NW,KVBLK=64;
constexpr int ATTN_UNIT_ROWS=QB;
__device__ __forceinline__ int crow(int r,int hi){return (r&3)+8*(r>>2)+4*hi;}
#define SBAR() __builtin_amdgcn_sched_barrier(0)
typedef __attribute__((address_space(3))) const float* lds_cfptr;
__device__ __forceinline__ void cbias(f32x16&p0,f32x16&p1,int t,int kr0,int r0,int wid,int r32,int hi,lds_cfptr bt){
  if(t<4)return;
  asm volatile("; LAUNDER":"+v"(r32),"+v"(hi));
  const float NEG=-INFINITY; const int kr=kr0+t-4, r=r0+(wid>>1); int rs=r-4; rs=rs<0?0:(rs>120?120:rs);
  if(kr<rs||kr>=rs+8){
    #pragma unroll
    for(int rr=0;rr<16;++rr){p0[rr]=NEG;p1[rr]=NEG;}
    return; }
  const int dr=kr-r+7, qc=32*(wid&1)+r32; int cs=qc-8; cs=cs<0?0:(cs>48?48:cs);
  const lds_cfptr brow=bt+dr*31;
  #pragma unroll
  for(int rr=0;rr<16;++rr){
    const int kc=(rr&3)+8*(rr>>2)+4*hi;
    { const int dc=kc-qc+15; const bool ok=(kc>=cs)&&(kc<cs+16); const int di=dc<0?0:(dc>30?30:dc); const float b=brow[di]; p0[rr]=ok?p0[rr]+b:NEG; }
    { const int k2=kc+32, dc=k2-qc+15; const bool ok=(k2>=cs)&&(k2<cs+16); const int di=dc<0?0:(dc>30?30:dc); const float b=brow[di]; p1[rr]=ok?p1[rr]+b:NEG; }
  }
}

template<int PAR> __device__ __forceinline__ void cbias_par(f32x16&p0,f32x16&p1,int t,int kr0,int r0,int wid,int r32,int hi,lds_cfptr bt){
  if(t<4)return;
  asm volatile("; LAUNDER":"+v"(r32),"+v"(hi));
  const float NEG=-INFINITY; const int kr=kr0+t-4, r=r0+(wid>>1); int rs=r-4; rs=rs<0?0:(rs>120?120:rs);
  if(kr<rs||kr>=rs+8){
    #pragma unroll
    for(int rr=0;rr<16;++rr){p0[rr]=NEG;p1[rr]=NEG;}
    return; }
  const int dr=kr-r+7, qc=32*PAR+r32; int cs=qc-8; cs=cs<0?0:(cs>48?48:cs);
  const lds_cfptr bl=bt+dr*31+(15-qc+4*hi);
  const int ncs=4*hi-cs;
  #pragma unroll
  for(int rr=0;rr<16;++rr){
    const int kconst=(rr&3)+8*(rr>>2);
    if constexpr(PAR==0){
      { const unsigned d=(unsigned)(kconst+ncs); const float b=bl[kconst]; p0[rr]=(d<16u)?p0[rr]+b:NEG; }
      if(kconst<8){ const unsigned d=(unsigned)(kconst+32+ncs); const float b=bl[kconst+32]; p1[rr]=(d<16u)?p1[rr]+b:NEG; } else p1[rr]=NEG;
    } else {
      if(kconst>=24){ const unsigned d=(unsigned)(kconst+ncs); const float b=bl[kconst]; p0[rr]=(d<16u)?p0[rr]+b:NEG; } else p0[rr]=NEG;
      { const unsigned d=(unsigned)(kconst+32+ncs); const float b=bl[kconst+32]; p1[rr]=(d<16u)?p1[rr]+b:NEG; }
    }
  }
}
constexpr int NSLOT=3, SLOTB=8192;
constexpr int LDS_K=0, LDS_V=NSLOT*SLOTB, LDS_WS=2*NSLOT*SLOTB, LDS_OST=LDS_WS+NW*64*4, LDS_BYTES=LDS_OST+NW*4096;
constexpr float C2=0.125f*1.4426950408889634f;
__device__ __forceinline__ void glds16(const void*gsrc,unsigned lds_dst){unsigned keep;
  asm volatile("s_mov_b32 %0, m0\n\ts_mov_b32 m0, %2\n\ts_nop 0\n\tglobal_load_lds_dwordx4 %1, off\n\ts_mov_b32 m0, %0":"=&s"(keep):"v"(gsrc),"s"(lds_dst):"memory");}
__device__ __forceinline__ void glds16s(const void*sbase,unsigned voff,unsigned lds_dst){unsigned keep;
  asm volatile("s_mov_b32 %0, m0\n\ts_mov_b32 m0, %3\n\ts_nop 0\n\tglobal_load_lds_dwordx4 %1, %2\n\ts_mov_b32 m0, %0":"=&s"(keep):"v"(voff),"s"(sbase),"s"(lds_dst):"memory");}
__device__ __forceinline__ float max3f(float a,float b,float c){float r;asm("v_max3_f32 %0, %1, %2, %3":"=v"(r):"v"(a),"v"(b),"v"(c));return r;}
__device__ __forceinline__ float max2f(float a,float b){float r;asm("v_max_f32_e32 %0, %1, %2":"=v"(r):"v"(a),"v"(b));return r;}
__device__ __forceinline__ float fadd_s(float a,float b){float r;asm("v_add_f32_e32 %0, %1, %2":"=v"(r):"v"(a),"v"(b));return r;}
__device__ __forceinline__ float fsub_s(float a,float b){float r;asm("v_sub_f32_e32 %0, %1, %2":"=v"(r):"v"(a),"v"(b));return r;}
typedef float f32x2_t __attribute__((ext_vector_type(2))); typedef __bf16 bf16x2_t __attribute__((ext_vector_type(2)));
__device__ __forceinline__ unsigned cvtpk_s(float lo,float hi){f32x2_t v={lo,hi};bf16x2_t b=__builtin_convertvector(v,bf16x2_t);return __builtin_bit_cast(unsigned,b);}
#define WAIT_BAR(N) asm volatile("s_waitcnt vmcnt(" #N ") lgkmcnt(0)\n\ts_barrier":::"memory")

__device__ __forceinline__ void qkt(f32x16&p0,f32x16&p1,const char*Kslot,const bf16x8*qr,const f32x16&negm,int r32,int hi){
  const char*kb=Kslot+hi*1024+r32*16;
  #pragma unroll
  for(int d0=0;d0<4;++d0){
    const bf16x8 b0=*reinterpret_cast<const bf16x8*>(kb+d0*2048);
    const bf16x8 b1=*reinterpret_cast<const bf16x8*>(kb+d0*2048+512);
    if(d0==0){p0=__builtin_amdgcn_mfma_f32_32x32x16_bf16(b0,qr[0],negm,0,0,0);p1=__builtin_amdgcn_mfma_f32_32x32x16_bf16(b1,qr[0],negm,0,0,0);}
    else{p0=__builtin_amdgcn_mfma_f32_32x32x16_bf16(b0,qr[d0],p0,0,0,0);p1=__builtin_amdgcn_mfma_f32_32x32x16_bf16(b1,qr[d0],p1,0,0,0);}}
}
typedef __attribute__((address_space(3))) const char* lds_cptr;
typedef short v4i16_t __attribute__((ext_vector_type(4)));
__device__ __forceinline__ void kload8(bf16x8*kf,lds_cptr kp){
  kf[0]=*(const __attribute__((address_space(3))) bf16x8*)(kp);      kf[1]=*(const __attribute__((address_space(3))) bf16x8*)(kp+512);
  kf[2]=*(const __attribute__((address_space(3))) bf16x8*)(kp+2048); kf[3]=*(const __attribute__((address_space(3))) bf16x8*)(kp+2560);
  kf[4]=*(const __attribute__((address_space(3))) bf16x8*)(kp+4096); kf[5]=*(const __attribute__((address_space(3))) bf16x8*)(kp+4608);
  kf[6]=*(const __attribute__((address_space(3))) bf16x8*)(kp+6144); kf[7]=*(const __attribute__((address_space(3))) bf16x8*)(kp+6656);
}
__device__ __forceinline__ void kload2(bf16x8*kf,lds_cptr kp,int j){ kf[2*j]=*(const __attribute__((address_space(3))) bf16x8*)(kp+j*2048); kf[2*j+1]=*(const __attribute__((address_space(3))) bf16x8*)(kp+j*2048+512); }
__device__ __forceinline__ s16x4 vtr(lds_cptr p){ return __builtin_bit_cast(s16x4,__builtin_amdgcn_ds_read_tr16_b64_v4i16((__attribute__((address_space(3))) v4i16_t*)p)); }
__device__ __forceinline__ float rowmax(const f32x16&p0,const f32x16&p1){
  float a=max3f(p0[0],p0[1],p1[0]),b=max3f(p0[2],p0[3],p1[1]);a=max3f(a,p1[2],p1[3]);
  #pragma unroll
  for(int r=4;r<16;r+=4){a=max3f(a,p0[r],p0[r+1]);b=max3f(b,p0[r+2],p0[r+3]);a=max3f(a,p1[r],p1[r+1]);b=max3f(b,p1[r+2],p1[r+3]);}
  const float m=max2f(a,b);
  auto rr=__builtin_amdgcn_permlane32_swap(__float_as_uint(m),__float_as_uint(m),false,false);
  return max2f(__uint_as_float(rr[0]),__uint_as_float(rr[1]));
}
__device__ __forceinline__ void pv(f32x16*o,int vb,bf16x8 pa0,bf16x8 pa1,bf16x8 pa2,bf16x8 pa3){
  #pragma unroll
  for(int d0=0;d0<2;++d0){s16x4 lo[4],hi[4];
    #pragma unroll
    for(int ks=0;ks<4;++ks){
      asm volatile("ds_read_b64_tr_b16 %0,%1 offset:%c2":"=&v"(lo[ks]):"v"(vb),"i"(d0*4096+ks*1024):"memory");
      asm volatile("ds_read_b64_tr_b16 %0,%1 offset:%c2":"=&v"(hi[ks]):"v"(vb),"i"(d0*4096+ks*1024+512):"memory");}
    asm volatile("s_waitcnt lgkmcnt(0)":::"memory");SBAR();
    #define PK(k) (bf16x8){lo[k][0],lo[k][1],lo[k][2],lo[k][3],hi[k][0],hi[k][1],hi[k][2],hi[k][3]}
    o[d0]=__builtin_amdgcn_mfma_f32_32x32x16_bf16(pa0,PK(0),o[d0],0,0,0);
    o[d0]=__builtin_amdgcn_mfma_f32_32x32x16_bf16(pa1,PK(1),o[d0],0,0,0);
    o[d0]=__builtin_amdgcn_mfma_f32_32x32x16_bf16(pa2,PK(2),o[d0],0,0,0);
    o[d0]=__builtin_amdgcn_mfma_f32_32x32x16_bf16(pa3,PK(3),o[d0],0,0,0);
    #undef PK
  }
}

#ifndef ATTN_STORE16
#define ATTN_STORE16(p,v) (*(u32x4*)(p)=(v))
#endif
typedef int i32x8a __attribute__((ext_vector_type(8)));
typedef int i32x4a __attribute__((ext_vector_type(4)));
__device__ __forceinline__ i32x8a cat8a(i32x4a lo,i32x4a hi){ return __builtin_shufflevector(lo,hi,0,1,2,3,4,5,6,7); }
__device__ __forceinline__ i32x8a kfrag8(lds_cptr kp){ return cat8a(*(const __attribute__((address_space(3))) i32x4a*)(kp), *(const __attribute__((address_space(3))) i32x4a*)(kp+1024)); }
#define MF8(a,b,c) __builtin_amdgcn_mfma_scale_f32_32x32x64_f8f6f4(a,b,c,0,0,0,0,0,0)
template<int THRL,bool ISC,bool K8> __device__ __forceinline__ void attn_unit(const bf16*Qw0,const bf16*__restrict__ Kh,const bf16*__restrict__ Vh,bf16*Ow0,int NT,int kr0,int r0,lds_cfptr bt,char*shm,const unsigned char*Q8w0,const unsigned char*__restrict__ K8h){
  int tid_=threadIdx.x; asm volatile("; LAUNDER":"+v"(tid_)); const int tid=tid_,lane=tid&63,r32=lane&31,hi=lane>>5; const int wid=__builtin_amdgcn_readfirstlane(tid>>6);
  const bf16*Qw=Qw0+(long)(wid*QBLK)*QKP;
  const unsigned lds0=(unsigned)(uintptr_t)shm;
  float*wsf=(float*)(shm+LDS_WS)+wid*64;
  const bf16*ksrc=Kh+(long)lane*QKP+wid*8;
  const unsigned char*ksrc8=K8h+(long)lane*64+(wid&3)*16;
  const bf16*vsrc=Vh+(long)(16*(wid&3)+(lane>>2))*QKP+(wid>>2)*32+(lane&3)*8;
  const unsigned kdst=lds0+LDS_K+(K8?(wid&3):wid)*1024, vdst=lds0+LDS_V+wid*1024;
  #define KROW(t) (ISC ? ((t)<4 ? 64*(t) : 256+64*(kr0+(t)-4)) : 64*(t))
  #define DMA_K(t,slot) do{ if constexpr(K8){ glds16(ksrc8+(long)KROW(t)*64,(unsigned)__builtin_amdgcn_readfirstlane(kdst+(slot))); } else { glds16(ksrc+(long)KROW(t)*QKP,(unsigned)__builtin_amdgcn_readfirstlane(kdst+(slot))); } }while(0)
  #define DMA_V(t,slot) glds16(vsrc+(long)KROW(t)*QKP,(unsigned)__builtin_amdgcn_readfirstlane(vdst+(slot)))
  const int vb0=(int)(lds0+LDS_V)+((lane>>4)&1)*32+(lane&3)*8+(4*hi+((lane&15)>>2))*64;
  const char*Kbase=shm+LDS_K; bf16x8 kf[8];
  const lds_cptr shm3=(lds_cptr)shm; const lds_cptr kp0=shm3+LDS_K+(K8?2*hi:hi)*1024+r32*16; const lds_cptr vp0=shm3+LDS_V+((lane>>4)&1)*32+(lane&3)*8+(4*hi+((lane&15)>>2))*64;
  DMA_K(0,0);DMA_V(0,0);DMA_K(1,SLOTB);
  bf16x8 qr[4]; i32x8a q8=i32x8a{}; i32x8a k8a=i32x8a{},k8b=i32x8a{};
  if constexpr(K8){ const unsigned char*qp=Q8w0+(long)(wid*QBLK+r32)*64+32*hi; q8=cat8a(*reinterpret_cast<const i32x4a*>(qp),*reinterpret_cast<const i32x4a*>(qp+16));
    #pragma unroll
    for(int d0=0;d0<4;++d0)qr[d0]=bf16x8{}; }
  else {
  #pragma unroll
  for(int d0=0;d0<4;++d0)qr[d0]=*reinterpret_cast<const bf16x8*>(&Qw[(long)r32*QKP+d0*16+hi*8]); }
  float mhat=0.f,l_reg=0.f;f32x16 o[2];o[0]=f32x16{};o[1]=f32x16{};f32x16 negm=f32x16{};asm volatile("":"+v"(negm));
  #define CMASK(P0,P1,t) do{ if constexpr(ISC){ cbias(P0,P1,(t),kr0,r0,wid,r32,hi,bt); } }while(0)
  bool resc=false;
  #define START(P0,P1) do{ const float rm=rowmax(P0,P1); resc=false; \
    { const float dl=rm; mhat=fadd_s(mhat,dl); \
      _Pragma("unroll") for(int r=0;r<16;++r){P0[r]=fsub_s(P0[r],dl);P1[r]=fsub_s(P1[r],dl);} \
      _Pragma("unroll") for(int r=0;r<16;++r)negm[r]=-mhat; asm volatile("":"+v"(negm)); } \
    _Pragma("unroll") for(int r=0;r<16;++r)P0[r]=__builtin_amdgcn_exp2f(P0[r]); }while(0)
  #define RESC() do{ if(resc){ asm volatile("s_waitcnt lgkmcnt(0)":::"memory"); \
      _Pragma("unroll") for(int d_=0;d_<2;++d_) _Pragma("unroll") for(int r=0;r<16;++r)o[d_][r]*=wsf[crow(r,hi)]; } }while(0)
  f32x16 pA0,pA1,pB0,pB1;
  int sl_prev=0,sl_cur=0,sl_next=SLOTB;
  #define ROT() do{sl_prev=sl_cur;sl_cur=sl_next;sl_next=(sl_next==(NSLOT-1)*SLOTB)?0:sl_next+SLOTB;}while(0)
  DMA_K(2,2*SLOTB);
  WAIT_BAR(3);
  if constexpr(K8){ pA0=MF8(kfrag8(kp0),q8,negm); pA1=MF8(kfrag8(kp0+512),q8,negm); } else qkt(pA0,pA1,Kbase,qr,negm,r32,hi);
  asm volatile("s_nop 15\n\ts_nop 7":"+v"(pA0),"+v"(pA1));CMASK(pA0,pA1,0);
  START(pA0,pA1);
  _Pragma("unroll") for(int r=0;r<16;++r)pA1[r]=__builtin_amdgcn_exp2f(pA1[r]);
  WAIT_BAR(0);
  DMA_K(3,0);DMA_V(1,SLOTB);
  ROT();
  if constexpr(K8){ k8a=kfrag8(kp0+sl_cur); k8b=kfrag8(kp0+sl_cur+512); } else kload8(kf,kp0+sl_cur);
  WAIT_BAR(2);
  s16x4 vlo[8],vhi[8]; u32x4 pw0,pw1,pw2,pw3;
  #define PKW(P,B) cvtpk_s(P[B],P[B+1])
  #define PAF(k) __builtin_bit_cast(bf16x8,pw##k)
  #define VFR(i) (bf16x8){vlo[i][0],vlo[i][1],vlo[i][2],vlo[i][3],vhi[i][0],vhi[i][1],vhi[i][2],vhi[i][3]}
  #define PIN(x) asm volatile("":"+v"(x))
  #define MX3(a,b,c) __builtin_fmaxf(__builtin_fmaxf((a),(b)),(c))
  #define GAPA(MF,A0,A1,A2,A3,W0,W1,PW) do{ MF; sacc+=A0; sacc+=A1; sacc+=A2; sacc+=A3; PIN(sacc); W0; W1; PIN(PW); SBAR(); }while(0)
  #define EX(v) __builtin_amdgcn_exp2f(v)
  #define GAPB(MF,X,B) do{ MF; X[B]=EX(X[B]); X[B+1]=EX(X[B+1]); X[B+2]=EX(X[B+2]); X[B+3]=EX(X[B+3]); PIN(X); SBAR(); }while(0)
  #define VRD(i) do{ vlo[i]=vtr(vp_+(((i)>>2)*4096+((i)&3)*1024)); vhi[i]=vtr(vp_+(((i)>>2)*4096+((i)&3)*1024+512)); }while(0)
  #define KRD(G,j) do{ if(G){ if constexpr(K8){ if constexpr((j)==0){ k8a=kfrag8(kp0+sl_next); SBAR(); } else if constexpr((j)==1){ k8b=kfrag8(kp0+sl_next+512); SBAR(); } } else { kload2(kf,kp0+sl_next,j); SBAR(); } } }while(0)
  #define QKMU(i,C0,C1) do{ if constexpr(K8){ if constexpr((i)==0){ C0=MF8(k8a,q8,negm); } else if constexpr((i)==4){ C1=MF8(k8b,q8,negm); } } else { \
      if constexpr((i)==0){ C0=__builtin_amdgcn_mfma_f32_32x32x16_bf16(kf[0],qr[0],negm,0,0,0); } else if constexpr((i)==1){ C1=__builtin_amdgcn_mfma_f32_32x32x16_bf16(kf[1],qr[0],negm,0,0,0); } \
      else if constexpr(((i)&1)==0){ C0=__builtin_amdgcn_mfma_f32_32x32x16_bf16(kf[i],qr[(i)>>1],C0,0,0,0); } else { C1=__builtin_amdgcn_mfma_f32_32x32x16_bf16(kf[i],qr[(i)>>1],C1,0,0,0); } } }while(0)
  #define STEP(C0,C1,P0,P1,t,GK,GV,GL) do{ SBAR(); \
    const lds_cptr vp_=vp0+sl_prev; \
    VRD(0); SBAR(); float sacc=(P0[0]+P0[1]); \
    GAPA(QKMU(0,C0,C1), P0[2],P0[3],P0[4],P0[5],     pw0[0]=PKW(P0,0), pw0[1]=PKW(P0,2), pw0); \
    VRD(4); SBAR(); GAPA(QKMU(1,C0,C1), P0[6],P0[7],P0[8],P0[9],     pw0[2]=PKW(P0,4), pw0[3]=PKW(P0,6), pw0); \
    VRD(1); SBAR(); GAPA(QKMU(2,C0,C1),   P0[10],P0[11],P0[12],P0[13], pw1[0]=PKW(P0,8), pw1[1]=PKW(P0,10), pw1); \
    VRD(5); SBAR(); GAPA(QKMU(3,C0,C1),   P0[14],P0[15],P1[0],P1[1],   pw1[2]=PKW(P0,12),pw1[3]=PKW(P0,14), pw1); \
    VRD(2); SBAR(); GAPA(QKMU(4,C0,C1),   P1[2],P1[3],P1[4],P1[5],     pw2[0]=PKW(P1,0), pw2[1]=PKW(P1,2), pw2); \
    VRD(6); SBAR(); GAPA(QKMU(5,C0,C1),   P1[6],P1[7],P1[8],P1[9],     pw2[2]=PKW(P1,4), pw2[3]=PKW(P1,6), pw2); \
    VRD(3); SBAR(); GAPA(QKMU(6,C0,C1),   P1[10],P1[11],P1[12],P1[13], pw3[0]=PKW(P1,8), pw3[1]=PKW(P1,10), pw3); \
    VRD(7); SBAR(); GAPA(QKMU(7,C0,C1),   P1[14],P1[15],0.f,0.f,       pw3[2]=PKW(P1,12),pw3[3]=PKW(P1,14), pw3); \
    l_reg+=sacc; \
    if(GK){DMA_K((t)+3,sl_cur);} if(GV){DMA_V((t)+1,sl_next);} \
    CMASK(C0,C1,t); \
    { float a=MX3(C0[0],C0[1],C1[0]),b=MX3(C0[2],C0[3],C1[1]); a=MX3(a,C1[2],C1[3]); \
      _Pragma("unroll") for(int r=4;r<16;r+=4){a=MX3(a,C0[r],C0[r+1]);b=MX3(b,C0[r+2],C0[r+3]);a=MX3(a,C1[r],C1[r+1]);b=MX3(b,C1[r+2],C1[r+3]);} \
      float rm=__builtin_fmaxf(a,b); { auto rr=__builtin_amdgcn_permlane32_swap(__float_as_uint(rm),__float_as_uint(rm),false,false); rm=__builtin_fmaxf(__uint_as_float(rr[0]),__uint_as_float(rr[1])); } \
      resc=false; \
      if(__builtin_expect(__any(rm>(float)THRL),0)){ const float dl=__builtin_fmaxf(rm,0.f); mhat+=dl; \
        _Pragma("unroll") for(int r=0;r<16;++r){C0[r]-=dl;C1[r]-=dl;} \
        _Pragma("unroll") for(int r=0;r<16;++r)negm[r]=-mhat; asm volatile("":"+v"(negm)); \
        const float f=__builtin_amdgcn_exp2f(-dl); l_reg*=f; if(hi==0)wsf[r32]=f; resc=true; } } \
    SBAR(); \
    GAPB(o[0]=__builtin_amdgcn_mfma_f32_32x32x16_bf16(PAF(0),VFR(0),o[0],0,0,0), C0,0); \
    GAPB(o[1]=__builtin_amdgcn_mfma_f32_32x32x16_bf16(PAF(0),VFR(4),o[1],0,0,0), C0,4); \
    KRD(GL,0); GAPB(o[0]=__builtin_amdgcn_mfma_f32_32x32x16_bf16(PAF(1),VFR(1),o[0],0,0,0), C0,8); \
    KRD(GL,1); GAPB(o[1]=__builtin_amdgcn_mfma_f32_32x32x16_bf16(PAF(1),VFR(5),o[1],0,0,0), C0,12); \
    KRD(GL,2); GAPB(o[0]=__builtin_amdgcn_mfma_f32_32x32x16_bf16(PAF(2),VFR(2),o[0],0,0,0), C1,0); \
    KRD(GL,3); GAPB(o[1]=__builtin_amdgcn_mfma_f32_32x32x16_bf16(PAF(2),VFR(6),o[1],0,0,0), C1,4); \
    GAPB(o[0]=__builtin_amdgcn_mfma_f32_32x32x16_bf16(PAF(3),VFR(3),o[0],0,0,0), C1,8); \
    GAPB(o[1]=__builtin_amdgcn_mfma_f32_32x32x16_bf16(PAF(3),VFR(7),o[1],0,0,0), C1,12); \
    }while(0)
  int t=1;
  for(;t+5<NT;t+=2){
    STEP(pB0,pB1,pA0,pA1,t,true,true,true);     WAIT_BAR(2); RESC(); ROT();
    STEP(pA0,pA1,pB0,pB1,t+1,true,true,true);   WAIT_BAR(2); RESC(); ROT();
  }
  #define ENDW(tt) do{ if((tt)+3<NT){WAIT_BAR(2);} else if((tt)+2<NT){WAIT_BAR(1);} else {WAIT_BAR(0);} }while(0)
  for(;t+1<NT;t+=2){
    STEP(pB0,pB1,pA0,pA1,t,(t+3<NT),(t+1<NT),(t+1<NT));       ENDW(t);   RESC(); ROT();
    STEP(pA0,pA1,pB0,pB1,t+1,(t+4<NT),(t+2<NT),(t+2<NT));     ENDW(t+1); RESC(); ROT();
  }
  STEP(pB0,pB1,pA0,pA1,NT-1,false,false,false); RESC();
  { float sacc=pB0[0]+pB0[1]; _Pragma("unroll") for(int r=2;r<16;++r)sacc+=pB0[r]; _Pragma("unroll") for(int r=0;r<16;++r)sacc+=pB1[r]; l_reg+=sacc;
    pw0=(u32x4){PKW(pB0,0),PKW(pB0,2),PKW(pB0,4),PKW(pB0,6)};pw1=(u32x4){PKW(pB0,8),PKW(pB0,10),PKW(pB0,12),PKW(pB0,14)};pw2=(u32x4){PKW(pB1,0),PKW(pB1,2),PKW(pB1,4),PKW(pB1,6)};pw3=(u32x4){PKW(pB1,8),PKW(pB1,10),PKW(pB1,12),PKW(pB1,14)};
    SBAR(); pv(o,vb0+sl_cur,PAF(0),PAF(1),PAF(2),PAF(3)); }
  #undef PKW
  #undef PAF
  #undef VFR
  #undef PIN
  #undef MX3
  #undef GAPA
  #undef GAPB
  #undef EX
  #undef VRD
  #undef KRD
  #undef QKMU
  #undef STEP
  #undef ENDW
  {auto rr=__builtin_amdgcn_permlane32_swap(__float_as_uint(l_reg),__float_as_uint(l_reg),false,false);l_reg=__uint_as_float(rr[0])+__uint_as_float(rr[1]);}
  if(hi==0)wsf[32+r32]=l_reg;asm volatile("s_waitcnt lgkmcnt(0)":::"memory");
  float rli[16];
  #pragma unroll
  for(int r=0;r<16;++r)rli[r]=__builtin_amdgcn_rcpf(wsf[32+crow(r,hi)]);
  bf16*Ow=Ow0+(long)(wid*QBLK)*OPITCH;
  { bf16*stg=(bf16*)(shm+LDS_OST)+wid*2048;
    #pragma unroll
    for(int r=0;r<16;++r){const int orow=crow(r,hi);
      #pragma unroll
      for(int d0=0;d0<2;++d0)stg[orow*64+d0*32+r32]=__float2bfloat16(o[d0][r]*rli[r]);}
    asm volatile("s_waitcnt lgkmcnt(0)":::"memory");
    #pragma unroll
    for(int i=0;i<4;++i){const int row=i*8+(lane>>3),ch=lane&7; const u32x4 v=*(const u32x4*)(stg+row*64+ch*8); ATTN_STORE16(Ow+(long)row*OPITCH+ch*8,v);} }
  asm volatile("s_waitcnt lgkmcnt(0)\n\ts_barrier":::"memory");
  #undef DMA_K
  #undef KROW
  #undef DMA_V
  #undef CMASK
  #undef START
  #undef RESC
  #undef ROT
}
constexpr int ATTN_LDS_BYTES=LDS_BYTES;
constexpr int FS_K=0, FS_V=3*8192, FS_WS=FS_V+3*16384, FS_OST=FS_WS+NW*64*4, FS_BYTES=FS_OST+NW*4096;
constexpr float FS_LMIN=1e-30f, FS_LMAX=1e36f;
constexpr bool FS_MFSUM=false;
#define WAIT_BAR_V(NV_,A2,A1) do{ if constexpr((NV_)==2){WAIT_BAR(A2);}else{WAIT_BAR(A1);} }while(0)
template<int VW> __device__ __forceinline__ void pv_w(f32x16*o,int vb,bf16x8 pa0,bf16x8 pa1,bf16x8 pa2,bf16x8 pa3){
  #pragma unroll
  for(int d0=0;d0<2*VW;++d0){s16x4 lo[4],hi[4];
    #pragma unroll
    for(int ks=0;ks<4;++ks){
      asm volatile("ds_read_b64_tr_b16 %0,%1 offset:%c2":"=&v"(lo[ks]):"v"(vb),"i"(d0*4096+ks*1024):"memory");
      asm volatile("ds_read_b64_tr_b16 %0,%1 offset:%c2":"=&v"(hi[ks]):"v"(vb),"i"(d0*4096+ks*1024+512):"memory");}
    asm volatile("s_waitcnt lgkmcnt(0)":::"memory");SBAR();
    #define PK(k) (bf16x8){lo[k][0],lo[k][1],lo[k][2],lo[k][3],hi[k][0],hi[k][1],hi[k][2],hi[k][3]}
    o[d0]=__builtin_amdgcn_mfma_f32_32x32x16_bf16(pa0,PK(0),o[d0],0,0,0);
    o[d0]=__builtin_amdgcn_mfma_f32_32x32x16_bf16(pa1,PK(1),o[d0],0,0,0);
    o[d0]=__builtin_amdgcn_mfma_f32_32x32x16_bf16(pa2,PK(2),o[d0],0,0,0);
    o[d0]=__builtin_amdgcn_mfma_f32_32x32x16_bf16(pa3,PK(3),o[d0],0,0,0);
    #undef PK
  }
}
template<int VW,bool ISC,bool K8> __device__ __forceinline__ bool attn_fs(const bf16*Qw0,const bf16*__restrict__ Kh,const bf16*__restrict__ Vh,bf16*Ow0,int NT,int kr0,int r0,lds_cfptr bt,char*shm,const unsigned char*Q8w0,const unsigned char*__restrict__ K8h){
  int tid_=threadIdx.x; asm volatile("; LAUNDER":"+v"(tid_)); const int tid=tid_,lane=tid&63,r32=lane&31,hi=lane>>5; const int wid=__builtin_amdgcn_readfirstlane(tid>>6);
  const bf16*Qw=Qw0+(long)(wid*QBLK)*QKP;
  const unsigned lds0=(unsigned)(uintptr_t)shm;
  float*wsf=(float*)(shm+FS_WS)+wid*64;
  const bf16*ksrc=Kh+(long)lane*QKP+wid*8;
  const unsigned char*ksrc8=K8h+(long)lane*64+(wid&3)*16;
  const bf16*vsrc=Vh+(long)(16*(wid&3)+(lane>>2))*QKP+(wid>>2)*32+(lane&3)*8;
  const unsigned kdst=lds0+FS_K+(K8?(wid&3):wid)*1024, vdst=lds0+FS_V+wid*1024;
  #define KROW(t) (ISC ? ((t)<4 ? 64*(t) : 256+64*(kr0+(t)-4)) : 64*(t))
  #define DMA_K(t,slot) do{ if constexpr(K8){ glds16(ksrc8+(long)KROW(t)*64,(unsigned)__builtin_amdgcn_readfirstlane(kdst+(slot))); } else { glds16(ksrc+(long)KROW(t)*QKP,(unsigned)__builtin_amdgcn_readfirstlane(kdst+(slot))); } }while(0)
  #define DMA_V(t,slot) do{ glds16(vsrc+(long)KROW(t)*QKP,(unsigned)__builtin_amdgcn_readfirstlane(vdst+2*(slot))); \
      if constexpr(VW==2){ glds16(vsrc+(long)KROW(t)*QKP+QKV_BLK,(unsigned)__builtin_amdgcn_readfirstlane(vdst+2*(slot)+8192)); } }while(0)
  const int vb0=(int)(lds0+FS_V)+((lane>>4)&1)*32+(lane&3)*8+(4*hi+((lane&15)>>2))*64;
  const char*Kbase=shm+FS_K; bf16x8 kf[8];
  const lds_cptr shm3=(lds_cptr)shm; const lds_cptr kp0=shm3+FS_K+(K8?2*hi:hi)*1024+r32*16; const lds_cptr vp0=shm3+FS_V+((lane>>4)&1)*32+(lane&3)*8+(4*hi+((lane&15)>>2))*64;
  DMA_K(0,0);DMA_V(0,0);DMA_K(1,SLOTB);
  bf16x8 qr[4]; i32x8a q8=i32x8a{}; i32x8a k8a=i32x8a{},k8b=i32x8a{};
  if constexpr(K8){ const unsigned char*qp=Q8w0+(long)(wid*QBLK+r32)*64+32*hi; q8=cat8a(*reinterpret_cast<const i32x4a*>(qp),*reinterpret_cast<const i32x4a*>(qp+16));
    #pragma unroll
    for(int d0=0;d0<4;++d0)qr[d0]=bf16x8{}; }
  else {
  #pragma unroll
  for(int d0=0;d0<4;++d0)qr[d0]=*reinterpret_cast<const bf16x8*>(&Qw[(long)r32*QKP+d0*16+hi*8]); }
  float l_reg=0.f;f32x16 o[2*VW];
  #pragma unroll
  for(int d0=0;d0<2*VW;++d0)o[d0]=f32x16{};
  const f32x16 zero16=f32x16{};
  f32x16 lacc=f32x16{}; const bf16x8 ones8=(bf16x8){0x3F80,0x3F80,0x3F80,0x3F80,0x3F80,0x3F80,0x3F80,0x3F80};
  #define CMASK(P0,P1,t) do{ if constexpr(ISC){ if(wid&1) cbias_par<1>(P0,P1,(t),kr0,r0,wid,r32,hi,bt); else cbias_par<0>(P0,P1,(t),kr0,r0,wid,r32,hi,bt); } }while(0)
  f32x16 pA0,pA1,pB0,pB1;
  int sl_prev=0,sl_cur=0,sl_next=SLOTB;
  #define ROT() do{sl_prev=sl_cur;sl_cur=sl_next;sl_next=(sl_next==(NSLOT-1)*SLOTB)?0:sl_next+SLOTB;}while(0)
  DMA_K(2,2*SLOTB);
  WAIT_BAR_V(VW,4,3);
  if(tid==0)*(volatile unsigned*)(shm+FS_WS)=0u;
  if constexpr(K8){ pA0=MF8(kfrag8(kp0),q8,zero16); pA1=MF8(kfrag8(kp0+512),q8,zero16); } else qkt(pA0,pA1,Kbase,qr,zero16,r32,hi);
  asm volatile("s_nop 15\n\ts_nop 7":"+v"(pA0),"+v"(pA1));CMASK(pA0,pA1,0);
  _Pragma("unroll") for(int r=0;r<16;++r){pA0[r]=__builtin_amdgcn_exp2f(pA0[r]);pA1[r]=__builtin_amdgcn_exp2f(pA1[r]);}
  WAIT_BAR(0);
  DMA_K(3,0);DMA_V(1,SLOTB);
  ROT();
  if constexpr(K8){ k8a=kfrag8(kp0+sl_cur); k8b=kfrag8(kp0+sl_cur+512); } else kload8(kf,kp0+sl_cur);
  WAIT_BAR_V(VW,3,2);
  s16x4 vlo[8],vhi[8]; u32x4 pw0,pw1,pw2,pw3;
  #define PKW(P,B) cvtpk_s(P[B],P[B+1])
  #define PAF(k) __builtin_bit_cast(bf16x8,pw##k)
  #define VFR(i) (bf16x8){vlo[i][0],vlo[i][1],vlo[i][2],vlo[i][3],vhi[i][0],vhi[i][1],vhi[i][2],vhi[i][3]}
  #define PIN(x) asm volatile("":"+v"(x))
  #define MF(a,b,c) __builtin_amdgcn_mfma_f32_32x32x16_bf16(a,b,c,0,0,0)
  #define GAPA(MFX,A0,A1,A2,A3,W0,W1,PW) do{ MFX; if constexpr(!(VW==1&&FS_MFSUM)){ sacc+=A0; sacc+=A1; sacc+=A2; sacc+=A3; PIN(sacc); } W0; W1; PIN(PW); SBAR(); }while(0)
  #define QKM(i,C0,C1) do{ if constexpr(K8){ if constexpr((i)==0){ C0=MF8(k8a,q8,zero16); } else if constexpr((i)==4){ C1=MF8(k8b,q8,zero16); } } else { \
      if constexpr((i)==0){ C0=MF(kf[0],qr[0],zero16); } else if constexpr((i)==1){ C1=MF(kf[1],qr[0],zero16); } else if constexpr(((i)&1)==0){ C0=MF(kf[i],qr[(i)>>1],C0); } else { C1=MF(kf[i],qr[(i)>>1],C1); } } }while(0)
  #define EX(v) __builtin_amdgcn_exp2f(v)
  #define GAPB4(MFX,X,B) do{ MFX; X[B]=EX(X[B]); X[B+1]=EX(X[B+1]); X[B+2]=EX(X[B+2]); X[B+3]=EX(X[B+3]); PIN(X); SBAR(); }while(0)
  #define GAPB2(MFX,X,B) do{ MFX; X[B]=EX(X[B]); X[B+1]=EX(X[B+1]); PIN(X); SBAR(); }while(0)
  #define VRDX(j,dq,ks) do{ vlo[j]=vtr(vp_+((dq)*4096+(ks)*1024)); vhi[j]=vtr(vp_+((dq)*4096+(ks)*1024+512)); }while(0)
  #define KRD(G,j) do{ if(G){ if constexpr(K8){ if constexpr((j)==0){ k8a=kfrag8(kp0+sl_next); SBAR(); } else if constexpr((j)==1){ k8b=kfrag8(kp0+sl_next+512); SBAR(); } } else { kload2(kf,kp0+sl_next,j); SBAR(); } } }while(0)
  #define STEP(C0,C1,P0,P1,t,GK,GV,GL) do{ SBAR(); \
    const lds_cptr vp_=vp0+2*sl_prev; \
    if constexpr(VW==1){ VRDX(0,0,0); } else { VRDX(0,0,0); } SBAR(); float sacc=(P0[0]+P0[1]); \
    GAPA(QKM(0,C0,C1), P0[2],P0[3],P0[4],P0[5],     pw0[0]=PKW(P0,0), pw0[1]=PKW(P0,2), pw0); \
    if constexpr(VW==1){ VRDX(4,1,0); } else { VRDX(1,1,0); } SBAR(); GAPA(QKM(1,C0,C1), P0[6],P0[7],P0[8],P0[9],     pw0[2]=PKW(P0,4), pw0[3]=PKW(P0,6), pw0); \
    if constexpr(VW==1){ VRDX(1,0,1); } else { VRDX(2,2,0); } SBAR(); GAPA(QKM(2,C0,C1),   P0[10],P0[11],P0[12],P0[13], pw1[0]=PKW(P0,8), pw1[1]=PKW(P0,10), pw1); \
    if constexpr(VW==1){ VRDX(5,1,1); } else { VRDX(3,3,0); } SBAR(); GAPA(QKM(3,C0,C1),   P0[14],P0[15],P1[0],P1[1],   pw1[2]=PKW(P0,12),pw1[3]=PKW(P0,14), pw1); \
    if constexpr(VW==1){ VRDX(2,0,2); } else { VRDX(4,0,1); } SBAR(); GAPA(QKM(4,C0,C1),   P1[2],P1[3],P1[4],P1[5],     pw2[0]=PKW(P1,0), pw2[1]=PKW(P1,2), pw2); \
    if constexpr(VW==1){ VRDX(6,1,2); } else { VRDX(5,1,1); } SBAR(); GAPA(QKM(5,C0,C1),   P1[6],P1[7],P1[8],P1[9],     pw2[2]=PKW(P1,4), pw2[3]=PKW(P1,6), pw2); \
    if constexpr(VW==1){ VRDX(3,0,3); } else { VRDX(6,2,1); } SBAR(); GAPA(QKM(6,C0,C1),   P1[10],P1[11],P1[12],P1[13], pw3[0]=PKW(P1,8), pw3[1]=PKW(P1,10), pw3); \
    if constexpr(VW==1){ VRDX(7,1,3); } else { VRDX(7,3,1); } SBAR(); GAPA(QKM(7,C0,C1),   P1[14],P1[15],0.f,0.f,       pw3[2]=PKW(P1,12),pw3[3]=PKW(P1,14), pw3); \
    l_reg+=sacc; \
    if(GK){DMA_K((t)+3,sl_cur);} if(GV){DMA_V((t)+1,sl_next);} \
    CMASK(C0,C1,t); \
    SBAR(); \
    if constexpr(VW==1){ \
      GAPB4(o[0]=MF(PAF(0),VFR(0),o[0]), C0,0); \
      GAPB4(o[1]=MF(PAF(0),VFR(4),o[1]), C0,4); \
      if constexpr(FS_MFSUM){lacc=MF(PAF(0),ones8,lacc);} KRD(GL,0); GAPB4(o[0]=MF(PAF(1),VFR(1),o[0]), C0,8); \
      KRD(GL,1); GAPB4(o[1]=MF(PAF(1),VFR(5),o[1]), C0,12); \
      if constexpr(FS_MFSUM){lacc=MF(PAF(1),ones8,lacc);} KRD(GL,2); GAPB4(o[0]=MF(PAF(2),VFR(2),o[0]), C1,0); \
      KRD(GL,3); GAPB4(o[1]=MF(PAF(2),VFR(6),o[1]), C1,4); \
      if constexpr(FS_MFSUM){lacc=MF(PAF(2),ones8,lacc);} GAPB4(o[0]=MF(PAF(3),VFR(3),o[0]), C1,8); \
      if constexpr(FS_MFSUM){lacc=MF(PAF(3),ones8,lacc);} GAPB4(o[1]=MF(PAF(3),VFR(7),o[1]), C1,12); \
    } else { \
      GAPB2(o[0]=MF(PAF(0),VFR(0),o[0]), C0,0);  VRDX(0,0,2); SBAR(); \
      GAPB2(o[1]=MF(PAF(0),VFR(1),o[1]), C0,2);  VRDX(1,1,2); SBAR(); \
      GAPB2(o[2]=MF(PAF(0),VFR(2),o[2]), C0,4);  VRDX(2,2,2); SBAR(); \
      GAPB2(o[3]=MF(PAF(0),VFR(3),o[3]), C0,6);  VRDX(3,3,2); SBAR(); \
      GAPB2(o[0]=MF(PAF(1),VFR(4),o[0]), C0,8);  VRDX(4,0,3); SBAR(); \
      GAPB2(o[1]=MF(PAF(1),VFR(5),o[1]), C0,10); VRDX(5,1,3); SBAR(); \
      GAPB2(o[2]=MF(PAF(1),VFR(6),o[2]), C0,12); VRDX(6,2,3); SBAR(); \
      GAPB2(o[3]=MF(PAF(1),VFR(7),o[3]), C0,14); VRDX(7,3,3); SBAR(); \
      KRD(GL,0); GAPB2(o[0]=MF(PAF(2),VFR(0),o[0]), C1,0); \
      KRD(GL,1); GAPB2(o[1]=MF(PAF(2),VFR(1),o[1]), C1,2); \
      KRD(GL,2); GAPB2(o[2]=MF(PAF(2),VFR(2),o[2]), C1,4); \
      KRD(GL,3); GAPB2(o[3]=MF(PAF(2),VFR(3),o[3]), C1,6); \
      GAPB2(o[0]=MF(PAF(3),VFR(4),o[0]), C1,8); \
      GAPB2(o[1]=MF(PAF(3),VFR(5),o[1]), C1,10); \
      GAPB2(o[2]=MF(PAF(3),VFR(6),o[2]), C1,12); \
      GAPB2(o[3]=MF(PAF(3),VFR(7),o[3]), C1,14); \
    } \
    }while(0)
  int t=1;
  for(;t+5<NT;t+=2){
    STEP(pB0,pB1,pA0,pA1,t,true,true,true);     WAIT_BAR_V(VW,3,2); ROT();
    STEP(pA0,pA1,pB0,pB1,t+1,true,true,true);   WAIT_BAR_V(VW,3,2); ROT();
  }
  #define ENDW(tt) do{ if((tt)+3<NT){WAIT_BAR_V(VW,3,2);} else if((tt)+2<NT){WAIT_BAR_V(VW,2,1);} else {WAIT_BAR(0);} }while(0)
  for(;t+1<NT;t+=2){
    STEP(pB0,pB1,pA0,pA1,t,(t+3<NT),(t+1<NT),(t+1<NT));       ENDW(t);   ROT();
    STEP(pA0,pA1,pB0,pB1,t+1,(t+4<NT),(t+2<NT),(t+2<NT));     ENDW(t+1); ROT();
  }
  STEP(pB0,pB1,pA0,pA1,NT-1,false,false,false);
  { if constexpr(!(VW==1&&FS_MFSUM)){ float sacc=pB0[0]+pB0[1]; _Pragma("unroll") for(int r=2;r<16;++r)sacc+=pB0[r]; _Pragma("unroll") for(int r=0;r<16;++r)sacc+=pB1[r]; l_reg+=sacc; }
    pw0=(u32x4){PKW(pB0,0),PKW(pB0,2),PKW(pB0,4),PKW(pB0,6)};pw1=(u32x4){PKW(pB0,8),PKW(pB0,10),PKW(pB0,12),PKW(pB0,14)};pw2=(u32x4){PKW(pB1,0),PKW(pB1,2),PKW(pB1,4),PKW(pB1,6)};pw3=(u32x4){PKW(pB1,8),PKW(pB1,10),PKW(pB1,12),PKW(pB1,14)};
    SBAR(); if constexpr(VW==1&&FS_MFSUM){ lacc=MF(PAF(0),ones8,lacc); lacc=MF(PAF(1),ones8,lacc); lacc=MF(PAF(2),ones8,lacc); lacc=MF(PAF(3),ones8,lacc); }
    pv_w<VW>(o,vb0+2*sl_cur,PAF(0),PAF(1),PAF(2),PAF(3)); }
  #undef PKW
  #undef PAF
  #undef VFR
  #undef PIN
  #undef MF
  #undef GAPA
  #undef QKM
  #undef GAPB4
  #undef GAPB2
  #undef EX
  #undef VRDX
  #undef KRD
  #undef STEP
  #undef ENDW
  float rli[16];
  if constexpr(VW==1&&FS_MFSUM){
    #pragma unroll
    for(int r=0;r<16;++r)rli[r]=__builtin_amdgcn_rcpf(lacc[r]);
    static_assert(!FS_MFSUM,"the row-sum range check reads l_reg");
  } else {
    {auto rr=__builtin_amdgcn_permlane32_swap(__float_as_uint(l_reg),__float_as_uint(l_reg),false,false);l_reg=__uint_as_float(rr[0])+__uint_as_float(rr[1]);}
    if(__any(!(l_reg>FS_LMIN&&l_reg<FS_LMAX))){ if(lane==0)*(volatile unsigned*)(shm+FS_WS)=1u; }
    if(hi==0)wsf[32+r32]=l_reg;asm volatile("s_waitcnt lgkmcnt(0)":::"memory");
    #pragma unroll
    for(int r=0;r<16;++r)rli[r]=__builtin_amdgcn_rcpf(wsf[32+crow(r,hi)]);
  }
  bf16*Ow=Ow0+(long)(wid*QBLK)*OPITCH;
  #pragma unroll
  for(int hv=0;hv<VW;++hv){ bf16*stg=(bf16*)(shm+FS_OST)+wid*2048;
    #pragma unroll
    for(int r=0;r<16;++r){const int orow=crow(r,hi);
      #pragma unroll
      for(int d0=0;d0<2;++d0)stg[orow*64+d0*32+r32]=__float2bfloat16(o[2*hv+d0][r]*rli[r]);}
    asm volatile("s_waitcnt lgkmcnt(0)":::"memory");
    #pragma unroll
    for(int i=0;i<4;++i){const int row=i*8+(lane>>3),ch=lane&7; const u32x4 v=*(const u32x4*)(stg+row*64+ch*8); ATTN_STORE16(Ow+(long)row*OPITCH+hv*64+ch*8,v);}
    asm volatile("s_waitcnt lgkmcnt(0)":::"memory"); }
  asm volatile("s_waitcnt lgkmcnt(0)\n\ts_barrier":::"memory");
  const bool redo=*(volatile unsigned*)(shm+FS_WS)!=0u;
  #undef DMA_K
  #undef KROW
  #undef DMA_V
  #undef CMASK
  #undef ROT
  return redo;
}
#undef WAIT_BAR_V
#undef MF8
constexpr int ATTN_FS_LDS_BYTES=FS_BYTES;
constexpr int F2_K=0, F2_V=4*4096, F2_WS=F2_V+4*16384, F2_OST=F2_WS+NW*64*4, F2_BYTES=F2_OST+NW*4096;
#define MF8(a,b,c) __builtin_amdgcn_mfma_scale_f32_32x32x64_f8f6f4(a,b,c,0,0,0,0,0,0)
#define WAIT_BAR_V(NV_,A2,A1) do{ if constexpr((NV_)==2){WAIT_BAR(A2);}else{WAIT_BAR(A1);} }while(0)
template<int VW,bool ISC> __device__ __forceinline__ bool attn_fs2(const bf16*__restrict__ Vh,bf16*Ow0,int NT,int kr0,int r0,lds_cfptr bt,char*shm,const unsigned char*Q8w0,const unsigned char*__restrict__ K8h){
  int tid_=threadIdx.x; asm volatile("; LAUNDER":"+v"(tid_)); const int tid=tid_,lane=tid&63,r32=lane&31,hi=lane>>5; const int wid=__builtin_amdgcn_readfirstlane(tid>>6);
  const bool g2=wid>=4;
  const unsigned lds0=(unsigned)(uintptr_t)shm;
  float*wsf=(float*)(shm+F2_WS)+wid*64;
  const unsigned char*ksrc8=K8h+(long)lane*64+(wid&3)*16;
  const bf16*vsrc=Vh+(long)(16*(wid&3)+(lane>>2))*QKP+(wid>>2)*32+(lane&3)*8;
  const unsigned kdst=lds0+F2_K+(wid&3)*1024, vdst=lds0+F2_V+wid*1024;
  #define KS(t) ((((t))&3)*4096)
  #define VS(t) ((((t))&3)*16384)
  #define KROW(t) (ISC ? ((t)<4 ? 64*(t) : 256+64*(kr0+(t)-4)) : 64*(t))
  #define DMA_K(t) glds16(ksrc8+(long)KROW(t)*64,(unsigned)__builtin_amdgcn_readfirstlane(kdst+KS(t)))
  #define DMA_V(t) do{ glds16(vsrc+(long)KROW(t)*QKP,(unsigned)__builtin_amdgcn_readfirstlane(vdst+VS(t))); \
      if constexpr(VW==2){ glds16(vsrc+(long)KROW(t)*QKP+QKV_BLK,(unsigned)__builtin_amdgcn_readfirstlane(vdst+VS(t)+8192)); } }while(0)
  const int vb0=(int)(lds0+F2_V)+((lane>>4)&1)*32+(lane&3)*8+(4*hi+((lane&15)>>2))*64;
  const lds_cptr shm3=(lds_cptr)shm; const lds_cptr kp0=shm3+F2_K+(2*hi)*1024+r32*16; const lds_cptr vp0=shm3+F2_V+((lane>>4)&1)*32+(lane&3)*8+(4*hi+((lane&15)>>2))*64;
  DMA_K(0);DMA_V(0);DMA_K(1);
  i32x8a q8; { const unsigned char*qp=Q8w0+(long)(wid*QBLK+r32)*64+32*hi; q8=cat8a(*reinterpret_cast<const i32x4a*>(qp),*reinterpret_cast<const i32x4a*>(qp+16)); }
  i32x8a k8a=i32x8a{},k8b=i32x8a{};
  float l_reg=0.f;f32x16 o[2*VW];
  #pragma unroll
  for(int d0=0;d0<2*VW;++d0)o[d0]=f32x16{};
  const f32x16 zero16=f32x16{};
  #define CMASK(P0,P1,t) do{ if constexpr(ISC){ if(wid&1) cbias_par<1>(P0,P1,(t),kr0,r0,wid,r32,hi,bt); else cbias_par<0>(P0,P1,(t),kr0,r0,wid,r32,hi,bt); } }while(0)
  f32x16 pA0,pA1,pB0,pB1;
  DMA_K(2);
  WAIT_BAR_V(VW,4,3);
  if(tid==0)*(volatile unsigned*)(shm+F2_WS)=0u;
  pA0=MF8(kfrag8(kp0+KS(0)),q8,zero16); pA1=MF8(kfrag8(kp0+KS(0)+512),q8,zero16);
  asm volatile("s_nop 15\n\ts_nop 7":"+v"(pA0),"+v"(pA1));CMASK(pA0,pA1,0);
  if(!g2){ _Pragma("unroll") for(int r=0;r<16;++r){pA0[r]=__builtin_amdgcn_exp2f(pA0[r]);pA1[r]=__builtin_amdgcn_exp2f(pA1[r]);} }
  WAIT_BAR(0);
  DMA_K(3);DMA_V(1);
  if(!g2){ k8a=kfrag8(kp0+KS(1)); k8b=kfrag8(kp0+KS(1)+512); }
  WAIT_BAR_V(VW,3,2);
  s16x4 vlo[8],vhi[8]; u32x4 pw0,pw1,pw2,pw3;
  #define PKW(P,B) cvtpk_s(P[B],P[B+1])
  #define PAF(k) __builtin_bit_cast(bf16x8,pw##k)
  #define VFR(i) (bf16x8){vlo[i][0],vlo[i][1],vlo[i][2],vlo[i][3],vhi[i][0],vhi[i][1],vhi[i][2],vhi[i][3]}
  #define PIN(x) asm volatile("":"+v"(x))
  #define MF(a,b,c) __builtin_amdgcn_mfma_f32_32x32x16_bf16(a,b,c,0,0,0)
  #define EX(v) __builtin_amdgcn_exp2f(v)
  #define GAPA(MFX,A0,A1,A2,A3,W0,W1,PW) do{ MFX; sacc+=A0; sacc+=A1; sacc+=A2; sacc+=A3; PIN(sacc); W0; W1; PIN(PW); SBAR(); }while(0)
  #define GAPB4(MFX,X,B) do{ MFX; X[B]=EX(X[B]); X[B+1]=EX(X[B+1]); X[B+2]=EX(X[B+2]); X[B+3]=EX(X[B+3]); PIN(X); SBAR(); }while(0)
  #define GAPB2(MFX,X,B) do{ MFX; X[B]=EX(X[B]); X[B+1]=EX(X[B+1]); PIN(X); SBAR(); }while(0)
  #define VRDX(j,dq,ks) do{ vlo[j]=vtr(vp_+((dq)*4096+(ks)*1024)); vhi[j]=vtr(vp_+((dq)*4096+(ks)*1024+512)); }while(0)
  #define XPART(C0,C1,P0,P1,t) do{ SBAR(); \
    const lds_cptr vp_=vp0+VS((t)-1); \
    VRDX(0,0,0); SBAR(); float sacc=(P0[0]+P0[1]); \
    GAPA(C0=MF8(k8a,q8,zero16), P0[2],P0[3],P0[4],P0[5],     pw0[0]=PKW(P0,0), pw0[1]=PKW(P0,2), pw0); \
    if constexpr(VW==1){ VRDX(4,1,0); } else { VRDX(1,1,0); } SBAR(); GAPA((void)0, P0[6],P0[7],P0[8],P0[9],     pw0[2]=PKW(P0,4), pw0[3]=PKW(P0,6), pw0); \
    if constexpr(VW==1){ VRDX(1,0,1); } else { VRDX(2,2,0); } SBAR(); GAPA((void)0, P0[10],P0[11],P0[12],P0[13], pw1[0]=PKW(P0,8), pw1[1]=PKW(P0,10), pw1); \
    if constexpr(VW==1){ VRDX(5,1,1); } else { VRDX(3,3,0); } SBAR(); GAPA((void)0, P0[14],P0[15],P1[0],P1[1],   pw1[2]=PKW(P0,12),pw1[3]=PKW(P0,14), pw1); \
    if constexpr(VW==1){ VRDX(2,0,2); } else { VRDX(4,0,1); } SBAR(); GAPA(C1=MF8(k8b,q8,zero16), P1[2],P1[3],P1[4],P1[5],     pw2[0]=PKW(P1,0), pw2[1]=PKW(P1,2), pw2); \
    if constexpr(VW==1){ VRDX(6,1,2); } else { VRDX(5,1,1); } SBAR(); GAPA((void)0, P1[6],P1[7],P1[8],P1[9],     pw2[2]=PKW(P1,4), pw2[3]=PKW(P1,6), pw2); \
    if constexpr(VW==1){ VRDX(3,0,3); } else { VRDX(6,2,1); } SBAR(); GAPA((void)0, P1[10],P1[11],P1[12],P1[13], pw3[0]=PKW(P1,8), pw3[1]=PKW(P1,10), pw3); \
    if constexpr(VW==1){ VRDX(7,1,3); } else { VRDX(7,3,1); } SBAR(); GAPA((void)0, P1[14],P1[15],0.f,0.f,       pw3[2]=PKW(P1,12),pw3[3]=PKW(P1,14), pw3); \
    l_reg+=sacc; }while(0)
  #define KRD8(G,tk,j) do{ if(G){ if constexpr((j)==0){ k8a=kfrag8(kp0+KS(tk)); } else { k8b=kfrag8(kp0+KS(tk)+512); } SBAR(); } }while(0)
  #define YPART(E0,E1,tv,tk,GLK) do{ SBAR(); \
    if constexpr(VW==1){ \
      GAPB4(o[0]=MF(PAF(0),VFR(0),o[0]), E0,0); \
      GAPB4(o[1]=MF(PAF(0),VFR(4),o[1]), E0,4); \
      KRD8(GLK,tk,0); GAPB4(o[0]=MF(PAF(1),VFR(1),o[0]), E0,8); \
      KRD8(GLK,tk,1); GAPB4(o[1]=MF(PAF(1),VFR(5),o[1]), E0,12); \
      GAPB4(o[0]=MF(PAF(2),VFR(2),o[0]), E1,0); \
      GAPB4(o[1]=MF(PAF(2),VFR(6),o[1]), E1,4); \
      GAPB4(o[0]=MF(PAF(3),VFR(3),o[0]), E1,8); \
      GAPB4(o[1]=MF(PAF(3),VFR(7),o[1]), E1,12); \
    } else { const lds_cptr vp_=vp0+VS(tv); \
      GAPB2(o[0]=MF(PAF(0),VFR(0),o[0]), E0,0);  VRDX(0,0,2); SBAR(); \
      GAPB2(o[1]=MF(PAF(0),VFR(1),o[1]), E0,2);  VRDX(1,1,2); SBAR(); \
      GAPB2(o[2]=MF(PAF(0),VFR(2),o[2]), E0,4);  VRDX(2,2,2); SBAR(); \
      GAPB2(o[3]=MF(PAF(0),VFR(3),o[3]), E0,6);  VRDX(3,3,2); SBAR(); \
      GAPB2(o[0]=MF(PAF(1),VFR(4),o[0]), E0,8);  VRDX(4,0,3); SBAR(); \
      GAPB2(o[1]=MF(PAF(1),VFR(5),o[1]), E0,10); VRDX(5,1,3); SBAR(); \
      GAPB2(o[2]=MF(PAF(1),VFR(6),o[2]), E0,12); VRDX(6,2,3); SBAR(); \
      GAPB2(o[3]=MF(PAF(1),VFR(7),o[3]), E0,14); VRDX(7,3,3); SBAR(); \
      KRD8(GLK,tk,0); GAPB2(o[0]=MF(PAF(2),VFR(0),o[0]), E1,0); \
      KRD8(GLK,tk,1); GAPB2(o[1]=MF(PAF(2),VFR(1),o[1]), E1,2); \
      GAPB2(o[2]=MF(PAF(2),VFR(2),o[2]), E1,4); \
      GAPB2(o[3]=MF(PAF(2),VFR(3),o[3]), E1,6); \
      GAPB2(o[0]=MF(PAF(3),VFR(4),o[0]), E1,8); \
      GAPB2(o[1]=MF(PAF(3),VFR(5),o[1]), E1,10); \
      GAPB2(o[2]=MF(PAF(3),VFR(6),o[2]), E1,12); \
      GAPB2(o[3]=MF(PAF(3),VFR(7),o[3]), E1,14); \
    } }while(0)
  #define YPART0(E0,E1,tk) do{ SBAR(); k8a=kfrag8(kp0+KS(tk)); k8b=kfrag8(kp0+KS(tk)+512); SBAR(); \
    _Pragma("unroll") for(int r=0;r<16;++r){E0[r]=EX(E0[r]);E1[r]=EX(E1[r]);} PIN(E0); PIN(E1); SBAR(); }while(0)
  #define DMAS(t,GK,GV) do{ if(GK){DMA_K((t)+3);} if(GV){DMA_V((t)+1);} }while(0)
  #define STEP1(C0,C1,P0,P1,t,GK,GV,GL) do{ XPART(C0,C1,P0,P1,t); DMAS(t,GK,GV); CMASK(C0,C1,t); YPART(C0,C1,(t)-1,(t)+1,GL); }while(0)
  #define STEP2(C0,C1,P0,P1,t,GK,GV)    do{ YPART(P0,P1,(t)-2,(t),true); DMAS(t,GK,GV); XPART(C0,C1,P0,P1,t); CMASK(C0,C1,t); }while(0)
  #define ENDW(tt) do{ if((tt)+3<NT){WAIT_BAR_V(VW,3,2);} else if((tt)+2<NT){WAIT_BAR_V(VW,2,1);} else {WAIT_BAR(0);} }while(0)
  if(!g2){
    STEP1(pB0,pB1,pA0,pA1,1,(4<NT),(2<NT),(2<NT)); ENDW(1);
    int t=2;
    for(;t+6<NT;t+=2){
      STEP1(pA0,pA1,pB0,pB1,t,true,true,true);     WAIT_BAR_V(VW,3,2);
      STEP1(pB0,pB1,pA0,pA1,t+1,true,true,true);   WAIT_BAR_V(VW,3,2);
    }
    for(;t+2<NT;t+=2){
      STEP1(pA0,pA1,pB0,pB1,t,(t+3<NT),(t+1<NT),(t+1<NT));       ENDW(t);
      STEP1(pB0,pB1,pA0,pA1,t+1,(t+4<NT),(t+2<NT),(t+2<NT));     ENDW(t+1);
    }
    STEP1(pA0,pA1,pB0,pB1,NT-2,false,true,true); ENDW(NT-2);
    STEP1(pB0,pB1,pA0,pA1,NT-1,false,false,false);
  } else {
    { YPART0(pA0,pA1,1); DMAS(1,(4<NT),(2<NT)); XPART(pB0,pB1,pA0,pA1,1); CMASK(pB0,pB1,1); } ENDW(1);
    int t=2;
    for(;t+6<NT;t+=2){
      STEP2(pA0,pA1,pB0,pB1,t,true,true);     WAIT_BAR_V(VW,3,2);
      STEP2(pB0,pB1,pA0,pA1,t+1,true,true);   WAIT_BAR_V(VW,3,2);
    }
    for(;t+2<NT;t+=2){
      STEP2(pA0,pA1,pB0,pB1,t,(t+3<NT),(t+1<NT));       ENDW(t);
      STEP2(pB0,pB1,pA0,pA1,t+1,(t+4<NT),(t+2<NT));     ENDW(t+1);
    }
    STEP2(pA0,pA1,pB0,pB1,NT-2,false,true); ENDW(NT-2);
    STEP2(pB0,pB1,pA0,pA1,NT-1,false,false);
    YPART(pB0,pB1,NT-2,0,false);
  }
  { float sacc=pB0[0]+pB0[1]; _Pragma("unroll") for(int r=2;r<16;++r)sacc+=pB0[r]; _Pragma("unroll") for(int r=0;r<16;++r)sacc+=pB1[r]; l_reg+=sacc;
    pw0=(u32x4){PKW(pB0,0),PKW(pB0,2),PKW(pB0,4),PKW(pB0,6)};pw1=(u32x4){PKW(pB0,8),PKW(pB0,10),PKW(pB0,12),PKW(pB0,14)};pw2=(u32x4){PKW(pB1,0),PKW(pB1,2),PKW(pB1,4),PKW(pB1,6)};pw3=(u32x4){PKW(pB1,8),PKW(pB1,10),PKW(pB1,12),PKW(pB1,14)};
    SBAR(); pv_w<VW>(o,vb0+VS(NT-1),PAF(0),PAF(1),PAF(2),PAF(3)); }
  #undef PKW
  #undef PAF
  #undef VFR
  #undef PIN
  #undef MF
  #undef GAPA
  #undef GAPB4
  #undef GAPB2
  #undef EX
  #undef VRDX
  #undef KRD8
  #undef XPART
  #undef YPART
  #undef YPART0
  #undef DMAS
  #undef STEP1
  #undef STEP2
  #undef ENDW
  float rli[16];
  {auto rr=__builtin_amdgcn_permlane32_swap(__float_as_uint(l_reg),__float_as_uint(l_reg),false,false);l_reg=__uint_as_float(rr[0])+__uint_as_float(rr[1]);}
  if(__any(!(l_reg>FS_LMIN&&l_reg<FS_LMAX))){ if(lane==0)*(volatile unsigned*)(shm+F2_WS)=1u; }
  if(hi==0)wsf[32+r32]=l_reg;asm volatile("s_waitcnt lgkmcnt(0)":::"memory");
  #pragma unroll
  for(int r=0;r<16;++r)rli[r]=__builtin_amdgcn_rcpf(wsf[32+crow(r,hi)]);
  bf16*Ow=Ow0+(long)(wid*QBLK)*OPITCH;
  #pragma unroll
  for(int hv=0;hv<VW;++hv){ bf16*stg=(bf16*)(shm+F2_OST)+wid*2048;
    #pragma unroll
    for(int r=0;r<16;++r){const int orow=crow(r,hi);
      #pragma unroll
      for(int d0=0;d0<2;++d0)stg[orow*64+d0*32+r32]=__float2bfloat16(o[2*hv+d0][r]*rli[r]);}
    asm volatile("s_waitcnt lgkmcnt(0)":::"memory");
    #pragma unroll
    for(int i=0;i<4;++i){const int row=i*8+(lane>>3),ch=lane&7; const u32x4 v=*(const u32x4*)(stg+row*64+ch*8); ATTN_STORE16(Ow+(long)row*OPITCH+hv*64+ch*8,v);}
    asm volatile("s_waitcnt lgkmcnt(0)":::"memory"); }
  asm volatile("s_waitcnt lgkmcnt(0)\n\ts_barrier":::"memory");
  const bool redo=*(volatile unsigned*)(shm+F2_WS)!=0u;
  #undef DMA_K
  #undef KROW
  #undef DMA_V
  #undef CMASK
  #undef KS
  #undef VS
  return redo;
}
#undef WAIT_BAR_V
#undef MF8
constexpr int ATTN_FS2_LDS_BYTES=F2_BYTES;
constexpr int F8_S=4096, F8_K=0, F8_V=3*F8_S, F8_WS=F8_V+3*2*F8_S, F8_OST=F8_WS+NW*64*4, F8_BYTES=F8_OST+NW*4096;
constexpr float V8_SCALE=8.0f, F8_TRIG=128.0f;
#ifndef F8_CHK
#define F8_CHK 7
#endif
#define F8_PMEAN (1.0f/(float)(1<<FB))
#define F8_LOGK (6.0f-(float)FB)
#define F8_LMINF (2.0f*F8_PMEAN)
constexpr long VT_BLK=33792L*64;
#define MF8(a,b,c) __builtin_amdgcn_mfma_scale_f32_32x32x64_f8f6f4(a,b,c,0,0,0,0,0,0)
template<int VW,bool ISC,int FB> __device__ __forceinline__ bool attn_fs8(const unsigned char*__restrict__ VTh,int TR,bf16*Ow0,int NT,int kr0,int r0,lds_cfptr bt,char*shm,const unsigned char*Q8w0,const unsigned char*__restrict__ K8h){
  int tid_=threadIdx.x; asm volatile("; LAUNDER":"+v"(tid_)); const int tid=tid_,lane=tid&63,r32=lane&31,hi=lane>>5; const int wid=__builtin_amdgcn_readfirstlane(tid>>6);
  const unsigned lds0=(unsigned)(uintptr_t)shm;
  float*wsf=(float*)(shm+F8_WS)+wid*64;
  const unsigned char*ksrc8=K8h+(long)lane*64+(wid&3)*16;
  const unsigned char*vsrc8=VTh+(long)lane*64+(wid&3)*16+(VW==2?(long)(wid>>2)*VT_BLK:0L);
  const unsigned kdst=lds0+F8_K+(wid&3)*1024, vdst=lds0+F8_V+(wid&3)*1024+(VW==2?(wid>>2)*4096:0);
  #define KROW(t) (ISC ? ((t)<4 ? 64*(t) : 256+64*(kr0+(t)-4)) : 64*(t))
  #define DMA_K(t,slot) glds16(ksrc8+(long)KROW(t)*64,(unsigned)__builtin_amdgcn_readfirstlane(kdst+(slot)))
  #define DMA_V(t,slot) glds16(vsrc8+(long)KROW(t)*64,(unsigned)__builtin_amdgcn_readfirstlane(vdst+2*(slot)))
  const lds_cptr shm3=(lds_cptr)shm; const lds_cptr kp0=shm3+F8_K+(2*hi)*1024+r32*16; const lds_cptr vq0=shm3+F8_V+(2*hi)*1024+r32*16;
  glds16(ksrc8+(long)KROW(TR)*64,(unsigned)__builtin_amdgcn_readfirstlane(lds0+F8_V+4*F8_S+(wid&3)*1024));
  DMA_K(0,0);DMA_V(0,0);DMA_K(1,F8_S);
  i32x8a q8; { const unsigned char*qp=Q8w0+(long)(wid*QBLK+r32)*64+32*hi; q8=cat8a(*reinterpret_cast<const i32x4a*>(qp),*reinterpret_cast<const i32x4a*>(qp+16)); }
  i32x8a k8a,k8b;
  float l_reg=0.f;f32x16 o[2*VW];
  #pragma unroll
  for(int d0=0;d0<2*VW;++d0)o[d0]=f32x16{};
  const f32x16 zero16=f32x16{};
  #define CMASK(P0,P1,t) do{ if constexpr(ISC){ if(wid&1) cbias_par<1>(P0,P1,(t),kr0,r0,wid,r32,hi,bt); else cbias_par<0>(P0,P1,(t),kr0,r0,wid,r32,hi,bt); } }while(0)
  f32x16 pA0,pA1,pB0,pB1;
  int sl_prev=0,sl_cur=0,sl_next=F8_S;
  #define ROT() do{sl_prev=sl_cur;sl_cur=sl_next;sl_next=(sl_next==2*F8_S)?0:sl_next+F8_S;}while(0)
  DMA_K(2,2*F8_S);
  WAIT_BAR(5);
  if(tid==0)*(volatile unsigned*)(shm+F8_WS)=0u;
  f32x16 negc;
  { const lds_cptr kr_=shm3+F8_V+4*F8_S+(2*hi)*1024+r32*16;
    pA0=MF8(kfrag8(kr_),q8,zero16); pA1=MF8(kfrag8(kr_+512),q8,zero16);
    asm volatile("s_nop 15\n\ts_nop 7":"+v"(pA0),"+v"(pA1));CMASK(pA0,pA1,TR);
    float ts=0.f;
    if constexpr(ISC){ _Pragma("unroll") for(int r=0;r<16;++r){ts+=__builtin_amdgcn_exp2f(pA0[r]);ts+=__builtin_amdgcn_exp2f(pA1[r]);} }
    else { _Pragma("unroll") for(int r=0;r<16;++r){ts+=pA0[r];ts+=pA1[r];} }
    {auto rr=__builtin_amdgcn_permlane32_swap(__float_as_uint(ts),__float_as_uint(ts),false,false);ts=__uint_as_float(rr[0])+__uint_as_float(rr[1]);}
    const float nc=ISC?F8_LOGK-__builtin_amdgcn_logf(ts):-(ts*(1.0f/64.0f))-(float)FB;
    _Pragma("unroll") for(int r=0;r<16;++r)negc[r]=nc; }
  pA0=MF8(kfrag8(kp0),q8,negc); pA1=MF8(kfrag8(kp0+512),q8,negc);
  asm volatile("s_nop 15\n\ts_nop 7":"+v"(pA0),"+v"(pA1));CMASK(pA0,pA1,0);
  _Pragma("unroll") for(int r=0;r<16;++r){pA0[r]=__builtin_amdgcn_exp2f(pA0[r]);pA1[r]=__builtin_amdgcn_exp2f(pA1[r]);}
  WAIT_BAR(0);
  DMA_K(3,0);DMA_V(1,F8_S);
  ROT();
  k8a=kfrag8(kp0+sl_cur); k8b=kfrag8(kp0+sl_cur+512);
  WAIT_BAR(2);
  i32x8a vfa[2]; i32x8a pq=i32x8a{};
  #define PIN(x) asm volatile("":"+v"(x))
  #define EX(v) __builtin_amdgcn_exp2f(v)
  #define CV8(P,B,W) W=__builtin_amdgcn_cvt_pk_fp8_f32(P[B],P[(B)+1],W,false); W=__builtin_amdgcn_cvt_pk_fp8_f32(P[(B)+2],P[(B)+3],W,true)
  #define VOFF(dq) (((dq)>>1)*4096+((dq)&1)*512)
  #define SUM8(P,B) do{ sacc+=P[B]; sacc+=P[(B)+1]; sacc+=P[(B)+2]; sacc+=P[(B)+3]; sacc+=P[(B)+4]; sacc+=P[(B)+5]; sacc+=P[(B)+6]; sacc+=P[(B)+7]; PIN(sacc); }while(0)
  #define PK8(P,B,I) do{ int w0_=pq[I],w1_=pq[(I)+1]; CV8(P,B,w0_); CV8(P,(B)+4,w1_); pq[I]=w0_; pq[(I)+1]=w1_; PIN(pq); }while(0)
  #define EXP8(X,B) do{ X[B]=EX(X[B]); X[(B)+1]=EX(X[(B)+1]); X[(B)+2]=EX(X[(B)+2]); X[(B)+3]=EX(X[(B)+3]); X[(B)+4]=EX(X[(B)+4]); X[(B)+5]=EX(X[(B)+5]); X[(B)+6]=EX(X[(B)+6]); X[(B)+7]=EX(X[(B)+7]); PIN(X); }while(0)
  #define RESCALE(P0,P1,HASC,C0,C1) do{ if(__builtin_expect(__any(sacc>F8_TRIG),0)){ \
      int ex_=((__float_as_int(sacc)>>23)&255)-133; ex_=ex_<0?0:ex_; \
      {auto rr=__builtin_amdgcn_permlane32_swap((unsigned)ex_,(unsigned)ex_,false,false); const int e0_=(int)rr[0],e1_=(int)rr[1]; ex_=e0_>e1_?e0_:e1_;} \
      const float f_=__builtin_amdgcn_ldexpf(1.0f,-ex_), d_=(float)ex_; \
      _Pragma("unroll") for(int r=0;r<16;++r){P0[r]*=f_;P1[r]*=f_;negc[r]-=d_;} \
      sacc*=f_; l_reg*=f_; \
      if constexpr(HASC){ _Pragma("unroll") for(int r=0;r<16;++r){C0[r]-=d_;C1[r]-=d_;} } \
      if(hi==0)wsf[32+r32]=f_; asm volatile("s_waitcnt lgkmcnt(0)":::"memory"); \
      _Pragma("unroll") for(int r=0;r<16;++r){ const float fr_=wsf[32+crow(r,hi)]; _Pragma("unroll") for(int dq=0;dq<2*VW;++dq)o[dq][r]*=fr_; } \
      asm volatile("s_waitcnt lgkmcnt(0)":::"memory"); } }while(0)
  #define STEP(C0,C1,P0,P1,t,GK,GV,GL) do{ SBAR(); \
    const lds_cptr vq_=vq0+2*sl_prev; \
    vfa[0]=kfrag8(vq_+VOFF(0)); SBAR(); \
    float sacc=0.f; \
    C0=MF8(k8a,q8,negc); SBAR(); \
    SUM8(P0,0); SBAR(); \
    vfa[1]=kfrag8(vq_+VOFF(1)); SBAR(); \
    SUM8(P0,8); SBAR(); \
    C1=MF8(k8b,q8,negc); SBAR(); \
    SUM8(P1,0); SUM8(P1,8); SBAR(); \
    RESCALE(P0,P1,true,C0,C1); \
    PK8(P0,0,0); PK8(P0,8,2); PK8(P1,0,4); PK8(P1,8,6); SBAR(); \
    l_reg+=sacc; \
    if(GK){DMA_K((t)+3,sl_cur);} if(GV){DMA_V((t)+1,sl_next);} \
    CMASK(C0,C1,t); \
    SBAR(); \
    if constexpr(VW==1){ \
      o[0]=MF8(pq,vfa[0],o[0]); SBAR(); EXP8(C0,0); SBAR(); \
      if(GL){ k8a=kfrag8(kp0+sl_next); SBAR(); } EXP8(C0,8); SBAR(); \
      o[1]=MF8(pq,vfa[1],o[1]); SBAR(); EXP8(C1,0); SBAR(); \
      if(GL){ k8b=kfrag8(kp0+sl_next+512); SBAR(); } EXP8(C1,8); SBAR(); \
    } else { \
      o[0]=MF8(pq,vfa[0],o[0]); SBAR(); vfa[0]=kfrag8(vq_+VOFF(2)); SBAR(); EXP8(C0,0); SBAR(); \
      o[1]=MF8(pq,vfa[1],o[1]); SBAR(); vfa[1]=kfrag8(vq_+VOFF(3)); SBAR(); if(GL){ k8a=kfrag8(kp0+sl_next); SBAR(); } EXP8(C0,8); SBAR(); \
      o[2]=MF8(pq,vfa[0],o[2]); SBAR(); EXP8(C1,0); SBAR(); \
      o[3]=MF8(pq,vfa[1],o[3]); SBAR(); if(GL){ k8b=kfrag8(kp0+sl_next+512); SBAR(); } EXP8(C1,8); SBAR(); \
    } \
    }while(0)
  int t=1;
  for(;t+5<NT;t+=2){
    STEP(pB0,pB1,pA0,pA1,t,true,true,true);     WAIT_BAR(2); ROT();
    STEP(pA0,pA1,pB0,pB1,t+1,true,true,true);   WAIT_BAR(2); ROT();
  }
  #define ENDW(tt) do{ if((tt)+3<NT){WAIT_BAR(2);} else if((tt)+2<NT){WAIT_BAR(1);} else {WAIT_BAR(0);} }while(0)
  for(;t+1<NT;t+=2){
    STEP(pB0,pB1,pA0,pA1,t,(t+3<NT),(t+1<NT),(t+1<NT));       ENDW(t);   ROT();
    STEP(pA0,pA1,pB0,pB1,t+1,(t+4<NT),(t+2<NT),(t+2<NT));     ENDW(t+1); ROT();
  }
  STEP(pB0,pB1,pA0,pA1,NT-1,false,false,false);
  { const lds_cptr vq_=vq0+2*sl_cur;
    float sacc=0.f; SUM8(pB0,0); SUM8(pB0,8); SUM8(pB1,0); SUM8(pB1,8); RESCALE(pB0,pB1,false,pB0,pB1); l_reg+=sacc;
    PK8(pB0,0,0); PK8(pB0,8,2); PK8(pB1,0,4); PK8(pB1,8,6); SBAR();
    #pragma unroll
    for(int dq=0;dq<2*VW;++dq)o[dq]=MF8(pq,kfrag8(vq_+VOFF(dq)),o[dq]); }
  #undef PIN
  #undef EX
  #undef CV8
  #undef VOFF
  #undef SUM8
  #undef PK8
  #undef EXP8
  #undef STEP
  #undef RESCALE
  #undef ENDW
  float rli[16];
  {auto rr=__builtin_amdgcn_permlane32_swap(__float_as_uint(l_reg),__float_as_uint(l_reg),false,false);l_reg=__uint_as_float(rr[0])+__uint_as_float(rr[1]);}
  if(__any(!((l_reg>F8_LMINF*(float)NT||!(F8_CHK&1))&&(l_reg<FS_LMAX||!(F8_CHK&4))&&!(F8_CHK&8)))){ if(lane==0)*(volatile unsigned*)(shm+F8_WS)=1u; }
  if(hi==0)wsf[32+r32]=l_reg;asm volatile("s_waitcnt lgkmcnt(0)":::"memory");
  #pragma unroll
  for(int r=0;r<16;++r)rli[r]=__builtin_amdgcn_rcpf(wsf[32+crow(r,hi)])*(1.0f/V8_SCALE);
  bf16*Ow=Ow0+(long)(wid*QBLK)*OPITCH;
  #pragma unroll
  for(int hv=0;hv<VW;++hv){ bf16*stg=(bf16*)(shm+F8_OST)+wid*2048;
    #pragma unroll
    for(int r=0;r<16;++r){const int orow=crow(r,hi);
      #pragma unroll
      for(int d0=0;d0<2;++d0)stg[orow*64+d0*32+r32]=__float2bfloat16(o[2*hv+d0][r]*rli[r]);}
    asm volatile("s_waitcnt lgkmcnt(0)":::"memory");
    #pragma unroll
    for(int i=0;i<4;++i){const int row=i*8+(lane>>3),ch=lane&7; const u32x4 v=*(const u32x4*)(stg+row*64+ch*8); ATTN_STORE16(Ow+(long)row*OPITCH+hv*64+ch*8,v);}
    asm volatile("s_waitcnt lgkmcnt(0)":::"memory"); }
  asm volatile("s_waitcnt lgkmcnt(0)\n\ts_barrier":::"memory");
  const bool redo=*(volatile unsigned*)(shm+F8_WS)!=0u;
  #undef DMA_K
  #undef KROW
  #undef DMA_V
  #undef CMASK
  #undef ROT
  return redo;
}
#undef MF8
#undef F8_PMEAN
#undef F8_LOGK
#undef F8_LMINF
constexpr int ATTN_FS8_LDS_BYTES=F8_BYTES;
#ifndef F8_MSUM
#define F8_MSUM 0
#endif
constexpr int P8_K=0, P8_V=2*8192, P8_WS=P8_V+2*16384, P8_OST=P8_WS+NW*64*4, P8_BYTES=P8_OST+NW*4096;
#define F8_PMEAN (1.0f/(float)(1<<FB))
#define F8_LOGK (6.0f-(float)FB)
#define F8_LMINF (2.0f*F8_PMEAN)
#define MF8(a,b,c) __builtin_amdgcn_mfma_scale_f32_32x32x64_f8f6f4(a,b,c,0,0,0,0,0,0)
template<int VW,bool ISC,int FB> __device__ __forceinline__ bool attn_fs8p(const unsigned char*__restrict__ VTh,int TR,bf16*Ow0,int NT,int kr0,int r0,lds_cfptr bt,char*shm,const unsigned char*Q8w0,const unsigned char*__restrict__ K8h){
  int tid_=threadIdx.x; asm volatile("; LAUNDER":"+v"(tid_)); const int tid=tid_,lane=tid&63,r32=lane&31,hi=lane>>5; const int wid=__builtin_amdgcn_readfirstlane(tid>>6);
  const unsigned lds0=(unsigned)(uintptr_t)shm;
  float*wsf=(float*)(shm+P8_WS)+wid*64;
  constexpr int VTS=4096*VW, VSL=2*VTS;
  const int wt=wid>>2, wc4=wid&3;
  const unsigned char*ksrc8=K8h+(long)lane*64+wc4*16;
  const unsigned char*vsrc8=VTh+(long)lane*64+wc4*16;
  const unsigned kdst=lds0+P8_K+wt*4096+wc4*1024, vdst=lds0+P8_V+wt*VTS+wc4*1024;
  #define KROW(t) (ISC ? ((t)<4 ? 64*(t) : 256+64*(kr0+(t)-4)) : 64*(t))
  #define DMA_KP(p) glds16(ksrc8+(long)KROW(2*(p)+wt)*64,(unsigned)__builtin_amdgcn_readfirstlane(kdst+((p)&1)*8192))
  #define DMA_VP(p) do{ glds16(vsrc8+(long)KROW(2*(p)+wt)*64,(unsigned)__builtin_amdgcn_readfirstlane(vdst+((p)&1)*VSL)); \
      if constexpr(VW==2){ glds16(vsrc8+VT_BLK+(long)KROW(2*(p)+wt)*64,(unsigned)__builtin_amdgcn_readfirstlane(vdst+((p)&1)*VSL+4096)); } }while(0)
  const lds_cptr shm3=(lds_cptr)shm; const lds_cptr kp0=shm3+P8_K+(2*hi)*1024+r32*16; const lds_cptr vq0=shm3+P8_V+(2*hi)*1024+r32*16;
  #define KADR(t) (kp0+(((t)>>1)&1)*8192+((t)&1)*4096)
  #define VADR(t) (vq0+(((t)>>1)&1)*VSL+((t)&1)*VTS)
  glds16(ksrc8+(long)KROW(TR)*64,(unsigned)__builtin_amdgcn_readfirstlane(lds0+P8_V+VSL+wc4*1024));
  DMA_KP(0);DMA_VP(0);DMA_KP(1);
  i32x8a q8; { const unsigned char*qp=Q8w0+(long)(wid*QBLK+r32)*64+32*hi; q8=cat8a(*reinterpret_cast<const i32x4a*>(qp),*reinterpret_cast<const i32x4a*>(qp+16)); }
  i32x8a k8a,k8b;
  constexpr bool MS=(VW==1)&&(F8_MSUM!=0);
  float l_reg=0.f;f32x16 o[2*VW]; f32x16 lsum=f32x16{}; const i32x8a ones8=(i32x8a){0x38383838,0x38383838,0x38383838,0x38383838,0x38383838,0x38383838,0x38383838,0x38383838};
  #pragma unroll
  for(int d0=0;d0<2*VW;++d0)o[d0]=f32x16{};
  const f32x16 zero16=f32x16{};
  #define CMASK(P0,P1,t) do{ if constexpr(ISC){ if(wid&1) cbias_par<1>(P0,P1,(t),kr0,r0,wid,r32,hi,bt); else cbias_par<0>(P0,P1,(t),kr0,r0,wid,r32,hi,bt); } }while(0)
  f32x16 pA0,pA1,pB0,pB1;
  WAIT_BAR(0);
  if(tid==0)*(volatile unsigned*)(shm+P8_WS)=0u;
  f32x16 negc;
  { const lds_cptr kr_=shm3+P8_V+VSL+(2*hi)*1024+r32*16;
    pA0=MF8(kfrag8(kr_),q8,zero16); pA1=MF8(kfrag8(kr_+512),q8,zero16);
    asm volatile("s_nop 15\n\ts_nop 7":"+v"(pA0),"+v"(pA1));CMASK(pA0,pA1,TR);
    float ts=0.f;
    if constexpr(ISC){ _Pragma("unroll") for(int r=0;r<16;++r){ts+=__builtin_amdgcn_exp2f(pA0[r]);ts+=__builtin_amdgcn_exp2f(pA1[r]);} }
    else { _Pragma("unroll") for(int r=0;r<16;++r){ts+=pA0[r];ts+=pA1[r];} }
    {auto rr=__builtin_amdgcn_permlane32_swap(__float_as_uint(ts),__float_as_uint(ts),false,false);ts=__uint_as_float(rr[0])+__uint_as_float(rr[1]);}
    const float nc=ISC?F8_LOGK-__builtin_amdgcn_logf(ts):-(ts*(1.0f/64.0f))-(float)FB;
    _Pragma("unroll") for(int r=0;r<16;++r)negc[r]=nc; }
  pA0=MF8(kfrag8(KADR(0)),q8,negc); pA1=MF8(kfrag8(KADR(0)+512),q8,negc);
  asm volatile("s_nop 15\n\ts_nop 7":"+v"(pA0),"+v"(pA1));CMASK(pA0,pA1,0);
  _Pragma("unroll") for(int r=0;r<16;++r){pA0[r]=__builtin_amdgcn_exp2f(pA0[r]);pA1[r]=__builtin_amdgcn_exp2f(pA1[r]);}
  k8a=kfrag8(KADR(1)); k8b=kfrag8(KADR(1)+512);
  WAIT_BAR(0);
  i32x8a vfa[2]; i32x8a pq=i32x8a{};
  #define PIN(x) asm volatile("":"+v"(x))
  #define EX(v) __builtin_amdgcn_exp2f(v)
  #define CV8(P,B,W) W=__builtin_amdgcn_cvt_pk_fp8_f32(P[B],P[(B)+1],W,false); W=__builtin_amdgcn_cvt_pk_fp8_f32(P[(B)+2],P[(B)+3],W,true)
  #define VOFF(dq) (((dq)>>1)*4096+((dq)&1)*512)
  #define MX3(a_,b_) asm("v_max3_f32 %0, %0, %1, %2":"+v"(sacc):"v"(a_),"v"(b_))
  #define SUM8(P,B) do{ if constexpr(MS){ MX3(P[B],P[(B)+1]); MX3(P[(B)+2],P[(B)+3]); MX3(P[(B)+4],P[(B)+5]); MX3(P[(B)+6],P[(B)+7]); PIN(sacc); } \
      else { sacc+=P[B]; sacc+=P[(B)+1]; sacc+=P[(B)+2]; sacc+=P[(B)+3]; sacc+=P[(B)+4]; sacc+=P[(B)+5]; sacc+=P[(B)+6]; sacc+=P[(B)+7]; PIN(sacc); } }while(0)
  #define PK8(P,B,I) do{ int w0_=pq[I],w1_=pq[(I)+1]; CV8(P,B,w0_); CV8(P,(B)+4,w1_); pq[I]=w0_; pq[(I)+1]=w1_; PIN(pq); }while(0)
  #define EXP8(X,B) do{ X[B]=EX(X[B]); X[(B)+1]=EX(X[(B)+1]); X[(B)+2]=EX(X[(B)+2]); X[(B)+3]=EX(X[(B)+3]); X[(B)+4]=EX(X[(B)+4]); X[(B)+5]=EX(X[(B)+5]); X[(B)+6]=EX(X[(B)+6]); X[(B)+7]=EX(X[(B)+7]); PIN(X); }while(0)
  #define RESCALE(P0,P1,HASC,C0,C1) do{ if(__builtin_expect(__any(sacc>F8_TRIG),0)){ \
      int ex_=((__float_as_int(sacc)>>23)&255)-133; ex_=ex_<0?0:ex_; \
      {auto rr=__builtin_amdgcn_permlane32_swap((unsigned)ex_,(unsigned)ex_,false,false); const int e0_=(int)rr[0],e1_=(int)rr[1]; ex_=e0_>e1_?e0_:e1_;} \
      const float f_=__builtin_amdgcn_ldexpf(1.0f,-ex_), d_=(float)ex_; \
      _Pragma("unroll") for(int r=0;r<16;++r){P0[r]*=f_;P1[r]*=f_;negc[r]-=d_;} \
      sacc*=f_; l_reg*=f_; \
      if constexpr(HASC){ _Pragma("unroll") for(int r=0;r<16;++r){C0[r]-=d_;C1[r]-=d_;} } \
      if(hi==0)wsf[32+r32]=f_; asm volatile("s_waitcnt lgkmcnt(0)":::"memory"); \
      _Pragma("unroll") for(int r=0;r<16;++r){ const float fr_=wsf[32+crow(r,hi)]; _Pragma("unroll") for(int dq=0;dq<2*VW;++dq)o[dq][r]*=fr_; if constexpr(MS){lsum[r]*=fr_;} } \
      asm volatile("s_waitcnt lgkmcnt(0)":::"memory"); } }while(0)
  #define STEP(C0,C1,P0,P1,t,VQ,KN,GL) do{ SBAR(); \
    const lds_cptr vq_=(VQ); const lds_cptr kn_=(KN); \
    vfa[0]=kfrag8(vq_+VOFF(0)); SBAR(); \
    float sacc=0.f; \
    C0=MF8(k8a,q8,negc); SBAR(); \
    SUM8(P0,0); SBAR(); \
    vfa[1]=kfrag8(vq_+VOFF(1)); SBAR(); \
    SUM8(P0,8); SBAR(); \
    C1=MF8(k8b,q8,negc); SBAR(); \
    SUM8(P1,0); SUM8(P1,8); SBAR(); \
    RESCALE(P0,P1,true,C0,C1); \
    PK8(P0,0,0); PK8(P0,8,2); PK8(P1,0,4); PK8(P1,8,6); SBAR(); \
    if constexpr(!MS){ l_reg+=sacc; } \
    CMASK(C0,C1,t); \
    SBAR(); \
    if constexpr(VW==1){ \
      o[0]=MF8(pq,vfa[0],o[0]); SBAR(); EXP8(C0,0); SBAR(); \
      if(GL){ k8a=kfrag8(kn_); SBAR(); } EXP8(C0,8); SBAR(); \
      o[1]=MF8(pq,vfa[1],o[1]); SBAR(); EXP8(C1,0); SBAR(); \
      if constexpr(MS){ lsum=MF8(pq,ones8,lsum); SBAR(); } \
      if(GL){ k8b=kfrag8(kn_+512); SBAR(); } EXP8(C1,8); SBAR(); \
    } else { \
      o[0]=MF8(pq,vfa[0],o[0]); SBAR(); vfa[0]=kfrag8(vq_+VOFF(2)); SBAR(); EXP8(C0,0); SBAR(); \
      o[1]=MF8(pq,vfa[1],o[1]); SBAR(); vfa[1]=kfrag8(vq_+VOFF(3)); SBAR(); if(GL){ k8a=kfrag8(kn_); SBAR(); } EXP8(C0,8); SBAR(); \
      o[2]=MF8(pq,vfa[0],o[2]); SBAR(); EXP8(C1,0); SBAR(); \
      o[3]=MF8(pq,vfa[1],o[3]); SBAR(); if(GL){ k8b=kfrag8(kn_+512); SBAR(); } EXP8(C1,8); SBAR(); \
    } \
    }while(0)
  const int NG=(NT>>1)-1;
  for(int g=0;g<NG;++g){
    if(g+2<(NT>>1)){DMA_KP(g+2);} DMA_VP(g+1);
    STEP(pB0,pB1,pA0,pA1,2*g+1,VADR(2*g),KADR(2*g+2),true);
    STEP(pA0,pA1,pB0,pB1,2*g+2,VADR(2*g+1),KADR(2*g+3),true);
    WAIT_BAR(0);
  }
  STEP(pB0,pB1,pA0,pA1,NT-1,VADR(NT-2),KADR(0),false);
  { const lds_cptr vq_=VADR(NT-1);
    float sacc=0.f; SUM8(pB0,0); SUM8(pB0,8); SUM8(pB1,0); SUM8(pB1,8); RESCALE(pB0,pB1,false,pB0,pB1); if constexpr(!MS){ l_reg+=sacc; }
    PK8(pB0,0,0); PK8(pB0,8,2); PK8(pB1,0,4); PK8(pB1,8,6); SBAR();
    if constexpr(MS){ lsum=MF8(pq,ones8,lsum); }
    #pragma unroll
    for(int dq=0;dq<2*VW;++dq)o[dq]=MF8(pq,kfrag8(vq_+VOFF(dq)),o[dq]); }
  #undef PIN
  #undef EX
  #undef CV8
  #undef VOFF
  #undef SUM8
  #undef MX3
  #undef PK8
  #undef EXP8
  #undef STEP
  #undef RESCALE
  float rli[16];
  if constexpr(MS){
    float mn=lsum[0],mx=lsum[0];
    #pragma unroll
    for(int r=1;r<16;++r){mn=fminf(mn,lsum[r]);mx=fmaxf(mx,lsum[r]);}
    bool bad=!((mn>F8_LMINF*(float)NT||!(F8_CHK&1))&&(mx<FS_LMAX||!(F8_CHK&4))&&!(F8_CHK&8));
    #pragma unroll
    for(int r=0;r<16;++r)bad=bad||(lsum[r]!=lsum[r]);
    if(__any(bad)){ if(lane==0)*(volatile unsigned*)(shm+P8_WS)=1u; }
    #pragma unroll
    for(int r=0;r<16;++r)rli[r]=__builtin_amdgcn_rcpf(lsum[r])*(1.0f/V8_SCALE);
  } else {
  {auto rr=__builtin_amdgcn_permlane32_swap(__float_as_uint(l_reg),__float_as_uint(l_reg),false,false);l_reg=__uint_as_float(rr[0])+__uint_as_float(rr[1]);}
  if(__any(!((l_reg>F8_LMINF*(float)NT||!(F8_CHK&1))&&(l_reg<FS_LMAX||!(F8_CHK&4))&&!(F8_CHK&8)))){ if(lane==0)*(volatile unsigned*)(shm+P8_WS)=1u; }
  if(hi==0)wsf[32+r32]=l_reg;asm volatile("s_waitcnt lgkmcnt(0)":::"memory");
  #pragma unroll
  for(int r=0;r<16;++r)rli[r]=__builtin_amdgcn_rcpf(wsf[32+crow(r,hi)])*(1.0f/V8_SCALE);
  }
  bf16*Ow=Ow0+(long)(wid*QBLK)*OPITCH;
  #pragma unroll
  for(int hv=0;hv<VW;++hv){ bf16*stg=(bf16*)(shm+P8_OST)+wid*2048;
    #pragma unroll
    for(int r=0;r<16;++r){const int orow=crow(r,hi);
      #pragma unroll
      for(int d0=0;d0<2;++d0)stg[orow*64+d0*32+r32]=__float2bfloat16(o[2*hv+d0][r]*rli[r]);}
    asm volatile("s_waitcnt lgkmcnt(0)":::"memory");
    #pragma unroll
    for(int i=0;i<4;++i){const int row=i*8+(lane>>3),ch=lane&7; const u32x4 v=*(const u32x4*)(stg+row*64+ch*8); ATTN_STORE16(Ow+(long)row*OPITCH+hv*64+ch*8,v);}
    asm volatile("s_waitcnt lgkmcnt(0)":::"memory"); }
  asm volatile("s_waitcnt lgkmcnt(0)\n\ts_barrier":::"memory");
  const bool redo=*(volatile unsigned*)(shm+P8_WS)!=0u;
  #undef DMA_KP
  #undef DMA_VP
  #undef KROW
  #undef KADR
  #undef VADR
  #undef CMASK
  return redo;
}
#undef MF8
#undef F8_PMEAN
#undef F8_LOGK
#undef F8_LMINF
constexpr int ATTN_FS8P_LDS_BYTES=P8_BYTES;
constexpr int Q8_K=0, Q8_V=2*16384, Q8_REF=Q8_V+2*32768, Q8_WS=Q8_REF+4096, Q8_OST=Q8_K, Q8_BYTES=Q8_WS+NW*64*4;
#define F8_PMEAN (1.0f/(float)(1<<FB))
#define F8_LOGK (6.0f-(float)FB)
#define F8_LMINF (2.0f*F8_PMEAN)
#define MF8(a,b,c) __builtin_amdgcn_mfma_scale_f32_32x32x64_f8f6f4(a,b,c,0,0,0,0,0,0)
template<int VW,bool ISC,int FB> __device__ __forceinline__ bool attn_fs8q(const unsigned char*__restrict__ VTh,int TR,bf16*Ow0,int NT,int kr0,int r0,lds_cfptr bt,char*shm,const unsigned char*Q8w0,const unsigned char*__restrict__ K8h){
  int tid_=threadIdx.x; asm volatile("; LAUNDER":"+v"(tid_)); const int tid=tid_,lane=tid&63,r32=lane&31,hi=lane>>5; const int wid=__builtin_amdgcn_readfirstlane(tid>>6);
  const unsigned lds0=(unsigned)(uintptr_t)shm;
  float*wsf=(float*)(shm+Q8_WS)+wid*64;
  constexpr bool MS=false;
  constexpr int VTS=4096*VW, VSL=4*VTS;
  const int wt=wid>>2, wc4=wid&3;
  const unsigned char*ksrc8=K8h+(long)lane*64+wc4*16;
  const unsigned char*vsrc8=VTh+(long)lane*64+wc4*16;
  #define KROW(t) (ISC ? ((t)<4 ? 64*(t) : 256+64*(kr0+(t)-4)) : 64*(t))
  #define DMA_KG(j) do{ _Pragma("unroll") for(int h_=0;h_<2;++h_){ const int ps_=wt+2*h_, tl_=4*(j)-3+ps_; \
      if(tl_>=0&&tl_<NT){ glds16(ksrc8+(long)KROW(tl_)*64,(unsigned)__builtin_amdgcn_readfirstlane(lds0+Q8_K+((j)&1)*16384+ps_*4096+wc4*1024)); } } }while(0)
  #define DMA_VQ(i) do{ _Pragma("unroll") for(int h_=0;h_<2;++h_){ const int ps_=wt+2*h_, tl_=4*(i)+ps_; \
      glds16(vsrc8+(long)KROW(tl_)*64,(unsigned)__builtin_amdgcn_readfirstlane(lds0+Q8_V+((i)&1)*VSL+ps_*VTS+wc4*1024)); \
      if constexpr(VW==2){ glds16(vsrc8+VT_BLK+(long)KROW(tl_)*64,(unsigned)__builtin_amdgcn_readfirstlane(lds0+Q8_V+((i)&1)*VSL+ps_*VTS+4096+wc4*1024)); } } }while(0)
  const lds_cptr shm3=(lds_cptr)shm; const lds_cptr kp0=shm3+Q8_K+(2*hi)*1024+r32*16; const lds_cptr vq0=shm3+Q8_V+(2*hi)*1024+r32*16;
  #define KADR(t) (kp0+((((t)+3)>>2)&1)*16384+(((t)+3)&3)*4096)
  #define VADR(t) (vq0+(((t)>>2)&1)*VSL+((t)&3)*VTS)
  glds16(ksrc8+(long)KROW(TR)*64,(unsigned)__builtin_amdgcn_readfirstlane(lds0+Q8_REF+wc4*1024));
  DMA_KG(0);DMA_KG(1);DMA_VQ(0);
  i32x8a q8; { const unsigned char*qp=Q8w0+(long)(wid*QBLK+r32)*64+32*hi; q8=cat8a(*reinterpret_cast<const i32x4a*>(qp),*reinterpret_cast<const i32x4a*>(qp+16)); }
  i32x8a k8a,k8b;
  float l_reg=0.f;f32x16 o[2*VW]; f32x16 lsum=f32x16{}; const i32x8a ones8=i32x8a{};
  #pragma unroll
  for(int d0=0;d0<2*VW;++d0)o[d0]=f32x16{};
  const f32x16 zero16=f32x16{};
  #define CMASK(P0,P1,t) do{ if constexpr(ISC){ if(wid&1) cbias_par<1>(P0,P1,(t),kr0,r0,wid,r32,hi,bt); else cbias_par<0>(P0,P1,(t),kr0,r0,wid,r32,hi,bt); } }while(0)
  f32x16 pA0,pA1,pB0,pB1;
  WAIT_BAR(0);
  if(tid==0)*(volatile unsigned*)(shm+Q8_WS)=0u;
  f32x16 negc;
  { const lds_cptr kr_=shm3+Q8_REF+(2*hi)*1024+r32*16;
    pA0=MF8(kfrag8(kr_),q8,zero16); pA1=MF8(kfrag8(kr_+512),q8,zero16);
    asm volatile("s_nop 15\n\ts_nop 7":"+v"(pA0),"+v"(pA1));CMASK(pA0,pA1,TR);
    float ts=0.f;
    if constexpr(ISC){ _Pragma("unroll") for(int r=0;r<16;++r){ts+=__builtin_amdgcn_exp2f(pA0[r]);ts+=__builtin_amdgcn_exp2f(pA1[r]);} }
    else { _Pragma("unroll") for(int r=0;r<16;++r){ts+=pA0[r];ts+=pA1[r];} }
    {auto rr=__builtin_amdgcn_permlane32_swap(__float_as_uint(ts),__float_as_uint(ts),false,false);ts=__uint_as_float(rr[0])+__uint_as_float(rr[1]);}
    const float nc=ISC?F8_LOGK-__builtin_amdgcn_logf(ts):-(ts*(1.0f/64.0f))-(float)FB;
    _Pragma("unroll") for(int r=0;r<16;++r)negc[r]=nc; }
  pA0=MF8(kfrag8(KADR(0)),q8,negc); pA1=MF8(kfrag8(KADR(0)+512),q8,negc);
  asm volatile("s_nop 15\n\ts_nop 7":"+v"(pA0),"+v"(pA1));CMASK(pA0,pA1,0);
  _Pragma("unroll") for(int r=0;r<16;++r){pA0[r]=__builtin_amdgcn_exp2f(pA0[r]);pA1[r]=__builtin_amdgcn_exp2f(pA1[r]);}
  WAIT_BAR(0);
  i32x8a vfa[2]; i32x8a pq=i32x8a{};
  #define PIN(x) asm volatile("":"+v"(x))
  #define EX(v) __builtin_amdgcn_exp2f(v)
  #define CV8(P,B,W) W=__builtin_amdgcn_cvt_pk_fp8_f32(P[B],P[(B)+1],W,false); W=__builtin_amdgcn_cvt_pk_fp8_f32(P[(B)+2],P[(B)+3],W,true)
  #define VOFF(dq) (((dq)>>1)*4096+((dq)&1)*512)
  #define MX3(a_,b_) asm("v_max3_f32 %0, %0, %1, %2":"+v"(sacc):"v"(a_),"v"(b_))
  #define SUM8(P,B) do{ if constexpr(MS){ MX3(P[B],P[(B)+1]); MX3(P[(B)+2],P[(B)+3]); MX3(P[(B)+4],P[(B)+5]); MX3(P[(B)+6],P[(B)+7]); PIN(sacc); } \
      else { sacc+=P[B]; sacc+=P[(B)+1]; sacc+=P[(B)+2]; sacc+=P[(B)+3]; sacc+=P[(B)+4]; sacc+=P[(B)+5]; sacc+=P[(B)+6]; sacc+=P[(B)+7]; PIN(sacc); } }while(0)
  #define PK8(P,B,I) do{ int w0_=pq[I],w1_=pq[(I)+1]; CV8(P,B,w0_); CV8(P,(B)+4,w1_); pq[I]=w0_; pq[(I)+1]=w1_; PIN(pq); }while(0)
  #define EXP8(X,B) do{ X[B]=EX(X[B]); X[(B)+1]=EX(X[(B)+1]); X[(B)+2]=EX(X[(B)+2]); X[(B)+3]=EX(X[(B)+3]); X[(B)+4]=EX(X[(B)+4]); X[(B)+5]=EX(X[(B)+5]); X[(B)+6]=EX(X[(B)+6]); X[(B)+7]=EX(X[(B)+7]); PIN(X); }while(0)
  #define RESCALE(P0,P1,HASC,C0,C1) do{ if(__builtin_expect(__any(sacc>F8_TRIG),0)){ \
      int ex_=((__float_as_int(sacc)>>23)&255)-133; ex_=ex_<0?0:ex_; \
      {auto rr=__builtin_amdgcn_permlane32_swap((unsigned)ex_,(unsigned)ex_,false,false); const int e0_=(int)rr[0],e1_=(int)rr[1]; ex_=e0_>e1_?e0_:e1_;} \
      const float f_=__builtin_amdgcn_ldexpf(1.0f,-ex_), d_=(float)ex_; \
      _Pragma("unroll") for(int r=0;r<16;++r){P0[r]*=f_;P1[r]*=f_;negc[r]-=d_;} \
      sacc*=f_; l_reg*=f_; \
      if constexpr(HASC){ _Pragma("unroll") for(int r=0;r<16;++r){C0[r]-=d_;C1[r]-=d_;} } \
      if(hi==0)wsf[32+r32]=f_; asm volatile("s_waitcnt lgkmcnt(0)":::"memory"); \
      _Pragma("unroll") for(int r=0;r<16;++r){ const float fr_=wsf[32+crow(r,hi)]; _Pragma("unroll") for(int dq=0;dq<2*VW;++dq)o[dq][r]*=fr_; if constexpr(MS){lsum[r]*=fr_;} } \
      asm volatile("s_waitcnt lgkmcnt(0)":::"memory"); } }while(0)
  #define STEP(C0,C1,P0,P1,t,KFIRST,GL) do{ SBAR(); \
    const lds_cptr vq_=VADR((t)-1); const lds_cptr kn_=KADR((t)+1); \
    if(KFIRST){ k8a=kfrag8(KADR(t)); k8b=kfrag8(KADR(t)+512); SBAR(); } \
    vfa[0]=kfrag8(vq_+VOFF(0)); SBAR(); \
    float sacc=0.f; \
    C0=MF8(k8a,q8,negc); SBAR(); \
    SUM8(P0,0); SBAR(); \
    vfa[1]=kfrag8(vq_+VOFF(1)); SBAR(); \
    SUM8(P0,8); SBAR(); \
    C1=MF8(k8b,q8,negc); SBAR(); \
    SUM8(P1,0); SUM8(P1,8); SBAR(); \
    RESCALE(P0,P1,true,C0,C1); \
    PK8(P0,0,0); PK8(P0,8,2); PK8(P1,0,4); PK8(P1,8,6); SBAR(); \
    if constexpr(!MS){ l_reg+=sacc; } \
    CMASK(C0,C1,t); \
    SBAR(); \
    if constexpr(VW==1){ \
      o[0]=MF8(pq,vfa[0],o[0]); SBAR(); EXP8(C0,0); SBAR(); \
      if(GL){ k8a=kfrag8(kn_); SBAR(); } EXP8(C0,8); SBAR(); \
      o[1]=MF8(pq,vfa[1],o[1]); SBAR(); EXP8(C1,0); SBAR(); \
      if constexpr(MS){ lsum=MF8(pq,ones8,lsum); SBAR(); } \
      if(GL){ k8b=kfrag8(kn_+512); SBAR(); } EXP8(C1,8); SBAR(); \
    } else { \
      o[0]=MF8(pq,vfa[0],o[0]); SBAR(); vfa[0]=kfrag8(vq_+VOFF(2)); SBAR(); EXP8(C0,0); SBAR(); \
      o[1]=MF8(pq,vfa[1],o[1]); SBAR(); vfa[1]=kfrag8(vq_+VOFF(3)); SBAR(); if(GL){ k8a=kfrag8(kn_); SBAR(); } EXP8(C0,8); SBAR(); \
      o[2]=MF8(pq,vfa[0],o[2]); SBAR(); EXP8(C1,0); SBAR(); \
      o[3]=MF8(pq,vfa[1],o[3]); SBAR(); if(GL){ k8b=kfrag8(kn_+512); SBAR(); } EXP8(C1,8); SBAR(); \
    } \
    }while(0)
  const int NGq=NT>>2;
  for(int g=0;g<NGq-1;++g){
    DMA_KG(g+2); DMA_VQ(g+1);
    STEP(pB0,pB1,pA0,pA1,4*g+1,true,true);
    STEP(pA0,pA1,pB0,pB1,4*g+2,false,true);
    STEP(pB0,pB1,pA0,pA1,4*g+3,false,true);
    STEP(pA0,pA1,pB0,pB1,4*g+4,false,false);
    WAIT_BAR(0);
  }
  STEP(pB0,pB1,pA0,pA1,NT-3,true,true);
  STEP(pA0,pA1,pB0,pB1,NT-2,false,true);
  STEP(pB0,pB1,pA0,pA1,NT-1,false,false);
  WAIT_BAR(0);
  { const lds_cptr vq_=VADR(NT-1);
    float sacc=0.f; SUM8(pB0,0); SUM8(pB0,8); SUM8(pB1,0); SUM8(pB1,8); RESCALE(pB0,pB1,false,pB0,pB1); l_reg+=sacc;
    PK8(pB0,0,0); PK8(pB0,8,2); PK8(pB1,0,4); PK8(pB1,8,6); SBAR();
    #pragma unroll
    for(int dq=0;dq<2*VW;++dq)o[dq]=MF8(pq,kfrag8(vq_+VOFF(dq)),o[dq]); }
  #undef PIN
  #undef EX
  #undef CV8
  #undef VOFF
  #undef SUM8
  #undef MX3
  #undef PK8
  #undef EXP8
  #undef STEP
  #undef RESCALE
  float rli[16];
  if constexpr(MS){
    float mn=lsum[0],mx=lsum[0];
    #pragma unroll
    for(int r=1;r<16;++r){mn=fminf(mn,lsum[r]);mx=fmaxf(mx,lsum[r]);}
    bool bad=!((mn>F8_LMINF*(float)NT||!(F8_CHK&1))&&(mx<FS_LMAX||!(F8_CHK&4))&&!(F8_CHK&8));
    #pragma unroll
    for(int r=0;r<16;++r)bad=bad||(lsum[r]!=lsum[r]);
    if(__any(bad)){ if(lane==0)*(volatile unsigned*)(shm+Q8_WS)=1u; }
    #pragma unroll
    for(int r=0;r<16;++r)rli[r]=__builtin_amdgcn_rcpf(lsum[r])*(1.0f/V8_SCALE);
  } else {
  {auto rr=__builtin_amdgcn_permlane32_swap(__float_as_uint(l_reg),__float_as_uint(l_reg),false,false);l_reg=__uint_as_float(rr[0])+__uint_as_float(rr[1]);}
  if(__any(!((l_reg>F8_LMINF*(float)NT||!(F8_CHK&1))&&(l_reg<FS_LMAX||!(F8_CHK&4))&&!(F8_CHK&8)))){ if(lane==0)*(volatile unsigned*)(shm+Q8_WS)=1u; }
  if(hi==0)wsf[32+r32]=l_reg;asm volatile("s_waitcnt lgkmcnt(0)":::"memory");
  #pragma unroll
  for(int r=0;r<16;++r)rli[r]=__builtin_amdgcn_rcpf(wsf[32+crow(r,hi)])*(1.0f/V8_SCALE);
  }
  bf16*Ow=Ow0+(long)(wid*QBLK)*OPITCH;
  #pragma unroll
  for(int hv=0;hv<VW;++hv){ bf16*stg=(bf16*)(shm+Q8_OST)+wid*2048;
    #pragma unroll
    for(int r=0;r<16;++r){const int orow=crow(r,hi);
      #pragma unroll
      for(int d0=0;d0<2;++d0)stg[orow*64+d0*32+r32]=__float2bfloat16(o[2*hv+d0][r]*rli[r]);}
    asm volatile("s_waitcnt lgkmcnt(0)":::"memory");
    #pragma unroll
    for(int i=0;i<4;++i){const int row=i*8+(lane>>3),ch=lane&7; const u32x4 v=*(const u32x4*)(stg+row*64+ch*8); ATTN_STORE16(Ow+(long)row*OPITCH+hv*64+ch*8,v);}
    asm volatile("s_waitcnt lgkmcnt(0)":::"memory"); }
  asm volatile("s_waitcnt lgkmcnt(0)\n\ts_barrier":::"memory");
  const bool redo=*(volatile unsigned*)(shm+Q8_WS)!=0u;
  #undef DMA_KG
  #undef DMA_VQ
  #undef KROW
  #undef KADR
  #undef VADR
  #undef CMASK
  return redo;
}
#undef MF8
#undef F8_PMEAN
#undef F8_LOGK
#undef F8_LMINF
constexpr int ATTN_FS8Q_LDS_BYTES=Q8_BYTES;
#undef SBAR
#undef WAIT_BAR
}
#define GAS __attribute__((address_space(1)))
#define LAS __attribute__((address_space(3)))
typedef unsigned short bf16;
typedef unsigned v4u __attribute__((ext_vector_type(4)));
typedef float f32x4 __attribute__((ext_vector_type(4)));
typedef short bf16x8 __attribute__((ext_vector_type(8)));
typedef GAS unsigned gu32;
typedef GAS unsigned long long gu64;
#define RLX_AGENT __ATOMIC_RELAXED, __HIP_MEMORY_SCOPE_AGENT
#define LDS_WAIT() asm volatile("s_waitcnt lgkmcnt(0)" ::: "memory")
#define VM_WAIT() asm volatile("s_waitcnt vmcnt(0)" ::: "memory")
__device__ __forceinline__ unsigned long long rt() { return __builtin_amdgcn_s_memrealtime(); }
__device__ __forceinline__ unsigned f2bf(float f) { unsigned u = __builtin_bit_cast(unsigned, f); return (u + 0x7fffu + ((u >> 16) & 1u)) >> 16; }
__device__ __forceinline__ unsigned pk2(float lo, float hi) { return f2bf(lo) | (f2bf(hi) << 16); }

#define XB_TMO      128
#define XB_XCNT(j)  (256  + 64 * (j))
#define XB_XSUB(j)  (1280 + 64 * (j))
#define XB_XGEN(j)  (2304 + 64 * (j))
#define XB_TOP      3328
#define XB_TOPGEN   3392
#define XCD_BAR_WORDS 3456
#define XB_SPIN_CAP (1u << 22)

__device__ __forceinline__ unsigned xb_ld(unsigned* p)              { return __hip_atomic_load(p, __ATOMIC_RELAXED, __HIP_MEMORY_SCOPE_AGENT); }
__device__ __forceinline__ unsigned xb_add(unsigned* p, unsigned v) { return __hip_atomic_fetch_add(p, v, __ATOMIC_RELAXED, __HIP_MEMORY_SCOPE_AGENT); }
__device__ __forceinline__ unsigned xb_xcc_id() { return (unsigned)__builtin_amdgcn_s_getreg((3 << 11) | 20) & 0xFu; }
#define XB_SPIN(cond, bar) do { unsigned _sp = 0; while (cond) { __builtin_amdgcn_s_sleep(1); \
    if ((++_sp & 255u) == 0u) { if (xb_ld(&(bar)[XB_TMO])) break; if (_sp > XB_SPIN_CAP) { atomicAdd(&(bar)[XB_TMO], 1u); break; } } } } while (0)

struct XcdBarrier {
    unsigned* bar; unsigned x;
    volatile LAS unsigned* st;
};

__device__ __forceinline__ XcdBarrier xcd_barrier_post(unsigned* bar, volatile LAS unsigned* st) {
    XcdBarrier b; b.bar = bar; b.x = xb_xcc_id(); b.st = st;
    if (threadIdx.x == 0) (void)xb_add(&bar[XB_XCNT(b.x)], 1u);
    return b;
}
__device__ __forceinline__ void xcd_barrier_complete(unsigned* bar, unsigned x, unsigned& nloc, unsigned& nx) {
    const unsigned G = gridDim.x * gridDim.y * gridDim.z;
    unsigned sum, cnt, mine, sp = 0u;
    for (;;) {
        sum = 0u; cnt = 0u; mine = 0u;
#pragma unroll
        for (unsigned j = 0; j < 16; ++j) { const unsigned c = xb_ld(&bar[XB_XCNT(j)]); sum += c; cnt += (c > 0u) ? 1u : 0u; mine = (j == x) ? c : mine; }
        if (sum == G) break;
        __builtin_amdgcn_s_sleep(1);
        if ((++sp & 255u) == 0u) { if (xb_ld(&bar[XB_TMO])) break; if (sp > XB_SPIN_CAP) { atomicAdd(&bar[XB_TMO], 1u); break; } }
    }
    nloc = mine > 0u ? mine : 1u; nx = cnt > 0u ? cnt : 1u;
}

__device__ __forceinline__ void xcd_barrier(const XcdBarrier& b) {
    asm volatile("s_waitcnt vmcnt(0)" ::: "memory");
    __syncthreads();
    if (threadIdx.x == 0) {
        unsigned* bar = b.bar;
        __builtin_amdgcn_s_waitcnt(0);
        unsigned nloc = b.st[0], nx = b.st[1];
        if (nloc == 0u) { xcd_barrier_complete(bar, b.x, nloc, nx); b.st[0] = nloc; b.st[1] = nx; }
        const unsigned old = xb_add(&bar[XB_XSUB(b.x)], 1u);
        const unsigned gen = old / nloc;
        if (old + 1u == (gen + 1u) * nloc) {
            __builtin_amdgcn_fence(__ATOMIC_RELEASE, "agent");
            asm volatile("s_waitcnt vmcnt(0)" ::: "memory");
            const unsigned og = xb_add(&bar[XB_TOP], 1u);
            const unsigned tg = og / nx;
            if (og + 1u == (tg + 1u) * nx) xb_add(&bar[XB_TOPGEN], 1u);
            else XB_SPIN(xb_ld(&bar[XB_TOPGEN]) == tg, bar);
            __builtin_amdgcn_fence(__ATOMIC_ACQUIRE, "agent");
            xb_add(&bar[XB_XGEN(b.x)], 1u);
            asm volatile("s_waitcnt vmcnt(0)" ::: "memory");
        } else {
            XB_SPIN(xb_ld(&bar[XB_XGEN(b.x)]) == gen, bar);
            __builtin_amdgcn_fence(__ATOMIC_ACQUIRE, "agent");
            asm volatile("s_waitcnt vmcnt(0)" ::: "memory");
        }
    }
    __syncthreads();
}

constexpr int NWAVES = 8;
constexpr int D = 1024, BATCH = 4, SEQ = 8192, DEPTH = 4, CTX = 256, NTOK = CTX + SEQ  , M = BATCH * NTOK  ;
constexpr int DIN = 6912;
constexpr int C_AQ = 0, C_AK = 512, C_AV = 640, C_BQ = 768, C_BK = 1280, C_BV = 1792, C_CQ = 2304, C_CK = 2816, C_CV = 3328, C_G = 3840;
constexpr int FF = 2816, NE = 8, FE = 3584;
constexpr int OPITCH = 2048, O_A = 0, O_B1 = 512, O_B2 = 1024, O_C = 1536;
constexpr int SMAX = 69632;
constexpr float EPS = 1e-6f;
constexpr float LOG2E = 1.4426950408889634f;
constexpr int PANELS_PER_B = NTOK / 256;
constexpr size_t QKV_BLK = (size_t)M * 64;
constexpr size_t WS_G_OFF = (size_t)248 << 20;
static_assert(attn_body::QKP == 64 && attn_body::OPITCH == OPITCH && attn_body::QKV_BLK == (long)QKV_BLK && 60 * QKV_BLK * 2 <= WS_G_OFF, "attention body pitches");
#ifndef CFG_ATT8
#define CFG_ATT8 1
#endif
constexpr bool ATT8 = CFG_ATT8;
__device__ __forceinline__ size_t q8_blk(int col) { const int b = col >> 6; return (size_t)(b < 10 ? b : b < 28 ? b - 2 : b - 10) * QKV_BLK; }
__device__ __forceinline__ size_t qkv_blk(int col) { return (size_t)(col >> 6) * QKV_BLK; }
enum { I_X = 0, I_C, I_CTX, I_CCTX, I_WMOD, I_BMOD, I_GMIX, I_GFFN, I_WIN, I_QNA, I_KNA, I_LQ1, I_LK1, I_LQ2, I_LK2, I_SUBLN, I_RPB, I_WBRA, I_WBRB, I_WBRC, I_WOUT,
       I_FW1, I_FW3, I_FW2, I_ROUTER, I_MW1, I_MW3, I_MW2, I_GFINAL, N_IN };

constexpr size_t MiB = 1u << 20;
constexpr size_t WS_CTL = 0, CTL_ZERO_BYTES = 1 * MiB;
constexpr size_t WS_MOD = 1 * MiB;
constexpr size_t WS_ROPE = 1 * MiB + 512 * 1024;
constexpr size_t WS_TOK = 2 * MiB;
constexpr size_t WS_WBASE = 3 * MiB + 512 * 1024;
constexpr size_t WS_XC = 4 * MiB;
constexpr size_t WS_W = 8 * MiB;
constexpr size_t WS_WIN = WS_W, WS_WBR = WS_W + 14 * MiB, WS_WOUT = WS_W + 17 * MiB, WS_W13 = WS_W + 19 * MiB, WS_W2 = WS_W + 131 * MiB;
constexpr size_t WS_XN = 196 * MiB;
constexpr size_t WS_MB = 262 * MiB;
constexpr size_t WS_P = 398 * MiB;
constexpr size_t WS_O = 844 * MiB;
constexpr size_t WS_YS = 874 * MiB;
#ifndef CFG_TAIL
#define CFG_TAIL 0
#endif
constexpr bool TAIL_SPLIT = CFG_TAIL;
constexpr size_t WS_PART = WS_MB + 64 * MiB;
constexpr size_t WS_XB = 1010 * MiB;
constexpr size_t WS_END = 1076 * MiB;
constexpr size_t WS_Q8 = WS_MB + 34 * MiB;
static_assert(WS_Q8 + (size_t)42 * M * 64 <= WS_P, "fp8 q/k blocks");
static_assert(WS_W2 + (size_t)NE * D * FE * 2 <= WS_XN && WS_XN + (size_t)M * D * 2 <= WS_MB && WS_MB + (size_t)SMAX * D * 2 <= WS_P && WS_MB + (size_t)M * D * 4 <= WS_P, "ws map 1");
static_assert(WS_P + WS_G_OFF + (size_t)M * 3072 * 2 <= WS_O && WS_O + (size_t)M * OPITCH * 2 <= WS_END && WS_P + (size_t)SMAX * FE * 2 <= WS_YS && WS_YS + (size_t)SMAX * D * 2 <= WS_XB && WS_XB + (size_t)M * D * 2 <= WS_END, "ws map 2");
static_assert(WS_PART + (size_t)256 * 65536 * 4 <= WS_P, "ws map 4");
static_assert(WS_W13 + (size_t)NE * 2 * FE * D * 2 <= WS_W2 && WS_WIN + (size_t)DIN * D * 2 <= WS_WBR, "ws map 3");
constexpr int CW_BAR = 4096;
constexpr int CW_CNT = 8192;
constexpr int CW_QK = 12288;
static_assert((CW_CNT + 2 * 8 * 64) * 4 <= (int)CTL_ZERO_BYTES && CW_CNT + 2 * 8 * 64 <= CW_QK && (CW_QK + DEPTH * 8 * 64) * 4 <= (int)CTL_ZERO_BYTES, "CTL words inside the memset region");

constexpr int RING_OFF = 0, RING_BYTES = 131072;
constexpr int LDSCTL_OFF = RING_BYTES, MISC_OFF = LDSCTL_OFF + 320;
constexpr int LDS_BYTES = 147456;
constexpr int BIAS_OFF = LDSCTL_OFF + 1024;
static_assert(attn_body::ATTN_LDS_BYTES <= RING_BYTES && attn_body::ATTN_FS_LDS_BYTES <= RING_BYTES && attn_body::ATTN_FS2_LDS_BYTES <= RING_BYTES && attn_body::ATTN_FS8_LDS_BYTES <= RING_BYTES && attn_body::ATTN_FS8P_LDS_BYTES <= RING_BYTES && attn_body::ATTN_FS8Q_LDS_BYTES <= RING_BYTES && BIAS_OFF + 8 * 465 * 4 <= LDS_BYTES, "LDS map");

typedef unsigned u32x2 __attribute__((ext_vector_type(2)));
typedef float f32x2v __attribute__((ext_vector_type(2)));
struct Args { const float* in[N_IN]; float* out; unsigned char* ws; };
typedef const __attribute__((address_space(4))) Args* CArgsP;
struct Frame {
    LAS unsigned char* lds;
    int tid, lane, wave, vcu, G;
};
#define REFRESH(F) do { int t_ = threadIdx.x; asm volatile("; LAUNDER" : "+v"(t_)); (F).tid = t_; (F).lane = t_ & 63; (F).wave = __builtin_amdgcn_readfirstlane(t_ >> 6); } while (0)
__device__ __forceinline__ CArgsP fresh_args() { CArgsP p = (CArgsP)__builtin_amdgcn_kernarg_segment_ptr(); asm volatile("; LAUNDER_S" : "+s"(p)); return p; }

__device__ __forceinline__ float wave_sum(float v) {
#pragma unroll
    for (int o = 1; o < 64; o <<= 1) v += __shfl_xor(v, o);
    return v;
}
__device__ __forceinline__ unsigned cvtpk(float lo, float hi) { return pg8::cvt_pk_bf16(lo, hi); }
__device__ __forceinline__ float bf_lo(unsigned w) { return __uint_as_float(w << 16); }
__device__ __forceinline__ float bf_hi(unsigned w) { return __uint_as_float(w & 0xffff0000u); }
#ifndef CFG_SAT8
#define CFG_SAT8 1
#endif
#ifndef PROBE_SAT
#define PROBE_SAT 0
#endif
__device__ __forceinline__ unsigned pk4_fp8(float a, float b, float c, float d) {
#if !CFG_SAT8
    a = __builtin_amdgcn_fmed3f(a, -448.f, 448.f); b = __builtin_amdgcn_fmed3f(b, -448.f, 448.f); c = __builtin_amdgcn_fmed3f(c, -448.f, 448.f); d = __builtin_amdgcn_fmed3f(d, -448.f, 448.f);
#endif
    int w = __builtin_amdgcn_cvt_pk_fp8_f32(a, b, 0, false); w = __builtin_amdgcn_cvt_pk_fp8_f32(c, d, w, true); return (unsigned)w; }
#ifndef CFG_DENSE8
#define CFG_DENSE8 0
#endif
#ifndef CFG_MOEDOWN8
#define CFG_MOEDOWN8 1
#endif
#ifndef CFG_INPROJ8
#define CFG_INPROJ8 1
#endif
constexpr bool DENSE8 = CFG_DENSE8, MOEDOWN8 = CFG_MOEDOWN8;
#ifndef CFG_AQK8
#define CFG_AQK8 0
#endif
constexpr bool AQK8 = CFG_AQK8 && CFG_ATT8; constexpr float AQK_SCALE = 8.0f;
#ifndef CFG_GATEE
#define CFG_GATEE 1
#endif
#ifndef CFG_YS8
#define CFG_YS8 1
#endif
constexpr bool YS8 = CFG_YS8; constexpr float YS_SCALE = 16.0f;
#ifndef CFG_GATE8
#define CFG_GATE8 1
#endif
constexpr bool GATE8 = CFG_GATE8;
constexpr int INPROJ8 = CFG_INPROJ8;
constexpr int IN8_TILES = INPROJ8 == 1 ? 27 : INPROJ8 == 2 ? 12 : INPROJ8 == 3 ? 16 : INPROJ8 == 4 ? 23 : 0;
constexpr size_t WS_WIN8 = WS_W + 83 * MiB;
__device__ __forceinline__ int in8_tile(int p) { return INPROJ8 == 1 ? p : INPROJ8 == 2 ? 15 + p : INPROJ8 == 4 ? (p < 7 ? p : p < 11 ? p + 2 : p + 4) : (p < 2 ? 7 + p : p < 4 ? 11 + p : 11 + p); }
__device__ __forceinline__ int in16_tile(int p) { return INPROJ8 == 3 ? (p < 7 ? p : p + 2) : INPROJ8 == 4 ? (p < 2 ? 7 + p : 11 + p) : p; }
typedef float f32x2p __attribute__((ext_vector_type(2)));
__device__ __forceinline__ void load_gates8(const bf16* Gp, size_t idx, float (&gl)[8]) {
    if constexpr (GATE8) { const u32x2 w = *(const GAS u32x2*)((const unsigned char*)Gp + idx);
        const f32x2p a = __builtin_amdgcn_cvt_pk_f32_fp8((int)w.x, false), b = __builtin_amdgcn_cvt_pk_f32_fp8((int)w.x, true), c = __builtin_amdgcn_cvt_pk_f32_fp8((int)w.y, false), d = __builtin_amdgcn_cvt_pk_f32_fp8((int)w.y, true);
        gl[0] = a.x; gl[1] = a.y; gl[2] = b.x; gl[3] = b.y; gl[4] = c.x; gl[5] = c.y; gl[6] = d.x; gl[7] = d.y; }
    else { const v4u w = *(const GAS v4u*)(Gp + idx);
        gl[0] = bf_lo(w.x); gl[1] = bf_hi(w.x); gl[2] = bf_lo(w.y); gl[3] = bf_hi(w.y); gl[4] = bf_lo(w.z); gl[5] = bf_hi(w.z); gl[6] = bf_lo(w.w); gl[7] = bf_hi(w.w); }
}
constexpr float WSC = 64.f, WSCI = 1.0f / 64.f;
constexpr float GATE_YMAX = 66.0f;
__device__ __forceinline__ float sigmoidf_(float x) { return __builtin_amdgcn_rcpf(1.0f + __builtin_amdgcn_exp2f(-x * LOG2E)); }

#define NT_LOAD(p) __builtin_nontemporal_load(p)
__device__ __forceinline__ void tr_item(const float* W, int K, int N, bf16* WT, int base, int il, LAS float* scr, int item, int lane) {
    const int nblk = N / 32, kb = item / nblk, nb = item % nblk, k0 = 64 * kb, n0 = 32 * nb;
#pragma unroll 8
    for (int i = 0; i < 32; ++i) { const int kk = 2 * i + (lane >> 5); scr[kk * 33 + (lane & 31)] = NT_LOAD(&W[(size_t)(k0 + kk) * N + n0 + (lane & 31)]); }
    LDS_WAIT(); asm volatile("" ::: "memory");
    const int c = lane & 7;
#pragma unroll
    for (int j = 0; j < 4; ++j) { const int n = (lane >> 3) + 8 * j; const LAS float* s = scr + (8 * c) * 33 + n;
        v4u o; o.x = cvtpk(s[0 * 33], s[1 * 33]); o.y = cvtpk(s[2 * 33], s[3 * 33]); o.z = cvtpk(s[4 * 33], s[5 * 33]); o.w = cvtpk(s[6 * 33], s[7 * 33]);
        const int ng = n0 + n, drow = base + (il ? (256 * (ng >> 7) + (ng & 127)) : ng);
        *(GAS v4u*)(WT + (size_t)drow * K + k0 + 8 * c) = o; }
    LDS_WAIT(); asm volatile("" ::: "memory");
}
__device__ __forceinline__ void tr_item_f8(const float* W, int K, int N, unsigned char* WT, int base, int il, LAS float* scr, int item, int lane) {
    const int nblk = N / 32, kb = item / nblk, nb = item % nblk, k0 = 64 * kb, n0 = 32 * nb;
#pragma unroll 8
    for (int i = 0; i < 32; ++i) { const int kk = 2 * i + (lane >> 5); scr[kk * 33 + (lane & 31)] = NT_LOAD(&W[(size_t)(k0 + kk) * N + n0 + (lane & 31)]) * WSC; }
    LDS_WAIT(); asm volatile("" ::: "memory");
    const int c = lane & 3;
#pragma unroll
    for (int j = 0; j < 2; ++j) { const int n = (lane >> 2) + 16 * j; const LAS float* s = scr + (16 * c) * 33 + n;
        v4u o; o.x = pk4_fp8(s[0 * 33], s[1 * 33], s[2 * 33], s[3 * 33]); o.y = pk4_fp8(s[4 * 33], s[5 * 33], s[6 * 33], s[7 * 33]);
        o.z = pk4_fp8(s[8 * 33], s[9 * 33], s[10 * 33], s[11 * 33]); o.w = pk4_fp8(s[12 * 33], s[13 * 33], s[14 * 33], s[15 * 33]);
        const int ng = n0 + n, drow = base + (il ? (256 * (ng >> 7) + (ng & 127)) : ng);
        *(GAS v4u*)(WT + (size_t)drow * K + k0 + 16 * c) = o; }
    LDS_WAIT(); asm volatile("" ::: "memory");
}
__device__ __forceinline__ void convert_weights(Frame& F, CArgsP AP, int l) {
    LAS float* scr = (LAS float*)(F.lds + RING_OFF + F.wave * 16384);
    const int gw = F.vcu * NWAVES + F.wave, NGW = F.G * NWAVES;
    bf16* WIN = (bf16*)(AP->ws + WS_WIN); bf16* WBR = (bf16*)(AP->ws + WS_WBR); bf16* WOUT = (bf16*)(AP->ws + WS_WOUT); unsigned char* W13 = AP->ws + WS_W13; unsigned char* W2 = AP->ws + WS_W2;
    constexpr int I_IN = (D / 64) * (DIN / 32), I_BR = (512 / 64) * (D / 32), I_OUT = (D / 64) * (D / 32);
    constexpr int I_F1 = (D / 64) * (FF / 32), I_F2 = (FF / 64) * (D / 32), I_M1 = (D / 64) * (FE / 32), I_M2 = (FE / 64) * (D / 32);
    const int i2 = l >> 1;
    const int nbase = I_IN + 3 * I_BR + I_OUT;
    const int nitems = nbase + ((l & 1) ? NE * (2 * I_M1 + I_M2) : (2 * I_F1 + I_F2));
    for (int it = gw; it < nitems; it += NGW) {
        int r = it;
        if (r < I_IN) { if constexpr (INPROJ8 != 1) tr_item(AP->in[I_WIN] + (size_t)l * D * DIN, D, DIN, WIN, 0, 0, scr, r, F.lane);
            if constexpr (INPROJ8 != 0) tr_item_f8(AP->in[I_WIN] + (size_t)l * D * DIN, D, DIN, AP->ws + WS_WIN8, 0, 0, scr, r, F.lane); continue; } r -= I_IN;
        if (r < 3 * I_BR) { const int x = r / I_BR; r -= x * I_BR; const float* src = (x == 0 ? AP->in[I_WBRA] : x == 1 ? AP->in[I_WBRB] : AP->in[I_WBRC]) + (size_t)l * 512 * D;
            tr_item(src, 512, D, WBR + (size_t)x * D * 512, 0, 0, scr, r, F.lane); continue; } r -= 3 * I_BR;
        if (r < I_OUT) { tr_item(AP->in[I_WOUT] + (size_t)l * D * D, D, D, WOUT, 0, 0, scr, r, F.lane); continue; } r -= I_OUT;
        if (!(l & 1)) {
            if (r < I_F1) { if constexpr (DENSE8) tr_item_f8(AP->in[I_FW1] + (size_t)i2 * D * FF, D, FF, W13, 0, 1, scr, r, F.lane); else tr_item(AP->in[I_FW1] + (size_t)i2 * D * FF, D, FF, (bf16*)W13, 0, 1, scr, r, F.lane); continue; } r -= I_F1;
            if (r < I_F1) { if constexpr (DENSE8) tr_item_f8(AP->in[I_FW3] + (size_t)i2 * D * FF, D, FF, W13, 128, 1, scr, r, F.lane); else tr_item(AP->in[I_FW3] + (size_t)i2 * D * FF, D, FF, (bf16*)W13, 128, 1, scr, r, F.lane); continue; } r -= I_F1;
            if constexpr (DENSE8) tr_item_f8(AP->in[I_FW2] + (size_t)i2 * FF * D, FF, D, W2, 0, 0, scr, r, F.lane); else tr_item(AP->in[I_FW2] + (size_t)i2 * FF * D, FF, D, (bf16*)W2, 0, 0, scr, r, F.lane);
        } else {
            const int per = 2 * I_M1 + I_M2, e = r / per; r -= e * per; const size_t eo = (size_t)(i2 * NE + e);
            if (r < I_M1) { tr_item_f8(AP->in[I_MW1] + eo * D * FE, D, FE, W13 + (size_t)e * 2 * FE * D, 0, 1, scr, r, F.lane); continue; } r -= I_M1;
            if (r < I_M1) { tr_item_f8(AP->in[I_MW3] + eo * D * FE, D, FE, W13 + (size_t)e * 2 * FE * D, 128, 1, scr, r, F.lane); continue; } r -= I_M1;
            if constexpr (MOEDOWN8) tr_item_f8(AP->in[I_MW2] + eo * FE * D, FE, D, W2 + (size_t)e * D * FE, 0, 0, scr, r, F.lane); else tr_item(AP->in[I_MW2] + eo * FE * D, FE, D, (bf16*)W2 + (size_t)e * D * FE, 0, 0, scr, r, F.lane);
        }
    }
}

__device__ __forceinline__ void prologue_mod(Frame& F, CArgsP AP) {
    LAS float* sv = (LAS float*)(F.lds + RING_OFF);
    LAS float* red = sv + 5 * 1024;
    for (int i = F.tid; i < 5 * 1024; i += NWAVES * 64) { const int j = i >> 10, k = i & 1023; const float v = j < 4 ? AP->in[I_C][j * 1024 + k] : AP->in[I_CCTX][k]; sv[i] = v * sigmoidf_(v); }
    __syncthreads();
    float* MOD = (float*)(AP->ws + WS_MOD);
    for (int it = blockIdx.x; it < DEPTH * 96; it += F.G) {
        const int l = it / 96, cb = it % 96, col = cb * 64 + F.lane;
        const float* wp = AP->in[I_WMOD] + ((size_t)l * D + F.wave * 128) * 6144 + col;
        const LAS float* s = sv + F.wave * 128;
        float a0 = 0.f, a1 = 0.f, a2 = 0.f, a3 = 0.f, a4 = 0.f;
#pragma unroll 8
        for (int k = 0; k < 128; ++k) { const float w = NT_LOAD(&wp[(size_t)k * 6144]); a0 += s[k] * w; a1 += s[1024 + k] * w; a2 += s[2048 + k] * w; a3 += s[3072 + k] * w; a4 += s[4096 + k] * w; }
        LAS float* rr = red + F.wave * 320 + F.lane;
        rr[0] = a0; rr[64] = a1; rr[128] = a2; rr[192] = a3; rr[256] = a4;
        __syncthreads();
        if (F.tid < 320) { const int j = F.tid >> 6, ln = F.tid & 63; float sacc = 0.f;
#pragma unroll
            for (int w = 0; w < 8; ++w) sacc += red[w * 320 + j * 64 + ln];
            MOD[(size_t)(l * 5 + j) * 6144 + cb * 64 + ln] = sacc + AP->in[I_BMOD][l * 6144 + cb * 64 + ln]; }
        __syncthreads();
    }
    if (blockIdx.x == 0) {
        float* RT = (float*)(AP->ws + WS_ROPE);
        for (int i = F.tid; i < 128 * 16; i += NWAVES * 64) {
            const int pos = i >> 4, j = i & 15;
            double inv = 1.0; for (int q = 0; q < j; ++q) inv *= 0.56234132519034908;
            const float invf = (float)inv; const float angf = (float)pos * invf;
            double a = (double)angf; const double TWO_PI = 6.283185307179586476925;
            const double nrev = __builtin_floor(a / TWO_PI + 0.5); a -= nrev * TWO_PI;
            const double a2 = a * a; double cs = 1.0, sn = a, tc = 1.0, ts = a;
            for (int q = 1; q < 16; ++q) { tc *= -a2 / (double)((2 * q - 1) * (2 * q)); ts *= -a2 / (double)((2 * q) * (2 * q + 1)); cs += tc; sn += ts; }
            RT[2 * i] = (float)cs; RT[2 * i + 1] = (float)sn;
        }
    }
}

struct RowRef { int b, n, bsel; bool isctx; };
__device__ __forceinline__ RowRef row_ref(int row) { RowRef r; r.b = row / NTOK; r.n = row - r.b * NTOK; r.isctx = r.n < CTX; r.bsel = r.isctx ? 4 : r.b; return r; }
__device__ __forceinline__ bf16* row_xb(CArgsP AP, int row) { return (bf16*)(AP->ws + WS_XB) + (size_t)row * D; }
__device__ __forceinline__ void load_row_xb(const bf16* p, int lane, u32x2 (&raw)[4]) {
#pragma unroll
    for (int j = 0; j < 4; ++j) raw[j] = *(const GAS u32x2*)(p + 256 * j + 4 * lane);
}
__device__ __forceinline__ void unpack_row(const u32x2 (&raw)[4], f32x4 (&v)[4]) {
#pragma unroll
    for (int j = 0; j < 4; ++j) v[j] = (f32x4){bf_lo(raw[j].x), bf_hi(raw[j].x), bf_lo(raw[j].y), bf_hi(raw[j].y)};
}
__device__ __forceinline__ void load_row(const float* p, int lane, f32x4 (&v)[4]) {
#pragma unroll
    for (int j = 0; j < 4; ++j) v[j] = *(const GAS f32x4*)(p + 256 * j + 4 * lane);
}
__device__ __forceinline__ void store_row(float* p, int lane, const f32x4 (&v)[4]) {
#pragma unroll
    for (int j = 0; j < 4; ++j) *(GAS f32x4*)(p + 256 * j + 4 * lane) = v[j];
}
__device__ __forceinline__ void moe_combine(Frame& F, CArgsP AP, int row, const RowRef& r, int lp, f32x4 (&v)[4]) {
    const unsigned* info = (const unsigned*)(AP->ws + WS_TOK) + (size_t)row * 8;
    const float w0 = __uint_as_float(info[4]), w1 = __uint_as_float(info[5]); const unsigned s0 = info[6], s1 = info[7];
    const bf16* Y = (const bf16*)(AP->ws + WS_YS);
    const float* gate = (const float*)(AP->ws + WS_MOD) + (size_t)(lp * 5 + r.bsel) * 6144 + 5 * 1024;
#pragma unroll
    for (int j = 0; j < 4; ++j) {
        const u32x2 y0 = *(const GAS u32x2*)(Y + (size_t)s0 * D + 256 * j + 4 * F.lane), y1 = *(const GAS u32x2*)(Y + (size_t)s1 * D + 256 * j + 4 * F.lane);
        const f32x4 g = *(const GAS f32x4*)(gate + 256 * j + 4 * F.lane);
        v[j].x += g.x * (w0 * bf_lo(y0.x) + w1 * bf_lo(y1.x)); v[j].y += g.y * (w0 * bf_hi(y0.x) + w1 * bf_hi(y1.x));
        v[j].z += g.z * (w0 * bf_lo(y0.y) + w1 * bf_lo(y1.y)); v[j].w += g.w * (w0 * bf_hi(y0.y) + w1 * bf_hi(y1.y));
    }
}
__device__ __forceinline__ void comb_info(CArgsP AP, int row, float& w0, float& w1, unsigned& s0, unsigned& s1) {
    const v4u q = *(const GAS v4u*)((const unsigned*)(AP->ws + WS_TOK) + (size_t)row * 8 + 4); w0 = __uint_as_float(q.x); w1 = __uint_as_float(q.y); s0 = q.z; s1 = q.w; }
__device__ __forceinline__ void comb_rows(CArgsP AP, unsigned s0, unsigned s1, int lane, u32x2 (&y0)[4], u32x2 (&y1)[4]) {
    if constexpr (YS8) { const unsigned char* Y8 = AP->ws + WS_YS;
#pragma unroll
        for (int j = 0; j < 4; ++j) { y0[j] = (u32x2){*(const GAS unsigned*)(Y8 + (size_t)s0 * D + 256 * j + 4 * lane), 0u}; y1[j] = (u32x2){*(const GAS unsigned*)(Y8 + (size_t)s1 * D + 256 * j + 4 * lane), 0u}; } }
    else { const bf16* Y = (const bf16*)(AP->ws + WS_YS);
#pragma unroll
    for (int j = 0; j < 4; ++j) { y0[j] = *(const GAS u32x2*)(Y + (size_t)s0 * D + 256 * j + 4 * lane); y1[j] = *(const GAS u32x2*)(Y + (size_t)s1 * D + 256 * j + 4 * lane); } } }
__device__ __forceinline__ void comb_apply(CArgsP AP, const RowRef& r, int lp, int lane, float w0, float w1, const u32x2 (&y0)[4], const u32x2 (&y1)[4], f32x4 (&v)[4]) {
    const float* gate = (const float*)(AP->ws + WS_MOD) + (size_t)(lp * 5 + r.bsel) * 6144 + 5 * 1024;
#pragma unroll
    for (int j = 0; j < 4; ++j) {
        const f32x4 g = *(const GAS f32x4*)(gate + 256 * j + 4 * lane);
        if constexpr (YS8) { const f32x2p a0 = __builtin_amdgcn_cvt_pk_f32_fp8((int)y0[j].x, false), a1 = __builtin_amdgcn_cvt_pk_f32_fp8((int)y0[j].x, true), b0 = __builtin_amdgcn_cvt_pk_f32_fp8((int)y1[j].x, false), b1 = __builtin_amdgcn_cvt_pk_f32_fp8((int)y1[j].x, true);
            const float u0 = w0 * (1.0f / YS_SCALE), u1 = w1 * (1.0f / YS_SCALE);
            v[j].x += g.x * (u0 * a0.x + u1 * b0.x); v[j].y += g.y * (u0 * a0.y + u1 * b0.y); v[j].z += g.z * (u0 * a1.x + u1 * b1.x); v[j].w += g.w * (u0 * a1.y + u1 * b1.y); }
        else {
        v[j].x += g.x * (w0 * bf_lo(y0[j].x) + w1 * bf_lo(y1[j].x)); v[j].y += g.y * (w0 * bf_hi(y0[j].x) + w1 * bf_hi(y1[j].x));
        v[j].z += g.z * (w0 * bf_lo(y0[j].y) + w1 * bf_lo(y1[j].y)); v[j].w += g.w * (w0 * bf_hi(y0[j].y) + w1 * bf_hi(y1[j].y)); }
    }
}
__device__ __forceinline__ float row_rstd(const f32x4 (&v)[4]) {
    float s = 0.f;
#pragma unroll
    for (int j = 0; j < 4; ++j) s += (v[j].x * v[j].x + v[j].y * v[j].y) + (v[j].z * v[j].z + v[j].w * v[j].w);
    return 1.0f / sqrtf(wave_sum(s) * (1.0f / D) + EPS);
}
__device__ __forceinline__ void norm_mod(const f32x4 (&v)[4], float rstd, const float* g, const float* shift, const float* scale, int lane, f32x4 (&y)[4]) {
#pragma unroll
    for (int j = 0; j < 4; ++j) {
        const f32x4 gg = *(const GAS f32x4*)(g + 256 * j + 4 * lane), sh = *(const GAS f32x4*)(shift + 256 * j + 4 * lane), sc = *(const GAS f32x4*)(scale + 256 * j + 4 * lane);
        y[j] = (v[j] * rstd) * gg * (sc + 1.0f) + sh;
    }
}
__device__ __forceinline__ void store_row_bf16(bf16* p, int lane, const f32x4 (&y)[4]) {
#pragma unroll
    for (int j = 0; j < 4; ++j) { u32x2 o; o.x = cvtpk(y[j].x, y[j].y); o.y = cvtpk(y[j].z, y[j].w); *(GAS u32x2*)(p + 256 * j + 4 * lane) = o; }
}

struct TailTab { const float* part; int npz; LAS unsigned char* lt; };
__device__ __forceinline__ TailTab tail_setup(Frame& F, CArgsP AP, int nt_k, LAS unsigned char* lt) {
    pg8::TileOrder T; T.init(M / 256, D / 256, F.G, 0);
    const int nfull = T.nwg / T.G, R = T.nwg - nfull * T.G, P = nt_k >> 1; int npz = R ? T.G / R : 1; npz = npz < P ? npz : P;
    __syncthreads();
    for (int i = F.tid; i < (M / 256) * 4; i += NWAVES * 64) lt[i] = 0;
    __syncthreads();
    if (F.tid < R) { int pm, pn; if (T.tile_at((long)nfull * T.G + F.tid, pm, pn)) lt[pm * 4 + pn] = (unsigned char)(F.tid + 1); }
    __syncthreads();
    TailTab t; t.part = (const float*)(AP->ws + WS_PART); t.npz = npz; t.lt = lt; return t;
}
__device__ __forceinline__ bool tail_add(const TailTab& t, int row, int lane, const float* gate, float sc, f32x4 (&v)[4]) {
    const int pm = row >> 8, rit = row & 255; bool any = false;
#pragma unroll
    for (int jq = 0; jq < 4; ++jq) { const int idx = __builtin_amdgcn_readfirstlane((int)t.lt[pm * 4 + jq]);
        if (idx) { any = true; f32x4 sacc = {0.f, 0.f, 0.f, 0.f}; const float* pp = t.part + ((size_t)(idx - 1) * t.npz * 256 + rit) * 256 + 4 * lane;
            for (int p = 0; p < t.npz; ++p) sacc += *(const GAS f32x4*)(pp + (size_t)p * 65536);
            const f32x4 g4 = *(const GAS f32x4*)(gate + 256 * jq + 4 * lane); v[jq] += g4 * sc * sacc; } }
    return any;
}
__device__ __forceinline__ void phase_norm1(Frame& F, CArgsP AP, int l, bool commit) {
    const int gw = F.vcu * NWAVES + F.wave, NGW = F.G * NWAVES;
    bf16* XN = (bf16*)(AP->ws + WS_XN);
    const float* MOD = (const float*)(AP->ws + WS_MOD);
    const float* g = AP->in[I_GMIX] + l * D;
#define N1_SRC(rr_, row_) ((rr_).isctx ? AP->in[I_CTX] + (size_t)((rr_).b * CTX + (rr_).n) * D : AP->in[I_X] + (size_t)((rr_).b * SEQ + ((rr_).n - CTX)) * D)
    const bool tail = TAIL_SPLIT && (l > 0) && !((l - 1) & 1);
    TailTab tt{}; if (tail) tt = tail_setup(F, AP, DENSE8 ? FF / 128 : FF / 64, (LAS unsigned char*)(F.lds + RING_OFF + 40960));
    f32x4 vnx[4]; u32x2 rnx[4];
#pragma unroll
    for (int j = 0; j < 4; ++j) { vnx[j] = (f32x4){0.f, 0.f, 0.f, 0.f}; rnx[j] = (u32x2){0u, 0u}; }
    if (gw < M) { if (l == 0) { const RowRef r0 = row_ref(gw); load_row(N1_SRC(r0, gw), F.lane, vnx); } else load_row_xb(row_xb(AP, gw), F.lane, rnx); }
    const bool comb = (l > 0) && ((l - 1) & 1);
    float cw0 = 0.f, cw1 = 0.f, nw0 = 0.f, nw1 = 0.f; unsigned ns0 = 0u, ns1 = 0u; u32x2 cy0[4], cy1[4];
#pragma unroll
    for (int j = 0; j < 4; ++j) { cy0[j] = (u32x2){0u, 0u}; cy1[j] = (u32x2){0u, 0u}; }
    if (comb && gw < M) { unsigned s0_, s1_; comb_info(AP, gw, cw0, cw1, s0_, s1_); comb_rows(AP, s0_, s1_, F.lane, cy0, cy1); if (gw + NGW < M) comb_info(AP, gw + NGW, nw0, nw1, ns0, ns1); }
    for (int row = gw; row < M; row += NGW) {
        const RowRef r = row_ref(row); bf16* xr = row_xb(AP, row);
        f32x4 v[4];
        if (l == 0) {
#pragma unroll
            for (int j = 0; j < 4; ++j) v[j] = vnx[j];
        } else unpack_row(rnx, v);
        if (row + NGW < M) { if (l == 0) { const RowRef rn = row_ref(row + NGW); load_row(N1_SRC(rn, row + NGW), F.lane, vnx); } else load_row_xb(row_xb(AP, row + NGW), F.lane, rnx); }
        if (comb) { const float w0_ = cw0, w1_ = cw1; u32x2 a0[4], a1[4];
#pragma unroll
            for (int j = 0; j < 4; ++j) { a0[j] = cy0[j]; a1[j] = cy1[j]; }
            if (row + NGW < M) { cw0 = nw0; cw1 = nw1; comb_rows(AP, ns0, ns1, F.lane, cy0, cy1); if (row + 2 * NGW < M) comb_info(AP, row + 2 * NGW, nw0, nw1, ns0, ns1); }
            comb_apply(AP, r, l - 1, F.lane, w0_, w1_, a0, a1, v); }
        bool tailed = false; if (tail) tailed = tail_add(tt, row, F.lane, MOD + (size_t)((l - 1) * 5 + r.bsel) * 6144 + 5 * 1024, DENSE8 ? WSCI : 1.0f, v);
        if ((l == 0 || comb || tailed) && commit) store_row_bf16(xr, F.lane, v);
        const float rstd = row_rstd(v);
        const float* mv = MOD + (size_t)(l * 5 + r.bsel) * 6144;
        f32x4 y[4]; norm_mod(v, rstd, g, mv + 0 * 1024, mv + 1 * 1024, F.lane, y);
        if constexpr (INPROJ8 != 0) {
#pragma unroll
            for (int j = 0; j < 4; ++j) *(GAS unsigned*)(AP->ws + WS_MB + (size_t)row * D + 256 * j + 4 * F.lane) = pk4_fp8(y[j].x, y[j].y, y[j].z, y[j].w);
        }
        if constexpr (INPROJ8 != 1) store_row_bf16(XN + (size_t)row * D, F.lane, y);
    }
}
__device__ __forceinline__ void phase_norm2(Frame& F, CArgsP AP, int l, bool commit) {
    const int gw = F.vcu * NWAVES + F.wave, NGW = F.G * NWAVES;
    unsigned char* XN8 = AP->ws + WS_XN;
    const float* MOD = (const float*)(AP->ws + WS_MOD);
    const float* g = AP->in[I_GFFN] + l * D;
    const bool moe = (l & 1) && commit;
    const bool moe_layer = (l & 1);
    LAS float* Rt = (LAS float*)(F.lds + RING_OFF);
    if (moe) {
        const float* R = AP->in[I_ROUTER] + (size_t)(l >> 1) * D * NE;
        for (int i = F.tid; i < D * NE; i += NWAVES * 64) Rt[(i & 7) * 1024 + (i >> 3)] = R[i];
        __syncthreads();
    }
    unsigned* cnt = (unsigned*)(AP->ws + WS_CTL) + CW_CNT + (l >> 1) * 8 * 64;
    int lc0 = 0, lc1 = 0, lc2 = 0, lc3 = 0, lc4 = 0, lc5 = 0, lc6 = 0, lc7 = 0;
    const bool tail = TAIL_SPLIT && (l < DEPTH - 1);
    TailTab tt{}; if (tail) tt = tail_setup(F, AP, D / 64, (LAS unsigned char*)(F.lds + RING_OFF + 40960));
    u32x2 rnx[4];
#pragma unroll
    for (int j = 0; j < 4; ++j) rnx[j] = (u32x2){0u, 0u};
    if (gw < M) load_row_xb(row_xb(AP, gw), F.lane, rnx);
    for (int row = gw; row < M; row += NGW) {
        const RowRef r = row_ref(row);
        f32x4 v[4]; unpack_row(rnx, v);
        if (row + NGW < M) load_row_xb(row_xb(AP, row + NGW), F.lane, rnx);
        if (r.isctx && l == DEPTH - 1) continue;
        const float* mv = MOD + (size_t)(l * 5 + r.bsel) * 6144;
        if (tail && tail_add(tt, row, F.lane, mv + 2 * 1024, 1.0f, v) && commit) store_row_bf16(row_xb(AP, row), F.lane, v);
        const float rstd = row_rstd(v);
        f32x4 y[4]; norm_mod(v, rstd, g, mv + 3 * 1024, mv + 4 * 1024, F.lane, y);
        if (moe_layer || DENSE8) {
#pragma unroll
            for (int j = 0; j < 4; ++j) *(GAS unsigned*)(XN8 + (size_t)row * D + 256 * j + 4 * F.lane) = pk4_fp8(y[j].x, y[j].y, y[j].z, y[j].w);
        } else store_row_bf16((bf16*)XN8 + (size_t)row * D, F.lane, y);
        if (moe) {
            float lg[8];
#pragma unroll
            for (int e = 0; e < 8; ++e) { float s = 0.f;
#pragma unroll
                for (int j = 0; j < 4; ++j) { const f32x4 w = *(const LAS f32x4*)(Rt + e * 1024 + 256 * j + 4 * F.lane); s += (y[j].x * w.x + y[j].y * w.y) + (y[j].z * w.z + y[j].w * w.w); }
                lg[e] = wave_sum(s); }
            int e0 = 0; float v0 = lg[0];
#pragma unroll
            for (int e = 1; e < 8; ++e) if (lg[e] > v0) { v0 = lg[e]; e0 = e; }
            int e1 = -1; float v1 = -INFINITY;
#pragma unroll
            for (int e = 0; e < 8; ++e) if (e != e0 && lg[e] > v1) { v1 = lg[e]; e1 = e; }
            const float ex = __expf(v1 - v0), w0 = 1.0f / (1.0f + ex), w1 = ex * w0;
            const int s0 = __builtin_amdgcn_readfirstlane(e0), s1 = __builtin_amdgcn_readfirstlane(e1);
            const int p0 = (s0 == 0 ? lc0 : 0) + (s0 == 1 ? lc1 : 0) + (s0 == 2 ? lc2 : 0) + (s0 == 3 ? lc3 : 0) + (s0 == 4 ? lc4 : 0) + (s0 == 5 ? lc5 : 0) + (s0 == 6 ? lc6 : 0) + (s0 == 7 ? lc7 : 0);
            const int p1 = (s1 == 0 ? lc0 : 0) + (s1 == 1 ? lc1 : 0) + (s1 == 2 ? lc2 : 0) + (s1 == 3 ? lc3 : 0) + (s1 == 4 ? lc4 : 0) + (s1 == 5 ? lc5 : 0) + (s1 == 6 ? lc6 : 0) + (s1 == 7 ? lc7 : 0);
            lc0 += (s0 == 0) + (s1 == 0); lc1 += (s0 == 1) + (s1 == 1); lc2 += (s0 == 2) + (s1 == 2); lc3 += (s0 == 3) + (s1 == 3);
            lc4 += (s0 == 4) + (s1 == 4); lc5 += (s0 == 5) + (s1 == 5); lc6 += (s0 == 6) + (s1 == 6); lc7 += (s0 == 7) + (s1 == 7);
            if (F.lane == 0) {
                unsigned* info = (unsigned*)(AP->ws + WS_TOK) + (size_t)row * 8;
                info[0] = (unsigned)s0; info[1] = (unsigned)s1; info[2] = (unsigned)p0; info[3] = (unsigned)p1; info[4] = __float_as_uint(w0); info[5] = __float_as_uint(w1);
            }
        }
    }
    if (moe) {
        const int mine = F.lane == 0 ? lc0 : F.lane == 1 ? lc1 : F.lane == 2 ? lc2 : F.lane == 3 ? lc3 : F.lane == 4 ? lc4 : F.lane == 5 ? lc5 : F.lane == 6 ? lc6 : lc7;
        if (F.lane < 8) { const unsigned base = __hip_atomic_fetch_add(cnt + F.lane * 64, (unsigned)mine, RLX_AGENT); ((unsigned*)(AP->ws + WS_WBASE))[(size_t)gw * 8 + F.lane] = base; }
    }
}
struct MoeOff { int off[9]; int cnt[8]; };
__device__ __forceinline__ void moe_offsets(Frame& F, CArgsP AP, int l, MoeOff& o) {
    const unsigned* cnt = (const unsigned*)(AP->ws + WS_CTL) + CW_CNT + (l >> 1) * 8 * 64;
    int acc = 0;
#pragma unroll
    for (int e = 0; e < 8; ++e) { const int c = (int)__builtin_amdgcn_readfirstlane(__hip_atomic_load(cnt + e * 64, RLX_AGENT)); o.cnt[e] = c; o.off[e] = acc; acc += (c + 255) & ~255; }
    o.off[8] = acc;
}
__device__ __forceinline__ void phase_moe_gather(Frame& F, CArgsP AP, int l) {
    const int gw = F.vcu * NWAVES + F.wave, NGW = F.G * NWAVES;
    MoeOff mo; moe_offsets(F, AP, l, mo);
    const unsigned char* XN = AP->ws + WS_XN; unsigned char* XS = AP->ws + WS_MB;
    int wbv[8];
    { const unsigned* wb = (const unsigned*)(AP->ws + WS_WBASE) + (size_t)gw * 8;
#pragma unroll
        for (int e = 0; e < 8; ++e) wbv[e] = (int)wb[e] + mo.off[e]; }
    v4u qn = (v4u){0u, 0u, 0u, 0u}, an = (v4u){0u, 0u, 0u, 0u};
    if (gw < M) { qn = *(const GAS v4u*)((const unsigned*)(AP->ws + WS_TOK) + (size_t)gw * 8); an = *(const GAS v4u*)(XN + (size_t)gw * D + 16 * F.lane); }
    for (int row = gw; row < M; row += NGW) {
        const v4u q = qn, a = an;
        if (row + NGW < M) { qn = *(const GAS v4u*)((const unsigned*)(AP->ws + WS_TOK) + (size_t)(row + NGW) * 8); an = *(const GAS v4u*)(XN + (size_t)(row + NGW) * D + 16 * F.lane); }
        if (l == DEPTH - 1 && (row % NTOK) < CTX) continue;
        const int e0 = (int)q.x, e1 = (int)q.y;
        int o0 = 0, o1 = 0;
#pragma unroll
        for (int e = 0; e < 8; ++e) { o0 = (e == e0) ? wbv[e] : o0; o1 = (e == e1) ? wbv[e] : o1; }
        const unsigned s0 = (unsigned)o0 + q.z, s1 = (unsigned)o1 + q.w;
        *(GAS v4u*)(XS + (size_t)s0 * D + 16 * F.lane) = a; *(GAS v4u*)(XS + (size_t)s1 * D + 16 * F.lane) = a;
        if (F.lane == 0) { unsigned* info = (unsigned*)(AP->ws + WS_TOK) + (size_t)row * 8; info[6] = s0; info[7] = s1; }
    }
    for (int p = gw; p < 8 * 256; p += NGW) {
        const int e = p >> 8, k = p & 255; int c = 0, o = 0;
#pragma unroll
        for (int q = 0; q < 8; ++q) { c = (q == e) ? mo.cnt[q] : c; o = (q == e) ? mo.off[q] : o; }
        if (c + k < ((c + 255) & ~255)) { unsigned zz = 0u; asm volatile("" : "+v"(zz)); const v4u z = {zz, zz, zz, zz};     *(GAS v4u*)(XS + (size_t)(o + c + k) * D + 16 * F.lane) = z; }
    }
}
__device__ __forceinline__ void phase_post(Frame& F, CArgsP AP, int l, bool commit) {
    const int gw = F.vcu * NWAVES + F.wave, NGW = F.G * NWAVES;
    bf16* P = (bf16*)(AP->ws + WS_P);
    const float* RT = (const float*)(AP->ws + WS_ROPE);
    const float C2 = 0.125f * LOG2E;
    const int l8 = F.lane & 7;
    float qg[8], kg[8];
#pragma unroll
    for (int i = 0; i < 8; ++i) { qg[i] = AP->in[I_QNA][l * 64 + 8 * l8 + i]; kg[i] = AP->in[I_KNA][l * 64 + 8 * l8 + i]; }
    v4u wnx[2];
#pragma unroll
    for (int s = 0; s < 2; ++s) wnx[s] = (v4u){0u, 0u, 0u, 0u};
#define POST_ADDR(row_, col_) (P + qkv_blk(col_) + (size_t)(F.lane >> 3) * QKV_BLK + (size_t)(row_) * 64 + 8 * (F.lane & 7))
#define POST_ADDR8(row_, col_) (AP->ws + WS_Q8 + q8_blk(col_) + (size_t)(F.lane >> 3) * QKV_BLK + (size_t)(row_) * 64 + 8 * (F.lane & 7))
    if (gw < M) {
#pragma unroll
        for (int s = 0; s < 2; ++s) { const int col = (s == 0) ? C_AQ : C_AK;
            if ((s != 1) || (F.lane < 16)) { if constexpr (AQK8) { const u32x2 t8 = *(const GAS u32x2*)POST_ADDR8(gw, col); wnx[s] = (v4u){t8.x, t8.y, 0u, 0u}; } else wnx[s] = *(const GAS v4u*)POST_ADDR(gw, col); } } }
    for (int row = gw; row < M; row += NGW) {
        const RowRef r = row_ref(row);
        float cs[4], sn[4];
#pragma unroll
        for (int j = 0; j < 4; ++j) { cs[j] = 1.f; sn[j] = 0.f; }
        if (!r.isctx) { const int t = r.n - CTX, pos = l8 < 4 ? (t >> 6) : (t & 63); const float* tp = RT + (size_t)(pos * 16 + (l8 & 3) * 4) * 2;
            const f32x4 c0 = *(const GAS f32x4*)tp, c1 = *(const GAS f32x4*)(tp + 4); cs[0] = c0.x; sn[0] = c0.y; cs[1] = c0.z; sn[1] = c0.w; cs[2] = c1.x; sn[2] = c1.y; cs[3] = c1.z; sn[3] = c1.w; }
        v4u wcur[2];
#pragma unroll
        for (int s = 0; s < 2; ++s) wcur[s] = wnx[s];
        if (row + NGW < M) {
#pragma unroll
            for (int s = 0; s < 2; ++s) { const int col = (s == 0) ? C_AQ : C_AK;
                if ((s != 1) || (F.lane < 16)) { if constexpr (AQK8) { const u32x2 t8 = *(const GAS u32x2*)POST_ADDR8(row + NGW, col); wnx[s] = (v4u){t8.x, t8.y, 0u, 0u}; } else wnx[s] = *(const GAS v4u*)POST_ADDR(row + NGW, col); } } }
#pragma unroll
        for (int s = 0; s < 2; ++s) {
            const int col = (s == 0) ? C_AQ : C_AK;
            const bool act = (s != 1) || (F.lane < 16);
            GAS v4u* p = (GAS v4u*)POST_ADDR(row, col);
            const v4u w = wcur[s];
            float x[8];
            if constexpr (AQK8) { const f32x2p a0 = __builtin_amdgcn_cvt_pk_f32_fp8((int)w.x, false), a1 = __builtin_amdgcn_cvt_pk_f32_fp8((int)w.x, true), a2 = __builtin_amdgcn_cvt_pk_f32_fp8((int)w.y, false), a3 = __builtin_amdgcn_cvt_pk_f32_fp8((int)w.y, true);
                x[0] = a0.x; x[1] = a0.y; x[2] = a1.x; x[3] = a1.y; x[4] = a2.x; x[5] = a2.y; x[6] = a3.x; x[7] = a3.y; }
            else { x[0] = bf_lo(w.x); x[1] = bf_hi(w.x); x[2] = bf_lo(w.y); x[3] = bf_hi(w.y); x[4] = bf_lo(w.z); x[5] = bf_hi(w.z); x[6] = bf_lo(w.w); x[7] = bf_hi(w.w); }
            if (s <= 1) {
                float ss = 0.f;
#pragma unroll
                for (int i = 0; i < 8; ++i) ss += x[i] * x[i];
                ss += __shfl_xor(ss, 1); ss += __shfl_xor(ss, 2); ss += __shfl_xor(ss, 4);
                const float rs = 1.0f / sqrtf(ss * (1.0f / 64.0f) + (AQK8 ? EPS * AQK_SCALE * AQK_SCALE : EPS));
#pragma unroll
                for (int i = 0; i < 8; ++i) x[i] = x[i] * rs * (s == 0 ? qg[i] : kg[i]);
            }
            if (s < 4) {
#pragma unroll
                for (int j = 0; j < 4; ++j) { const float y1 = x[2 * j] * cs[j] - x[2 * j + 1] * sn[j], y2 = x[2 * j] * sn[j] + x[2 * j + 1] * cs[j]; x[2 * j] = y1; x[2 * j + 1] = y2; }
            }
            if (s == 0 || s == 2 || s == 4) {
#pragma unroll
                for (int i = 0; i < 8; ++i) x[i] *= C2;
            }
            { v4u wq; wq.x = cvtpk(x[0], x[1]); wq.y = cvtpk(x[2], x[3]); wq.z = cvtpk(x[4], x[5]); wq.w = cvtpk(x[6], x[7]); if (act && !ATT8) *p = commit ? wq : w; }
            if (ATT8 && act) { const float f8s = (s == 0) ? 4.0f : 0.25f; u32x2 w8; w8.x = pk4_fp8(x[0] * f8s, x[1] * f8s, x[2] * f8s, x[3] * f8s); w8.y = pk4_fp8(x[4] * f8s, x[5] * f8s, x[6] * f8s, x[7] * f8s);
                *(GAS u32x2*)(AP->ws + WS_Q8 + q8_blk(col) + (size_t)(F.lane >> 3) * QKV_BLK + (size_t)row * 64 + 8 * (F.lane & 7)) = w8; }
        }
    }
}
__device__ __forceinline__ float layer_lam_init(int l) { return 0.8f - 0.6f * __expf(-0.3f * (float)l); }
__device__ __forceinline__ void phase_bcomb(Frame& F, CArgsP AP, int l, bool commit) {
    const int gw = F.vcu * NWAVES + F.wave, NGW = F.G * NWAVES;
    bf16* OB = (bf16*)(AP->ws + WS_O);
    const float li = layer_lam_init(l);
    const float s1 = wave_sum(AP->in[I_LQ1][l * 64 + F.lane] * AP->in[I_LK1][l * 64 + F.lane]), s2 = wave_sum(AP->in[I_LQ2][l * 64 + F.lane] * AP->in[I_LK2][l * 64 + F.lane]);
    const float lam = __expf(s1) - __expf(s2) + li;
    const float post = 1.0f - li;
    float sg[8];
#pragma unroll
    for (int q = 0; q < 8; ++q) sg[q] = AP->in[I_SUBLN][l * 128 + ((8 * F.lane) & 127) + q] * post;
    for (int row = gw; row < M; row += NGW) {
        bf16* pr = OB + (size_t)row * OPITCH;
        const v4u a = *(const GAS v4u*)(pr + O_B1 + 8 * F.lane), b = *(const GAS v4u*)(pr + O_B2 + 8 * F.lane);
        float d[8];
        d[0] = bf_lo(a.x) - lam * bf_lo(b.x); d[1] = bf_hi(a.x) - lam * bf_hi(b.x); d[2] = bf_lo(a.y) - lam * bf_lo(b.y); d[3] = bf_hi(a.y) - lam * bf_hi(b.y);
        d[4] = bf_lo(a.z) - lam * bf_lo(b.z); d[5] = bf_hi(a.z) - lam * bf_hi(b.z); d[6] = bf_lo(a.w) - lam * bf_lo(b.w); d[7] = bf_hi(a.w) - lam * bf_hi(b.w);
        float ss = 0.f;
#pragma unroll
        for (int q = 0; q < 8; ++q) ss += d[q] * d[q];
#pragma unroll
        for (int o = 1; o < 16; o <<= 1) ss += __shfl_xor(ss, o);
        const float rs = 1.0f / sqrtf(ss * (1.0f / 128.0f) + EPS);
        v4u o; o.x = cvtpk(d[0] * rs * sg[0], d[1] * rs * sg[1]); o.y = cvtpk(d[2] * rs * sg[2], d[3] * rs * sg[3]); o.z = cvtpk(d[4] * rs * sg[4], d[5] * rs * sg[5]); o.w = cvtpk(d[6] * rs * sg[6], d[7] * rs * sg[7]);
        *(GAS v4u*)(pr + O_B1 + 8 * F.lane) = commit ? o : a;
    }
}
__device__ __forceinline__ void phase_final(Frame& F, CArgsP AP, bool poison) {
    const int gw = F.vcu * NWAVES + F.wave, NGW = F.G * NWAVES;
    const float* g = AP->in[I_GFINAL];
    u32x2 rnx[4];
#pragma unroll
    for (int j = 0; j < 4; ++j) rnx[j] = (u32x2){0u, 0u};
#define FIN_ROW(lr_) (((lr_) / SEQ) * NTOK + CTX + ((lr_) % SEQ))
    if (gw < BATCH * SEQ) load_row_xb(row_xb(AP, FIN_ROW(gw)), F.lane, rnx);
    float cw0 = 0.f, cw1 = 0.f, nw0 = 0.f, nw1 = 0.f; unsigned ns0 = 0u, ns1 = 0u; u32x2 cy0[4], cy1[4];
#pragma unroll
    for (int j = 0; j < 4; ++j) { cy0[j] = (u32x2){0u, 0u}; cy1[j] = (u32x2){0u, 0u}; }
    if (gw < BATCH * SEQ) { unsigned s0_, s1_; comb_info(AP, FIN_ROW(gw), cw0, cw1, s0_, s1_); comb_rows(AP, s0_, s1_, F.lane, cy0, cy1); if (gw + NGW < BATCH * SEQ) comb_info(AP, FIN_ROW(gw + NGW), nw0, nw1, ns0, ns1); }
    for (int lr = gw; lr < BATCH * SEQ; lr += NGW) {
        const int b = lr / SEQ, t = lr - b * SEQ, row = b * NTOK + CTX + t;
        const RowRef r = row_ref(row); float* xr = AP->out + (size_t)lr * D;
        f32x4 v[4]; unpack_row(rnx, v);
        if (lr + NGW < BATCH * SEQ) load_row_xb(row_xb(AP, FIN_ROW(lr + NGW)), F.lane, rnx);
        { const float w0_ = cw0, w1_ = cw1; u32x2 a0[4], a1[4];
#pragma unroll
            for (int j = 0; j < 4; ++j) { a0[j] = cy0[j]; a1[j] = cy1[j]; }
            if (lr + NGW < BATCH * SEQ) { cw0 = nw0; cw1 = nw1; comb_rows(AP, ns0, ns1, F.lane, cy0, cy1); if (lr + 2 * NGW < BATCH * SEQ) comb_info(AP, FIN_ROW(lr + 2 * NGW), nw0, nw1, ns0, ns1); }
            comb_apply(AP, r, DEPTH - 1, F.lane, w0_, w1_, a0, a1, v); }
        const float rstd = row_rstd(v);
#pragma unroll
        for (int j = 0; j < 4; ++j) { const f32x4 gg = *(const GAS f32x4*)(g + 256 * j + 4 * F.lane); v[j] = (v[j] * rstd) * gg;
            if (poison) { const float q = __builtin_nanf(""); v[j] = (f32x4){q, q, q, q}; } }
        store_row(xr, F.lane, v);
    }
}

struct SchedPlain {
    pg8::TileOrder T; size_t astep, bstep; bool latent_only; int nt; bool tail_split; int colmap;
    __device__ __forceinline__ bool next(int i, pg8::Unit& u) const {
        const int nfull = T.nwg / T.G;
        if (!tail_split || i < nfull) { if (!T.tile(i, u.pm, u.pn)) return false; u.aux = 0; u.nt = nt; if (latent_only) u.pm += u.pm / 32 + 1; if (colmap == 1) u.pn = in8_tile(u.pn); else if (colmap == 2) u.pn = in16_tile(u.pn);
            u.aoff = (size_t)u.pm * astep; u.boff = (size_t)u.pn * bstep; return true; }
        if (i > nfull) return false;
        const int R = T.nwg - nfull * T.G; if (R == 0) return false;
        const int P = nt >> 1; int npz = T.G / R; npz = npz < P ? npz : P;
        if (T.c >= R * npz) return false;
        const int j = T.c / npz, p = T.c - j * npz;
        if (!T.tile_at((long)nfull * T.G + j, u.pm, u.pn)) return false;
        if (latent_only) u.pm += u.pm / 32 + 1;
        const int pair0 = p * P / npz, pair1 = (p + 1) * P / npz;
        u.aux = (T.c << 1) | 1; u.nt = 2 * (pair1 - pair0);
        const size_t koff = (size_t)pair0 * 2 * 128;
        u.aoff = (size_t)u.pm * astep + koff; u.boff = (size_t)u.pn * bstep + koff; return true; }
    __device__ __forceinline__ void a_ready(const pg8::Unit&) const {}
    __device__ __forceinline__ void done(const pg8::Unit&) const {}
};
struct SchedMerge {
    pg8::TileOrder T; bool latent_only;
    __device__ __forceinline__ bool next(int i, pg8::Unit& u) const {
        const int nfull = T.nwg / T.G;
        int br, p = 0; bool piece = false;
        if (i < 3 * nfull) { const int ti = i / 3; br = i - ti * 3; if (!T.tile(ti, u.pm, u.pn)) return false; }
        else { if (i > 3 * nfull) return false; const int R = T.nwg - nfull * T.G; if (T.c >= R * 12) return false;
            const int j = T.c / 12, q = T.c - j * 12; br = q >> 2; p = q & 3; piece = true; if (!T.tile_at((long)nfull * T.G + j, u.pm, u.pn)) return false; }
        u.aux = piece ? (4 | (T.c << 3)) : br; u.nt = piece ? 2 : 512 / 64; if (latent_only) u.pm += u.pm / 32 + 1;
        const int acol = br == 0 ? O_A : br == 1 ? O_B1 : O_C;
        u.aoff = ((size_t)u.pm * 256 * OPITCH + acol) * 2 + (size_t)p * 256; u.boff = ((size_t)br * D + u.pn * 256) * 512 * 2 + (size_t)p * 256; return true; }
    __device__ __forceinline__ void a_ready(const pg8::Unit&) const {}
    __device__ __forceinline__ void done(const pg8::Unit&) const {}
};
struct SchedMoe {
    pg8::TileOrder T; int pp1, pp2, pp3, pp4, pp5, pp6, pp7, nt; size_t astep, bexp, bstep;
    __device__ __forceinline__ void init(const MoeOff& o, int nN, int G, int c, size_t astep_, size_t bexp_, size_t bstep_, int nt_) {
        nt = nt_;
        T.init(o.off[8] >> 8, nN, G, c); pp1 = o.off[1] >> 8; pp2 = o.off[2] >> 8; pp3 = o.off[3] >> 8; pp4 = o.off[4] >> 8; pp5 = o.off[5] >> 8; pp6 = o.off[6] >> 8; pp7 = o.off[7] >> 8;
        astep = astep_; bexp = bexp_; bstep = bstep_; }
    __device__ __forceinline__ bool next(int i, pg8::Unit& u) const {
        if (!T.tile(i, u.pm, u.pn)) return false;
        const int e = (u.pm >= pp1) + (u.pm >= pp2) + (u.pm >= pp3) + (u.pm >= pp4) + (u.pm >= pp5) + (u.pm >= pp6) + (u.pm >= pp7);
        u.aux = e; u.nt = nt; u.aoff = (size_t)u.pm * astep; u.boff = (size_t)e * bexp + (size_t)u.pn * bstep; return true; }
    __device__ __forceinline__ void a_ready(const pg8::Unit&) const {}
    __device__ __forceinline__ void done(const pg8::Unit&) const {}
};
using pg8::f32x4;
#ifndef CFG_WIDE8
#define CFG_WIDE8 1
#endif
__device__ __forceinline__ void store8_wide(unsigned char* slot_m, size_t bytes_16rows, u32x2 a, u32x2 b, int fq) {
    const auto rx = __builtin_amdgcn_permlane16_swap(a.x, b.x, false, false); const auto ry = __builtin_amdgcn_permlane16_swap(a.y, b.y, false, false);
    unsigned char* p = (fq & 1) ? slot_m + bytes_16rows - 8 : slot_m;
    *(GAS v4u*)p = (v4u){rx[0], ry[0], rx[1], ry[1]};
}
struct EpiInProj {
    static constexpr bool PERM = true, AFTER_DRAIN = false, CHAIN = false;
    bf16* QKVC; bf16* G; const float* RT; unsigned char* Q8; float sc;
    __device__ __forceinline__ void operator()(const pg8::f32x4 (&acc)[2][2][4][2], const pg8::Unit& u, int wr, int wc, int fr, int fq) const {
        const int row0 = u.pm * 256 + wr * 64 + fr, c0 = u.pn * 256 + wc * 32 + 8 * fq;
        const bool qkv = u.pn < 15;
        const bool rope = (u.pn >= 3 && u.pn <= 6) && (u.pm % PANELS_PER_B != 0);
        const float qs = (u.pn == 3 || u.pn == 4 || u.pn == 9 || u.pn == 10) ? 0.125f * LOG2E : (u.pn >= 15 ? -LOG2E : 1.0f);
        const bool f8copy = ATT8 && ((u.pn >= 3 && u.pn <= 6) || (u.pn >= 9 && u.pn <= 12));
        const float f8s = (u.pn == 3 || u.pn == 4 || u.pn == 9 || u.pn == 10) ? 4.0f : 0.25f;
        const float scq = sc * qs * (f8copy ? f8s : 1.0f);
        const int tbase = (u.pm % PANELS_PER_B - 1) * 256 + wr * 64 + fr;
        bf16* const base0 = qkv ? QKVC + (size_t)(c0 >> 6) * QKV_BLK + (c0 & 63) : G + (c0 - C_G);
        bf16* const base1 = qkv ? QKVC + (size_t)((c0 + 128) >> 6) * QKV_BLK + ((c0 + 128) & 63) : G + (c0 + 128 - C_G);
        const size_t pitch = qkv ? 64 : 3072;
#pragma unroll
        for (int ai = 0; ai < 2; ++ai) { u32x2 pend[2] = {(u32x2){0u, 0u}, (u32x2){0u, 0u}};
#pragma unroll
            for (int m = 0; m < 4; ++m) {
                float cs[4] = {1.f, 1.f, 1.f, 1.f}, sn[4] = {0.f, 0.f, 0.f, 0.f};
                if (rope) { const int t = tbase + ai * 128 + m * 16, pos = (wc & 1) ? (t & 63) : (t >> 6);
                    const float* tp = RT + (size_t)(pos * 16 + 4 * fq) * 2; const pg8::f32x4 t0 = *(const GAS pg8::f32x4*)tp, t1 = *(const GAS pg8::f32x4*)(tp + 4);
                    cs[0] = t0[0]; sn[0] = t0[1]; cs[1] = t0[2]; sn[1] = t0[3]; cs[2] = t1[0]; sn[2] = t1[1]; cs[3] = t1[2]; sn[3] = t1[3]; }
#pragma unroll
                for (int bj = 0; bj < 2; ++bj) { pg8::f32x4 v0 = acc[ai][bj][m][0] * scq, v1 = acc[ai][bj][m][1] * scq;
                    if (rope) { const float a0 = v0[0] * cs[0] - v0[1] * sn[0], a1 = v0[0] * sn[0] + v0[1] * cs[0], a2 = v0[2] * cs[1] - v0[3] * sn[1], a3 = v0[2] * sn[1] + v0[3] * cs[1];
                        const float b0 = v1[0] * cs[2] - v1[1] * sn[2], b1 = v1[0] * sn[2] + v1[1] * cs[2], b2 = v1[2] * cs[3] - v1[3] * sn[3], b3 = v1[2] * sn[3] + v1[3] * cs[3];
                        v0 = (pg8::f32x4){a0, a1, a2, a3}; v1 = (pg8::f32x4){b0, b1, b2, b3}; }
                    const size_t ro = (size_t)(row0 + ai * 128 + m * 16);
                    const bool a8 = AQK8 && (u.pn < 2 || (u.pn == 2 && bj == 0));
                    if (f8copy || a8) { const int c = c0 + bj * 128; u32x2 w8; if (a8) { w8.x = pk4_fp8(v0[0] * AQK_SCALE, v0[1] * AQK_SCALE, v0[2] * AQK_SCALE, v0[3] * AQK_SCALE); w8.y = pk4_fp8(v1[0] * AQK_SCALE, v1[1] * AQK_SCALE, v1[2] * AQK_SCALE, v1[3] * AQK_SCALE); } else { w8.x = pk4_fp8(v0[0], v0[1], v0[2], v0[3]); w8.y = pk4_fp8(v1[0], v1[1], v1[2], v1[3]); }
                        if constexpr (CFG_WIDE8) { if (m & 1) store8_wide(Q8 + q8_blk(c) + (ro - 16) * 64 + (c & 63), (size_t)16 * 64, pend[bj], w8, fq); else pend[bj] = w8; }
                        else *(GAS u32x2*)(Q8 + q8_blk(c) + ro * 64 + (c & 63)) = w8;
                        continue; }
                    if (GATE8 && !qkv) { if constexpr (CFG_GATEE) { _Pragma("unroll") for (int q = 0; q < 4; ++q) { v0[q] = __builtin_amdgcn_exp2f(v0[q]); v1[q] = __builtin_amdgcn_exp2f(v1[q]); } }
                        else { _Pragma("unroll") for (int q = 0; q < 4; ++q) { v0[q] = fminf(v0[q], GATE_YMAX); v1[q] = fminf(v1[q], GATE_YMAX); } }
                        u32x2 w8; w8.x = pk4_fp8(v0[0], v0[1], v0[2], v0[3]); w8.y = pk4_fp8(v1[0], v1[1], v1[2], v1[3]);
                        if constexpr (CFG_WIDE8) { if (m & 1) store8_wide((unsigned char*)G + (ro - 16) * 3072 + (c0 + bj * 128 - C_G), (size_t)16 * 3072, pend[bj], w8, fq); else pend[bj] = w8; }
                        else *(GAS u32x2*)((unsigned char*)G + ro * 3072 + (c0 + bj * 128 - C_G)) = w8; }
                    else { if (!qkv) { _Pragma("unroll") for (int q = 0; q < 4; ++q) { v0[q] = fminf(v0[q], GATE_YMAX); v1[q] = fminf(v1[q], GATE_YMAX); } }
                        v4u w; w.x = cvtpk(v0[0], v0[1]); w.y = cvtpk(v0[2], v0[3]); w.z = cvtpk(v1[0], v1[1]); w.w = cvtpk(v1[2], v1[3]);
                        *(GAS v4u*)((bj ? base1 : base0) + ro * pitch) = w; } }
                if (m & 1) asm volatile("" ::: "memory"); } }
    }
};
struct EpiStore {
    static constexpr bool PERM = true, AFTER_DRAIN = false, CHAIN = false;
    bf16* O; int ldc; float sc;
    __device__ __forceinline__ void operator()(const pg8::f32x4 (&acc)[2][2][4][2], const pg8::Unit& u, int wr, int wc, int fr, int fq) const {
        const int row0 = u.pm * 256 + wr * 64 + fr, col0 = u.pn * 256 + wc * 32 + 8 * fq;
        u32x2 pend[2][2];
#pragma unroll
        for (int a_ = 0; a_ < 2; ++a_)
#pragma unroll
            for (int b_ = 0; b_ < 2; ++b_) pend[a_][b_] = (u32x2){0u, 0u};
#pragma unroll
        for (int ai = 0; ai < 2; ++ai)
#pragma unroll
            for (int m = 0; m < 4; ++m) { bf16* rowp = O + (size_t)(row0 + ai * 128 + m * 16) * ldc + col0;
#pragma unroll
                for (int bj = 0; bj < 2; ++bj) { const pg8::f32x4 v0 = acc[ai][bj][m][0] * sc, v1 = acc[ai][bj][m][1] * sc;
                    if constexpr (YS8) { u32x2 w8; w8.x = pk4_fp8(v0[0], v0[1], v0[2], v0[3]); w8.y = pk4_fp8(v1[0], v1[1], v1[2], v1[3]);
                        if constexpr (CFG_WIDE8) { if (m & 1) store8_wide((unsigned char*)O + (size_t)(row0 + ai * 128 + (m - 1) * 16) * ldc + col0 + bj * 128, (size_t)16 * ldc, pend[ai][bj], w8, fq); else pend[ai][bj] = w8; }
                        else *(GAS u32x2*)((unsigned char*)O + (size_t)(row0 + ai * 128 + m * 16) * ldc + col0 + bj * 128) = w8; }
                    else { v4u w; w.x = cvtpk(v0[0], v0[1]); w.y = cvtpk(v0[2], v0[3]); w.z = cvtpk(v1[0], v1[1]); w.w = cvtpk(v1[2], v1[3]);
                    *(GAS v4u*)(rowp + bj * 128) = w; } } }
    }
};
template <bool OUT8> struct EpiSwiglu {
    static constexpr bool PERM = true, AFTER_DRAIN = false, CHAIN = false;
    unsigned char* H; int ldh; float sc;
    __device__ __forceinline__ void operator()(const pg8::f32x4 (&acc)[2][2][4][2], const pg8::Unit& u, int wr, int wc, int fr, int fq) const {
        const int row0 = u.pm * 256 + wr * 64 + fr, hid0 = u.pn * 128 + wc * 32 + 8 * fq;
        const float nk = -sc * LOG2E, isc2 = 1.0f / (sc * sc);
        u32x2 pendw[2] = {(u32x2){0u, 0u}, (u32x2){0u, 0u}};
#pragma unroll
        for (int ai = 0; ai < 2; ++ai)
#pragma unroll
            for (int m = 0; m < 4; ++m) { unsigned char* rowp = H + ((size_t)(row0 + ai * 128 + m * 16) * ldh + hid0) * (OUT8 ? 1 : 2);
                float h[8];
#pragma unroll
                for (int n = 0; n < 2; ++n) {
                    const pg8::f32x4 G = acc[ai][0][m][n], U = acc[ai][1][m][n];
                    const pg8::f32x4 X = G * nk;
                    pg8::f32x4 T; T[0] = __builtin_amdgcn_exp2f(X[0]); T[1] = __builtin_amdgcn_exp2f(X[1]); T[2] = __builtin_amdgcn_exp2f(X[2]); T[3] = __builtin_amdgcn_exp2f(X[3]);
                    const pg8::f32x4 Dn = T * isc2 + isc2;
                    pg8::f32x4 R; R[0] = __builtin_amdgcn_rcpf(Dn[0]); R[1] = __builtin_amdgcn_rcpf(Dn[1]); R[2] = __builtin_amdgcn_rcpf(Dn[2]); R[3] = __builtin_amdgcn_rcpf(Dn[3]);
                    const pg8::f32x4 H = (G * U) * R;
                    h[4 * n + 0] = H[0]; h[4 * n + 1] = H[1]; h[4 * n + 2] = H[2]; h[4 * n + 3] = H[3]; }
                if constexpr (OUT8) { u32x2 w; w.x = pk4_fp8(h[0], h[1], h[2], h[3]); w.y = pk4_fp8(h[4], h[5], h[6], h[7]);
                    if constexpr (CFG_WIDE8) { if (m & 1) store8_wide(rowp - (size_t)16 * ldh, (size_t)16 * ldh, pendw[ai], w, fq); else pendw[ai] = w; }
                    else *(GAS u32x2*)rowp = w; }
                else { v4u w; w.x = cvtpk(h[0], h[1]); w.y = cvtpk(h[2], h[3]); w.z = cvtpk(h[4], h[5]); w.w = cvtpk(h[6], h[7]); *(GAS v4u*)rowp = w; } }
    }
};
struct EpiMerge {
    static constexpr bool PERM = true, AFTER_DRAIN = false, CHAIN = true;
    const bf16* P; float* Mf; bf16* Mb;
    static __device__ __forceinline__ float einv_(float y) { return (CFG_GATEE && GATE8) ? 1.0f + y : 1.0f + __builtin_amdgcn_exp2f(y); }
    __device__ __forceinline__ void operator()(const pg8::f32x4 (&)[2][2][4][2], const pg8::Unit&, int, int, int, int) const {}
    __device__ __forceinline__ bool chain(pg8::f32x4 (&acc)[2][2][4][2], const pg8::Unit& u, int wr, int wc, int fr, int fq) const {
        if (u.aux & 4) {
            float* pbase = Mf + ((size_t)(u.aux >> 3) * 256 + (wr * 64 + fr)) * 256 + (wc * 32 + 8 * fq);
#pragma unroll
            for (int ai = 0; ai < 2; ++ai)
#pragma unroll
                for (int m = 0; m < 4; ++m) { float* rowp = pbase + (size_t)(ai * 128 + m * 16) * 256;
#pragma unroll
                    for (int bj = 0; bj < 2; ++bj) { *(GAS pg8::f32x4*)(rowp + bj * 128) = acc[ai][bj][m][0]; *(GAS pg8::f32x4*)(rowp + bj * 128 + 4) = acc[ai][bj][m][1]; }
                    if (m & 1) asm volatile("" ::: "memory"); }
            return false;
        }
        const int br = u.aux, row0 = u.pm * 256 + wr * 64 + fr, col0 = u.pn * 256 + wc * 32 + 8 * fq;
        const bf16* gp = P + (size_t)row0 * 3072 + br * D + col0; bf16* mp0 = Mb + (size_t)row0 * D + col0;
        const bool last = (br == 2);
        v4u gq[2][4], hq[2][4];
#define MRG_LOAD(g_, b_) do { _Pragma("unroll") for (int mm_ = 0; mm_ < 2; ++mm_) _Pragma("unroll") for (int bj_ = 0; bj_ < 2; ++bj_) { \
            const size_t r_ = (size_t)(((g_) >> 1) * 128 + (2 * ((g_) & 1) + mm_) * 16); \
            if constexpr (GATE8) { const unsigned char* g8_ = (const unsigned char*)P + ((size_t)row0 + r_) * 3072 + br * D + col0 + bj_ * 128; \
                const u32x2 t0_ = *(const GAS u32x2*)g8_; gq[b_][mm_ * 2 + bj_] = (v4u){t0_.x, t0_.y, 0u, 0u}; \
                if (!last) { const u32x2 t1_ = *(const GAS u32x2*)(g8_ + D); hq[b_][mm_ * 2 + bj_] = (v4u){t1_.x, t1_.y, 0u, 0u}; } } \
            else { gq[b_][mm_ * 2 + bj_] = *(const GAS v4u*)(gp + r_ * 3072 + bj_ * 128); \
                if (!last) hq[b_][mm_ * 2 + bj_] = *(const GAS v4u*)(gp + r_ * 3072 + D + bj_ * 128); } } } while (0)
#pragma unroll
        for (int b_ = 0; b_ < 2; ++b_)
#pragma unroll
            for (int i_ = 0; i_ < 4; ++i_) hq[b_][i_] = (v4u){0u, 0u, 0u, 0u};
        MRG_LOAD(0, 0);
        asm volatile("" ::: "memory");
#pragma unroll
        for (int g = 0; g < 4; ++g) {
            if (g < 3) MRG_LOAD(g + 1, (g + 1) & 1);
            asm volatile("" ::: "memory");
#pragma unroll
            for (int mm = 0; mm < 2; ++mm)
#pragma unroll
                for (int bj = 0; bj < 2; ++bj) { const int ai = g >> 1, m = 2 * (g & 1) + mm;
                    const v4u gw = gq[g & 1][mm * 2 + bj], hw = hq[g & 1][mm * 2 + bj];
                    float gx[8], hx[8];
                    if constexpr (GATE8) { const f32x2p a0 = __builtin_amdgcn_cvt_pk_f32_fp8((int)gw.x, false), a1 = __builtin_amdgcn_cvt_pk_f32_fp8((int)gw.x, true), a2 = __builtin_amdgcn_cvt_pk_f32_fp8((int)gw.y, false), a3 = __builtin_amdgcn_cvt_pk_f32_fp8((int)gw.y, true);
                        const f32x2p b0 = __builtin_amdgcn_cvt_pk_f32_fp8((int)hw.x, false), b1 = __builtin_amdgcn_cvt_pk_f32_fp8((int)hw.x, true), b2 = __builtin_amdgcn_cvt_pk_f32_fp8((int)hw.y, false), b3 = __builtin_amdgcn_cvt_pk_f32_fp8((int)hw.y, true);
                        gx[0] = a0.x; gx[1] = a0.y; gx[2] = a1.x; gx[3] = a1.y; gx[4] = a2.x; gx[5] = a2.y; gx[6] = a3.x; gx[7] = a3.y;
                        hx[0] = b0.x; hx[1] = b0.y; hx[2] = b1.x; hx[3] = b1.y; hx[4] = b2.x; hx[5] = b2.y; hx[6] = b3.x; hx[7] = b3.y; }
                    else { gx[0] = bf_lo(gw.x); gx[1] = bf_hi(gw.x); gx[2] = bf_lo(gw.y); gx[3] = bf_hi(gw.y); gx[4] = bf_lo(gw.z); gx[5] = bf_hi(gw.z); gx[6] = bf_lo(gw.w); gx[7] = bf_hi(gw.w);
                        hx[0] = bf_lo(hw.x); hx[1] = bf_hi(hw.x); hx[2] = bf_lo(hw.y); hx[3] = bf_hi(hw.y); hx[4] = bf_lo(hw.z); hx[5] = bf_hi(hw.z); hx[6] = bf_lo(hw.w); hx[7] = bf_hi(hw.w); }
                    pg8::f32x4& v0 = acc[ai][bj][m][0]; pg8::f32x4& v1 = acc[ai][bj][m][1];
                    if constexpr (CFG_GATEE && GATE8) {
                        const pg8::f32x4 E0 = (pg8::f32x4){gx[0], gx[1], gx[2], gx[3]} + 1.0f, E1 = (pg8::f32x4){gx[4], gx[5], gx[6], gx[7]} + 1.0f;
                        pg8::f32x4 I0, I1; I0[0] = __builtin_amdgcn_rcpf(E0[0]); I0[1] = __builtin_amdgcn_rcpf(E0[1]); I0[2] = __builtin_amdgcn_rcpf(E0[2]); I0[3] = __builtin_amdgcn_rcpf(E0[3]);
                        I1[0] = __builtin_amdgcn_rcpf(E1[0]); I1[1] = __builtin_amdgcn_rcpf(E1[1]); I1[2] = __builtin_amdgcn_rcpf(E1[2]); I1[3] = __builtin_amdgcn_rcpf(E1[3]);
                        if (!last) { I0 = I0 * ((pg8::f32x4){hx[0], hx[1], hx[2], hx[3]} + 1.0f); I1 = I1 * ((pg8::f32x4){hx[4], hx[5], hx[6], hx[7]} + 1.0f); }
                        v0 = v0 * I0; v1 = v1 * I1; }
                    else { float f[8];
#pragma unroll
                    for (int q = 0; q < 8; ++q) { const float gi = __builtin_amdgcn_rcpf(einv_(gx[q])); f[q] = last ? gi : gi * einv_(hx[q]); }
                    v0[0] *= f[0]; v0[1] *= f[1]; v0[2] *= f[2]; v0[3] *= f[3]; v1[0] *= f[4]; v1[1] *= f[5]; v1[2] *= f[6]; v1[3] *= f[7]; }
                    if (last) { v4u w; w.x = cvtpk(v0[0], v0[1]); w.y = cvtpk(v0[2], v0[3]); w.z = cvtpk(v1[0], v1[1]); w.w = cvtpk(v1[2], v1[3]);
                        *(GAS v4u*)(mp0 + (size_t)(ai * 128 + m * 16) * D + bj * 128) = w; } }
            asm volatile("" ::: "memory");
        }
#undef MRG_LOAD
        return !last;
    }
};
struct EpiResid {
    static constexpr bool PERM = true, AFTER_DRAIN = false, CHAIN = false;
    bf16* XB; const float* gate; float* PARTp; float sc;
    __device__ __forceinline__ void operator()(const pg8::f32x4 (&acc)[2][2][4][2], const pg8::Unit& u, int wr, int wc, int fr, int fq) const {
        if (u.aux & 1) {
            float* pbase = PARTp + ((size_t)(u.aux >> 1) * 256 + (wr * 64 + fr)) * 256 + (wc * 32 + 8 * fq);
#pragma unroll
            for (int ai = 0; ai < 2; ++ai)
#pragma unroll
                for (int m = 0; m < 4; ++m) { float* rowp = pbase + (size_t)(ai * 128 + m * 16) * 256;
#pragma unroll
                    for (int bj = 0; bj < 2; ++bj) { *(GAS pg8::f32x4*)(rowp + bj * 128) = acc[ai][bj][m][0]; *(GAS pg8::f32x4*)(rowp + bj * 128 + 4) = acc[ai][bj][m][1]; }
                    if (m & 1) asm volatile("" ::: "memory"); }
            return;
        }
        const int b = u.pm / PANELS_PER_B, j = u.pm - b * PANELS_PER_B;
        const float* gv = gate + (size_t)((j == 0) ? 4 : b) * 6144;
        const int col0 = u.pn * 256 + wc * 32 + 8 * fq;
        pg8::f32x4 g4[2][2];
#pragma unroll
        for (int bj = 0; bj < 2; ++bj)
#pragma unroll
            for (int n = 0; n < 2; ++n) g4[bj][n] = *(const GAS pg8::f32x4*)(gv + col0 + bj * 128 + 4 * n) * sc;
        bf16* base = XB + (size_t)(u.pm * 256 + wr * 64 + fr) * D + col0;
        v4u wq[4][4];
#define RES_LOAD(g_) do { _Pragma("unroll") for (int mm_ = 0; mm_ < 2; ++mm_) _Pragma("unroll") for (int bj_ = 0; bj_ < 2; ++bj_) \
            wq[g_][mm_ * 2 + bj_] = *(const GAS v4u*)(base + (size_t)(((g_) >> 1) * 128 + (2 * ((g_) & 1) + mm_) * 16) * D + bj_ * 128); } while (0)
        RES_LOAD(0); RES_LOAD(1); RES_LOAD(2); RES_LOAD(3);
        asm volatile("" ::: "memory");
#pragma unroll
        for (int g = 0; g < 4; ++g) {
#pragma unroll
            for (int mm = 0; mm < 2; ++mm)
#pragma unroll
                for (int bj = 0; bj < 2; ++bj) { const int ai = g >> 1, m = 2 * (g & 1) + mm; const v4u w = wq[g][mm * 2 + bj];
                    const pg8::f32x4 d0 = g4[bj][0] * acc[ai][bj][m][0], d1 = g4[bj][1] * acc[ai][bj][m][1];
                    v4u o; o.x = cvtpk(bf_lo(w.x) + d0[0], bf_hi(w.x) + d0[1]); o.y = cvtpk(bf_lo(w.y) + d0[2], bf_hi(w.y) + d0[3]);
                    o.z = cvtpk(bf_lo(w.z) + d1[0], bf_hi(w.z) + d1[1]); o.w = cvtpk(bf_lo(w.w) + d1[2], bf_hi(w.w) + d1[3]);
                    *(GAS v4u*)(base + (size_t)(ai * 128 + m * 16) * D + bj * 128) = o; }
            asm volatile("" ::: "memory");
        }
#undef RES_LOAD
    }
};

__device__ __forceinline__ void phase_merge_fix(Frame& F, CArgsP AP, int l) {
    pg8::TileOrder T; T.init(M / 256, D / 256, F.G, 0);
    const int nfull = T.nwg / T.G, R = T.nwg - nfull * T.G;
    const float* PART = (const float*)(AP->ws + WS_PART); const bf16* P = (const bf16*)(AP->ws + WS_P + WS_G_OFF); bf16* Mb = (bf16*)(AP->ws + WS_XN);
    for (int id = F.vcu * (NWAVES * 64) + F.tid; id < R * 8192; id += F.G * NWAVES * 64) {
        const int j = id >> 13, rem = id & 8191, rit = rem >> 5, ch = rem & 31;
        int pm, pn; if (!T.tile_at((long)nfull * T.G + j, pm, pn)) continue;
        const size_t row = (size_t)pm * 256 + rit; const int col = pn * 256 + ch * 8;
        float m8[8];
#pragma unroll
        for (int q = 0; q < 8; ++q) m8[q] = 0.f;
#pragma unroll
        for (int br = 0; br < 3; ++br) {
            f32x4 s0 = {0.f, 0.f, 0.f, 0.f}, s1 = {0.f, 0.f, 0.f, 0.f};
#pragma unroll
            for (int p = 0; p < 4; ++p) { const float* pp = PART + ((size_t)(j * 12 + br * 4 + p) * 256 + rit) * 256 + ch * 8; s0 += *(const GAS f32x4*)pp; s1 += *(const GAS f32x4*)(pp + 4); }
            float gl[8]; load_gates8(P, row * 3072 + br * D + col, gl);
#define GY_(y_) __builtin_amdgcn_rcpf(1.0f + ((CFG_GATEE && GATE8) ? (y_) : __builtin_amdgcn_exp2f(y_)))
            m8[0] += GY_(gl[0]) * s0[0]; m8[1] += GY_(gl[1]) * s0[1]; m8[2] += GY_(gl[2]) * s0[2]; m8[3] += GY_(gl[3]) * s0[3];
            m8[4] += GY_(gl[4]) * s1[0]; m8[5] += GY_(gl[5]) * s1[1]; m8[6] += GY_(gl[6]) * s1[2]; m8[7] += GY_(gl[7]) * s1[3];
#undef GY_
        }
        v4u w; w.x = cvtpk(m8[0], m8[1]); w.y = cvtpk(m8[2], m8[3]); w.z = cvtpk(m8[4], m8[5]); w.w = cvtpk(m8[6], m8[7]);
        *(GAS v4u*)(Mb + row * D + col) = w;
    }
}
#ifndef CFG_PV8
#define CFG_PV8 3
#endif
#ifndef CFG_PAIR
#define CFG_PAIR 1
#endif
#if CFG_PAIR == 2
#define FS8FN attn_fs8q
#elif CFG_PAIR
#define FS8FN attn_fs8p
#else
#define FS8FN attn_fs8
#endif
#ifndef F8_BA
#define F8_BA 5
#endif
#ifndef F8_BB
#define F8_BB 7
#endif
#if !CFG_ATT8
#undef CFG_PV8
#define CFG_PV8 0
#endif
constexpr size_t WS_VT8 = WS_XN;
constexpr int NVB = 18;
static_assert((size_t)NVB * M * 64 <= (size_t)M * D * 2, "V^T tiles fit the XN region");
__device__ __forceinline__ const unsigned char* vt8_tiles(CArgsP AP, int vb, size_t r0) { return AP->ws + WS_VT8 + ((size_t)vb * (M / 64) + r0 / 64) * 4096; }
__device__ __forceinline__ void phase_vt8(Frame& F, CArgsP AP) {
    const int gw = F.vcu * NWAVES + F.wave, NGW = F.G * NWAVES;
    const bf16* P = (const bf16*)(AP->ws + WS_P); unsigned char* VT = AP->ws + WS_VT8;
    LAS unsigned* T = (LAS unsigned*)(F.lds + RING_OFF) + F.wave * (64 * 17);
    const LAS unsigned char* Tb = (const LAS unsigned char*)T;
    const int k = F.lane, kk = k & 31, pos = ((kk >> 2) & 1) * 32 + (kk & 3) + 4 * (kk >> 3) + 16 * (k >> 5);
    constexpr int VB0 = (CFG_PV8 & 2) ? 0 : ((CFG_PV8 & 1) ? 2 : 10), VB1 = (CFG_PV8 & 4) ? 18 : ((CFG_PV8 & 1) ? 10 : 2);
    v4u wn[8];
#pragma unroll
    for (int j = 0; j < 8; ++j) wn[j] = (v4u){0u, 0u, 0u, 0u};
    { const int it0 = gw + VB0 * (M / 64);
      if (it0 < VB1 * (M / 64)) { const int vb0 = it0 / (M / 64), tl0 = it0 - vb0 * (M / 64);
        const int col0 = vb0 < 2 ? C_AV + 64 * vb0 : (vb0 < 10 ? C_BV + 64 * (vb0 - 2) : C_CV + 64 * (vb0 - 10));
        const bf16* src0 = P + qkv_blk(col0) + ((size_t)tl0 * 64 + k) * 64;
#pragma unroll
        for (int j = 0; j < 8; ++j) wn[j] = *(const GAS v4u*)(src0 + 8 * j); } }
    for (int it = gw + VB0 * (M / 64); it < VB1 * (M / 64); it += NGW) {
        const int vb = it / (M / 64), tile = it - vb * (M / 64);
        const int col = vb < 2 ? C_AV + 64 * vb : (vb < 10 ? C_BV + 64 * (vb - 2) : C_CV + 64 * (vb - 10));
        v4u w[8];
#pragma unroll
        for (int j = 0; j < 8; ++j) w[j] = wn[j];
        if (it + NGW < VB1 * (M / 64)) { const int itn = it + NGW, vbn = itn / (M / 64), tln = itn - vbn * (M / 64);
            const int coln = vbn < 2 ? C_AV + 64 * vbn : (vbn < 10 ? C_BV + 64 * (vbn - 2) : C_CV + 64 * (vbn - 10));
            const bf16* srcn = P + qkv_blk(coln) + ((size_t)tln * 64 + k) * 64;
#pragma unroll
            for (int j = 0; j < 8; ++j) wn[j] = *(const GAS v4u*)(srcn + 8 * j); }
#pragma unroll
        for (int j = 0; j < 8; ++j) {
            T[pos * 17 + 2 * j] = pk4_fp8(8.f * bf_lo(w[j].x), 8.f * bf_hi(w[j].x), 8.f * bf_lo(w[j].y), 8.f * bf_hi(w[j].y));
            T[pos * 17 + 2 * j + 1] = pk4_fp8(8.f * bf_lo(w[j].z), 8.f * bf_hi(w[j].z), 8.f * bf_lo(w[j].w), 8.f * bf_hi(w[j].w)); }
        asm volatile("s_waitcnt lgkmcnt(0)" ::: "memory");
        unsigned char* dst = VT + ((size_t)vb * (M / 64) + tile) * 4096 + (size_t)k * 64;
#pragma unroll
        for (int g4 = 0; g4 < 4; ++g4) { unsigned o[4];
#pragma unroll
            for (int g = 0; g < 4; ++g) { const int p0 = 16 * g4 + 4 * g;
                o[g] = (unsigned)Tb[(p0 + 0) * 68 + k] | ((unsigned)Tb[(p0 + 1) * 68 + k] << 8) | ((unsigned)Tb[(p0 + 2) * 68 + k] << 16) | ((unsigned)Tb[(p0 + 3) * 68 + k] << 24); }
            *(GAS v4u*)(dst + 16 * g4) = (v4u){o[0], o[1], o[2], o[3]}; }
        asm volatile("s_waitcnt lgkmcnt(0)" ::: "memory");
    }
}
#ifndef CFG_BFUSE
#define CFG_BFUSE 1
#endif
__device__ __forceinline__ v4u ld16_sc1(const bf16* p) { v4u r; asm volatile("global_load_dwordx4 %0, %1, off sc1" : "=v"(r) : "v"(p) : "memory"); return r; }
__device__ __forceinline__ void bcomb_unit(Frame& F, CArgsP AP, int l, size_t row0, int head) {
    bf16* OB = (bf16*)(AP->ws + WS_O);
    const int lane = F.tid & 63, wave = __builtin_amdgcn_readfirstlane(F.tid >> 6), l16 = lane & 15, rsub = lane >> 4;
    const float li = layer_lam_init(l);
    const float s1 = wave_sum(AP->in[I_LQ1][l * 64 + lane] * AP->in[I_LK1][l * 64 + lane]), s2 = wave_sum(AP->in[I_LQ2][l * 64 + lane] * AP->in[I_LK2][l * 64 + lane]);
    const float lam = __expf(s1) - __expf(s2) + li;
    const float post = 1.0f - li;
    float sg[8];
#pragma unroll
    for (int q = 0; q < 8; ++q) sg[q] = AP->in[I_SUBLN][l * 128 + 8 * l16 + q] * post;
    asm volatile("s_waitcnt vmcnt(0)" ::: "memory");
    bf16* const pr0 = OB + (row0 + (size_t)(wave * 32 + rsub)) * OPITCH + head * 128 + 8 * l16;
    v4u av[8], bv[8];
#pragma unroll
    for (int i = 0; i < 8; ++i) { av[i] = ld16_sc1(pr0 + (size_t)(4 * i) * OPITCH + O_B1); bv[i] = ld16_sc1(pr0 + (size_t)(4 * i) * OPITCH + O_B2); }
    asm volatile("s_waitcnt vmcnt(0)" ::: "memory");
#pragma unroll
    for (int i = 0; i < 8; ++i) {
        v4u a = av[i], b = bv[i];
        asm volatile("" : "+v"(a), "+v"(b));
        float d[8];
        d[0] = bf_lo(a.x) - lam * bf_lo(b.x); d[1] = bf_hi(a.x) - lam * bf_hi(b.x); d[2] = bf_lo(a.y) - lam * bf_lo(b.y); d[3] = bf_hi(a.y) - lam * bf_hi(b.y);
        d[4] = bf_lo(a.z) - lam * bf_lo(b.z); d[5] = bf_hi(a.z) - lam * bf_hi(b.z); d[6] = bf_lo(a.w) - lam * bf_lo(b.w); d[7] = bf_hi(a.w) - lam * bf_hi(b.w);
        float ss = 0.f;
#pragma unroll
        for (int q = 0; q < 8; ++q) ss += d[q] * d[q];
#pragma unroll
        for (int o = 1; o < 16; o <<= 1) ss += __shfl_xor(ss, o);
        const float rs = 1.0f / sqrtf(ss * (1.0f / 128.0f) + EPS);
        v4u o; o.x = cvtpk(d[0] * rs * sg[0], d[1] * rs * sg[1]); o.y = cvtpk(d[2] * rs * sg[2], d[3] * rs * sg[3]); o.z = cvtpk(d[4] * rs * sg[4], d[5] * rs * sg[5]); o.w = cvtpk(d[6] * rs * sg[6], d[7] * rs * sg[7]);
        *(GAS v4u*)(pr0 + (size_t)(4 * i) * OPITCH + O_B1) = o;
    }
}
#ifndef CFG_FS2
#define CFG_FS2 0
#endif
#if CFG_PV8 & 1
#define FSU2(Q_, K_, V_, VT_, TR_, ...) attn_body::FS8FN<2, false, F8_BB>(VT_, TR_, __VA_ARGS__)
#else
#define FSU2(Q_, K_, V_, VT_, TR_, ...) attn_body::attn_fs<2, false, ATT8>(Q_, K_, V_, __VA_ARGS__)
#endif
#if CFG_PV8 & 2
#define FSU1(Q_, K_, V_, VT_, TR_, ...) attn_body::FS8FN<1, false, F8_BA>(VT_, TR_, __VA_ARGS__)
#else
#define FSU1(Q_, K_, V_, VT_, TR_, ...) attn_body::attn_fs<1, false, ATT8>(Q_, K_, V_, __VA_ARGS__)
#endif
#if CFG_PV8 & 4
#define FSUC(Q_, K_, V_, VT_, TR_, ...) attn_body::FS8FN<1, true, F8_BA>(VT_, TR_, __VA_ARGS__)
#else
#define FSUC(Q_, K_, V_, VT_, TR_, ...) attn_body::attn_fs<1, true, ATT8>(Q_, K_, V_, __VA_ARGS__)
#endif
__device__ __forceinline__ void attn_fast(Frame& F, CArgsP AP, int l, char* shm, LAS float* bt, int parts) {
    using abf = attn_body::bf16;
    const abf* P = (const abf*)(AP->ws + WS_P); abf* OB = (abf*)(AP->ws + WS_O);
    const int nunits = 3072 + ((l < DEPTH - 1) ? 96 : 0);
    if (parts & 1) for (int f = F.vcu + 4 * 256; f < nunits; f += F.G) {
        const int round = f >> 8, v = f & 255, x = v >> 5, c = v & 31;
        int b, head, map0, map1, qrow, NT;
        if (round >= 4 && round < 8) { const int i4 = round - 4; b = x >> 1; head = 2 * (x & 1) + (i4 >> 1); map0 = map1 = i4 & 1; qrow = CTX + 256 * c; NT = NTOK / 64; }
        else if (f >= 3072 + 32 && f < 3072 + 48) { const int w = f - 3072 - 32; b = w >> 2; head = w & 3; map0 = 0; map1 = 1; qrow = 0; NT = CTX / 64; }
        else continue;
        const size_t r0 = (size_t)b * NTOK;
        for (int map = map0; map <= map1; ++map) {
        const abf* Qp = P + qkv_blk(C_BQ + map * 256 + head * 64) + (r0 + qrow) * 64; const abf* Kp = P + qkv_blk(C_BK + map * 256 + head * 64) + r0 * 64; const abf* Vp = P + qkv_blk(C_BV + head * 128) + r0 * 64;
        abf* Op = OB + (r0 + qrow) * OPITCH + (map ? O_B2 : O_B1) + head * 128;
        const unsigned char* Q8 = AP->ws + WS_Q8;
        if (FSU2(Qp, Kp, Vp, vt8_tiles(AP, 2 + 2 * head, r0), (NT > 4 ? 4 : 0), Op, NT, 0, 0, (attn_body::lds_cfptr)bt, shm, Q8 + q8_blk(C_BQ + map * 256 + head * 64) + (r0 + qrow) * 64, Q8 + q8_blk(C_BK + map * 256 + head * 64) + r0 * 64)) {
            attn_body::attn_unit<8, false, ATT8>(Qp, Kp, Vp, Op, NT, 0, 0, (attn_body::lds_cfptr)bt, shm, Q8 + q8_blk(C_BQ + map * 256 + head * 64) + (r0 + qrow) * 64, Q8 + q8_blk(C_BK + map * 256 + head * 64) + r0 * 64);
            attn_body::attn_unit<8, false, ATT8>(Qp, Kp, Vp + QKV_BLK, Op + 64, NT, 0, 0, (attn_body::lds_cfptr)bt, shm, Q8 + q8_blk(C_BQ + map * 256 + head * 64) + (r0 + qrow) * 64, Q8 + q8_blk(C_BK + map * 256 + head * 64) + r0 * 64); }
        }
        if (CFG_BFUSE && map1 == 1) bcomb_unit(F, AP, l, r0 + qrow, head);
    }
    if (parts & 2) for (int f = F.vcu; f < nunits; f += F.G) {
        const int round = f >> 8, v = f & 255, x = v >> 5, c = v & 31;
        int b, qcol, kcol, vcol, ocol, qrow, NT;
        if (round < 4) { b = x >> 1; const int kvh = x & 1, qh = kvh * 4 + round; qcol = C_AQ + qh * 64; kcol = C_AK + kvh * 64; vcol = C_AV + kvh * 64; ocol = O_A + qh * 64; qrow = CTX + 256 * c; NT = NTOK / 64; }
        else if (f >= 3072 && f < 3072 + 32) { const int w = f - 3072; b = w >> 3; const int qh = w & 7, kvh = qh >> 2; qcol = C_AQ + qh * 64; kcol = C_AK + kvh * 64; vcol = C_AV + kvh * 64; ocol = O_A + qh * 64; qrow = 0; NT = CTX / 64; }
        else if (f >= 3072 + 64) { const int w = f - 3072 - 64; b = w >> 3; const int h = w & 7; qcol = C_CQ + h * 64; kcol = C_CK + h * 64; vcol = C_CV + h * 64; ocol = O_C + h * 64; qrow = 0; NT = CTX / 64; }
        else continue;
        const size_t r0 = (size_t)b * NTOK;
        const unsigned char* Q8 = AP->ws + WS_Q8;
        bool redo;
        if (((CFG_PV8 & 2) != 0) && (vcol < C_CV || (CFG_PV8 & 4) != 0))
            redo = attn_body::FS8FN<1, false, F8_BA>(vt8_tiles(AP, vcol >= C_CV ? 10 + ((vcol - C_CV) >> 6) : ((vcol - C_AV) >> 6), r0), (NT > 4 ? 4 : 0), OB + (r0 + qrow) * OPITCH + ocol, NT, 0, 0, (attn_body::lds_cfptr)bt, shm,
                                           Q8 + q8_blk(qcol) + (r0 + qrow) * 64, Q8 + q8_blk(kcol) + r0 * 64);
        else
            redo = attn_body::attn_fs<1, false, ATT8>(P + qkv_blk(qcol) + (r0 + qrow) * 64, P + qkv_blk(kcol) + r0 * 64, P + qkv_blk(vcol) + r0 * 64, OB + (r0 + qrow) * OPITCH + ocol, NT, 0, 0, (attn_body::lds_cfptr)bt, shm,
                                           Q8 + q8_blk(qcol) + (r0 + qrow) * 64, Q8 + q8_blk(kcol) + r0 * 64);
        if (redo)
            attn_body::attn_unit<8, false, ATT8>(P + qkv_blk(qcol) + (r0 + qrow) * 64, P + qkv_blk(kcol) + r0 * 64, P + qkv_blk(vcol) + r0 * 64, OB + (r0 + qrow) * OPITCH + ocol, NT, 0, 0, (attn_body::lds_cfptr)bt, shm,
                                           Q8 + q8_blk(qcol) + (r0 + qrow) * 64, Q8 + q8_blk(kcol) + r0 * 64);
    }
    if (parts & 4) for (int f = F.vcu + 8 * 256; f < 3072; f += F.G) {
        const int round = f >> 8, v = f & 255, x = v >> 5, c = v & 31;
        const int b = x >> 1, h = 4 * (x & 1) + (round - 8), g0 = 4 * c; int kr0 = g0 - 4; kr0 = kr0 < 0 ? 0 : (kr0 > 116 ? 116 : kr0);
        const size_t r0 = (size_t)b * NTOK; const int qrow = CTX + 256 * c;
        const unsigned char* Q8 = AP->ws + WS_Q8;
        if (FSUC(P + qkv_blk(C_CQ + h * 64) + (r0 + qrow) * 64, P + qkv_blk(C_CK + h * 64) + r0 * 64, P + qkv_blk(C_CV + h * 64) + r0 * 64, vt8_tiles(AP, 10 + h, r0), 4 + (g0 + 2 - kr0), OB + (r0 + qrow) * OPITCH + O_C + h * 64, 16, kr0, g0,
                                    (attn_body::lds_cfptr)(bt + h * 465), shm, Q8 + q8_blk(C_CQ + h * 64) + (r0 + qrow) * 64, Q8 + q8_blk(C_CK + h * 64) + r0 * 64))
            attn_body::attn_unit<8, true, ATT8>(P + qkv_blk(C_CQ + h * 64) + (r0 + qrow) * 64, P + qkv_blk(C_CK + h * 64) + r0 * 64, P + qkv_blk(C_CV + h * 64) + r0 * 64, OB + (r0 + qrow) * OPITCH + O_C + h * 64, 16, kr0, g0,
                                    (attn_body::lds_cfptr)(bt + h * 465), shm, Q8 + q8_blk(C_CQ + h * 64) + (r0 + qrow) * 64, Q8 + q8_blk(C_CK + h * 64) + r0 * 64);
    }
}
__device__ __forceinline__ void phase_attn(Frame& F, CArgsP AP, int l, unsigned char* lds_generic, int parts) {
    char* shm = (char*)lds_generic + RING_OFF;
    LAS float* bt = (LAS float*)(F.lds + BIAS_OFF);
    for (int i = F.tid; i < 8 * 465; i += NWAVES * 64) bt[i] = AP->in[I_RPB][(size_t)l * 8 * 465 + i] * LOG2E;
    __syncthreads();
    attn_fast(F, AP, l, shm, bt, parts);
}

#ifndef DUP_PHASE
#define DUP_PHASE (-1)
#endif
#ifndef DUP_PHASE_B
#define DUP_PHASE_B (-1)
#endif
#ifndef PROBE_NOEPI
#define PROBE_NOEPI 0
#endif
#ifndef DUP_ATT
#define DUP_ATT 7
#endif
#ifndef DUP_VT
#define DUP_VT 1
#endif
#ifndef DUP_CONV
#define DUP_CONV 1
#endif
#if defined(PROBE_A)
#define TS0() do { if (blockIdx.x == 0) { t_begin = __builtin_amdgcn_s_memrealtime(); } } while (0)
#define TS1(id) do { if (blockIdx.x == 0) { const unsigned long long d_ = __builtin_amdgcn_s_memrealtime() - t_begin; if ((id) == PROBE_A) t_a += d_; if ((id) == PROBE_B) t_b += d_; } } while (0)
#else
#define TS0() do {} while (0)
#define TS1(id) do {} while (0)
#endif
__global__ void __launch_bounds__(NWAVES * 64, 2) fwd_kernel(Args args) {
    extern __shared__ __attribute__((aligned(16))) unsigned char lds[];
    Frame F;
    F.lds = (LAS unsigned char*)lds;
#if CFG_SAT8
    __builtin_amdgcn_s_setreg(1 | (23 << 6) | (0 << 11), 1);
#endif
    REFRESH(F);
    F.G = gridDim.x; { const int bx = blockIdx.x; F.vcu = (F.G % 8 == 0) ? (bx % 8) * (F.G / 8) + bx / 8 : bx; }
    for (int u = F.tid; u < (LDS_BYTES - LDSCTL_OFF) / 4; u += NWAVES * 64) ((LAS unsigned*)(F.lds + LDSCTL_OFF))[u] = 0u;
    __syncthreads();
    {   CArgsP AP = fresh_args(); (void)xcd_barrier_post((unsigned*)(AP->ws + WS_CTL) + CW_BAR, (volatile LAS unsigned*)(F.lds + MISC_OFF) + 8); }
#ifndef DUP_BAR
#define DUP_BAR 1
#endif
#define GRID_BAR() for (int nb_ = 0; nb_ < DUP_BAR; ++nb_) do { CArgsP AP_ = fresh_args(); XcdBarrier b_; b_.bar = (unsigned*)(AP_->ws + WS_CTL) + CW_BAR; b_.x = xb_xcc_id(); b_.st = (volatile LAS unsigned*)(F.lds + MISC_OFF) + 8; xcd_barrier(b_); } while (0)
#define PH(...) do { REFRESH(F); CArgsP AP = fresh_args(); __VA_ARGS__; } while (0)
    const int G = F.G, cblk = (int)blockIdx.x;

#if defined(PROBE_A)
    unsigned long long t_begin = 0, t_a = 0, t_b = 0;
#endif
    TS0();
        for (int rep_ = 0; rep_ < ((0 == DUP_PHASE || 0 == DUP_PHASE_B || DUP_PHASE == 99) ? 2 : 1); ++rep_) {
    PH(prologue_mod(F, AP));
    PH(convert_weights(F, AP, 0));
    GRID_BAR();
        }
    TS1(0); TS0();

    for (int l = 0; l < DEPTH; ++l) {
        for (int rep_ = 0; rep_ < ((1 == DUP_PHASE || 1 == DUP_PHASE_B || DUP_PHASE == 99) ? 2 : 1); ++rep_) {
        if (l > 0) { for (int rc_ = 0; rc_ < DUP_CONV; ++rc_) { PH(convert_weights(F, AP, l)); } }
        PH(phase_norm1(F, AP, l, rep_ + 1 == ((1 == DUP_PHASE || 1 == DUP_PHASE_B || DUP_PHASE == 99) ? 2 : 1)));
        GRID_BAR();
        }
        TS1(1); TS0();
        for (int rep_ = 0; rep_ < ((2 == DUP_PHASE || 2 == DUP_PHASE_B || DUP_PHASE == 99) ? 2 : 1); ++rep_) {
        {   CArgsP AP = fresh_args();
            pg8::Gemm g{(const bf16*)(AP->ws + WS_XN), (const bf16*)(AP->ws + WS_WIN), D, D, D};
            if constexpr (IN8_TILES > 0) {
                pg8::Gemm g8{(const bf16*)(AP->ws + WS_MB), (const bf16*)(AP->ws + WS_WIN8), D, D, D};
                SchedPlain S; S.T.init(M / 256, IN8_TILES, G, cblk); S.astep = (size_t)256 * D; S.bstep = (size_t)256 * D; S.latent_only = false; S.nt = D / 128; S.tail_split = false; S.colmap = 1;
                EpiInProj E{(bf16*)(AP->ws + WS_P), (bf16*)(AP->ws + WS_P + WS_G_OFF), (const float*)(AP->ws + WS_ROPE), AP->ws + WS_Q8, WSCI};
                pg8::gemm_phase<EpiInProj, SchedPlain, true, true>(F.lds + RING_OFF, g8, S, E, !PROBE_NOEPI || rep_ + 1 == ((2 == DUP_PHASE || 2 == DUP_PHASE_B || DUP_PHASE == 99) ? 2 : 1)); }
            if constexpr (IN8_TILES < 27) {
                SchedPlain S; S.T.init(M / 256, DIN / 256 - IN8_TILES, G, cblk); S.astep = (size_t)256 * D * 2; S.bstep = (size_t)256 * D * 2; S.latent_only = false; S.nt = D / 64; S.tail_split = false; S.colmap = (IN8_TILES > 0) ? 2 : 0;
                EpiInProj E{(bf16*)(AP->ws + WS_P), (bf16*)(AP->ws + WS_P + WS_G_OFF), (const float*)(AP->ws + WS_ROPE), AP->ws + WS_Q8, 1.0f};
                pg8::gemm_phase<EpiInProj, SchedPlain, true, false>(F.lds + RING_OFF, g, S, E); } }
        GRID_BAR();
        }
        TS1(2); TS0();
        for (int rep_ = 0; rep_ < ((3 == DUP_PHASE || 3 == DUP_PHASE_B || DUP_PHASE == 99) ? 2 : 1); ++rep_) {
        PH(phase_post(F, AP, l, rep_ + 1 == ((3 == DUP_PHASE || 3 == DUP_PHASE_B || DUP_PHASE == 99) ? 2 : 1)));
        if (CFG_PV8) for (int rv_ = 0; rv_ < DUP_VT; ++rv_) PH(phase_vt8(F, AP));
        GRID_BAR();
        }
        TS1(3); TS0();
        for (int rep_ = 0; rep_ < ((4 == DUP_PHASE || 4 == DUP_PHASE_B || DUP_PHASE == 99) ? 2 : 1); ++rep_) {
        PH(phase_attn(F, AP, l, lds, rep_ ? DUP_ATT : 7));
        GRID_BAR();
        }
        TS1(4); TS0();
        for (int rep_ = 0; rep_ < ((5 == DUP_PHASE || 5 == DUP_PHASE_B || DUP_PHASE == 99) ? 2 : 1); ++rep_) {
        if (!CFG_BFUSE) { PH(phase_bcomb(F, AP, l, rep_ + 1 == ((5 == DUP_PHASE || 5 == DUP_PHASE_B || DUP_PHASE == 99) ? 2 : 1)));
        GRID_BAR(); }
        }
        TS1(5); TS0();
        for (int rep_ = 0; rep_ < ((6 == DUP_PHASE || 6 == DUP_PHASE_B || DUP_PHASE == 99) ? 2 : 1); ++rep_) {
        {   CArgsP AP = fresh_args();
            pg8::Gemm g{(const bf16*)(AP->ws + WS_O), (const bf16*)(AP->ws + WS_WBR), OPITCH, 512, 512};
            const bool lastl = (l == DEPTH - 1);
            SchedMerge S; S.T.init(lastl ? BATCH * SEQ / 256 : M / 256, D / 256, G, cblk); S.latent_only = lastl;
            EpiMerge E{(const bf16*)(AP->ws + WS_P + WS_G_OFF), (float*)(AP->ws + WS_PART), (bf16*)(AP->ws + WS_XN)};
            pg8::gemm_phase<EpiMerge, SchedMerge, true>(F.lds + RING_OFF, g, S, E, !PROBE_NOEPI || rep_ + 1 == ((6 == DUP_PHASE || 6 == DUP_PHASE_B || DUP_PHASE == 99) ? 2 : 1)); }
        GRID_BAR();
        if (l < DEPTH - 1) { PH(phase_merge_fix(F, AP, l)); GRID_BAR(); }
        }
        TS1(6); TS0();
        for (int rep_ = 0; rep_ < ((7 == DUP_PHASE || 7 == DUP_PHASE_B || DUP_PHASE == 99) ? 2 : 1); ++rep_) {
        {   CArgsP AP = fresh_args();
            pg8::Gemm g{(const bf16*)(AP->ws + WS_XN), (const bf16*)(AP->ws + WS_WOUT), D, D, D};
            const bool lastl = (l == DEPTH - 1);
            SchedPlain S; S.T.init(lastl ? BATCH * SEQ / 256 : M / 256, D / 256, G, cblk); S.astep = (size_t)256 * D * 2; S.bstep = (size_t)256 * D * 2; S.latent_only = lastl; S.nt = D / 64; S.colmap = 0; S.tail_split = TAIL_SPLIT;
            EpiResid E{(bf16*)(AP->ws + WS_XB), (const float*)(AP->ws + WS_MOD) + (size_t)(l * 5) * 6144 + 2 * 1024, (float*)(AP->ws + WS_PART), (rep_ + 1 == ((7 == DUP_PHASE || 7 == DUP_PHASE_B || DUP_PHASE == 99) ? 2 : 1)) ? 1.0f : 0.0f};
            pg8::gemm_phase<EpiResid, SchedPlain, true>(F.lds + RING_OFF, g, S, E); }
        GRID_BAR();
        }
        TS1(7); TS0();
        for (int rep_ = 0; rep_ < ((8 == DUP_PHASE || 8 == DUP_PHASE_B || DUP_PHASE == 99) ? 2 : 1); ++rep_) {
        PH(phase_norm2(F, AP, l, rep_ + 1 == ((8 == DUP_PHASE || 8 == DUP_PHASE_B || DUP_PHASE == 99) ? 2 : 1)));
        GRID_BAR();
        }
        TS1(8); TS0();
        if (!(l & 1)) {
        for (int rep_ = 0; rep_ < ((9 == DUP_PHASE || 9 == DUP_PHASE_B || DUP_PHASE == 99) ? 2 : 1); ++rep_) {
            {   CArgsP AP = fresh_args();
                constexpr int EB = DENSE8 ? 1 : 2;
                pg8::Gemm g{(const bf16*)(AP->ws + WS_XN), (const bf16*)(AP->ws + WS_W13), D, D, D};
                SchedPlain S; S.T.init(M / 256, 2 * FF / 256, G, cblk); S.astep = (size_t)256 * D * EB; S.bstep = (size_t)256 * D * EB; S.latent_only = false; S.nt = DENSE8 ? D / 128 : D / 64; S.tail_split = false; S.colmap = 0;
                EpiSwiglu<DENSE8> E{AP->ws + WS_P, FF, DENSE8 ? WSCI : 1.0f};
                pg8::gemm_phase<EpiSwiglu<DENSE8>, SchedPlain, true, DENSE8>(F.lds + RING_OFF, g, S, E); }
            GRID_BAR();
        }
            TS1(9); TS0();
        for (int rep_ = 0; rep_ < ((10 == DUP_PHASE || 10 == DUP_PHASE_B || DUP_PHASE == 99) ? 2 : 1); ++rep_) {
            {   CArgsP AP = fresh_args();
                pg8::Gemm g{(const bf16*)(AP->ws + WS_P), (const bf16*)(AP->ws + WS_W2), FF, FF, FF};
                constexpr int EB = DENSE8 ? 1 : 2;
                SchedPlain S; S.T.init(M / 256, D / 256, G, cblk); S.astep = (size_t)256 * FF * EB; S.bstep = (size_t)256 * FF * EB; S.latent_only = false; S.nt = DENSE8 ? FF / 128 : FF / 64; S.tail_split = TAIL_SPLIT; S.colmap = 0;
                EpiResid E{(bf16*)(AP->ws + WS_XB), (const float*)(AP->ws + WS_MOD) + (size_t)(l * 5) * 6144 + 5 * 1024, (float*)(AP->ws + WS_PART), (rep_ + 1 == ((10 == DUP_PHASE || 10 == DUP_PHASE_B || DUP_PHASE == 99) ? 2 : 1)) ? (DENSE8 ? WSCI : 1.0f) : 0.0f};
                pg8::gemm_phase<EpiResid, SchedPlain, true, DENSE8>(F.lds + RING_OFF, g, S, E); }
            GRID_BAR();
        }
            TS1(10); TS0();
        } else {
        for (int rep_ = 0; rep_ < ((11 == DUP_PHASE || 11 == DUP_PHASE_B || DUP_PHASE == 99) ? 2 : 1); ++rep_) {
            PH(phase_moe_gather(F, AP, l));
            GRID_BAR();
        }
            TS1(11); TS0();
        for (int rep_ = 0; rep_ < ((12 == DUP_PHASE || 12 == DUP_PHASE_B || DUP_PHASE == 99) ? 2 : 1); ++rep_) {
            {   CArgsP AP = fresh_args();
                MoeOff mo; moe_offsets(F, AP, l, mo);
                pg8::Gemm g{(const bf16*)(AP->ws + WS_MB), (const bf16*)(AP->ws + WS_W13), D, D, D};
                SchedMoe S; S.init(mo, 2 * FE / 256, G, cblk, (size_t)256 * D, (size_t)2 * FE * D, (size_t)256 * D, D / 128);
                EpiSwiglu<MOEDOWN8> E{AP->ws + WS_P, FE, WSCI};
                pg8::gemm_phase<EpiSwiglu<MOEDOWN8>, SchedMoe, true, true>(F.lds + RING_OFF, g, S, E, !PROBE_NOEPI || rep_ + 1 == ((12 == DUP_PHASE || 12 == DUP_PHASE_B || DUP_PHASE == 99) ? 2 : 1)); }
            GRID_BAR();
        }
            TS1(12); TS0();
        for (int rep_ = 0; rep_ < ((13 == DUP_PHASE || 13 == DUP_PHASE_B || DUP_PHASE == 99) ? 2 : 1); ++rep_) {
            {   CArgsP AP = fresh_args();
                MoeOff mo; moe_offsets(F, AP, l, mo);
                pg8::Gemm g{(const bf16*)(AP->ws + WS_P), (const bf16*)(AP->ws + WS_W2), FE, FE, FE};
                constexpr int EB = MOEDOWN8 ? 1 : 2;
                SchedMoe S; S.init(mo, D / 256, G, cblk, (size_t)256 * FE * EB, (size_t)D * FE * EB, (size_t)256 * FE * EB, MOEDOWN8 ? FE / 128 : FE / 64);
                EpiStore E{(bf16*)(AP->ws + WS_YS), D, (MOEDOWN8 ? WSCI : 1.0f) * (YS8 ? YS_SCALE : 1.0f)};
                pg8::gemm_phase<EpiStore, SchedMoe, true, MOEDOWN8>(F.lds + RING_OFF, g, S, E); }
            GRID_BAR();
        }
            TS1(13); TS0();
        }
    }
    {   REFRESH(F); CArgsP AP = fresh_args();
        const bool poison = __hip_atomic_load((unsigned*)(AP->ws + WS_CTL) + CW_BAR + XB_TMO, RLX_AGENT) != 0u;
#if PROBE_SAT
        { float big = 1.0e6f, nbig = -3.0e5f; asm volatile("" : "+v"(big), "+v"(nbig)); const int t_ = __builtin_amdgcn_cvt_pk_fp8_f32(big, nbig, 0, false);
          phase_final(F, AP, poison || ((t_ & 0xFFFF) != 0xFE7E)); }
#else
        phase_final(F, AP, poison);
#endif
        }
#if defined(PROBE_A)
    TS1(14);
    {   CArgsP AP = fresh_args(); unsigned* pw = (unsigned*)(AP->ws + WS_CTL) + 16;
        if (blockIdx.x == 0 && threadIdx.x == 0) { __hip_atomic_store(pw, (unsigned)(t_a / 100ull), RLX_AGENT); __hip_atomic_store(pw + 1, (unsigned)(t_b / 100ull), RLX_AGENT); }
        GRID_BAR();
        const float ua = (float)__hip_atomic_load(pw, RLX_AGENT), ub = (float)__hip_atomic_load(pw + 1, RLX_AGENT);
        const float c1 = sqrtf(ua);
        for (size_t i = (size_t)blockIdx.x * (NWAVES * 64) + threadIdx.x; i < (size_t)BATCH * SEQ * D; i += (size_t)gridDim.x * (NWAVES * 64)) AP->out[i] = (i == 0) ? ub : c1; }
#endif
}

extern "C" void kernel_launch(void* const* d_in, const int* in_sizes, int n_in, void* d_out, int out_size, void* d_ws, size_t ws_size, hipStream_t stream) {
    static int grid = 0;
    if (grid == 0) {
        if (n_in != N_IN || in_sizes[0] != BATCH * SEQ * D || out_size != BATCH * SEQ * D || ws_size < WS_END) {
            fprintf(stderr, "kernel_launch: unexpected shapes: n_in %d in0 %d out %d ws %zu (need %zu)\n", n_in, n_in > 0 ? in_sizes[0] : -1, out_size, ws_size, (size_t)WS_END); grid = -1; return; }
        int dev = 0, cus = 0;
        if (hipGetDevice(&dev) != hipSuccess || hipDeviceGetAttribute(&cus, hipDeviceAttributeMultiprocessorCount, dev) != hipSuccess) { fprintf(stderr, "kernel_launch: device query failed\n"); grid = -1; return; }
        if (hipFuncSetAttribute((const void*)fwd_kernel, hipFuncAttributeMaxDynamicSharedMemorySize, LDS_BYTES) != hipSuccess) { fprintf(stderr, "kernel_launch: hipFuncSetAttribute failed\n"); grid = -1; return; }
        int per_cu = 0;
        if (hipOccupancyMaxActiveBlocksPerMultiprocessor(&per_cu, (const void*)fwd_kernel, NWAVES * 64, LDS_BYTES) != hipSuccess || per_cu < 1)
            fprintf(stderr, "kernel_launch: note: occupancy query reports %d workgroups per CU\n", per_cu);
        (void)hipGetLastError();
        grid = cus;
    }
    if (grid < 0) return;
    if (hipMemsetAsync((char*)d_ws + WS_CTL, 0, CTL_ZERO_BYTES, stream) != hipSuccess) { fprintf(stderr, "kernel_launch: memset failed\n"); return; }
    Args a{};
    for (int i = 0; i < N_IN; ++i) a.in[i] = (const float*)d_in[i];
    a.out = (float*)d_out; a.ws = (unsigned char*)d_ws;
    hipLaunchKernelGGL(fwd_kernel, dim3(grid), dim3(NWAVES * 64), LDS_BYTES, stream, a);
    const hipError_t le = hipPeekAtLastError();
    if (le != hipSuccess) fprintf(stderr, "kernel_launch: launch failed: %s\n", hipGetErrorName(le));
}
```
